# Optimizing an MI355X kernel written in HIP

```python
import math
import jax, jax.numpy as jnp
from jax import lax
import numpy as np

D_MODEL = 1024
BATCH = 8
SEQ = 2048
DEPTH = 4

CHUNK = 64
N_META = 16
Q_BLOCK = 128
EPS = 1e-6
ROPE_THETA = 10000.0

RET_HEADS = 4
RET_QK_DIM = 128
RET_V_DIM = 128
RET_QK_W = RET_HEADS * RET_QK_DIM
RET_WIDTH = RET_HEADS * RET_V_DIM

MLA_HEADS = 4
MLA_NOPE = 128
MLA_ROPE = 64
MLA_V = 128
MLA_Q_RANK = 256
MLA_KV_RANK = 128
MLA_WIDTH = MLA_HEADS * MLA_V

MIX_WIDTH = RET_WIDTH + MLA_WIDTH
IN_SIZES = (RET_QK_W, RET_QK_W, RET_WIDTH, RET_WIDTH, MLA_Q_RANK, MLA_KV_RANK, MLA_ROPE)
D_IN = sum(IN_SIZES)
IN_SPLITS = tuple(int(s) for s in np.cumsum(IN_SIZES)[:-1])

D_FF = 3584
N_EXPERTS = 8
TOP_K = 2
N_DENSE = (DEPTH + 1) // 2
N_MOE = DEPTH // 2

kernel_name = "hybrid_retention_mla_moe_chunk_causal"


def rms_norm(x, g):
    xf = x.astype(jnp.float32)
    y = xf * lax.rsqrt(jnp.mean(xf * xf, axis=-1, keepdims=True) + EPS)
    return (y * g.astype(jnp.float32)).astype(x.dtype)


def head_rms(t):
    tf = t.astype(jnp.float32)
    return (tf * lax.rsqrt(jnp.mean(tf * tf, axis=-1, keepdims=True) + EPS)).astype(t.dtype)


def to_heads(t, h):
    b, l, _ = t.shape
    return t.reshape(b, l, h, -1).transpose(0, 2, 1, 3)


def from_heads(t):
    b, h, l, d = t.shape
    return t.transpose(0, 2, 1, 3).reshape(b, l, h * d)


def rope(t, pos):
    d = t.shape[-1]
    inv = ROPE_THETA ** (-jnp.arange(0, d, 2, dtype=jnp.float32) / d)
    ang = pos[:, None] * inv[None, :]
    cos, sin = jnp.cos(ang), jnp.sin(ang)
    tf = t.astype(jnp.float32)
    t1, t2 = tf[..., : d // 2], tf[..., d // 2:]
    out = jnp.concatenate([t1 * cos - t2 * sin, t1 * sin + t2 * cos], axis=-1)
    return out.astype(t.dtype)


def chunk_end(p):
    if p < N_META:
        return N_META
    return N_META + ((p - N_META) // CHUNK + 1) * CHUNK


def retention(q, k, v):
    b, h, l, dk = q.shape
    dv = v.shape[-1]
    dt = q.dtype
    pad = (-N_META) % CHUNK
    padw = ((0, 0), (0, 0), (pad, 0), (0, 0))
    q, k, v = jnp.pad(q, padw), jnp.pad(k, padw), jnp.pad(v, padw)
    lp = l + pad
    nc = lp // CHUNK
    qc = q.reshape(b, h, nc, CHUNK, dk)
    kc = k.reshape(b, h, nc, CHUNK, dk)
    vc = v.reshape(b, h, nc, CHUNK, dv)

    log_gamma = jnp.log1p(-jnp.exp2(-5.0 - jnp.arange(h, dtype=jnp.float32)))
    idx = jnp.arange(CHUNK, dtype=jnp.float32)
    dist = jnp.abs(idx[:, None] - idx[None, :])
    decay_in = jnp.exp(log_gamma[:, None, None] * dist).astype(dt)
    xi = jnp.exp(log_gamma[:, None] * (idx + 1.0)).astype(dt)
    zeta = jnp.exp(log_gamma[:, None] * (CHUNK - 1.0 - idx)).astype(dt)
    g_chunk = jnp.exp(log_gamma * CHUNK).astype(dt)

    scores = jnp.einsum('bhncd,bhnsd->bhncs', qc, kc) * decay_in[None, :, None]
    y_intra = jnp.einsum('bhncs,bhnse->bhnce', scores, vc)

    kv_chunk = jnp.einsum('bhnsd,bhnse->bhnde', kc * zeta[None, :, None, :, None], vc)

    def step(state, kv):
        return g_chunk[None, :, None, None] * state + kv, state

    s0 = jnp.zeros((b, h, dk, dv), dt)
    _, s_prev = lax.scan(step, s0, jnp.moveaxis(kv_chunk, 2, 0))
    y_inter = jnp.einsum('bhncd,nbhde->bhnce', qc, s_prev) * xi[None, :, None, :, None]
    y = (y_intra + y_inter).reshape(b, h, lp, dv)
    return y[:, :, pad:]


def latent_attention(c_q, c_kv, k_rope, q_norm, w_uq, kv_norm, w_ukv, pos, chunk_ids):
    l = c_q.shape[1]
    q = to_heads(rms_norm(c_q, q_norm) @ w_uq, MLA_HEADS)
    q_nope, q_pe = q[..., :MLA_NOPE], rope(q[..., MLA_NOPE:], pos)
    kv = to_heads(rms_norm(c_kv, kv_norm) @ w_ukv, MLA_HEADS)
    k_nope, v = kv[..., :MLA_NOPE], kv[..., MLA_NOPE:]
    k_pe = rope(k_rope, pos)
    scale = (MLA_NOPE + MLA_ROPE) ** -0.5
    outs = []
    for q0 in range(0, l, Q_BLOCK):
        q1 = min(q0 + Q_BLOCK, l)
        kend = min(chunk_end(q1 - 1), l)
        s = (jnp.einsum('bhqd,bhkd->bhqk', q_nope[:, :, q0:q1], k_nope[:, :, :kend])
             + jnp.einsum('bhqd,bkd->bhqk', q_pe[:, :, q0:q1], k_pe[:, :kend])) * scale
        mask = chunk_ids[q0:q1, None] >= chunk_ids[None, :kend]
        s = jnp.where(mask, s.astype(jnp.float32), -jnp.inf)
        p = jax.nn.softmax(s, axis=-1).astype(v.dtype)
        outs.append(jnp.einsum('bhqk,bhkd->bhqd', p, v[:, :, :kend]))
    return jnp.concatenate(outs, axis=2)


def swiglu(h, w_gate, w_up, w_down):
    return (jax.nn.silu(h @ w_gate) * (h @ w_up)) @ w_down


def moe_swiglu(h, router_w, w_gate, w_up, w_down):
    logits = (h @ router_w).astype(jnp.float32)
    top_val, top_idx = lax.top_k(logits, TOP_K)
    gates = jax.nn.softmax(top_val, axis=-1)
    gate_dense = jnp.sum(jax.nn.one_hot(top_idx, N_EXPERTS, dtype=jnp.float32) * gates[..., None], axis=-2)
    gate_dense = gate_dense.astype(h.dtype)
    out = jnp.zeros_like(h)
    for e in range(N_EXPERTS):
        out = out + gate_dense[..., e:e + 1] * swiglu(h, w_gate[e], w_up[e], w_down[e])
    return out


def setup_inputs(seed: int = 0) -> dict:
    key = jax.random.key(seed)
    ks = jax.random.split(key, 24)
    f32 = jnp.float32

    def nrm(k, shape, fan_in):
        return jax.random.normal(k, shape, f32) * (fan_in ** -0.5)

    def gain(k, shape):
        return 1.0 + 0.02 * jax.random.normal(k, shape, f32)

    return {
        "x": jax.random.normal(ks[0], (BATCH, SEQ, D_MODEL), f32),
        "meta_tokens": jax.random.normal(ks[1], (N_META, D_MODEL), f32),
        "attn_norm": gain(ks[2], (DEPTH, D_MODEL)),
        "w_in": nrm(ks[3], (DEPTH, D_MODEL, D_IN), D_MODEL),
        "q_norm": gain(ks[4], (DEPTH, MLA_Q_RANK)),
        "w_uq": nrm(ks[5], (DEPTH, MLA_Q_RANK, MLA_HEADS * (MLA_NOPE + MLA_ROPE)), MLA_Q_RANK),
        "kv_norm": gain(ks[6], (DEPTH, MLA_KV_RANK)),
        "w_ukv": nrm(ks[7], (DEPTH, MLA_KV_RANK, MLA_HEADS * (MLA_NOPE + MLA_V)), MLA_KV_RANK),
        "ret_out_gain": gain(ks[8], (DEPTH, RET_WIDTH)),
        "mla_out_gain": gain(ks[9], (DEPTH, MLA_WIDTH)),
        "w_out": nrm(ks[10], (DEPTH, MIX_WIDTH, D_MODEL), MIX_WIDTH),
        "ffn_norm": gain(ks[11], (DEPTH, D_MODEL)),
        "dense_w_gate": nrm(ks[12], (N_DENSE, D_MODEL, D_FF), D_MODEL),
        "dense_w_up": nrm(ks[13], (N_DENSE, D_MODEL, D_FF), D_MODEL),
        "dense_w_down": nrm(ks[14], (N_DENSE, D_FF, D_MODEL), D_FF),
        "router_w": nrm(ks[15], (N_MOE, D_MODEL, N_EXPERTS), D_MODEL),
        "moe_w_gate": nrm(ks[16], (N_MOE, N_EXPERTS, D_MODEL, D_FF), D_MODEL),
        "moe_w_up": nrm(ks[17], (N_MOE, N_EXPERTS, D_MODEL, D_FF), D_MODEL),
        "moe_w_down": nrm(ks[18], (N_MOE, N_EXPERTS, D_FF, D_MODEL), D_FF),
        "final_norm": gain(ks[19], (D_MODEL,)),
    }


def reference(x, meta_tokens, attn_norm, w_in, q_norm, w_uq, kv_norm, w_ukv,
              ret_out_gain, mla_out_gain, w_out, ffn_norm, dense_w_gate, dense_w_up,
              dense_w_down, router_w, moe_w_gate, moe_w_up, moe_w_down, final_norm):
    b = x.shape[0]
    meta = jnp.broadcast_to(meta_tokens.astype(x.dtype)[None], (b, N_META, x.shape[-1]))
    h_res = jnp.concatenate([meta, x], axis=1)
    l = h_res.shape[1]
    p_int = jnp.arange(l, dtype=jnp.int32)
    pos = p_int.astype(jnp.float32)
    chunk_ids = jnp.where(p_int < N_META, 0, 1 + (p_int - N_META) // CHUNK)

    for layer in range(DEPTH):
        hn = rms_norm(h_res, attn_norm[layer])
        proj = hn @ w_in[layer]
        r_q, r_k, r_v, r_g, c_q, c_kv, k_rope = jnp.split(proj, IN_SPLITS, axis=-1)

        rq = rope(to_heads(r_q, RET_HEADS), pos) * (RET_QK_DIM ** -0.5)
        rk = rope(to_heads(r_k, RET_HEADS), pos)
        rv = to_heads(r_v, RET_HEADS)
        y_ret = from_heads(head_rms(retention(rq, rk, rv)))
        y_ret = y_ret * ret_out_gain[layer] * jax.nn.silu(r_g)

        y_mla = latent_attention(c_q, c_kv, k_rope, q_norm[layer], w_uq[layer],
                                 kv_norm[layer], w_ukv[layer], pos, chunk_ids)
        y_mla = from_heads(head_rms(y_mla)) * mla_out_gain[layer]

        mixed = jnp.concatenate([y_ret, y_mla], axis=-1) @ w_out[layer]
        h_res = h_res + mixed

        hn = rms_norm(h_res, ffn_norm[layer])
        li = layer // 2
        if layer % 2 == 0:
            ff = swiglu(hn, dense_w_gate[li], dense_w_up[li], dense_w_down[li])
        else:
            ff = moe_swiglu(hn, router_w[li], moe_w_gate[li], moe_w_up[li], moe_w_down[li])
        h_res = h_res + ff

    out = rms_norm(h_res, final_norm)
    return out[:, N_META:]
```

```cpp
#include <hip/hip_runtime.h>
#include <cstdio>
#include <cstdint>
namespace pg8 {
#define PG8_LAS __attribute__((address_space(3)))
typedef unsigned short bf16_t;
typedef short bf16x8 __attribute__((ext_vector_type(8)));
typedef float f32x4 __attribute__((ext_vector_type(4)));
typedef unsigned u32x4 __attribute__((ext_vector_type(4)));
constexpr int BM = 256, BK = 64, HALF = 128, HTB = HALF * BK * 2  , STAGE_BYTES = 8 * HTB, NXCD = 8, WGM = 8;

__host__ __device__ __forceinline__ int lds_byte(int r, int c) { const int st = (r >> 4) * 2 + (c >> 5), rr = r & 15, cc = c & 31, ob = rr * 64 + cc * 2; return st * 1024 + (ob ^ (((ob >> 9) & 1) << 5)); }
__host__ __device__ __forceinline__ void stage_rc(int b, int& R, int& C) { const int st = b / 1024, sb = b % 1024, swz = sb ^ (((sb >> 9) & 1) << 5); R = (st >> 1) * 16 + swz / 64; C = (st & 1) * 32 + (swz % 64) / 2; }
__host__ __device__ __forceinline__ int perm32(int rho) { const int n = rho >> 4, i = rho & 15; return 8 * (i >> 2) + 4 * n + (i & 3); }

struct Unit { int pm, pn, eb; };
struct Gemm { const bf16_t* A; const bf16_t* Bt; int M, N, K; size_t estride; };

struct StaticOrder {
    int nM, nN, nwg, G, c;
    __host__ __device__ void init(int M, int N, int G_, int c_) { nM = M / BM; nN = N / BM; nwg = nM * nN; G = G_; c = c_; }
    __host__ __device__ bool next(int i, Unit& u) const {
        const long L = (long)i * G + c; if (L >= nwg) return false;
        int wgid = (int)L; { const int q = nwg / NXCD, r = nwg % NXCD, xcd = wgid % NXCD, off = wgid / NXCD; wgid = (xcd < r ? xcd * (q + 1) : r * (q + 1) + (xcd - r) * q) + off; }
        const int nig = WGM * nN, gid = wgid / nig, fm = gid * WGM, gsz = (nM - fm) < WGM ? (nM - fm) : WGM;
        u.pm = fm + ((wgid % nig) % gsz); u.pn = (wgid % nig) / gsz; u.eb = 0; return true;
    }
    __device__ __forceinline__ void a_ready(const Unit&) const {}
    __device__ __forceinline__ void done(const Unit&) const {}
};
struct GroupedOrder {
    int nM, nN, nwg, G, c; int tp[9];
    __device__ __forceinline__ void init(const unsigned* cnt, int N, int G_, int c_) {
        tp[0] = 0;
#pragma unroll
        for (int e = 0; e < 8; ++e) tp[e + 1] = tp[e] + __builtin_amdgcn_readfirstlane((int)((cnt[e] + 255u) >> 8));
        nM = tp[8]; nN = N / BM; nwg = nM * nN; G = G_; c = c_; }
    __device__ __forceinline__ bool next(int i, Unit& u) const {
        const long L = (long)i * G + c; if (L >= nwg) return false;
        int wgid = (int)L; { const int q = nwg / NXCD, r = nwg % NXCD, xcd = wgid % NXCD, off = wgid / NXCD; wgid = (xcd < r ? xcd * (q + 1) : r * (q + 1) + (xcd - r) * q) + off; }
        const int nig = WGM * nN, gid = wgid / nig, fm = gid * WGM, gsz = (nM - fm) < WGM ? (nM - fm) : WGM;
        u.pm = fm + ((wgid % nig) % gsz); u.pn = (wgid % nig) / gsz;
        int e = 0;
#pragma unroll
        for (int k = 1; k < 8; ++k) e += (u.pm >= tp[k]) ? 1 : 0;
        u.eb = e; return true;
    }
    __device__ __forceinline__ void a_ready(const Unit&) const {}
    __device__ __forceinline__ void done(const Unit&) const {}
};
__device__ __forceinline__ unsigned cvt_pk_bf16(float lo, float hi) { unsigned r; asm volatile("v_cvt_pk_bf16_f32 %0, %1, %2" : "=v"(r) : "v"(lo), "v"(hi)); return r; }
template <class Epi, class Sched, bool ALIGN_EPI = false, bool SP2 = false>
__device__ __forceinline__ void gemm_phase(PG8_LAS unsigned char* lds, const Gemm g, const Sched& S, const Epi& E) {
    int tid_ = threadIdx.x; asm volatile("" : "+v"(tid_));
    const int tid = tid_, wid = __builtin_amdgcn_readfirstlane(tid >> 6), lane = tid & 63, wr = wid >> 2, wc = wid & 3, fr = lane & 15, fq = lane >> 4;
    const int K = g.K, nt = K / BK;
    unsigned voffA[2], voffB[2];
#pragma unroll
    for (int i = 0; i < 2; ++i) { int R, C; stage_rc(tid * 16 + i * 8192, R, C); const int Rb = Epi::PERM ? ((R & ~31) + perm32(R & 31)) : R;
        voffA[i] = (unsigned)(R * K + C) * 2u; voffB[i] = (unsigned)(Rb * K + C) * 2u; }
    const size_t kstep = (size_t)(BK * 2);
    const size_t hstep = (size_t)HALF * K * 2;
    const size_t tstep = 2 * hstep;
    const unsigned ldsw = (unsigned)wid * 1024u;
    const int aoff = lds_byte(wr * 64 + fr, fq * 8), boff = lds_byte(wc * 32 + fr, fq * 8);
#define PG8_SA(b, h) (((b) * 2 + (h)) * HTB)
#define PG8_SB(b, h) ((4 + (b) * 2 + (h)) * HTB)
#define PG8_STAGE(bufoff, gbase, voff) do { _Pragma("unroll") for (int _i = 0; _i < 2; ++_i) \
        __builtin_amdgcn_global_load_lds((const unsigned*)((const char*)(gbase) + (voff)[_i]), (PG8_LAS unsigned*)(lds + (bufoff) + ldsw + _i * 8192), 16, 0, 0); } while (0)
#define PG8_LDA(dst, b, h) do { _Pragma("unroll") for (int m = 0; m < 4; ++m) _Pragma("unroll") for (int k = 0; k < 2; ++k) dst[m][k] = *(const PG8_LAS bf16x8*)(lds + PG8_SA(b, h) + aoff + m * 2048 + k * 1024); } while (0)
#define PG8_LDB(dst, b, h) do { _Pragma("unroll") for (int n = 0; n < 2; ++n) _Pragma("unroll") for (int k = 0; k < 2; ++k) dst[n][k] = *(const PG8_LAS bf16x8*)(lds + PG8_SB(b, h) + boff + n * 2048 + k * 1024); } while (0)
#define PG8_MMA(ai, bj, At, Bt) do { __builtin_amdgcn_s_setprio(1); _Pragma("unroll") for (int m = 0; m < 4; ++m) _Pragma("unroll") for (int n = 0; n < 2; ++n) _Pragma("unroll") for (int k = 0; k < 2; ++k) \
        acc[ai][bj][m][n] = __builtin_amdgcn_mfma_f32_16x16x32_bf16(Bt[n][k], At[m][k], acc[ai][bj][m][n], 0, 0, 0); __builtin_amdgcn_s_setprio(0); } while (0)
#define PG8_WAIT_V(n) asm volatile("s_waitcnt vmcnt(" #n ")" ::: "memory")
#define PG8_WAIT_L(n) asm volatile("s_waitcnt lgkmcnt(" #n ")" ::: "memory")
#define PG8_BAR __builtin_amdgcn_s_barrier()
#define PG8_SCHED __builtin_amdgcn_sched_barrier(0)
    Unit cur, nxt; int ui = 0;
    if (!S.next(0, cur)) return;
    f32x4 acc[2][2][4][2];
#pragma unroll
    for (int a = 0; a < 2; ++a)
#pragma unroll
        for (int b = 0; b < 2; ++b)
#pragma unroll
            for (int m = 0; m < 4; ++m)
#pragma unroll
                for (int n = 0; n < 2; ++n) acc[a][b][m][n] = (f32x4){0.f, 0.f, 0.f, 0.f};
    bf16x8 At[4][2], B0[2][2], B1[2][2];
    const char* cA = (const char*)g.A + (size_t)cur.pm * tstep; const char* cB = (const char*)g.Bt + (size_t)cur.eb * g.estride + (size_t)cur.pn * tstep;
    S.a_ready(cur);
    if constexpr (SP2) {
        PG8_STAGE(PG8_SB(0, 0), cB, voffB); PG8_STAGE(PG8_SB(0, 1), cB + hstep, voffB); PG8_STAGE(PG8_SA(0, 0), cA, voffA); PG8_STAGE(PG8_SA(0, 1), cA + hstep, voffA);
        if (wr == 1) PG8_BAR;
        PG8_WAIT_V(2); PG8_BAR;
        PG8_STAGE(PG8_SB(1, 0), cB + kstep, voffB); PG8_STAGE(PG8_SA(1, 0), cA + kstep, voffA); PG8_STAGE(PG8_SB(1, 1), cB + hstep + kstep, voffB);
        PG8_WAIT_V(6); PG8_BAR;
    } else {
        PG8_STAGE(PG8_SB(0, 0), cB, voffB); PG8_STAGE(PG8_SA(0, 0), cA, voffA); PG8_STAGE(PG8_SB(0, 1), cB + hstep, voffB); PG8_STAGE(PG8_SA(0, 1), cA + hstep, voffA);
        if (wr == 1) PG8_BAR;
        PG8_WAIT_V(4); PG8_BAR;
        PG8_STAGE(PG8_SB(1, 0), cB + kstep, voffB); PG8_STAGE(PG8_SA(1, 0), cA + kstep, voffA); PG8_STAGE(PG8_SB(1, 1), cB + hstep + kstep, voffB);
        PG8_WAIT_V(6); PG8_BAR;
    }
    for (;;) {
        const bool has_next = S.next(ui + 1, nxt);
        const char* nA = has_next ? (const char*)g.A + (size_t)nxt.pm * tstep : cA; const char* nB = has_next ? (const char*)g.Bt + (size_t)nxt.eb * g.estride + (size_t)nxt.pn * tstep : cB;
        for (int t = 0; t < nt; t += 2) {
            const bool last = (t == nt - 2);
            const char* a1 = cA + (size_t)(t + 1) * kstep;
            const char* a2 = last ? nA : cA + (size_t)(t + 2) * kstep; const char* b2 = last ? nB : cB + (size_t)(t + 2) * kstep;
            const char* a3 = a2 + kstep; const char* b3 = b2 + kstep;
            if (last && has_next) S.a_ready(nxt);
            if constexpr (SP2) {
            PG8_LDB(B0, 0, 0); PG8_LDB(B1, 0, 1); PG8_SCHED; PG8_LDA(At, 0, 0); PG8_STAGE(PG8_SA(1, 1), a1 + hstep, voffA);
            PG8_WAIT_V(8); PG8_WAIT_L(0); PG8_BAR; PG8_MMA(0, 0, At, B0); PG8_MMA(0, 1, At, B1); PG8_BAR; PG8_SCHED;
            PG8_LDA(At, 0, 1); PG8_STAGE(PG8_SB(0, 0), b2, voffB); PG8_STAGE(PG8_SB(0, 1), b2 + hstep, voffB); PG8_STAGE(PG8_SA(0, 0), a2, voffA);
            PG8_WAIT_V(8); PG8_WAIT_L(0); PG8_BAR; PG8_MMA(1, 0, At, B0); PG8_MMA(1, 1, At, B1); PG8_BAR; PG8_SCHED;
            PG8_LDB(B0, 1, 0); PG8_LDB(B1, 1, 1); PG8_SCHED; PG8_LDA(At, 1, 0); PG8_STAGE(PG8_SA(0, 1), a2 + hstep, voffA);
            PG8_WAIT_V(8); PG8_WAIT_L(0); PG8_BAR; PG8_MMA(0, 0, At, B0); PG8_MMA(0, 1, At, B1); PG8_BAR; PG8_SCHED;
            PG8_LDA(At, 1, 1); PG8_STAGE(PG8_SB(1, 0), b3, voffB); PG8_STAGE(PG8_SB(1, 1), b3 + hstep, voffB); PG8_STAGE(PG8_SA(1, 0), a3, voffA);
            PG8_WAIT_V(8); PG8_WAIT_L(0); PG8_BAR; PG8_MMA(1, 0, At, B0); PG8_MMA(1, 1, At, B1); PG8_BAR; PG8_SCHED;
            } else {
            PG8_LDB(B0, 0, 0); PG8_SCHED; PG8_LDA(At, 0, 0); PG8_STAGE(PG8_SA(1, 1), a1 + hstep, voffA);
            PG8_WAIT_L(8); PG8_BAR; PG8_WAIT_L(0); PG8_MMA(0, 0, At, B0); PG8_BAR; PG8_SCHED;
            PG8_LDB(B1, 0, 1); PG8_STAGE(PG8_SB(0, 0), b2, voffB);
            PG8_BAR; PG8_WAIT_L(0); PG8_MMA(0, 1, At, B1); PG8_BAR;
            PG8_LDA(At, 0, 1); PG8_STAGE(PG8_SA(0, 0), a2, voffA);
            PG8_BAR; PG8_WAIT_L(0); PG8_MMA(1, 0, At, B0); PG8_BAR; PG8_SCHED;
            PG8_STAGE(PG8_SB(0, 1), b2 + hstep, voffB);
            PG8_WAIT_V(6); PG8_BAR; PG8_MMA(1, 1, At, B1); PG8_BAR;
            PG8_LDB(B0, 1, 0); PG8_SCHED; PG8_LDA(At, 1, 0); PG8_STAGE(PG8_SA(0, 1), a2 + hstep, voffA);
            PG8_WAIT_L(8); PG8_BAR; PG8_WAIT_L(0); PG8_MMA(0, 0, At, B0); PG8_BAR; PG8_SCHED;
            PG8_LDB(B1, 1, 1); PG8_STAGE(PG8_SB(1, 0), b3, voffB);
            PG8_BAR; PG8_WAIT_L(0); PG8_MMA(0, 1, At, B1); PG8_BAR;
            PG8_LDA(At, 1, 1); PG8_STAGE(PG8_SA(1, 0), a3, voffA);
            PG8_BAR; PG8_WAIT_L(0); PG8_MMA(1, 0, At, B0); PG8_BAR; PG8_SCHED;
            PG8_STAGE(PG8_SB(1, 1), b3 + hstep, voffB);
            PG8_WAIT_V(6); PG8_BAR; PG8_MMA(1, 1, At, B1); PG8_BAR;
            }
        }
        if constexpr (ALIGN_EPI) { if (wr == 0) PG8_BAR; }
        if constexpr (!Epi::AFTER_DRAIN) { E(acc, cur, wr, wc, fr, fq); S.done(cur); }
        if (!has_next) break;
#pragma unroll
        for (int a = 0; a < 2; ++a)
#pragma unroll
            for (int b = 0; b < 2; ++b)
#pragma unroll
                for (int m = 0; m < 4; ++m)
#pragma unroll
                    for (int n = 0; n < 2; ++n) acc[a][b][m][n] = (f32x4){0.f, 0.f, 0.f, 0.f};
        cur = nxt; cA = nA; cB = nB; ++ui;
        if constexpr (ALIGN_EPI) { if (wr == 1) PG8_BAR; }
    }
    PG8_WAIT_V(0);
    if constexpr (!ALIGN_EPI) { if (wr == 0) PG8_BAR; }
    PG8_BAR;
    if constexpr (Epi::AFTER_DRAIN) { E.fused(acc, cur, wr, wc, fr, fq, lds, wid, lane); S.done(cur); }
#undef PG8_SA
#undef PG8_SB
#undef PG8_STAGE
#undef PG8_LDA
#undef PG8_LDB
#undef PG8_MMA
#undef PG8_WAIT_V
#undef PG8_WAIT_L
#undef PG8_BAR
#undef PG8_SCHED
}
}

constexpr int NB = 8, SEQ = 2048, NMETA = 16, LSEQ = SEQ + NMETA;
constexpr int M = NB * LSEQ, MP = 16640;
constexpr int DM = 1024, DINP = 2560, FF = 3584, NEXP = 8, DEPTH = 4;
constexpr int NCH = 33;
constexpr int UPN = 1792, UPK = 384;
constexpr int XS_ROWS = 35072;
constexpr float EPS = 1e-6f;
constexpr int NWAVES = 8;
#ifndef MK_MULTI
#define MK_MULTI 0
#endif

constexpr size_t MiB = 1u << 20;
constexpr size_t WS_CTL = 0, CTL_ZERO_BYTES = 2 * MiB;
constexpr size_t CTL_SSQ = 65536, CTL_SSKV = CTL_SSQ + (size_t)DEPTH * MP * 4;
static_assert(CTL_SSKV + (size_t)DEPTH * MP * 4 <= CTL_ZERO_BYTES, "ctl");
constexpr int CW_TMO = 0, CW_BAR = 4096, CW_CNT = 8192  , CW_QUEUE = 8320  ;
constexpr size_t WS_WIN = 2 * MiB;
constexpr size_t WS_WUP = WS_WIN + (size_t)DEPTH * DINP * DM * 2;
constexpr size_t WS_WOUT = WS_WUP + (size_t)DEPTH * UPN * UPK * 2;
constexpr size_t WS_WDGU = WS_WOUT + (size_t)DEPTH * DM * DM * 2;
constexpr size_t WS_WDD = WS_WDGU + (size_t)2 * 2 * FF * DM * 2;
constexpr size_t WS_WMGU = WS_WDD + (size_t)2 * DM * FF * 2;
constexpr size_t WS_WMD = WS_WMGU + (size_t)2 * NEXP * 2 * FF * DM * 2;
constexpr size_t WS_TAB = WS_WMD + (size_t)2 * NEXP * DM * FF * 2;
constexpr size_t TAB_RC = 0, TAB_RS = (size_t)LSEQ * 64 * 4, TAB_MC = 2 * TAB_RS, TAB_MS = TAB_MC + (size_t)LSEQ * 32 * 4;
constexpr size_t WS_HRES = WS_TAB + 2 * MiB;
constexpr size_t WS_XN = WS_HRES + (size_t)MP * DM * 4;
constexpr size_t WS_TOK = WS_XN + (size_t)MP * DM * 2;
constexpr size_t WS_SORT = WS_TOK + (size_t)MP * 32;
constexpr size_t WS_XS = WS_SORT + 1 * MiB;
constexpr size_t WS_YS = WS_XS;
constexpr size_t WS_R = WS_XS + (size_t)XS_ROWS * DM * 2;
constexpr size_t R_RQ = 0, R_RK = R_RQ + (size_t)MP * 512 * 2, R_RKZ = R_RK + (size_t)MP * 512 * 2, R_RV = R_RKZ + (size_t)MP * 512 * 2, R_SG = R_RV + (size_t)MP * 512 * 2;
constexpr size_t R_LAT = R_SG + (size_t)MP * 512 * 2, R_KPE = R_LAT + (size_t)MP * 384 * 2;
constexpr size_t R_QN = R_KPE + (size_t)MP * 64 * 2, R_QPE = R_QN + (size_t)MP * 512 * 2, R_KN = R_QPE + (size_t)MP * 256 * 2, R_V = R_KN + (size_t)MP * 512 * 2;
constexpr size_t R_ST = R_V + (size_t)MP * 512 * 2;
constexpr size_t R_Y = R_ST + (size_t)NB * 4 * NCH * 128 * 128 * 2;
constexpr size_t R_MIX_END = R_Y + (size_t)MP * DM * 2;
constexpr size_t R_ACT = 0;
constexpr size_t R_END = ((size_t)XS_ROWS * FF * 2 > R_MIX_END) ? (size_t)XS_ROWS * FF * 2 : R_MIX_END;
constexpr size_t WS_END = WS_R + R_END;

constexpr int RING_BYTES = 131072, LDSCTL_OFF = RING_BYTES, MISC_OFF = LDSCTL_OFF + 320, LDS_BYTES = 147456;

#define GAS __attribute__((address_space(1)))
#define LAS __attribute__((address_space(3)))
typedef unsigned short bf16;
typedef unsigned v4u __attribute__((ext_vector_type(4)));
typedef unsigned v2u __attribute__((ext_vector_type(2)));
typedef float f32x4 __attribute__((ext_vector_type(4)));
typedef float f32x16 __attribute__((ext_vector_type(16)));
typedef short bf16x8 __attribute__((ext_vector_type(8)));
typedef short s16x4 __attribute__((ext_vector_type(4)));
typedef GAS unsigned gu32;
#define RLX_AGENT __ATOMIC_RELAXED, __HIP_MEMORY_SCOPE_AGENT
#define LDS_WAIT() asm volatile("s_waitcnt lgkmcnt(0)" ::: "memory")
#define VM_WAIT() asm volatile("s_waitcnt vmcnt(0)" ::: "memory")
__device__ __forceinline__ unsigned f2bf(float f) { unsigned u = __builtin_bit_cast(unsigned, f); return (u + 0x7fffu + ((u >> 16) & 1u)) >> 16; }
__device__ __forceinline__ unsigned pk2(float lo, float hi) { return pg8::cvt_pk_bf16(lo, hi); }
__device__ __forceinline__ float bf2f(unsigned short b) { return __builtin_bit_cast(float, (unsigned)b << 16); }
template <int X> __device__ __forceinline__ float xshfl(float v) {
    if constexpr (X < 32) return __builtin_bit_cast(float, __builtin_amdgcn_ds_swizzle(__builtin_bit_cast(int, v), (X << 10) | 0x1f));
    else { const unsigned u = __builtin_bit_cast(unsigned, v); auto r = __builtin_amdgcn_permlane32_swap(u, u, false, false); const unsigned a = r[0], b = r[1]; return __builtin_bit_cast(float, a == u ? b : a); }
}
template <int X> __device__ __forceinline__ float xadd(float v) {
    if constexpr (X < 32) return v + xshfl<X>(v);
    else { const unsigned u = __builtin_bit_cast(unsigned, v); auto r = __builtin_amdgcn_permlane32_swap(u, u, false, false); return __builtin_bit_cast(float, (unsigned)r[0]) + __builtin_bit_cast(float, (unsigned)r[1]); }
}
__device__ __forceinline__ float wave_sum(float v) { v = xadd<1>(v); v = xadd<2>(v); v = xadd<4>(v); v = xadd<8>(v); v = xadd<16>(v); v = xadd<32>(v); return v; }
#define XB_TMO      128
#define XB_XCNT(j)  (256  + 64 * (j))
#define XB_XSUB(j)  (1280 + 64 * (j))
#define XB_XGEN(j)  (2304 + 64 * (j))
#define XB_TOP      3328
#define XB_TOPGEN   3392
#define XCD_BAR_WORDS 3456
#define XB_SPIN_CAP (1u << 18)

__device__ __forceinline__ unsigned xb_ld(unsigned* p)              { return __hip_atomic_load(p, __ATOMIC_RELAXED, __HIP_MEMORY_SCOPE_AGENT); }
__device__ __forceinline__ unsigned xb_add(unsigned* p, unsigned v) { return __hip_atomic_fetch_add(p, v, __ATOMIC_RELAXED, __HIP_MEMORY_SCOPE_AGENT); }
__device__ __forceinline__ unsigned xb_xcc_id() { return (unsigned)__builtin_amdgcn_s_getreg((3 << 11) | 20) & 0xFu; }
#define XB_SPIN(cond, bar) do { unsigned _sp = 0; while (cond) { __builtin_amdgcn_s_sleep(1); \
    if ((++_sp & 255u) == 0u) { if (xb_ld(&(bar)[XB_TMO])) break; if (_sp > XB_SPIN_CAP) { atomicAdd(&(bar)[XB_TMO], 1u); break; } } } } while (0)

struct XcdBarrier {
    unsigned* bar; unsigned x;
    volatile LAS unsigned* st;
};

__device__ __forceinline__ XcdBarrier xcd_barrier_post(unsigned* bar, volatile LAS unsigned* st) {
    XcdBarrier b; b.bar = bar; b.x = xb_xcc_id(); b.st = st;
    if (threadIdx.x == 0) (void)xb_add(&bar[XB_XCNT(b.x)], 1u);
    return b;
}
__device__ __forceinline__ void xcd_barrier_complete(unsigned* bar, unsigned x, unsigned& nloc, unsigned& nx) {
    const unsigned G = gridDim.x * gridDim.y * gridDim.z;
    unsigned sum, cnt, mine, sp = 0u;
    for (;;) {
        sum = 0u; cnt = 0u; mine = 0u;
#pragma unroll
        for (unsigned j = 0; j < 16; ++j) { const unsigned c = xb_ld(&bar[XB_XCNT(j)]); sum += c; cnt += (c > 0u) ? 1u : 0u; }
        mine = xb_ld(&bar[XB_XCNT(x)]);
        if (sum == G) break;
        __builtin_amdgcn_s_sleep(1);
        if ((++sp & 255u) == 0u) { if (xb_ld(&bar[XB_TMO])) break; if (sp > XB_SPIN_CAP) { atomicAdd(&bar[XB_TMO], 1u); break; } }
    }
    nloc = mine > 0u ? mine : 1u; nx = cnt > 0u ? cnt : 1u;
}

__device__ __forceinline__ void xcd_barrier(const XcdBarrier& b) {
    asm volatile("s_waitcnt vmcnt(0)" ::: "memory");
    __syncthreads();
    if (threadIdx.x == 0) {
        unsigned* bar = b.bar;
        __builtin_amdgcn_s_waitcnt(0);
        unsigned nloc = b.st[0], nx = b.st[1];
        if (nloc == 0u) { xcd_barrier_complete(bar, b.x, nloc, nx); b.st[0] = nloc; b.st[1] = nx; }
        const unsigned old = xb_add(&bar[XB_XSUB(b.x)], 1u);
        const unsigned gen = old / nloc;
        if (old + 1u == (gen + 1u) * nloc) {
            __builtin_amdgcn_fence(__ATOMIC_RELEASE, "agent");
            asm volatile("s_waitcnt vmcnt(0)" ::: "memory");
            const unsigned og = xb_add(&bar[XB_TOP], 1u);
            const unsigned tg = og / nx;
            if (og + 1u == (tg + 1u) * nx) xb_add(&bar[XB_TOPGEN], 1u);
            else XB_SPIN(xb_ld(&bar[XB_TOPGEN]) == tg, bar);
            __builtin_amdgcn_fence(__ATOMIC_ACQUIRE, "agent");
            xb_add(&bar[XB_XGEN(b.x)], 1u);
            asm volatile("s_waitcnt vmcnt(0)" ::: "memory");
        } else {
            XB_SPIN(xb_ld(&bar[XB_XGEN(b.x)]) == gen, bar);
            __builtin_amdgcn_fence(__ATOMIC_ACQUIRE, "agent");
            asm volatile("s_waitcnt vmcnt(0)" ::: "memory");
        }
    }
    __syncthreads();
}

struct Frame {
    LAS unsigned char* lds;
    volatile LAS unsigned* MISC;
    gu32* ctl;
    int tid, lane, wave, vcu, G;
    unsigned char* ws;
};
struct Inputs { const float* p[20]; };
__device__ __forceinline__ const float* ldin(int k) { unsigned long long v = 0;
#if defined(__HIP_DEVICE_COMPILE__)
    auto ka = __builtin_amdgcn_kernarg_segment_ptr();
    asm volatile("s_load_dwordx2 %0, %1, %2\n\ts_waitcnt lgkmcnt(0)" : "=s"(v) : "s"(ka), "n"(k * 8));
#endif
    return (const float*)v; }
enum { I_X = 0, I_META, I_ATTN_NORM, I_WIN, I_QNORM, I_WUQ, I_KVNORM, I_WUKV, I_RETG, I_MLAG, I_WOUT, I_FFNNORM, I_DWG, I_DWU, I_DWD, I_ROUTER, I_MWG, I_MWU, I_MWD, I_FINAL };

__device__ __forceinline__ int chunk_idx(int p) { return p < NMETA ? 48 + p : ((p - NMETA) & 63); }
__device__ __forceinline__ float log2_gamma(int h) { return h == 0 ? -0.045803689613124755f : h == 1 ? -0.022720076500083562f : h == 2 ? -0.011315313227834085f : -0.005646563141142062f; }

__device__ __forceinline__ void transpose_item(const float* Wcol, int ldw, int krow0, const float* scale, bf16* WT, int Kdst, int k0dst, int n0, LAS float* scr, int lane) {
#pragma unroll 8
    for (int i = 0; i < 32; ++i) { const int kk = 2 * i + (lane >> 5); float v = 0.f;
        if (Wcol) { v = Wcol[(size_t)(krow0 + kk) * ldw]; if (scale) v *= scale[krow0 + kk]; }
        scr[kk * 33 + (lane & 31)] = v; }
    LDS_WAIT(); asm volatile("" ::: "memory");
    const int c = lane & 7;
#pragma unroll
    for (int j = 0; j < 4; ++j) { const int n = (lane >> 3) + 8 * j; const LAS float* s = scr + (8 * c) * 33 + n;
        v4u o; o.x = pk2(s[0 * 33], s[1 * 33]); o.y = pk2(s[2 * 33], s[3 * 33]); o.z = pk2(s[4 * 33], s[5 * 33]); o.w = pk2(s[6 * 33], s[7 * 33]);
        *(GAS v4u*)(WT + (size_t)(n0 + n) * Kdst + k0dst + 8 * c) = o; }
    LDS_WAIT(); asm volatile("" ::: "memory");
}
__device__ __forceinline__ int slot_o8(int t) { return (t & 0x60) | ((t & 0xC) << 1) | ((t & 0x10) >> 2) | (t & 3); }
__device__ __forceinline__ int win_col(int s) {
    const int pn = s >> 8, t = s & 255, bj = t >> 7, t7 = t & 127, wc = (t >> 5) & 3, n = (t >> 4) & 1, fq = (t >> 2) & 3, i = t & 3;
    if (pn < 4) return (pn >> 1) * 512 + (2 * (pn & 1) + bj) * 128 + 16 * wc + 4 * fq + i + 64 * n;
    if (pn < 8) return 1024 + ((pn - 4) >> 1) * 512 + (pn & 1) * 256 + 128 * bj + slot_o8(t7);
    if (pn == 8) return 2048 + 128 * bj + slot_o8(t7);
    if (bj == 0) return 2304 + slot_o8(t7);
    if (wc < 2) return 2432 + 16 * wc + 4 * fq + i + 32 * n;
    return -1;
}
__device__ __forceinline__ int wup_col(int s, bool& is_kv) {
    const int pn = s >> 8, t = s & 255, bj = t >> 7, t7 = t & 127, wc = (t >> 5) & 3, n = (t >> 4) & 1, fq = (t >> 2) & 3, i = t & 3;
    if (pn < 2) { is_kv = false; const int o = 256 * pn + 128 * bj + slot_o8(t7); return (o >> 7) * 192 + (o & 127); }
    if (pn == 2) { is_kv = false; const int hq = 2 * bj + (wc >> 1); return hq * 192 + 128 + 16 * (wc & 1) + 4 * fq + i + 32 * n; }
    is_kv = true;
    if (pn < 5) { const int o = 256 * (pn - 3) + 128 * bj + slot_o8(t7); return (o >> 7) * 256 + (o & 127); }
    { const int o = 256 * (pn - 5) + 128 * bj + slot_o8(t7); return (o >> 7) * 256 + 128 + (o & 127); }
}
__device__ __forceinline__ void sincos_d(double x, float& s, float& c) {
    const double k = __builtin_rint(x * 0.63661977236758134308);
    const double y = (x - k * 1.5707963267948966) - k * 6.123233995736766e-17;
    const double y2 = y * y;
    const double sn = y * (1.0 + y2 * (-1.0 / 6 + y2 * (1.0 / 120 + y2 * (-1.0 / 5040 + y2 * (1.0 / 362880 + y2 * (-1.0 / 39916800 + y2 * (1.0 / 6227020800.0)))))));
    const double cs = 1.0 + y2 * (-0.5 + y2 * (1.0 / 24 + y2 * (-1.0 / 720 + y2 * (1.0 / 40320 + y2 * (-1.0 / 3628800 + y2 * (1.0 / 479001600.0 + y2 * (-1.0 / 87178291200.0)))))));
    const int q = (int)((long long)k & 3);
    const double ss = (q & 1) ? cs : sn, cc = (q & 1) ? sn : cs;
    s = (float)((q & 2) ? -ss : ss); c = (float)(((q + 1) & 2) ? -cc : cc);
}
__device__ __forceinline__ void p0_prologue(Frame& F) {
    LAS float* scr = (LAS float*)(F.lds + F.wave * 16384);
    const int gw = F.vcu * NWAVES + F.wave, NGW = F.G * NWAVES, lane = F.lane;
    float* hres = (float*)(F.ws + WS_HRES);
    for (int r = gw; r < MP; r += NGW) {
        GAS f32x4* o = (GAS f32x4*)(hres + (size_t)r * DM) + lane;
        if (r < M) { const int b = r / LSEQ, p = r - b * LSEQ;
            const GAS f32x4* src = (const GAS f32x4*)(p < NMETA ? ldin(I_META) + (size_t)p * DM : ldin(I_X) + ((size_t)b * SEQ + (p - NMETA)) * DM) + lane;
#pragma unroll
            for (int j = 0; j < 4; ++j) o[64 * j] = src[64 * j]; }
        else {
#pragma unroll
            for (int j = 0; j < 4; ++j) o[64 * j] = (f32x4){0.f, 0.f, 0.f, 0.f}; }
    }
    { float* tab = (float*)(F.ws + WS_TAB);
      const int gt = gw * 64 + lane, NT = NGW * 64;
      for (int t = gt; t < LSEQ * 64; t += NT) { const int p = t >> 6, i = t & 63; const float inv = exp2f(-(float)(2 * i) * (13.287712379549449f / 128.0f)); const float ang = (float)p * inv;
          float s, c; sincos_d((double)ang, s, c); tab[TAB_RC / 4 + t] = c; tab[TAB_RS / 4 + t] = s; }
      for (int t = gt; t < LSEQ * 32; t += NT) { const int p = t >> 5, i = t & 31; const float inv = exp2f(-(float)(2 * i) * (13.287712379549449f / 64.0f)); const float ang = (float)p * inv;
          float s, c; sincos_d((double)ang, s, c); tab[TAB_MC / 4 + t] = c; tab[TAB_MS / 4 + t] = s; }
    }
    constexpr int I_IN = DEPTH * 16 * 80, I_UP = DEPTH * 6 * 56, I_OUT = DEPTH * 16 * 32, I_DGU = 2 * 16 * 224, I_DD = 2 * 56 * 32, I_MGU = 16 * 16 * 224, I_MD = 16 * 56 * 32;
    constexpr int NITEMS = I_IN + I_UP + I_OUT + I_DGU + I_DD + I_MGU + I_MD;
    for (int it = gw; it < NITEMS; it += NGW) {
        int r = it;
        if (r < I_IN) { const int l = r / 1280, q = r % 1280, kb = q / 80, nb = q % 80; const int col = win_col(nb * 32 + (lane & 31));
            const float* W = ldin(I_WIN) + (size_t)l * DM * 2496;
            transpose_item(col >= 0 ? W + col : nullptr, 2496, kb * 64, ldin(I_ATTN_NORM) + l * DM, (bf16*)(F.ws + WS_WIN) + (size_t)l * DINP * DM, DM, kb * 64, nb * 32, scr, lane); continue; }
        r -= I_IN;
        if (r < I_UP) { const int l = r / 336, q = r % 336, kb = q / 56, nb = q % 56; bool is_kv; const int col = wup_col(nb * 32 + (lane & 31), is_kv);
            const float* Wc = nullptr; const float* sc = nullptr; int ldw = 0, k0 = 0;
            if (!is_kv && kb < 4) { Wc = ldin(I_WUQ) + (size_t)l * 256 * 768 + col; sc = ldin(I_QNORM) + l * 256; ldw = 768; k0 = kb * 64; }
            if (is_kv && kb >= 4) { Wc = ldin(I_WUKV) + (size_t)l * 128 * 1024 + col; sc = ldin(I_KVNORM) + l * 128; ldw = 1024; k0 = (kb - 4) * 64; }
            transpose_item(Wc, ldw, k0, sc, (bf16*)(F.ws + WS_WUP) + (size_t)l * UPN * UPK, UPK, kb * 64, nb * 32, scr, lane); continue; }
        r -= I_UP;
        if (r < I_OUT) { const int l = r / 512, q = r % 512, kb = q / 32, nb = q % 32;
            transpose_item(ldin(I_WOUT) + (size_t)l * DM * DM + nb * 32 + (lane & 31), DM, kb * 64, nullptr, (bf16*)(F.ws + WS_WOUT) + (size_t)l * DM * DM, DM, kb * 64, nb * 32, scr, lane); continue; }
        r -= I_OUT;
        if (r < I_DGU + 0) { const int l = r / 3584, q = r % 3584, kb = q / 224, nb = q % 224; const int s = nb * 32 + (lane & 31), pn = s >> 8, t = s & 255;
            const float* W = ((t >> 7) ? ldin(I_DWU) : ldin(I_DWG)) + (size_t)l * DM * FF + 128 * pn + slot_o8(t & 127);
            transpose_item(W, FF, kb * 64, ldin(I_FFNNORM) + (2 * l) * DM, (bf16*)(F.ws + WS_WDGU) + (size_t)l * 2 * FF * DM, DM, kb * 64, nb * 32, scr, lane); continue; }
        r -= I_DGU;
        if (r < I_DD) { const int l = r / 1792, q = r % 1792, kb = q / 32, nb = q % 32;
            transpose_item(ldin(I_DWD) + (size_t)l * FF * DM + nb * 32 + (lane & 31), DM, kb * 64, nullptr, (bf16*)(F.ws + WS_WDD) + (size_t)l * DM * FF, FF, kb * 64, nb * 32, scr, lane); continue; }
        r -= I_DD;
        if (r < I_MGU) { const int le = r / 3584, q = r % 3584, kb = q / 224, nb = q % 224; const int s = nb * 32 + (lane & 31), pn = s >> 8, t = s & 255;
            const float* W = ((t >> 7) ? ldin(I_MWU) : ldin(I_MWG)) + (size_t)le * DM * FF + 128 * pn + slot_o8(t & 127);
            transpose_item(W, FF, kb * 64, ldin(I_FFNNORM) + (2 * (le >> 3) + 1) * DM, (bf16*)(F.ws + WS_WMGU) + (size_t)le * 2 * FF * DM, DM, kb * 64, nb * 32, scr, lane); continue; }
        r -= I_MGU;
        { const int le = r / 1792, q = r % 1792, kb = q / 32, nb = q % 32;
            transpose_item(ldin(I_MWD) + (size_t)le * FF * DM + nb * 32 + (lane & 31), DM, kb * 64, nullptr, (bf16*)(F.ws + WS_WMD) + (size_t)le * DM * FF, FF, kb * 64, nb * 32, scr, lane); }
    }
}

typedef pg8::f32x4 af4;
__device__ __forceinline__ v4u pack8(af4 a, af4 b) { v4u w; w.x = pk2(a[0], a[1]); w.y = pk2(a[2], a[3]); w.z = pk2(b[0], b[1]); w.w = pk2(b[2], b[3]); return w; }
__device__ __forceinline__ float silu_f(float x) { return x * __builtin_amdgcn_rcpf(1.0f + __builtin_amdgcn_exp2f(-1.4426950408889634f * x)); }

struct EpiInProj {
    static constexpr bool PERM = false, AFTER_DRAIN = false;
    unsigned char* R; float* ssq; float* sskv; const float* tab; float lg0, lg1, lg2, lg3;
    __device__ __forceinline__ void operator()(const af4 (&acc)[2][2][4][2], const pg8::Unit& u, int wr, int wc, int fr, int fq) const {
        const int pn = u.pn; const float lgs[2] = {(pn & 1) ? lg2 : lg0, (pn & 1) ? lg3 : lg1};
#pragma unroll
        for (int ai = 0; ai < 2; ++ai)
#pragma unroll
            for (int m = 0; m < 4; ++m) {
                const int row = u.pm * 256 + ai * 128 + wr * 64 + m * 16 + fr; const int b = row / LSEQ, p = row - b * LSEQ; const bool ok = row < M;
                const int pp = ok ? p : 0;
                if (pn < 4) {
                    const af4 cs = *(const af4*)(tab + TAB_RC / 4 + pp * 64 + 16 * wc + 4 * fq), sn = *(const af4*)(tab + TAB_RS / 4 + pp * 64 + 16 * wc + 4 * fq);
#pragma unroll
                    for (int bj = 0; bj < 2; ++bj) { const int h = 2 * (pn & 1) + bj; const af4 t1 = acc[ai][bj][m][0], t2 = acc[ai][bj][m][1];
                        af4 o1 = t1 * cs - t2 * sn, o2 = t1 * sn + t2 * cs; const size_t off = ((size_t)row * 512 + h * 128 + 32 * wc + 8 * fq) * 2;
                        if (pn < 2) { o1 *= 0.08838834764831845f; o2 *= 0.08838834764831845f; *(v4u*)(R + R_RQ + off) = pack8(o1, o2); }
                        else { *(v4u*)(R + R_RK + off) = pack8(o1, o2); const float z = __builtin_amdgcn_exp2f(lgs[bj] * (float)(63 - chunk_idx(pp))); *(v4u*)(R + R_RKZ + off) = pack8(o1 * z, o2 * z); } }
                } else if (pn < 6) {
#pragma unroll
                    for (int bj = 0; bj < 2; ++bj) *(v4u*)(R + R_RV + ((size_t)row * 512 + (pn & 1) * 256 + 128 * bj + 32 * wc + 8 * fq) * 2) = pack8(acc[ai][bj][m][0], acc[ai][bj][m][1]);
                } else if (pn < 8) {
#pragma unroll
                    for (int bj = 0; bj < 2; ++bj) { af4 a = acc[ai][bj][m][0], c = acc[ai][bj][m][1];
#pragma unroll
                        for (int j = 0; j < 4; ++j) { a[j] = silu_f(a[j]); c[j] = silu_f(c[j]); }
                        *(v4u*)(R + R_SG + ((size_t)row * 512 + (pn & 1) * 256 + 128 * bj + 32 * wc + 8 * fq) * 2) = pack8(a, c); }
                } else if (pn == 8) {
                    float s = 0.f;
#pragma unroll
                    for (int bj = 0; bj < 2; ++bj) { const af4 a = acc[ai][bj][m][0], c = acc[ai][bj][m][1]; s += (a[0] * a[0] + a[1] * a[1]) + (a[2] * a[2] + a[3] * a[3]) + (c[0] * c[0] + c[1] * c[1]) + (c[2] * c[2] + c[3] * c[3]);
                        *(v4u*)(R + R_LAT + ((size_t)row * 384 + 128 * bj + 32 * wc + 8 * fq) * 2) = pack8(a, c); }
                    s = xadd<16>(s); s = xadd<32>(s);
                    if (fq == 0) ssq[row * 4 + wc] = s;
                } else {
                    { const af4 a = acc[ai][0][m][0], c = acc[ai][0][m][1]; float s = (a[0] * a[0] + a[1] * a[1]) + (a[2] * a[2] + a[3] * a[3]) + (c[0] * c[0] + c[1] * c[1]) + (c[2] * c[2] + c[3] * c[3]);
                      *(v4u*)(R + R_LAT + ((size_t)row * 384 + 256 + 32 * wc + 8 * fq) * 2) = pack8(a, c);
                      s = xadd<16>(s); s = xadd<32>(s);
                      if (fq == 0) sskv[row * 4 + wc] = s; }
                    if (wc < 2) { const af4 cs = *(const af4*)(tab + TAB_MC / 4 + pp * 32 + 16 * wc + 4 * fq), sn = *(const af4*)(tab + TAB_MS / 4 + pp * 32 + 16 * wc + 4 * fq);
                        const af4 t1 = acc[ai][1][m][0], t2 = acc[ai][1][m][1];
                        *(v4u*)(R + R_KPE + ((size_t)row * 64 + 32 * wc + 8 * fq) * 2) = pack8(t1 * cs - t2 * sn, t1 * sn + t2 * cs); }
                }
                asm volatile("" ::: "memory");
            }
    }
};
constexpr float QSCALE = 0.07216878364870323f * 1.4426950408889634f;
struct EpiUp {
    static constexpr bool PERM = false, AFTER_DRAIN = false;
    unsigned char* R; const float* ssq; const float* sskv; const float* tab;
    __device__ __forceinline__ void operator()(const af4 (&acc)[2][2][4][2], const pg8::Unit& u, int wr, int wc, int fr, int fq) const {
        const int pn = u.pn;
#pragma unroll
        for (int ai = 0; ai < 2; ++ai)
#pragma unroll
            for (int m = 0; m < 4; ++m) {
                const int row = u.pm * 256 + ai * 128 + wr * 64 + m * 16 + fr; const int b = row / LSEQ, p = row - b * LSEQ; const int pp = row < M ? p : 0;
                if (pn < 3) { const af4 q4 = *(const af4*)(ssq + row * 4); const float sc = QSCALE * __builtin_amdgcn_rsqf(((q4[0] + q4[1]) + (q4[2] + q4[3])) * (1.0f / 256.0f) + EPS);
                    if (pn < 2) {
#pragma unroll
                        for (int bj = 0; bj < 2; ++bj) *(v4u*)(R + R_QN + ((size_t)row * 512 + 256 * pn + 128 * bj + 32 * wc + 8 * fq) * 2) = pack8(acc[ai][bj][m][0] * sc, acc[ai][bj][m][1] * sc);
                    } else { const af4 cs = *(const af4*)(tab + TAB_MC / 4 + pp * 32 + 16 * (wc & 1) + 4 * fq), sn = *(const af4*)(tab + TAB_MS / 4 + pp * 32 + 16 * (wc & 1) + 4 * fq);
#pragma unroll
                        for (int bj = 0; bj < 2; ++bj) { const int hq = 2 * bj + (wc >> 1); const af4 t1 = acc[ai][bj][m][0] * sc, t2 = acc[ai][bj][m][1] * sc;
                            *(v4u*)(R + R_QPE + ((size_t)row * 256 + hq * 64 + 32 * (wc & 1) + 8 * fq) * 2) = pack8(t1 * cs - t2 * sn, t1 * sn + t2 * cs); } }
                } else { const af4 q4 = *(const af4*)(sskv + row * 4); const float sc = __builtin_amdgcn_rsqf(((q4[0] + q4[1]) + (q4[2] + q4[3])) * (1.0f / 128.0f) + EPS); const size_t base = pn < 5 ? R_KN : R_V; const int t0 = pn < 5 ? pn - 3 : pn - 5;
#pragma unroll
                    for (int bj = 0; bj < 2; ++bj) *(v4u*)(R + base + ((size_t)row * 512 + 256 * t0 + 128 * bj + 32 * wc + 8 * fq) * 2) = pack8(acc[ai][bj][m][0] * sc, acc[ai][bj][m][1] * sc);
                }
                asm volatile("" ::: "memory");
            }
    }
};
struct EpiResid {
    static constexpr bool PERM = false, AFTER_DRAIN = false;
    float* H;
    __device__ __forceinline__ void operator()(const af4 (&acc)[2][2][4][2], const pg8::Unit& u, int wr, int wc, int fr, int fq) const {
        const int row0 = u.pm * 256 + wr * 64 + fr, col0 = u.pn * 256 + wc * 32 + 4 * fq;
#pragma unroll
        for (int ai = 0; ai < 2; ++ai)
#pragma unroll
            for (int m = 0; m < 4; ++m) { float* rowp = H + (size_t)(row0 + ai * 128 + m * 16) * DM + col0;
#pragma unroll
                for (int bj = 0; bj < 2; ++bj)
#pragma unroll
                    for (int n = 0; n < 2; ++n) { af4* q = (af4*)(rowp + bj * 128 + n * 16); *q = *q + acc[ai][bj][m][n]; } }
    }
};
struct EpiSwiGLU {
    static constexpr bool PERM = false, AFTER_DRAIN = false;
    bf16* A;
    __device__ __forceinline__ void operator()(const af4 (&acc)[2][2][4][2], const pg8::Unit& u, int wr, int wc, int fr, int fq) const {
        const int row0 = u.pm * 256 + wr * 64 + fr, col0 = u.pn * 128 + wc * 32 + 8 * fq;
#pragma unroll
        for (int ai = 0; ai < 2; ++ai)
#pragma unroll
            for (int m = 0; m < 4; ++m) { af4 a = acc[ai][0][m][0], c = acc[ai][0][m][1]; const af4 ua = acc[ai][1][m][0], uc = acc[ai][1][m][1];
#pragma unroll
                for (int j = 0; j < 4; ++j) { a[j] = silu_f(a[j]) * ua[j]; c[j] = silu_f(c[j]) * uc[j]; }
                *(v4u*)(A + (size_t)(row0 + ai * 128 + m * 16) * FF + col0) = pack8(a, c); }
    }
};
struct EpiMoeDown {
    static constexpr bool PERM = false, AFTER_DRAIN = false;
    bf16* Y;
    __device__ __forceinline__ void operator()(const af4 (&acc)[2][2][4][2], const pg8::Unit& u, int wr, int wc, int fr, int fq) const {
        const int row0 = u.pm * 256 + wr * 64 + fr, col0 = u.pn * 256 + wc * 32 + 4 * fq;
#pragma unroll
        for (int ai = 0; ai < 2; ++ai)
#pragma unroll
            for (int m = 0; m < 4; ++m) { bf16* rowp = Y + (size_t)(row0 + ai * 128 + m * 16) * DM + col0;
#pragma unroll
                for (int bj = 0; bj < 2; ++bj)
#pragma unroll
                    for (int n = 0; n < 2; ++n) { const af4 a = acc[ai][bj][m][n]; v2u w; w.x = pk2(a[0], a[1]); w.y = pk2(a[2], a[3]); *(v2u*)(rowp + bj * 128 + n * 16) = w; } }
    }
};

__device__ __forceinline__ int expert_base(const unsigned* cnt, int e) { int acc = 0;
#pragma unroll
    for (int k = 0; k < 7; ++k) acc += (k < e) ? (int)((cnt[k] + 255u) & ~255u) : 0;
    return acc; }
__device__ __forceinline__ void load_row(Frame& F, float* hres, int r, bool moe_prev, const unsigned* cnt, f32x4 (&v)[4]) {
    GAS f32x4* xr = (GAS f32x4*)(hres + (size_t)r * DM) + F.lane;
#pragma unroll
    for (int j = 0; j < 4; ++j) v[j] = xr[64 * j];
    if (moe_prev) {
        const int* ti = (const int*)(F.ws + WS_TOK) + (size_t)r * 8; const int e1 = ti[0], e2 = ti[1], s1 = ti[2], s2 = ti[3]; const float w1 = __builtin_bit_cast(float, ti[4]), w2 = __builtin_bit_cast(float, ti[5]);
        const GAS v2u* y1 = (const GAS v2u*)((const bf16*)(F.ws + WS_YS) + (size_t)(expert_base(cnt, e1) + s1) * DM) + F.lane;
        const GAS v2u* y2 = (const GAS v2u*)((const bf16*)(F.ws + WS_YS) + (size_t)(expert_base(cnt, e2) + s2) * DM) + F.lane;
#pragma unroll
        for (int j = 0; j < 4; ++j) { const v2u a = y1[64 * j], c = y2[64 * j];
            v[j].x += w1 * __builtin_bit_cast(float, a.x << 16) + w2 * __builtin_bit_cast(float, c.x << 16);
            v[j].y += w1 * __builtin_bit_cast(float, a.x & 0xffff0000u) + w2 * __builtin_bit_cast(float, c.x & 0xffff0000u);
            v[j].z += w1 * __builtin_bit_cast(float, a.y << 16) + w2 * __builtin_bit_cast(float, c.y << 16);
            v[j].w += w1 * __builtin_bit_cast(float, a.y & 0xffff0000u) + w2 * __builtin_bit_cast(float, c.y & 0xffff0000u);
            xr[64 * j] = v[j]; }
    }
}
__device__ __forceinline__ float row_rstd(const f32x4 (&v)[4]) { float s = 0.f;
#pragma unroll
    for (int j = 0; j < 4; ++j) s += (v[j].x * v[j].x + v[j].y * v[j].y) + (v[j].z * v[j].z + v[j].w * v[j].w);
    return __builtin_amdgcn_rsqf(wave_sum(s) * (1.0f / DM) + EPS); }
__device__ __forceinline__ void store_xn(Frame& F, int r, const f32x4 (&v)[4], float rstd) {
    GAS v2u* o = (GAS v2u*)((bf16*)(F.ws + WS_XN) + (size_t)r * DM) + F.lane;
#pragma unroll
    for (int j = 0; j < 4; ++j) { v2u w; w.x = pk2(v[j].x * rstd, v[j].y * rstd); w.y = pk2(v[j].z * rstd, v[j].w * rstd); o[64 * j] = w; }
}
__device__ __forceinline__ void norm_phase(Frame& F, bool moe_prev, const unsigned* cnt_prev) {
    const int gw = F.vcu * NWAVES + F.wave, NGW = F.G * NWAVES; float* hres = (float*)(F.ws + WS_HRES);
    for (int r = gw; r < M; r += NGW) { f32x4 v[4]; load_row(F, hres, r, moe_prev, cnt_prev, v); store_xn(F, r, v, row_rstd(v)); }
}
__device__ __forceinline__ void route_phase(Frame& F, const float* gain, const float* router_w, unsigned* cnt) {
    const int gw = F.vcu * NWAVES + F.wave, NGW = F.G * NWAVES; float* hres = (float*)(F.ws + WS_HRES);
    LAS float* rw = (LAS float*)F.lds;
    for (int i = F.tid; i < DM * NEXP / 4; i += NWAVES * 64) ((LAS f32x4*)rw)[i] = ((const f32x4*)router_w)[i];
    __syncthreads();
    for (int r = gw; r < M; r += NGW) {
        f32x4 v[4]; load_row(F, hres, r, false, cnt, v); const float rstd = row_rstd(v); store_xn(F, r, v, rstd);
        float lg[8];
#pragma unroll
        for (int e = 0; e < 8; ++e) lg[e] = 0.f;
#pragma unroll
        for (int j = 0; j < 4; ++j) { const int k0 = 4 * F.lane + 256 * j; const f32x4 g = *(const f32x4*)(gain + k0);
            const float hv[4] = {v[j].x * rstd * g.x, v[j].y * rstd * g.y, v[j].z * rstd * g.z, v[j].w * rstd * g.w};
#pragma unroll
            for (int t = 0; t < 4; ++t) { const f32x4 wa = *(const LAS f32x4*)(rw + (k0 + t) * 8), wb = *(const LAS f32x4*)(rw + (k0 + t) * 8 + 4);
                lg[0] += hv[t] * wa.x; lg[1] += hv[t] * wa.y; lg[2] += hv[t] * wa.z; lg[3] += hv[t] * wa.w; lg[4] += hv[t] * wb.x; lg[5] += hv[t] * wb.y; lg[6] += hv[t] * wb.z; lg[7] += hv[t] * wb.w; } }
#pragma unroll
        for (int e = 0; e < 8; ++e) lg[e] = wave_sum(lg[e]);
        int e1 = 0; float v1 = lg[0];
#pragma unroll
        for (int e = 1; e < 8; ++e) if (lg[e] > v1) { v1 = lg[e]; e1 = e; }
        int e2 = -1; float v2 = -3.0e38f;
#pragma unroll
        for (int e = 0; e < 8; ++e) if (e != e1 && (e2 < 0 || lg[e] > v2)) { v2 = lg[e]; e2 = e; }
        const float w2 = 1.0f / (1.0f + __expf(v1 - v2)), w1 = 1.0f - w2;
        if (F.lane == 0) { const int s1 = (int)__hip_atomic_fetch_add(cnt + e1, 1u, RLX_AGENT), s2 = (int)__hip_atomic_fetch_add(cnt + e2, 1u, RLX_AGENT);
            int* ti = (int*)(F.ws + WS_TOK) + (size_t)r * 8; ti[0] = e1; ti[1] = e2; ti[2] = s1; ti[3] = s2; ti[4] = __builtin_bit_cast(int, w1); ti[5] = __builtin_bit_cast(int, w2); }
    }
}
__device__ __forceinline__ void gather_phase(Frame& F, const unsigned* cnt) {
    const int gw = F.vcu * NWAVES + F.wave, NGW = F.G * NWAVES;
    for (int r = gw; r < M; r += NGW) {
        const int* ti = (const int*)(F.ws + WS_TOK) + (size_t)r * 8; const int e1 = ti[0], e2 = ti[1], s1 = ti[2], s2 = ti[3];
        const GAS v4u* src = (const GAS v4u*)((const bf16*)(F.ws + WS_XN) + (size_t)r * DM) + F.lane;
        GAS v4u* d1 = (GAS v4u*)((bf16*)(F.ws + WS_XS) + (size_t)(expert_base(cnt, e1) + s1) * DM) + F.lane;
        GAS v4u* d2 = (GAS v4u*)((bf16*)(F.ws + WS_XS) + (size_t)(expert_base(cnt, e2) + s2) * DM) + F.lane;
        const v4u a = src[0], c = src[64]; d1[0] = a; d1[64] = c; d2[0] = a; d2[64] = c;
    }
    for (int e = 0; e < 8; ++e) { const int c0 = (int)cnt[e], c1 = (c0 + 255) & ~255, b0 = expert_base(cnt, e);
        for (int q = c0 + gw; q < c1; q += NGW) { GAS v4u* d = (GAS v4u*)((bf16*)(F.ws + WS_XS) + (size_t)(b0 + q) * DM) + F.lane; d[0] = (v4u){0u, 0u, 0u, 0u}; d[64] = (v4u){0u, 0u, 0u, 0u}; } }
}
__device__ __forceinline__ void final_phase(Frame& F, const float* gain, float* out, const unsigned* cnt_prev) {
    const int gw = F.vcu * NWAVES + F.wave, NGW = F.G * NWAVES; float* hres = (float*)(F.ws + WS_HRES);
    for (int q = gw; q < NB * SEQ; q += NGW) { const int b = q >> 11, s = q & 2047, r = b * LSEQ + NMETA + s;
        f32x4 v[4]; load_row(F, hres, r, true, cnt_prev, v); const float rstd = row_rstd(v);
        GAS f32x4* o = (GAS f32x4*)(out + (size_t)q * DM) + F.lane;
#pragma unroll
        for (int j = 0; j < 4; ++j) { const f32x4 g = *(const f32x4*)(gain + 4 * F.lane + 256 * j); o[64 * j] = (f32x4){v[j].x * rstd * g.x, v[j].y * rstd * g.y, v[j].z * rstd * g.z, v[j].w * rstd * g.w}; }
    }
}

typedef short v4i16_t __attribute__((ext_vector_type(4)));
__device__ __forceinline__ s16x4 vtr(const LAS unsigned char* p) { return __builtin_bit_cast(s16x4, __builtin_amdgcn_ds_read_tr16_b64_v4i16((LAS v4i16_t*)p)); }
#define MFMA16(a, b, c) __builtin_amdgcn_mfma_f32_16x16x32_bf16((a), (b), (c), 0, 0, 0)
#define CAT8(L, H) (bf16x8){L[0], L[1], L[2], L[3], H[0], H[1], H[2], H[3]}
__device__ __forceinline__ void ret_state_unit(Frame& F, int unit) {
    const int b = unit >> 5, h = (unit >> 3) & 3, es = unit & 7;
    int tid_ = threadIdx.x; asm volatile("" : "+v"(tid_));
    const int tid = tid_, lane = tid & 63, w = __builtin_amdgcn_readfirstlane(tid >> 6), l15 = lane & 15, kg = lane >> 4, q = l15 >> 2, p_ = l15 & 3;
    const float g64 = exp2f(64.0f * log2_gamma(h));
    const bf16* rkz = (const bf16*)(F.ws + WS_R + R_RKZ) + (size_t)b * LSEQ * 512 + h * 128;
    const bf16* rv = (const bf16*)(F.ws + WS_R + R_RV) + (size_t)b * LSEQ * 512 + h * 128 + es * 16;
    bf16* ST = (bf16*)(F.ws + WS_R + R_ST) + (size_t)((b * 4 + h) * NCH) * 16384;
    LAS unsigned char* KZ = F.lds; LAS unsigned char* VS = F.lds + 32768;
    v4u k0r, k1r, vr;
#define RS_LOAD(c) do { const int p0 = (c) == 0 ? 0 : NMETA + 64 * ((c) - 1); \
        k0r = *(const GAS v4u*)(rkz + (size_t)(p0 + (tid >> 4)) * 512 + (tid & 15) * 8); k1r = *(const GAS v4u*)(rkz + (size_t)(p0 + 32 + (tid >> 4)) * 512 + (tid & 15) * 8); \
        vr = (v4u){0u, 0u, 0u, 0u}; if (tid < 128 && ((c) != 0 || (tid >> 1) < NMETA)) vr = *(const GAS v4u*)(rv + (size_t)(p0 + (tid >> 1)) * 512 + (tid & 1) * 8); } while (0)
#define RS_WRITE(buf) do { *(LAS v4u*)(KZ + (buf) * 16384 + (tid >> 4) * 256 + (tid & 15) * 16) = k0r; *(LAS v4u*)(KZ + (buf) * 16384 + (32 + (tid >> 4)) * 256 + (tid & 15) * 16) = k1r; \
        if (tid < 128) *(LAS v4u*)(VS + (buf) * 2048 + (tid >> 1) * 32 + (tid & 1) * 16) = vr; } while (0)
    RS_LOAD(0); RS_WRITE(0); __syncthreads();
    af4 S = {0.f, 0.f, 0.f, 0.f};
    for (int c = 0; c <= 32; ++c) {
        { v2u o; o.x = pk2(S[0], S[1]); o.y = pk2(S[2], S[3]); *(GAS v2u*)(ST + (size_t)c * 16384 + (es * 16 + l15) * 128 + w * 16 + 4 * kg) = o; }
        if (c == 32) break;
        if (c + 1 < 32) RS_LOAD(c + 1);
        const LAS unsigned char* kz = KZ + (c & 1) * 16384 + w * 32 + p_ * 8; const LAS unsigned char* vs = VS + (c & 1) * 2048 + p_ * 8;
        S *= g64;
#pragma unroll
        for (int u = 0; u < 2; ++u) { const int R0 = 32 * u + 8 * kg + q;
            const s16x4 a0 = vtr(kz + R0 * 256), a1 = vtr(kz + (R0 + 4) * 256), b0 = vtr(vs + R0 * 32), b1 = vtr(vs + (R0 + 4) * 32);
            S = MFMA16(CAT8(a0, a1), CAT8(b0, b1), S); }
        if (c + 1 < 32) RS_WRITE((c + 1) & 1);
        __syncthreads();
    }
    __syncthreads();
#undef RS_LOAD
#undef RS_WRITE
}
__device__ __forceinline__ void ret_out_unit(Frame& F, int unit, const float* gain) {
    const int c = unit % NCH, bh = unit / NCH, b = bh >> 2, h = bh & 3;
    int tid_ = threadIdx.x; asm volatile("" : "+v"(tid_));
    const int tid = tid_, lane = tid & 63, w = __builtin_amdgcn_readfirstlane(tid >> 6), l15 = lane & 15, kg = lane >> 4, q = l15 >> 2, p_ = l15 & 3, it = w & 3, eh = w >> 2;
    const float lg = log2_gamma(h);
    const int p0 = c == 0 ? 0 : NMETA + 64 * (c - 1); const size_t r0 = (size_t)b * LSEQ + p0;
    const bf16* rq = (const bf16*)(F.ws + WS_R + R_RQ) + r0 * 512 + h * 128;
    const bf16* rk = (const bf16*)(F.ws + WS_R + R_RK) + r0 * 512 + h * 128;
    const bf16* rv = (const bf16*)(F.ws + WS_R + R_RV) + r0 * 512 + h * 128;
    const bf16* sg = (const bf16*)(F.ws + WS_R + R_SG) + r0 * 512 + h * 128;
    const bf16* ST = (const bf16*)(F.ws + WS_R + R_ST) + (size_t)((b * 4 + h) * NCH + c) * 16384;
    bf16* Y = (bf16*)(F.ws + WS_R + R_Y) + r0 * DM + h * 128;
    LAS unsigned char* VL = F.lds; LAS float* red = (LAS float*)(F.lds + 16384);
#pragma unroll
    for (int i = 0; i < 2; ++i) { const int idx = tid + 512 * i; *(LAS v4u*)(VL + (idx >> 4) * 256 + (idx & 15) * 16) = *(const GAS v4u*)(rv + (size_t)(idx >> 4) * 512 + (idx & 15) * 8); }
    bf16x8 qf[4];
#pragma unroll
    for (int ks = 0; ks < 4; ++ks) qf[ks] = *(const GAS bf16x8*)(rq + (size_t)(16 * it + l15) * 512 + 32 * ks + 8 * kg);
    af4 pj[4];
#pragma unroll
    for (int jt = 0; jt < 4; ++jt) { pj[jt] = (af4){0.f, 0.f, 0.f, 0.f};
#pragma unroll
        for (int ks = 0; ks < 4; ++ks) { const bf16x8 kf = *(const GAS bf16x8*)(rk + (size_t)(16 * jt + l15) * 512 + 32 * ks + 8 * kg); pj[jt] = MFMA16(kf, qf[ks], pj[jt]); } }
    bf16x8 pa[2];
    { const int il = 16 * it + l15; unsigned pw[4][2];
#pragma unroll
      for (int jt = 0; jt < 4; ++jt) { float v[4];
#pragma unroll
          for (int r = 0; r < 4; ++r) { const int jl = 16 * jt + 4 * kg + r; const int dd = il > jl ? il - jl : jl - il; float wgt = __builtin_amdgcn_exp2f(lg * (float)dd); if (c == 0 && jl >= NMETA) wgt = 0.f; v[r] = pj[jt][r] * wgt; }
          pw[jt][0] = pk2(v[0], v[1]); pw[jt][1] = pk2(v[2], v[3]); }
      pa[0] = __builtin_bit_cast(bf16x8, (v4u){pw[0][0], pw[0][1], pw[1][0], pw[1][1]}); pa[1] = __builtin_bit_cast(bf16x8, (v4u){pw[2][0], pw[2][1], pw[3][0], pw[3][1]}); }
    af4 acc[4];
#pragma unroll
    for (int et = 0; et < 4; ++et) acc[et] = (af4){0.f, 0.f, 0.f, 0.f};
    if (c > 0) {
#pragma unroll
        for (int et = 0; et < 4; ++et)
#pragma unroll
            for (int ks = 0; ks < 4; ++ks) { const bf16x8 sf = *(const GAS bf16x8*)(ST + (size_t)(64 * eh + 16 * et + l15) * 128 + 32 * ks + 8 * kg); acc[et] = MFMA16(qf[ks], sf, acc[et]); }
        float xi[4];
#pragma unroll
        for (int r = 0; r < 4; ++r) xi[r] = __builtin_amdgcn_exp2f(lg * (float)(16 * it + 4 * kg + r + 1));
#pragma unroll
        for (int et = 0; et < 4; ++et)
#pragma unroll
            for (int r = 0; r < 4; ++r) acc[et][r] *= xi[r];
    }
    __syncthreads();
#pragma unroll
    for (int et = 0; et < 4; ++et)
#pragma unroll
        for (int u = 0; u < 2; ++u) { const LAS unsigned char* vb = VL + (size_t)(32 * u + 4 * kg + q) * 256 + (64 * eh + 16 * et + 4 * p_) * 2;
            const s16x4 b0 = vtr(vb), b1 = vtr(vb + 16 * 256); acc[et] = MFMA16(pa[u], CAT8(b0, b1), acc[et]); }
    float ss[4];
#pragma unroll
    for (int r = 0; r < 4; ++r) { float s = 0.f;
#pragma unroll
        for (int et = 0; et < 4; ++et) s += acc[et][r] * acc[et][r];
        s = xadd<1>(s); s = xadd<2>(s); s = xadd<4>(s); s = xadd<8>(s); ss[r] = s; }
    if (l15 == 0) {
#pragma unroll
        for (int r = 0; r < 4; ++r) red[eh * 64 + 16 * it + 4 * kg + r] = ss[r]; }
    __syncthreads();
#pragma unroll
    for (int r = 0; r < 4; ++r) { const int il = 16 * it + 4 * kg + r; const float rstd = __builtin_amdgcn_rsqf((red[il] + red[64 + il]) * (1.0f / 128.0f) + EPS);
        if (c > 0 || il < NMETA) {
#pragma unroll
            for (int et = 0; et < 4; ++et) { const int e = 64 * eh + 16 * et + l15; const float o = acc[et][r] * rstd * gain[h * 128 + e] * bf2f(sg[(size_t)il * 512 + e]); Y[(size_t)il * DM + e] = (bf16)f2bf(o); } }
    }
    __syncthreads();
}

#define KSWZ(row, colB) ((row) * 256 + ((colB) ^ (((row) & 7) << 4)))
#define KPSWZ(row, colB) ((row) * 128 + ((colB) ^ (((row) & 7) << 4)))
#define SBAR() __builtin_amdgcn_sched_barrier(0)
__device__ __forceinline__ int crow(int r, int hi) { return (r & 3) + 8 * (r >> 2) + 4 * hi; }
__device__ __forceinline__ int v_st(int k, int c) { const int kk = (k & ~0xC) | ((k & 4) << 1) | ((k & 8) >> 1); return ((kk >> 3) * 4 + (c >> 5)) * 512 + ((kk & 7) * 32 + (c & 31)) * 2; }
__device__ __forceinline__ int v_rd_base(int lane) { return ((lane & 3) << 3) | (((lane >> 2) & 3) << 6) | (((lane >> 4) & 1) << 5) | (((lane >> 5) & 1) << 8); }
constexpr int v_rd_off(int d0, int ks, int half) { return d0 * 512 + ks * 4096 + half * 2048; }
template <int OFF> __device__ __forceinline__ s16x4 tr_read(int vb) { s16x4 r; asm volatile("ds_read_b64_tr_b16 %0, %1 offset:%2" : "=&v"(r) : "v"(vb), "i"(OFF) : "memory"); return r; }
template <int D0> __device__ __forceinline__ void pv_one(f32x16& od, int vb, bf16x8 pa0, bf16x8 pa1, bf16x8 pa2, bf16x8 pa3) {
    const s16x4 l0 = tr_read<v_rd_off(D0, 0, 0)>(vb), h0 = tr_read<v_rd_off(D0, 0, 1)>(vb), l1 = tr_read<v_rd_off(D0, 1, 0)>(vb), h1 = tr_read<v_rd_off(D0, 1, 1)>(vb);
    const s16x4 l2 = tr_read<v_rd_off(D0, 2, 0)>(vb), h2 = tr_read<v_rd_off(D0, 2, 1)>(vb), l3 = tr_read<v_rd_off(D0, 3, 0)>(vb), h3 = tr_read<v_rd_off(D0, 3, 1)>(vb);
    asm volatile("s_waitcnt lgkmcnt(0)" ::: "memory"); SBAR();
    od = __builtin_amdgcn_mfma_f32_32x32x16_bf16(pa0, CAT8(l0, h0), od, 0, 0, 0);
    od = __builtin_amdgcn_mfma_f32_32x32x16_bf16(pa1, CAT8(l1, h1), od, 0, 0, 0);
    od = __builtin_amdgcn_mfma_f32_32x32x16_bf16(pa2, CAT8(l2, h2), od, 0, 0, 0);
    od = __builtin_amdgcn_mfma_f32_32x32x16_bf16(pa3, CAT8(l3, h3), od, 0, 0, 0);
}
__device__ __forceinline__ void attn_unit(Frame& F, int b, int h, int j, const float* gain, char* lds) {
    int tid_ = threadIdx.x; asm volatile("" : "+v"(tid_));
    const int tid = tid_, wid = __builtin_amdgcn_readfirstlane(tid >> 6), lane = tid & 63, r32 = lane & 31, hi = lane >> 5;
    const unsigned char* Rb = F.ws + WS_R;
    const bf16* QN = (const bf16*)(Rb + R_QN); const bf16* QPE = (const bf16*)(Rb + R_QPE); const bf16* KN = (const bf16*)(Rb + R_KN) + h * 128; const bf16* VV = (const bf16*)(Rb + R_V) + h * 128; const bf16* KPE = (const bf16*)(Rb + R_KPE);
    char* V_lds = lds; char* K_lds = lds + 32768; char* KP_lds = lds + 65536; float* wsf = (float*)(lds + 81920) + wid * 64; float* li_l = wsf; float* al_l = wsf + 32;
    const int p0 = j < 0 ? 0 : NMETA + 256 * j; const size_t rowq = (size_t)b * LSEQ + p0 + wid * 32 + r32;
    bf16x8 qr[12];
#pragma unroll
    for (int d0 = 0; d0 < 8; ++d0) qr[d0] = *(const GAS bf16x8*)(QN + rowq * 512 + h * 128 + d0 * 16 + hi * 8);
#pragma unroll
    for (int d0 = 0; d0 < 4; ++d0) qr[8 + d0] = *(const GAS bf16x8*)(QPE + rowq * 256 + h * 64 + d0 * 16 + hi * 8);
    const int NT = j < 0 ? 1 : 4 * j + 5, my_last = j < 0 ? 0 : 1 + 4 * j + (wid >> 1);
    const int sr = tid >> 4, sc = (tid & 15) * 8, vst0 = v_st(sr, sc), vst1 = v_st(32 + sr, sc), kpr = tid >> 3, kpc = (tid & 7) * 8;
    const int vb0 = (int)(uintptr_t)V_lds + v_rd_base(lane);
    v4u vs0, vs1, ks0, ks1, kp;
#define A_LOAD(t) do { const size_t kr = (size_t)b * LSEQ + ((t) == 0 ? 0 : NMETA + 64 * ((t) - 1)); \
        vs0 = *(const GAS v4u*)(VV + (kr + sr) * 512 + sc); vs1 = *(const GAS v4u*)(VV + (kr + 32 + sr) * 512 + sc); ks0 = *(const GAS v4u*)(KN + (kr + sr) * 512 + sc); ks1 = *(const GAS v4u*)(KN + (kr + 32 + sr) * 512 + sc); \
        kp = *(const GAS v4u*)(KPE + (kr + kpr) * 64 + kpc); } while (0)
#define A_WRITE(bf) do { *(v4u*)(V_lds + (bf) * 16384 + vst0) = vs0; *(v4u*)(V_lds + (bf) * 16384 + vst1) = vs1; *(v4u*)(K_lds + (bf) * 16384 + KSWZ(sr, sc * 2)) = ks0; *(v4u*)(K_lds + (bf) * 16384 + KSWZ(32 + sr, sc * 2)) = ks1; \
        *(v4u*)(KP_lds + (bf) * 8192 + KPSWZ(kpr, kpc * 2)) = kp; } while (0)
    float m_reg = -1e30f, l_reg = 0.f; f32x16 o[4];
#pragma unroll
    for (int d = 0; d < 4; ++d)
#pragma unroll
        for (int r = 0; r < 16; ++r) o[d][r] = 0.f;
    A_LOAD(0); A_WRITE(0); __syncthreads();
    for (int t = 0; t < NT; ++t) {
        if (t > my_last && t + 1 < NT) A_LOAD(t + 1);
        if (t <= my_last) {
            const char* Kt = K_lds + (t & 1) * 16384; const char* KPt = KP_lds + (t & 1) * 8192;
            f32x16 p0v, p1v;
#pragma unroll
            for (int r = 0; r < 16; ++r) { p0v[r] = 0.f; p1v[r] = 0.f; }
#pragma unroll
            for (int d0 = 0; d0 < 8; ++d0) { const int cb = (d0 * 16 + hi * 8) * 2;
                const bf16x8 b0 = *(const bf16x8*)(Kt + KSWZ(r32, cb)), b1 = *(const bf16x8*)(Kt + KSWZ(32 + r32, cb));
                p0v = __builtin_amdgcn_mfma_f32_32x32x16_bf16(b0, qr[d0], p0v, 0, 0, 0); p1v = __builtin_amdgcn_mfma_f32_32x32x16_bf16(b1, qr[d0], p1v, 0, 0, 0); }
#pragma unroll
            for (int d0 = 0; d0 < 4; ++d0) { const int cb = (d0 * 16 + hi * 8) * 2;
                const bf16x8 b0 = *(const bf16x8*)(KPt + KPSWZ(r32, cb)), b1 = *(const bf16x8*)(KPt + KPSWZ(32 + r32, cb));
                p0v = __builtin_amdgcn_mfma_f32_32x32x16_bf16(b0, qr[8 + d0], p0v, 0, 0, 0); p1v = __builtin_amdgcn_mfma_f32_32x32x16_bf16(b1, qr[8 + d0], p1v, 0, 0, 0); }
            if (t == 0) {
#pragma unroll
                for (int r = 8; r < 16; ++r) p0v[r] = -1e30f;
#pragma unroll
                for (int r = 0; r < 16; ++r) p1v[r] = -1e30f; }
            float pmax = p0v[0];
#pragma unroll
            for (int r = 1; r < 16; ++r) pmax = fmaxf(pmax, p0v[r]);
#pragma unroll
            for (int r = 0; r < 16; ++r) pmax = fmaxf(pmax, p1v[r]);
            { auto rr = __builtin_amdgcn_permlane32_swap(__float_as_uint(pmax), __float_as_uint(pmax), false, false); pmax = fmaxf(__uint_as_float(rr[0]), __uint_as_float(rr[1])); }
            const float mn = fmaxf(m_reg, pmax), alpha = __builtin_amdgcn_exp2f(m_reg - mn); m_reg = mn;
            float ps = 0.f;
#pragma unroll
            for (int r = 0; r < 16; ++r) { p0v[r] = __builtin_amdgcn_exp2f(p0v[r] - mn); p1v[r] = __builtin_amdgcn_exp2f(p1v[r] - mn); ps += p0v[r] + p1v[r]; }
            { auto rr = __builtin_amdgcn_permlane32_swap(__float_as_uint(ps), __float_as_uint(ps), false, false); ps = __uint_as_float(rr[0]) + __uint_as_float(rr[1]); }
            l_reg = l_reg * alpha + ps;
            if (__any(alpha < 1.f)) { if (hi == 0) al_l[r32] = alpha; asm volatile("s_waitcnt lgkmcnt(0)" ::: "memory");
#pragma unroll
                for (int r = 0; r < 16; ++r) { const float a = al_l[crow(r, hi)];
#pragma unroll
                    for (int d = 0; d < 4; ++d) o[d][r] *= a; } }
            bf16x8 pa0, pa1, pa2, pa3;
#define PK4(P, BASE, OUT) do { unsigned a0 = pk2(P[BASE + 0], P[BASE + 1]), a1 = pk2(P[BASE + 2], P[BASE + 3]); \
    unsigned b0_ = pk2(P[BASE + 4], P[BASE + 5]), b1_ = pk2(P[BASE + 6], P[BASE + 7]); \
    auto r0_ = __builtin_amdgcn_permlane32_swap(a0, b0_, false, false); auto r1_ = __builtin_amdgcn_permlane32_swap(a1, b1_, false, false); \
    v4u w_ = {r0_[0], r1_[0], r0_[1], r1_[1]}; OUT = __builtin_bit_cast(bf16x8, w_); } while (0)
            PK4(p0v, 0, pa0); PK4(p0v, 8, pa1); PK4(p1v, 0, pa2); PK4(p1v, 8, pa3);
#undef PK4
            if (t + 1 < NT) A_LOAD(t + 1);
            const int vb = vb0 + (t & 1) * 16384;
            pv_one<0>(o[0], vb, pa0, pa1, pa2, pa3); pv_one<1>(o[1], vb, pa0, pa1, pa2, pa3); pv_one<2>(o[2], vb, pa0, pa1, pa2, pa3); pv_one<3>(o[3], vb, pa0, pa1, pa2, pa3);
        }
        if (t + 1 < NT) A_WRITE((t + 1) & 1);
        __syncthreads();
    }
    if (hi == 0) li_l[r32] = l_reg; asm volatile("s_waitcnt lgkmcnt(0)" ::: "memory");
    bf16* Y = (bf16*)(F.ws + WS_R + R_Y) + ((size_t)b * LSEQ + p0 + wid * 32) * DM + 512 + h * 128;
    float gn[4];
#pragma unroll
    for (int d = 0; d < 4; ++d) gn[d] = gain[h * 128 + 32 * d + r32];
#pragma unroll
    for (int r = 0; r < 16; ++r) { const int orow = crow(r, hi); const float lr = li_l[orow];
        float s = (o[0][r] * o[0][r] + o[1][r] * o[1][r]) + (o[2][r] * o[2][r] + o[3][r] * o[3][r]);
        s = xadd<1>(s); s = xadd<2>(s); s = xadd<4>(s); s = xadd<8>(s); s = xadd<16>(s);
        const float rstd = __builtin_amdgcn_rsqf(s * (1.0f / 128.0f) + EPS * lr * lr);
        if (j >= 0 || (wid == 0 && orow < NMETA)) {
#pragma unroll
            for (int d = 0; d < 4; ++d) Y[(size_t)orow * DM + 32 * d + r32] = (bf16)f2bf(o[d][r] * rstd * gn[d]); } }
    __syncthreads();
#undef A_LOAD
#undef A_WRITE
}

struct Args { Inputs in; float* out; unsigned char* ws; int phase; int pad; };
constexpr int N_ATT_UNITS = 288, N_RO_UNITS = NB * 4 * NCH;
constexpr int PH_PER_LAYER = 9, N_PHASES = 1 + DEPTH * PH_PER_LAYER + 1;

__global__ void __launch_bounds__(NWAVES * 64, 2) mk_fwd(Args args) {
    extern __shared__ __attribute__((aligned(16))) unsigned char lds[];
    Frame F;
    F.lds = (LAS unsigned char*)lds; F.MISC = (volatile LAS unsigned*)(F.lds + MISC_OFF);
    F.tid = threadIdx.x; F.lane = F.tid & 63; F.wave = __builtin_amdgcn_readfirstlane(F.tid >> 6);
    F.G = gridDim.x; { const int bx = blockIdx.x; F.vcu = (F.G % 8 == 0) ? (bx % 8) * (F.G / 8) + bx / 8 : bx; }
    F.ws = args.ws; F.ctl = (gu32*)(args.ws + WS_CTL);
    for (int u = F.tid; u < (LDS_BYTES - LDSCTL_OFF) / 4; u += NWAVES * 64) ((LAS unsigned*)(F.lds + LDSCTL_OFF))[u] = 0u;
    __syncthreads();
    XcdBarrier bar; bar.bar = (unsigned*)(F.ctl + CW_BAR); bar.x = 0; bar.st = nullptr;
    if (!MK_MULTI) bar = xcd_barrier_post((unsigned*)(F.ctl + CW_BAR), F.MISC + 8);
#define R (F.ws + WS_R)
#define tab ((const float*)(F.ws + WS_TAB))
#define hres ((float*)(F.ws + WS_HRES))
#define XN ((const pg8::bf16_t*)(F.ws + WS_XN))
    int ph = 0;
#ifndef MK_ALIGN
#define MK_ALIGN true
#endif
#ifndef MK_SP2
#define MK_SP2 true
#endif
#ifndef MK_MASK
#define MK_MASK 0xFFFFFFFFu
#endif
#define ON(k) (((MK_MASK) >> (k)) & 1u)
#define RUN() (MK_MULTI ? (ph == args.phase) : true)
#define SEAM() do { if (!MK_MULTI) { asm volatile("" : "+s"(bar.x)); bar.bar = (unsigned*)(F.ctl + CW_BAR); xcd_barrier(bar); } ++ph; int z_ = 0; asm volatile("" : "+v"(F.tid), "+s"(z_)); F.lane = F.tid & 63; F.wave = __builtin_amdgcn_readfirstlane(F.tid >> 6); F.ws = args.ws + z_; F.ctl = (gu32*)(F.ws + WS_CTL); } while (0)

    if (ON(0) && RUN()) p0_prologue(F);
    SEAM();
#pragma unroll 1
    for (int l = 0; l < DEPTH; ++l) {
        const bool moe = (l & 1) != 0; const int li = l >> 1;
        unsigned* cnt = (unsigned*)(F.ctl + CW_CNT) + li * 8;
        if (ON(1) && RUN()) norm_phase(F, l == 2, (const unsigned*)(F.ctl + CW_CNT));
        SEAM();
        if (ON(2) && RUN()) {
            pg8::Gemm g{XN, (const pg8::bf16_t*)(F.ws + WS_WIN) + (size_t)l * DINP * DM, MP, DINP, DM, 0};
            pg8::StaticOrder S; S.init(MP, DINP, F.G, (int)blockIdx.x);
            EpiInProj E{R, (float*)(F.ws + CTL_SSQ), (float*)(F.ws + CTL_SSKV), tab, log2_gamma(0), log2_gamma(1), log2_gamma(2), log2_gamma(3)};
            pg8::gemm_phase<EpiInProj, pg8::StaticOrder, MK_ALIGN, MK_SP2>(F.lds, g, S, E);
        }
        SEAM();
        if (ON(3) && RUN()) {
            pg8::Gemm g{(const pg8::bf16_t*)(R + R_LAT), (const pg8::bf16_t*)(F.ws + WS_WUP) + (size_t)l * UPN * UPK, MP, UPN, UPK, 0};
            pg8::StaticOrder S; S.init(MP, UPN, F.G, (int)blockIdx.x);
            EpiUp E{R, (const float*)(F.ws + CTL_SSQ), (const float*)(F.ws + CTL_SSKV), tab};
            pg8::gemm_phase<EpiUp, pg8::StaticOrder, MK_ALIGN, MK_SP2>(F.lds, g, S, E);
            if (ON(4)) for (int u = blockIdx.x; u < NB * 4 * 8; u += F.G) ret_state_unit(F, u);
        }
        SEAM();
        if (RUN()) {
            gu32* qh = F.ctl + CW_QUEUE + 64 * l;
            for (;;) {
                if (F.tid == 0) F.MISC[16] = __hip_atomic_fetch_add(qh, 1u, RLX_AGENT);
                __syncthreads(); const int u = (int)F.MISC[16]; __syncthreads();
                if (u >= N_ATT_UNITS + N_RO_UNITS) break;
                if (u < N_ATT_UNITS) { if (ON(5)) { const int j = u < 256 ? 7 - (u >> 5) : -1, bh = u & 31; attn_unit(F, bh >> 2, bh & 3, j, ldin(I_MLAG) + l * 512, (char*)lds); } }
                else if (ON(6)) ret_out_unit(F, u - N_ATT_UNITS, ldin(I_RETG) + l * 512);
            }
        }
        SEAM();
        if (ON(7) && RUN()) {
            pg8::Gemm g{(const pg8::bf16_t*)(R + R_Y), (const pg8::bf16_t*)(F.ws + WS_WOUT) + (size_t)l * DM * DM, MP, DM, DM, 0};
            pg8::StaticOrder S; S.init(MP, DM, F.G, (int)blockIdx.x);
            EpiResid E{hres};
            pg8::gemm_phase<EpiResid, pg8::StaticOrder, MK_ALIGN, MK_SP2>(F.lds, g, S, E);
        }
        SEAM();
        if (!moe) {
            if (ON(8) && RUN()) norm_phase(F, false, nullptr);
            SEAM();
            if (ON(9) && RUN()) {
                pg8::Gemm g{XN, (const pg8::bf16_t*)(F.ws + WS_WDGU) + (size_t)li * 2 * FF * DM, MP, 2 * FF, DM, 0};
                pg8::StaticOrder S; S.init(MP, 2 * FF, F.G, (int)blockIdx.x);
                EpiSwiGLU E{(bf16*)(R + R_ACT)};
                pg8::gemm_phase<EpiSwiGLU, pg8::StaticOrder, MK_ALIGN, MK_SP2>(F.lds, g, S, E);
            }
            SEAM();
            if (ON(10) && RUN()) {
                pg8::Gemm g{(const pg8::bf16_t*)(R + R_ACT), (const pg8::bf16_t*)(F.ws + WS_WDD) + (size_t)li * DM * FF, MP, DM, FF, 0};
                pg8::StaticOrder S; S.init(MP, DM, F.G, (int)blockIdx.x);
                EpiResid E{hres};
                pg8::gemm_phase<EpiResid, pg8::StaticOrder, MK_ALIGN, MK_SP2>(F.lds, g, S, E);
            }
            SEAM();
            ++ph;
        } else {
            if (ON(11) && RUN()) route_phase(F, ldin(I_FFNNORM) + l * DM, ldin(I_ROUTER) + (size_t)li * DM * NEXP, cnt);
            SEAM();
            if (ON(12) && RUN()) gather_phase(F, cnt);
            SEAM();
            if (ON(13) && RUN()) {
                pg8::Gemm g{(const pg8::bf16_t*)(F.ws + WS_XS), (const pg8::bf16_t*)(F.ws + WS_WMGU) + (size_t)li * NEXP * 2 * FF * DM, XS_ROWS, 2 * FF, DM, (size_t)2 * FF * DM * 2};
                pg8::GroupedOrder S; S.init(cnt, 2 * FF, F.G, (int)blockIdx.x);
                EpiSwiGLU E{(bf16*)(R + R_ACT)};
                pg8::gemm_phase<EpiSwiGLU, pg8::GroupedOrder, MK_ALIGN, MK_SP2>(F.lds, g, S, E);
            }
            SEAM();
            if (ON(14) && RUN()) {
                pg8::Gemm g{(const pg8::bf16_t*)(R + R_ACT), (const pg8::bf16_t*)(F.ws + WS_WMD) + (size_t)li * NEXP * DM * FF, XS_ROWS, DM, FF, (size_t)DM * FF * 2};
                pg8::GroupedOrder S; S.init(cnt, DM, F.G, (int)blockIdx.x);
                EpiMoeDown E{(bf16*)(F.ws + WS_YS)};
                pg8::gemm_phase<EpiMoeDown, pg8::GroupedOrder, MK_ALIGN, MK_SP2>(F.lds, g, S, E);
            }
            SEAM();
        }
    }
    if (ON(15) && RUN()) final_phase(F, ldin(I_FINAL), args.out, (const unsigned*)(F.ctl + CW_CNT) + 8);
#undef RUN
#undef SEAM
#undef R
#undef tab
#undef hres
#undef XN
}

extern "C" void kernel_launch(void* const* d_in, const int* in_sizes, int n_in, void* d_out, int out_size, void* d_ws, size_t ws_size, hipStream_t stream) {
    static int grid = 0;
    if (grid == 0) {
        if (n_in != 20 || in_sizes[0] != NB * SEQ * DM || out_size != NB * SEQ * DM || ws_size < WS_END) {
            fprintf(stderr, "kernel_launch: shape mismatch: n_in %d in0 %d out %d ws %zu (need >= %zu)\n", n_in, n_in > 0 ? in_sizes[0] : -1, out_size, ws_size, (size_t)WS_END); grid = -1; return; }
        int dev = 0, cus = 0, per_cu = 0;
        if (hipGetDevice(&dev) != hipSuccess || hipDeviceGetAttribute(&cus, hipDeviceAttributeMultiprocessorCount, dev) != hipSuccess) { grid = -1; return; }
        if (hipFuncSetAttribute((const void*)mk_fwd, hipFuncAttributeMaxDynamicSharedMemorySize, LDS_BYTES) != hipSuccess) { fprintf(stderr, "kernel_launch: hipFuncSetAttribute failed\n"); grid = -1; return; }
        if (hipOccupancyMaxActiveBlocksPerMultiprocessor(&per_cu, (const void*)mk_fwd, NWAVES * 64, LDS_BYTES) != hipSuccess || per_cu < 1)
            fprintf(stderr, "kernel_launch: occupancy query reports %d workgroups per CU\n", per_cu);
        (void)hipGetLastError();
        grid = cus;
    }
    if (grid < 0) return;
    if (hipMemsetAsync((char*)d_ws + WS_CTL, 0, CTL_ZERO_BYTES, stream) != hipSuccess) { fprintf(stderr, "kernel_launch: memset failed\n"); return; }
    Args a{};
    for (int i = 0; i < 20; ++i) a.in.p[i] = (const float*)d_in[i];
    a.out = (float*)d_out; a.ws = (unsigned char*)d_ws; a.phase = 0; a.pad = 0;
#if MK_MULTI
    for (int ph = 0; ph < N_PHASES; ++ph) { a.phase = ph; hipLaunchKernelGGL(mk_fwd, dim3(grid), dim3(NWAVES * 64), LDS_BYTES, stream, a); }
#else
    hipLaunchKernelGGL(mk_fwd, dim3(grid), dim3(NWAVES * 64), LDS_BYTES, stream, a);
#endif
    const hipError_t le = hipPeekAtLastError();
    if (le != hipSuccess) fprintf(stderr, "kernel_launch: launch failed: %s\n", hipGetErrorName(le));
}
```

```cpp
#include <hip/hip_runtime.h>
#include <cstdio>
#include <cstdint>
namespace pg8 {
#define PG8_LAS __attribute__((address_space(3)))
typedef unsigned short bf16_t;
typedef short bf16x8 __attribute__((ext_vector_type(8)));
typedef float f32x4 __attribute__((ext_vector_type(4)));
typedef unsigned u32x4 __attribute__((ext_vector_type(4)));
constexpr int BM = 256, BK = 64, HALF = 128, HTB = HALF * BK * 2  , STAGE_BYTES = 8 * HTB, NXCD = 8, WGM = 8;

__host__ __device__ __forceinline__ int lds_byte(int r, int c) { const int st = (r >> 4) * 2 + (c >> 5), rr = r & 15, cc = c & 31, ob = rr * 64 + cc * 2; return st * 1024 + (ob ^ (((ob >> 9) & 1) << 5)); }
__host__ __device__ __forceinline__ void stage_rc(int b, int& R, int& C) { const int st = b / 1024, sb = b % 1024, swz = sb ^ (((sb >> 9) & 1) << 5); R = (st >> 1) * 16 + swz / 64; C = (st & 1) * 32 + (swz % 64) / 2; }
__host__ __device__ __forceinline__ int perm32(int rho) { const int n = rho >> 4, i = rho & 15; return 8 * (i >> 2) + 4 * n + (i & 3); }

struct Unit { int pm, pn, eb; };
struct Gemm { const bf16_t* A; const bf16_t* Bt; int M, N, K; size_t estride; };

struct StaticOrder {
    int nM, nN, nwg, G, c;
    __host__ __device__ void init(int M, int N, int G_, int c_) { nM = M / BM; nN = N / BM; nwg = nM * nN; G = G_; c = c_; }
    __host__ __device__ bool next(int i, Unit& u) const {
        const long L = (long)i * G + c; if (L >= nwg) return false;
        int wgid = (int)L; { const int q = nwg / NXCD, r = nwg % NXCD, xcd = wgid % NXCD, off = wgid / NXCD; wgid = (xcd < r ? xcd * (q + 1) : r * (q + 1) + (xcd - r) * q) + off; }
        const int nig = WGM * nN, gid = wgid / nig, fm = gid * WGM, gsz = (nM - fm) < WGM ? (nM - fm) : WGM;
        u.pm = fm + ((wgid % nig) % gsz); u.pn = (wgid % nig) / gsz; u.eb = 0; return true;
    }
    __device__ __forceinline__ void a_ready(const Unit&) const {}
    __device__ __forceinline__ void done(const Unit&) const {}
};
struct GroupedOrder {
    int nM, nN, nwg, G, c; int tp[9];
    __device__ __forceinline__ void init(const unsigned* cnt, int N, int G_, int c_) {
        tp[0] = 0;
#pragma unroll
        for (int e = 0; e < 8; ++e) tp[e + 1] = tp[e] + __builtin_amdgcn_readfirstlane((int)((cnt[e] + 255u) >> 8));
        nM = tp[8]; nN = N / BM; nwg = nM * nN; G = G_; c = c_; }
    __device__ __forceinline__ bool next(int i, Unit& u) const {
        const long L = (long)i * G + c; if (L >= nwg) return false;
        int wgid = (int)L; { const int q = nwg / NXCD, r = nwg % NXCD, xcd = wgid % NXCD, off = wgid / NXCD; wgid = (xcd < r ? xcd * (q + 1) : r * (q + 1) + (xcd - r) * q) + off; }
        const int nig = WGM * nN, gid = wgid / nig, fm = gid * WGM, gsz = (nM - fm) < WGM ? (nM - fm) : WGM;
        u.pm = fm + ((wgid % nig) % gsz); u.pn = (wgid % nig) / gsz;
        int e = 0;
#pragma unroll
        for (int k = 1; k < 8; ++k) e += (u.pm >= tp[k]) ? 1 : 0;
        u.eb = e; return true;
    }
    __device__ __forceinline__ void a_ready(const Unit&) const {}
    __device__ __forceinline__ void done(const Unit&) const {}
};
__device__ __forceinline__ unsigned cvt_pk_bf16(float lo, float hi) { unsigned r; asm volatile("v_cvt_pk_bf16_f32 %0, %1, %2" : "=v"(r) : "v"(lo), "v"(hi)); return r; }
template <class Epi, class Sched, bool ALIGN_EPI = false, bool SP2 = false>
__device__ __forceinline__ void gemm_phase(PG8_LAS unsigned char* lds, const Gemm g, const Sched& S, const Epi& E) {
    int tid_ = threadIdx.x; asm volatile("" : "+v"(tid_));
    const int tid = tid_, wid = __builtin_amdgcn_readfirstlane(tid >> 6), lane = tid & 63, wr = wid >> 2, wc = wid & 3, fr = lane & 15, fq = lane >> 4;
    const int K = g.K, nt = K / BK;
    unsigned voffA[2], voffB[2];
#pragma unroll
    for (int i = 0; i < 2; ++i) { int R, C; stage_rc(tid * 16 + i * 8192, R, C); const int Rb = Epi::PERM ? ((R & ~31) + perm32(R & 31)) : R;
        voffA[i] = (unsigned)(R * K + C) * 2u; voffB[i] = (unsigned)(Rb * K + C) * 2u; }
    const size_t kstep = (size_t)(BK * 2);
    const size_t hstep = (size_t)HALF * K * 2;
    const size_t tstep = 2 * hstep;
    const unsigned ldsw = (unsigned)wid * 1024u;
    const int aoff = lds_byte(wr * 64 + fr, fq * 8), boff = lds_byte(wc * 32 + fr, fq * 8);
#define PG8_SA(b, h) (((b) * 2 + (h)) * HTB)
#define PG8_SB(b, h) ((4 + (b) * 2 + (h)) * HTB)
#define PG8_STAGE(bufoff, gbase, voff) do { _Pragma("unroll") for (int _i = 0; _i < 2; ++_i) \
        __builtin_amdgcn_global_load_lds((const unsigned*)((const char*)(gbase) + (voff)[_i]), (PG8_LAS unsigned*)(lds + (bufoff) + ldsw + _i * 8192), 16, 0, 0); } while (0)
#define PG8_LDA(dst, b, h) do { _Pragma("unroll") for (int m = 0; m < 4; ++m) _Pragma("unroll") for (int k = 0; k < 2; ++k) dst[m][k] = *(const PG8_LAS bf16x8*)(lds + PG8_SA(b, h) + aoff + m * 2048 + k * 1024); } while (0)
#define PG8_LDB(dst, b, h) do { _Pragma("unroll") for (int n = 0; n < 2; ++n) _Pragma("unroll") for (int k = 0; k < 2; ++k) dst[n][k] = *(const PG8_LAS bf16x8*)(lds + PG8_SB(b, h) + boff + n * 2048 + k * 1024); } while (0)
#define PG8_MMA(ai, bj, At, Bt) do { __builtin_amdgcn_s_setprio(1); _Pragma("unroll") for (int m = 0; m < 4; ++m) _Pragma("unroll") for (int n = 0; n < 2; ++n) _Pragma("unroll") for (int k = 0; k < 2; ++k) \
        acc[ai][bj][m][n] = __builtin_amdgcn_mfma_f32_16x16x32_bf16(Bt[n][k], At[m][k], acc[ai][bj][m][n], 0, 0, 0); __builtin_amdgcn_s_setprio(0); } while (0)
#define PG8_WAIT_V(n) asm volatile("s_waitcnt vmcnt(" #n ")" ::: "memory")
#define PG8_WAIT_L(n) asm volatile("s_waitcnt lgkmcnt(" #n ")" ::: "memory")
#define PG8_BAR __builtin_amdgcn_s_barrier()
#define PG8_SCHED __builtin_amdgcn_sched_barrier(0)
    Unit cur, nxt; int ui = 0;
    if (!S.next(0, cur)) return;
    f32x4 acc[2][2][4][2];
#pragma unroll
    for (int a = 0; a < 2; ++a)
#pragma unroll
        for (int b = 0; b < 2; ++b)
#pragma unroll
            for (int m = 0; m < 4; ++m)
#pragma unroll
                for (int n = 0; n < 2; ++n) acc[a][b][m][n] = (f32x4){0.f, 0.f, 0.f, 0.f};
    bf16x8 At[4][2], B0[2][2], B1[2][2];
    const char* cA = (const char*)g.A + (size_t)cur.pm * tstep; const char* cB = (const char*)g.Bt + (size_t)cur.eb * g.estride + (size_t)cur.pn * tstep;
    S.a_ready(cur);
    if constexpr (SP2) {
        PG8_STAGE(PG8_SB(0, 0), cB, voffB); PG8_STAGE(PG8_SB(0, 1), cB + hstep, voffB); PG8_STAGE(PG8_SA(0, 0), cA, voffA); PG8_STAGE(PG8_SA(0, 1), cA + hstep, voffA);
        if (wr == 1) PG8_BAR;
        PG8_WAIT_V(2); PG8_BAR;
        PG8_STAGE(PG8_SB(1, 0), cB + kstep, voffB); PG8_STAGE(PG8_SA(1, 0), cA + kstep, voffA); PG8_STAGE(PG8_SB(1, 1), cB + hstep + kstep, voffB);
        PG8_WAIT_V(6); PG8_BAR;
    } else {
        PG8_STAGE(PG8_SB(0, 0), cB, voffB); PG8_STAGE(PG8_SA(0, 0), cA, voffA); PG8_STAGE(PG8_SB(0, 1), cB + hstep, voffB); PG8_STAGE(PG8_SA(0, 1), cA + hstep, voffA);
        if (wr == 1) PG8_BAR;
        PG8_WAIT_V(4); PG8_BAR;
        PG8_STAGE(PG8_SB(1, 0), cB + kstep, voffB); PG8_STAGE(PG8_SA(1, 0), cA + kstep, voffA); PG8_STAGE(PG8_SB(1, 1), cB + hstep + kstep, voffB);
        PG8_WAIT_V(6); PG8_BAR;
    }
    for (;;) {
        const bool has_next = S.next(ui + 1, nxt);
        const char* nA = has_next ? (const char*)g.A + (size_t)nxt.pm * tstep : cA; const char* nB = has_next ? (const char*)g.Bt + (size_t)nxt.eb * g.estride + (size_t)nxt.pn * tstep : cB;
        for (int t = 0; t < nt; t += 2) {
            const bool last = (t == nt - 2);
            const char* a1 = cA + (size_t)(t + 1) * kstep;
            const char* a2 = last ? nA : cA + (size_t)(t + 2) * kstep; const char* b2 = last ? nB : cB + (size_t)(t + 2) * kstep;
            const char* a3 = a2 + kstep; const char* b3 = b2 + kstep;
            if (last && has_next) S.a_ready(nxt);
            if constexpr (SP2) {
            PG8_LDB(B0, 0, 0); PG8_LDB(B1, 0, 1); PG8_SCHED; PG8_LDA(At, 0, 0); PG8_STAGE(PG8_SA(1, 1), a1 + hstep, voffA);
            PG8_WAIT_V(8); PG8_WAIT_L(0); PG8_BAR; PG8_MMA(0, 0, At, B0); PG8_MMA(0, 1, At, B1); PG8_BAR; PG8_SCHED;
            PG8_LDA(At, 0, 1); PG8_STAGE(PG8_SB(0, 0), b2, voffB); PG8_STAGE(PG8_SB(0, 1), b2 + hstep, voffB); PG8_STAGE(PG8_SA(0, 0), a2, voffA);
            PG8_WAIT_V(8); PG8_WAIT_L(0); PG8_BAR; PG8_MMA(1, 0, At, B0); PG8_MMA(1, 1, At, B1); PG8_BAR; PG8_SCHED;
            PG8_LDB(B0, 1, 0); PG8_LDB(B1, 1, 1); PG8_SCHED; PG8_LDA(At, 1, 0); PG8_STAGE(PG8_SA(0, 1), a2 + hstep, voffA);
            PG8_WAIT_V(8); PG8_WAIT_L(0); PG8_BAR; PG8_MMA(0, 0, At, B0); PG8_MMA(0, 1, At, B1); PG8_BAR; PG8_SCHED;
            PG8_LDA(At, 1, 1); PG8_STAGE(PG8_SB(1, 0), b3, voffB); PG8_STAGE(PG8_SB(1, 1), b3 + hstep, voffB); PG8_STAGE(PG8_SA(1, 0), a3, voffA);
            PG8_WAIT_V(8); PG8_WAIT_L(0); PG8_BAR; PG8_MMA(1, 0, At, B0); PG8_MMA(1, 1, At, B1); PG8_BAR; PG8_SCHED;
            } else {
            PG8_LDB(B0, 0, 0); PG8_SCHED; PG8_LDA(At, 0, 0); PG8_STAGE(PG8_SA(1, 1), a1 + hstep, voffA);
            PG8_WAIT_L(8); PG8_BAR; PG8_WAIT_L(0); PG8_MMA(0, 0, At, B0); PG8_BAR; PG8_SCHED;
            PG8_LDB(B1, 0, 1); PG8_STAGE(PG8_SB(0, 0), b2, voffB);
            PG8_BAR; PG8_WAIT_L(0); PG8_MMA(0, 1, At, B1); PG8_BAR;
            PG8_LDA(At, 0, 1); PG8_STAGE(PG8_SA(0, 0), a2, voffA);
            PG8_BAR; PG8_WAIT_L(0); PG8_MMA(1, 0, At, B0); PG8_BAR; PG8_SCHED;
            PG8_STAGE(PG8_SB(0, 1), b2 + hstep, voffB);
            PG8_WAIT_V(6); PG8_BAR; PG8_MMA(1, 1, At, B1); PG8_BAR;
            PG8_LDB(B0, 1, 0); PG8_SCHED; PG8_LDA(At, 1, 0); PG8_STAGE(PG8_SA(0, 1), a2 + hstep, voffA);
            PG8_WAIT_L(8); PG8_BAR; PG8_WAIT_L(0); PG8_MMA(0, 0, At, B0); PG8_BAR; PG8_SCHED;
            PG8_LDB(B1, 1, 1); PG8_STAGE(PG8_SB(1, 0), b3, voffB);
            PG8_BAR; PG8_WAIT_L(0); PG8_MMA(0, 1, At, B1); PG8_BAR;
            PG8_LDA(At, 1, 1); PG8_STAGE(PG8_SA(1, 0), a3, voffA);
            PG8_BAR; PG8_WAIT_L(0); PG8_MMA(1, 0, At, B0); PG8_BAR; PG8_SCHED;
            PG8_STAGE(PG8_SB(1, 1), b3 + hstep, voffB);
            PG8_WAIT_V(6); PG8_BAR; PG8_MMA(1, 1, At, B1); PG8_BAR;
            }
        }
        if constexpr (ALIGN_EPI) { if (wr == 0) PG8_BAR; }
        if constexpr (!Epi::AFTER_DRAIN) { E(acc, cur, wr, wc, fr, fq); S.done(cur); }
        if (!has_next) break;
#pragma unroll
        for (int a = 0; a < 2; ++a)
#pragma unroll
            for (int b = 0; b < 2; ++b)
#pragma unroll
                for (int m = 0; m < 4; ++m)
#pragma unroll
                    for (int n = 0; n < 2; ++n) acc[a][b][m][n] = (f32x4){0.f, 0.f, 0.f, 0.f};
        cur = nxt; cA = nA; cB = nB; ++ui;
        if constexpr (ALIGN_EPI) { if (wr == 1) PG8_BAR; }
    }
    PG8_WAIT_V(0);
    if constexpr (!ALIGN_EPI) { if (wr == 0) PG8_BAR; }
    PG8_BAR;
    if constexpr (Epi::AFTER_DRAIN) { E.fused(acc, cur, wr, wc, fr, fq, lds, wid, lane); S.done(cur); }
#undef PG8_SA
#undef PG8_SB
#undef PG8_STAGE
#undef PG8_LDA
#undef PG8_LDB
#undef PG8_MMA
#undef PG8_WAIT_V
#undef PG8_WAIT_L
#undef PG8_BAR
#undef PG8_SCHED
}
}

constexpr int NB = 8, SEQ = 2048, NMETA = 16, LSEQ = SEQ + NMETA;
constexpr int M = NB * LSEQ, MP = 16640;
constexpr int DM = 1024, DINP = 2560, FF = 3584, NEXP = 8, DEPTH = 4;
constexpr int NCH = 33;
constexpr int UPN = 1792, UPK = 384;
constexpr int XS_ROWS = 35072;
constexpr float EPS = 1e-6f;
constexpr int NWAVES = 8;
#ifndef MK_MULTI
#define MK_MULTI 0
#endif

constexpr size_t MiB = 1u << 20;
constexpr size_t WS_CTL = 0, CTL_ZERO_BYTES = 2 * MiB;
constexpr size_t CTL_SSQ = 65536, CTL_SSKV = CTL_SSQ + (size_t)DEPTH * MP * 4;
static_assert(CTL_SSKV + (size_t)DEPTH * MP * 4 <= CTL_ZERO_BYTES, "ctl");
constexpr int CW_TMO = 0, CW_BAR = 4096, CW_CNT = 8192  , CW_QUEUE = 8320  ;
constexpr size_t WS_WIN = 2 * MiB;
constexpr size_t WS_WUP = WS_WIN + (size_t)DEPTH * DINP * DM * 2;
constexpr size_t WS_WOUT = WS_WUP + (size_t)DEPTH * UPN * UPK * 2;
constexpr size_t WS_WDGU = WS_WOUT + (size_t)DEPTH * DM * DM * 2;
constexpr size_t WS_WDD = WS_WDGU + (size_t)2 * 2 * FF * DM * 2;
constexpr size_t WS_WMGU = WS_WDD + (size_t)2 * DM * FF * 2;
constexpr size_t WS_WMD = WS_WMGU + (size_t)2 * NEXP * 2 * FF * DM * 2;
constexpr size_t WS_TAB = WS_WMD + (size_t)2 * NEXP * DM * FF * 2;
constexpr size_t TAB_RC = 0, TAB_RS = (size_t)LSEQ * 64 * 4, TAB_MC = 2 * TAB_RS, TAB_MS = TAB_MC + (size_t)LSEQ * 32 * 4;
constexpr size_t WS_HRES = WS_TAB + 2 * MiB;
constexpr size_t WS_XN = WS_HRES + (size_t)MP * DM * 4;
constexpr size_t WS_TOK = WS_XN + (size_t)MP * DM * 2;
constexpr size_t WS_SORT = WS_TOK + (size_t)MP * 32;
constexpr size_t WS_XS = WS_SORT + 1 * MiB;
constexpr size_t WS_YS = WS_XS;
constexpr size_t WS_R = WS_XS + (size_t)XS_ROWS * DM * 2;
constexpr size_t R_RQ = 0, R_RK = R_RQ + (size_t)MP * 512 * 2, R_RKZ = R_RK + (size_t)MP * 512 * 2, R_RV = R_RKZ + (size_t)MP * 512 * 2, R_SG = R_RV + (size_t)MP * 512 * 2;
constexpr size_t R_LAT = R_SG + (size_t)MP * 512 * 2, R_KPE = R_LAT + (size_t)MP * 384 * 2;
constexpr size_t R_QN = R_KPE + (size_t)MP * 64 * 2, R_QPE = R_QN + (size_t)MP * 512 * 2, R_KN = R_QPE + (size_t)MP * 256 * 2, R_V = R_KN + (size_t)MP * 512 * 2;
constexpr size_t R_ST = R_V + (size_t)MP * 512 * 2;
constexpr size_t R_Y = R_ST + (size_t)NB * 4 * NCH * 128 * 128 * 2;
constexpr size_t R_MIX_END = R_Y + (size_t)MP * DM * 2;
constexpr size_t R_ACT = 0;
constexpr size_t R_END = ((size_t)XS_ROWS * FF * 2 > R_MIX_END) ? (size_t)XS_ROWS * FF * 2 : R_MIX_END;
constexpr size_t WS_END = WS_R + R_END;

constexpr int RING_BYTES = 131072, LDSCTL_OFF = RING_BYTES, MISC_OFF = LDSCTL_OFF + 320, LDS_BYTES = 147456;

#define GAS __attribute__((address_space(1)))
#define LAS __attribute__((address_space(3)))
typedef unsigned short bf16;
typedef unsigned v4u __attribute__((ext_vector_type(4)));
typedef unsigned v2u __attribute__((ext_vector_type(2)));
typedef float f32x4 __attribute__((ext_vector_type(4)));
typedef float f32x16 __attribute__((ext_vector_type(16)));
typedef short bf16x8 __attribute__((ext_vector_type(8)));
typedef short s16x4 __attribute__((ext_vector_type(4)));
typedef GAS unsigned gu32;
#define RLX_AGENT __ATOMIC_RELAXED, __HIP_MEMORY_SCOPE_AGENT
#define LDS_WAIT() asm volatile("s_waitcnt lgkmcnt(0)" ::: "memory")
#define VM_WAIT() asm volatile("s_waitcnt vmcnt(0)" ::: "memory")
__device__ __forceinline__ unsigned f2bf(float f) { unsigned u = __builtin_bit_cast(unsigned, f); return (u + 0x7fffu + ((u >> 16) & 1u)) >> 16; }
__device__ __forceinline__ unsigned pk2(float lo, float hi) { return pg8::cvt_pk_bf16(lo, hi); }
__device__ __forceinline__ float bf2f(unsigned short b) { return __builtin_bit_cast(float, (unsigned)b << 16); }
template <int X> __device__ __forceinline__ float xshfl(float v) {
    if constexpr (X < 32) return __builtin_bit_cast(float, __builtin_amdgcn_ds_swizzle(__builtin_bit_cast(int, v), (X << 10) | 0x1f));
    else { const unsigned u = __builtin_bit_cast(unsigned, v); auto r = __builtin_amdgcn_permlane32_swap(u, u, false, false); const unsigned a = r[0], b = r[1]; return __builtin_bit_cast(float, a == u ? b : a); }
}
template <int X> __device__ __forceinline__ float xadd(float v) {
    if constexpr (X < 32) return v + xshfl<X>(v);
    else { const unsigned u = __builtin_bit_cast(unsigned, v); auto r = __builtin_amdgcn_permlane32_swap(u, u, false, false); return __builtin_bit_cast(float, (unsigned)r[0]) + __builtin_bit_cast(float, (unsigned)r[1]); }
}
__device__ __forceinline__ float wave_sum(float v) { v = xadd<1>(v); v = xadd<2>(v); v = xadd<4>(v); v = xadd<8>(v); v = xadd<16>(v); v = xadd<32>(v); return v; }
#define XB_TMO      128
#define XB_XCNT(j)  (256  + 64 * (j))
#define XB_XSUB(j)  (1280 + 64 * (j))
#define XB_XGEN(j)  (2304 + 64 * (j))
#define XB_TOP      3328
#define XB_TOPGEN   3392
#define XCD_BAR_WORDS 3456
#define XB_SPIN_CAP (1u << 18)

__device__ __forceinline__ unsigned xb_ld(unsigned* p)              { return __hip_atomic_load(p, __ATOMIC_RELAXED, __HIP_MEMORY_SCOPE_AGENT); }
__device__ __forceinline__ unsigned xb_add(unsigned* p, unsigned v) { return __hip_atomic_fetch_add(p, v, __ATOMIC_RELAXED, __HIP_MEMORY_SCOPE_AGENT); }
__device__ __forceinline__ unsigned xb_xcc_id() { return (unsigned)__builtin_amdgcn_s_getreg((3 << 11) | 20) & 0xFu; }
#define XB_SPIN(cond, bar) do { unsigned _sp = 0; while (cond) { __builtin_amdgcn_s_sleep(1); \
    if ((++_sp & 255u) == 0u) { if (xb_ld(&(bar)[XB_TMO])) break; if (_sp > XB_SPIN_CAP) { atomicAdd(&(bar)[XB_TMO], 1u); break; } } } } while (0)

struct XcdBarrier {
    unsigned* bar; unsigned x;
    volatile LAS unsigned* st;
};

__device__ __forceinline__ XcdBarrier xcd_barrier_post(unsigned* bar, volatile LAS unsigned* st) {
    XcdBarrier b; b.bar = bar; b.x = xb_xcc_id(); b.st = st;
    if (threadIdx.x == 0) (void)xb_add(&bar[XB_XCNT(b.x)], 1u);
    return b;
}
__device__ __forceinline__ void xcd_barrier_complete(unsigned* bar, unsigned x, unsigned& nloc, unsigned& nx) {
    const unsigned G = gridDim.x * gridDim.y * gridDim.z;
    unsigned sum, cnt, mine, sp = 0u;
    for (;;) {
        sum = 0u; cnt = 0u; mine = 0u;
#pragma unroll
        for (unsigned j = 0; j < 16; ++j) { const unsigned c = xb_ld(&bar[XB_XCNT(j)]); sum += c; cnt += (c > 0u) ? 1u : 0u; }
        mine = xb_ld(&bar[XB_XCNT(x)]);
        if (sum == G) break;
        __builtin_amdgcn_s_sleep(1);
        if ((++sp & 255u) == 0u) { if (xb_ld(&bar[XB_TMO])) break; if (sp > XB_SPIN_CAP) { atomicAdd(&bar[XB_TMO], 1u); break; } }
    }
    nloc = mine > 0u ? mine : 1u; nx = cnt > 0u ? cnt : 1u;
}

__device__ __forceinline__ void xcd_barrier(const XcdBarrier& b) {
    asm volatile("s_waitcnt vmcnt(0)" ::: "memory");
    __syncthreads();
    if (threadIdx.x == 0) {
        unsigned* bar = b.bar;
        __builtin_amdgcn_s_waitcnt(0);
        unsigned nloc = b.st[0], nx = b.st[1];
        if (nloc == 0u) { xcd_barrier_complete(bar, b.x, nloc, nx); b.st[0] = nloc; b.st[1] = nx; }
        const unsigned old = xb_add(&bar[XB_XSUB(b.x)], 1u);
        const unsigned gen = old / nloc;
        if (old + 1u == (gen + 1u) * nloc) {
            __builtin_amdgcn_fence(__ATOMIC_RELEASE, "agent");
            asm volatile("s_waitcnt vmcnt(0)" ::: "memory");
            const unsigned og = xb_add(&bar[XB_TOP], 1u);
            const unsigned tg = og / nx;
            if (og + 1u == (tg + 1u) * nx) xb_add(&bar[XB_TOPGEN], 1u);
            else XB_SPIN(xb_ld(&bar[XB_TOPGEN]) == tg, bar);
            __builtin_amdgcn_fence(__ATOMIC_ACQUIRE, "agent");
            xb_add(&bar[XB_XGEN(b.x)], 1u);
            asm volatile("s_waitcnt vmcnt(0)" ::: "memory");
        } else {
            XB_SPIN(xb_ld(&bar[XB_XGEN(b.x)]) == gen, bar);
            __builtin_amdgcn_fence(__ATOMIC_ACQUIRE, "agent");
            asm volatile("s_waitcnt vmcnt(0)" ::: "memory");
        }
    }
    __syncthreads();
}

struct Frame {
    LAS unsigned char* lds;
    volatile LAS unsigned* MISC;
    gu32* ctl;
    int tid, lane, wave, vcu, G;
    unsigned char* ws;
};
struct Inputs { const float* p[20]; };
__device__ __forceinline__ const float* ldin(int k) { unsigned long long v = 0;
#if defined(__HIP_DEVICE_COMPILE__)
    auto ka = __builtin_amdgcn_kernarg_segment_ptr();
    asm volatile("s_load_dwordx2 %0, %1, %2\n\ts_waitcnt lgkmcnt(0)" : "=s"(v) : "s"(ka), "n"(k * 8));
#endif
    return (const float*)v; }
enum { I_X = 0, I_META, I_ATTN_NORM, I_WIN, I_QNORM, I_WUQ, I_KVNORM, I_WUKV, I_RETG, I_MLAG, I_WOUT, I_FFNNORM, I_DWG, I_DWU, I_DWD, I_ROUTER, I_MWG, I_MWU, I_MWD, I_FINAL };

__device__ __forceinline__ int chunk_idx(int p) { return p < NMETA ? 48 + p : ((p - NMETA) & 63); }
__device__ __forceinline__ float log2_gamma(int h) { return h == 0 ? -0.045803689613124755f : h == 1 ? -0.022720076500083562f : h == 2 ? -0.011315313227834085f : -0.005646563141142062f; }

__device__ __forceinline__ void transpose_item(const float* Wcol, int ldw, int krow0, const float* scale, bf16* WT, int Kdst, int k0dst, int n0, int lane) {
    const int sg = lane & 7, kr = lane >> 3;
    f32x4 v[8];
#pragma unroll
    for (int i = 0; i < 8; ++i) v[i] = (f32x4){0.f, 0.f, 0.f, 0.f};
    if (Wcol) {
        const GAS float* src = (const GAS float*)Wcol + (size_t)(krow0 + 8 * kr) * ldw;
#pragma unroll
        for (int i = 0; i < 8; ++i) v[i] = *(const GAS f32x4*)(src + (size_t)i * ldw);
        if (scale) { const f32x4 s0 = *(const GAS f32x4*)(scale + krow0 + 8 * kr), s1 = *(const GAS f32x4*)(scale + krow0 + 8 * kr + 4);
            v[0] *= s0.x; v[1] *= s0.y; v[2] *= s0.z; v[3] *= s0.w; v[4] *= s1.x; v[5] *= s1.y; v[6] *= s1.z; v[7] *= s1.w; }
    }
    GAS bf16* dst = (GAS bf16*)WT + (size_t)(n0 + 4 * sg) * Kdst + k0dst + 8 * kr;
#pragma unroll
    for (int q = 0; q < 4; ++q) { v4u o; o.x = pk2(v[0][q], v[1][q]); o.y = pk2(v[2][q], v[3][q]); o.z = pk2(v[4][q], v[5][q]); o.w = pk2(v[6][q], v[7][q]);
        *(GAS v4u*)(dst + (size_t)q * Kdst) = o; }
}
__device__ __forceinline__ int slot_o8(int t) { return (t & 0x60) | ((t & 0xC) << 1) | ((t & 0x10) >> 2) | (t & 3); }
__device__ __forceinline__ int win_col(int s) {
    const int pn = s >> 8, t = s & 255, bj = t >> 7, t7 = t & 127, wc = (t >> 5) & 3, n = (t >> 4) & 1, fq = (t >> 2) & 3, i = t & 3;
    if (pn < 4) return (pn >> 1) * 512 + (2 * (pn & 1) + bj) * 128 + 16 * wc + 4 * fq + i + 64 * n;
    if (pn < 8) return 1024 + ((pn - 4) >> 1) * 512 + (pn & 1) * 256 + 128 * bj + slot_o8(t7);
    if (pn == 8) return 2048 + 128 * bj + slot_o8(t7);
    if (bj == 0) return 2304 + slot_o8(t7);
    if (wc < 2) return 2432 + 16 * wc + 4 * fq + i + 32 * n;
    return -1;
}
__device__ __forceinline__ int wup_col(int s, bool& is_kv) {
    const int pn = s >> 8, t = s & 255, bj = t >> 7, t7 = t & 127, wc = (t >> 5) & 3, n = (t >> 4) & 1, fq = (t >> 2) & 3, i = t & 3;
    if (pn < 2) { is_kv = false; const int o = 256 * pn + 128 * bj + slot_o8(t7); return (o >> 7) * 192 + (o & 127); }
    if (pn == 2) { is_kv = false; const int hq = 2 * bj + (wc >> 1); return hq * 192 + 128 + 16 * (wc & 1) + 4 * fq + i + 32 * n; }
    is_kv = true;
    if (pn < 5) { const int o = 256 * (pn - 3) + 128 * bj + slot_o8(t7); return (o >> 7) * 256 + (o & 127); }
    { const int o = 256 * (pn - 5) + 128 * bj + slot_o8(t7); return (o >> 7) * 256 + 128 + (o & 127); }
}
__device__ __forceinline__ void sincos_d(double x, float& s, float& c) {
    const double k = __builtin_rint(x * 0.63661977236758134308);
    const double y = (x - k * 1.5707963267948966) - k * 6.123233995736766e-17;
    const double y2 = y * y;
    const double sn = y * (1.0 + y2 * (-1.0 / 6 + y2 * (1.0 / 120 + y2 * (-1.0 / 5040 + y2 * (1.0 / 362880 + y2 * (-1.0 / 39916800 + y2 * (1.0 / 6227020800.0)))))));
    const double cs = 1.0 + y2 * (-0.5 + y2 * (1.0 / 24 + y2 * (-1.0 / 720 + y2 * (1.0 / 40320 + y2 * (-1.0 / 3628800 + y2 * (1.0 / 479001600.0 + y2 * (-1.0 / 87178291200.0)))))));
    const int q = (int)((long long)k & 3);
    const double ss = (q & 1) ? cs : sn, cc = (q & 1) ? sn : cs;
    s = (float)((q & 2) ? -ss : ss); c = (float)(((q + 1) & 2) ? -cc : cc);
}
__device__ __forceinline__ void p0_prologue(Frame& F) {
    const int gw = F.vcu * NWAVES + F.wave, NGW = F.G * NWAVES, lane = F.lane;
    float* hres = (float*)(F.ws + WS_HRES);
    for (int r = gw; r < MP; r += NGW) {
        GAS f32x4* o = (GAS f32x4*)(hres + (size_t)r * DM) + lane;
        if (r < M) { const int b = r / LSEQ, p = r - b * LSEQ;
            const GAS f32x4* src = (const GAS f32x4*)(p < NMETA ? ldin(I_META) + (size_t)p * DM : ldin(I_X) + ((size_t)b * SEQ + (p - NMETA)) * DM) + lane;
#pragma unroll
            for (int j = 0; j < 4; ++j) o[64 * j] = src[64 * j]; }
        else {
#pragma unroll
            for (int j = 0; j < 4; ++j) o[64 * j] = (f32x4){0.f, 0.f, 0.f, 0.f}; }
    }
    { float* tab = (float*)(F.ws + WS_TAB);
      const int gt = gw * 64 + lane, NT = NGW * 64;
      for (int t = gt; t < LSEQ * 64; t += NT) { const int p = t >> 6, i = t & 63; const float inv = exp2f(-(float)(2 * i) * (13.287712379549449f / 128.0f)); const float ang = (float)p * inv;
          float s, c; sincos_d((double)ang, s, c); tab[TAB_RC / 4 + t] = c; tab[TAB_RS / 4 + t] = s; }
      for (int t = gt; t < LSEQ * 32; t += NT) { const int p = t >> 5, i = t & 31; const float inv = exp2f(-(float)(2 * i) * (13.287712379549449f / 64.0f)); const float ang = (float)p * inv;
          float s, c; sincos_d((double)ang, s, c); tab[TAB_MC / 4 + t] = c; tab[TAB_MS / 4 + t] = s; }
    }
    constexpr int I_IN = DEPTH * 16 * 80, I_UP = DEPTH * 6 * 56, I_OUT = DEPTH * 16 * 32, I_DGU = 2 * 16 * 224, I_DD = 2 * 56 * 32, I_MGU = 16 * 16 * 224, I_MD = 16 * 56 * 32;
    constexpr int NITEMS = I_IN + I_UP + I_OUT + I_DGU + I_DD + I_MGU + I_MD;
    for (int it = gw; it < NITEMS; it += NGW) {
        int r = it;
        if (r < I_IN) { const int l = r / 1280, q = r % 1280, kb = q / 80, nb = q % 80; const int col = win_col(nb * 32 + 4 * (lane & 7));
            const float* W = ldin(I_WIN) + (size_t)l * DM * 2496;
            transpose_item(col >= 0 ? W + col : nullptr, 2496, kb * 64, ldin(I_ATTN_NORM) + l * DM, (bf16*)(F.ws + WS_WIN) + (size_t)l * DINP * DM, DM, kb * 64, nb * 32, lane); continue; }
        r -= I_IN;
        if (r < I_UP) { const int l = r / 336, q = r % 336, kb = q / 56, nb = q % 56; bool is_kv; const int col = wup_col(nb * 32 + 4 * (lane & 7), is_kv);
            const float* Wc = nullptr; const float* sc = nullptr; int ldw = 0, k0 = 0;
            if (!is_kv && kb < 4) { Wc = ldin(I_WUQ) + (size_t)l * 256 * 768 + col; sc = ldin(I_QNORM) + l * 256; ldw = 768; k0 = kb * 64; }
            if (is_kv && kb >= 4) { Wc = ldin(I_WUKV) + (size_t)l * 128 * 1024 + col; sc = ldin(I_KVNORM) + l * 128; ldw = 1024; k0 = (kb - 4) * 64; }
            transpose_item(Wc, ldw, k0, sc, (bf16*)(F.ws + WS_WUP) + (size_t)l * UPN * UPK, UPK, kb * 64, nb * 32, lane); continue; }
        r -= I_UP;
        if (r < I_OUT) { const int l = r / 512, q = r % 512, kb = q / 32, nb = q % 32;
            transpose_item(ldin(I_WOUT) + (size_t)l * DM * DM + nb * 32 + 4 * (lane & 7), DM, kb * 64, nullptr, (bf16*)(F.ws + WS_WOUT) + (size_t)l * DM * DM, DM, kb * 64, nb * 32, lane); continue; }
        r -= I_OUT;
        if (r < I_DGU + 0) { const int l = r / 3584, q = r % 3584, kb = q / 224, nb = q % 224; const int s = nb * 32 + 4 * (lane & 7), pn = s >> 8, t = s & 255;
            const float* W = ((t >> 7) ? ldin(I_DWU) : ldin(I_DWG)) + (size_t)l * DM * FF + 128 * pn + slot_o8(t & 127);
            transpose_item(W, FF, kb * 64, ldin(I_FFNNORM) + (2 * l) * DM, (bf16*)(F.ws + WS_WDGU) + (size_t)l * 2 * FF * DM, DM, kb * 64, nb * 32, lane); continue; }
        r -= I_DGU;
        if (r < I_DD) { const int l = r / 1792, q = r % 1792, kb = q / 32, nb = q % 32;
            transpose_item(ldin(I_DWD) + (size_t)l * FF * DM + nb * 32 + 4 * (lane & 7), DM, kb * 64, nullptr, (bf16*)(F.ws + WS_WDD) + (size_t)l * DM * FF, FF, kb * 64, nb * 32, lane); continue; }
        r -= I_DD;
        if (r < I_MGU) { const int le = r / 3584, q = r % 3584, kb = q / 224, nb = q % 224; const int s = nb * 32 + 4 * (lane & 7), pn = s >> 8, t = s & 255;
            const float* W = ((t >> 7) ? ldin(I_MWU) : ldin(I_MWG)) + (size_t)le * DM * FF + 128 * pn + slot_o8(t & 127);
            transpose_item(W, FF, kb * 64, ldin(I_FFNNORM) + (2 * (le >> 3) + 1) * DM, (bf16*)(F.ws + WS_WMGU) + (size_t)le * 2 * FF * DM, DM, kb * 64, nb * 32, lane); continue; }
        r -= I_MGU;
        { const int le = r / 1792, q = r % 1792, kb = q / 32, nb = q % 32;
            transpose_item(ldin(I_MWD) + (size_t)le * FF * DM + nb * 32 + 4 * (lane & 7), DM, kb * 64, nullptr, (bf16*)(F.ws + WS_WMD) + (size_t)le * DM * FF, FF, kb * 64, nb * 32, lane); }
    }
}

typedef pg8::f32x4 af4;
__device__ __forceinline__ v4u pack8(af4 a, af4 b) { v4u w; w.x = pk2(a[0], a[1]); w.y = pk2(a[2], a[3]); w.z = pk2(b[0], b[1]); w.w = pk2(b[2], b[3]); return w; }
__device__ __forceinline__ float silu_f(float x) { return x * __builtin_amdgcn_rcpf(1.0f + __builtin_amdgcn_exp2f(-1.4426950408889634f * x)); }

struct EpiInProj {
    static constexpr bool PERM = false, AFTER_DRAIN = false;
    unsigned char* R; float* ssq; float* sskv; const float* tab; float lg0, lg1, lg2, lg3;
    __device__ __forceinline__ void operator()(const af4 (&acc)[2][2][4][2], const pg8::Unit& u, int wr, int wc, int fr, int fq) const {
        const int pn = u.pn; const float lgs[2] = {(pn & 1) ? lg2 : lg0, (pn & 1) ? lg3 : lg1};
#pragma unroll
        for (int ai = 0; ai < 2; ++ai)
#pragma unroll
            for (int m = 0; m < 4; ++m) {
                const int row = u.pm * 256 + ai * 128 + wr * 64 + m * 16 + fr; const int b = row / LSEQ, p = row - b * LSEQ; const bool ok = row < M;
                const int pp = ok ? p : 0;
                if (pn < 4) {
                    const af4 cs = *(const af4*)(tab + TAB_RC / 4 + pp * 64 + 16 * wc + 4 * fq), sn = *(const af4*)(tab + TAB_RS / 4 + pp * 64 + 16 * wc + 4 * fq);
#pragma unroll
                    for (int bj = 0; bj < 2; ++bj) { const int h = 2 * (pn & 1) + bj; const af4 t1 = acc[ai][bj][m][0], t2 = acc[ai][bj][m][1];
                        af4 o1 = t1 * cs - t2 * sn, o2 = t1 * sn + t2 * cs; const size_t off = ((size_t)row * 512 + h * 128 + 32 * wc + 8 * fq) * 2;
                        if (pn < 2) { o1 *= 0.08838834764831845f; o2 *= 0.08838834764831845f; *(v4u*)(R + R_RQ + off) = pack8(o1, o2); }
                        else { *(v4u*)(R + R_RK + off) = pack8(o1, o2); const float z = __builtin_amdgcn_exp2f(lgs[bj] * (float)(63 - chunk_idx(pp))); *(v4u*)(R + R_RKZ + off) = pack8(o1 * z, o2 * z); } }
                } else if (pn < 6) {
#pragma unroll
                    for (int bj = 0; bj < 2; ++bj) *(v4u*)(R + R_RV + ((size_t)row * 512 + (pn & 1) * 256 + 128 * bj + 32 * wc + 8 * fq) * 2) = pack8(acc[ai][bj][m][0], acc[ai][bj][m][1]);
                } else if (pn < 8) {
#pragma unroll
                    for (int bj = 0; bj < 2; ++bj) { af4 a = acc[ai][bj][m][0], c = acc[ai][bj][m][1];
#pragma unroll
                        for (int j = 0; j < 4; ++j) { a[j] = silu_f(a[j]); c[j] = silu_f(c[j]); }
                        *(v4u*)(R + R_SG + ((size_t)row * 512 + (pn & 1) * 256 + 128 * bj + 32 * wc + 8 * fq) * 2) = pack8(a, c); }
                } else if (pn == 8) {
                    float s = 0.f;
#pragma unroll
                    for (int bj = 0; bj < 2; ++bj) { const af4 a = acc[ai][bj][m][0], c = acc[ai][bj][m][1]; s += (a[0] * a[0] + a[1] * a[1]) + (a[2] * a[2] + a[3] * a[3]) + (c[0] * c[0] + c[1] * c[1]) + (c[2] * c[2] + c[3] * c[3]);
                        *(v4u*)(R + R_LAT + ((size_t)row * 384 + 128 * bj + 32 * wc + 8 * fq) * 2) = pack8(a, c); }
                    s = xadd<16>(s); s = xadd<32>(s);
                    if (fq == 0) ssq[row * 4 + wc] = s;
                } else {
                    { const af4 a = acc[ai][0][m][0], c = acc[ai][0][m][1]; float s = (a[0] * a[0] + a[1] * a[1]) + (a[2] * a[2] + a[3] * a[3]) + (c[0] * c[0] + c[1] * c[1]) + (c[2] * c[2] + c[3] * c[3]);
                      *(v4u*)(R + R_LAT + ((size_t)row * 384 + 256 + 32 * wc + 8 * fq) * 2) = pack8(a, c);
                      s = xadd<16>(s); s = xadd<32>(s);
                      if (fq == 0) sskv[row * 4 + wc] = s; }
                    if (wc < 2) { const af4 cs = *(const af4*)(tab + TAB_MC / 4 + pp * 32 + 16 * wc + 4 * fq), sn = *(const af4*)(tab + TAB_MS / 4 + pp * 32 + 16 * wc + 4 * fq);
                        const af4 t1 = acc[ai][1][m][0], t2 = acc[ai][1][m][1];
                        *(v4u*)(R + R_KPE + ((size_t)row * 64 + 32 * wc + 8 * fq) * 2) = pack8(t1 * cs - t2 * sn, t1 * sn + t2 * cs); }
                }
                asm volatile("" ::: "memory");
            }
    }
};
constexpr float QSCALE = 0.07216878364870323f * 1.4426950408889634f;
struct EpiUp {
    static constexpr bool PERM = false, AFTER_DRAIN = false;
    unsigned char* R; const float* ssq; const float* sskv; const float* tab;
    __device__ __forceinline__ void operator()(const af4 (&acc)[2][2][4][2], const pg8::Unit& u, int wr, int wc, int fr, int fq) const {
        const int pn = u.pn;
#pragma unroll
        for (int ai = 0; ai < 2; ++ai)
#pragma unroll
            for (int m = 0; m < 4; ++m) {
                const int row = u.pm * 256 + ai * 128 + wr * 64 + m * 16 + fr; const int b = row / LSEQ, p = row - b * LSEQ; const int pp = row < M ? p : 0;
                if (pn < 3) { const af4 q4 = *(const af4*)(ssq + row * 4); const float sc = QSCALE * __builtin_amdgcn_rsqf(((q4[0] + q4[1]) + (q4[2] + q4[3])) * (1.0f / 256.0f) + EPS);
                    if (pn < 2) {
#pragma unroll
                        for (int bj = 0; bj < 2; ++bj) *(v4u*)(R + R_QN + ((size_t)row * 512 + 256 * pn + 128 * bj + 32 * wc + 8 * fq) * 2) = pack8(acc[ai][bj][m][0] * sc, acc[ai][bj][m][1] * sc);
                    } else { const af4 cs = *(const af4*)(tab + TAB_MC / 4 + pp * 32 + 16 * (wc & 1) + 4 * fq), sn = *(const af4*)(tab + TAB_MS / 4 + pp * 32 + 16 * (wc & 1) + 4 * fq);
#pragma unroll
                        for (int bj = 0; bj < 2; ++bj) { const int hq = 2 * bj + (wc >> 1); const af4 t1 = acc[ai][bj][m][0] * sc, t2 = acc[ai][bj][m][1] * sc;
                            *(v4u*)(R + R_QPE + ((size_t)row * 256 + hq * 64 + 32 * (wc & 1) + 8 * fq) * 2) = pack8(t1 * cs - t2 * sn, t1 * sn + t2 * cs); } }
                } else { const af4 q4 = *(const af4*)(sskv + row * 4); const float sc = __builtin_amdgcn_rsqf(((q4[0] + q4[1]) + (q4[2] + q4[3])) * (1.0f / 128.0f) + EPS); const size_t base = pn < 5 ? R_KN : R_V; const int t0 = pn < 5 ? pn - 3 : pn - 5;
#pragma unroll
                    for (int bj = 0; bj < 2; ++bj) *(v4u*)(R + base + ((size_t)row * 512 + 256 * t0 + 128 * bj + 32 * wc + 8 * fq) * 2) = pack8(acc[ai][bj][m][0] * sc, acc[ai][bj][m][1] * sc);
                }
                asm volatile("" ::: "memory");
            }
    }
};
struct EpiResid {
    static constexpr bool PERM = false, AFTER_DRAIN = false;
    float* H;
    __device__ __forceinline__ void operator()(const af4 (&acc)[2][2][4][2], const pg8::Unit& u, int wr, int wc, int fr, int fq) const {
        const int row0 = u.pm * 256 + wr * 64 + fr, col0 = u.pn * 256 + wc * 32 + 4 * fq;
#pragma unroll
        for (int ai = 0; ai < 2; ++ai)
#pragma unroll
            for (int m = 0; m < 4; ++m) { float* rowp = H + (size_t)(row0 + ai * 128 + m * 16) * DM + col0;
#pragma unroll
                for (int bj = 0; bj < 2; ++bj)
#pragma unroll
                    for (int n = 0; n < 2; ++n) { af4* q = (af4*)(rowp + bj * 128 + n * 16); *q = *q + acc[ai][bj][m][n]; } }
    }
};
struct EpiSwiGLU {
    static constexpr bool PERM = false, AFTER_DRAIN = false;
    bf16* A;
    __device__ __forceinline__ void operator()(const af4 (&acc)[2][2][4][2], const pg8::Unit& u, int wr, int wc, int fr, int fq) const {
        const int row0 = u.pm * 256 + wr * 64 + fr, col0 = u.pn * 128 + wc * 32 + 8 * fq;
#pragma unroll
        for (int ai = 0; ai < 2; ++ai)
#pragma unroll
            for (int m = 0; m < 4; ++m) { af4 a = acc[ai][0][m][0], c = acc[ai][0][m][1]; const af4 ua = acc[ai][1][m][0], uc = acc[ai][1][m][1];
#pragma unroll
                for (int j = 0; j < 4; ++j) { a[j] = silu_f(a[j]) * ua[j]; c[j] = silu_f(c[j]) * uc[j]; }
                *(v4u*)(A + (size_t)(row0 + ai * 128 + m * 16) * FF + col0) = pack8(a, c); }
    }
};
struct EpiMoeDown {
    static constexpr bool PERM = false, AFTER_DRAIN = false;
    bf16* Y;
    __device__ __forceinline__ void operator()(const af4 (&acc)[2][2][4][2], const pg8::Unit& u, int wr, int wc, int fr, int fq) const {
        const int row0 = u.pm * 256 + wr * 64 + fr, col0 = u.pn * 256 + wc * 32 + 4 * fq;
#pragma unroll
        for (int ai = 0; ai < 2; ++ai)
#pragma unroll
            for (int m = 0; m < 4; ++m) { bf16* rowp = Y + (size_t)(row0 + ai * 128 + m * 16) * DM + col0;
#pragma unroll
                for (int bj = 0; bj < 2; ++bj)
#pragma unroll
                    for (int n = 0; n < 2; ++n) { const af4 a = acc[ai][bj][m][n]; v2u w; w.x = pk2(a[0], a[1]); w.y = pk2(a[2], a[3]); *(v2u*)(rowp + bj * 128 + n * 16) = w; } }
    }
};

__device__ __forceinline__ int expert_base(const unsigned* cnt, int e) { int acc = 0;
#pragma unroll
    for (int k = 0; k < 7; ++k) acc += (k < e) ? (int)((cnt[k] + 255u) & ~255u) : 0;
    return acc; }
__device__ __forceinline__ void load_row(Frame& F, float* hres, int r, bool moe_prev, const unsigned* cnt, f32x4 (&v)[4]) {
    GAS f32x4* xr = (GAS f32x4*)(hres + (size_t)r * DM) + F.lane;
#pragma unroll
    for (int j = 0; j < 4; ++j) v[j] = xr[64 * j];
    if (moe_prev) {
        const int* ti = (const int*)(F.ws + WS_TOK) + (size_t)r * 8; const int e1 = ti[0], e2 = ti[1], s1 = ti[2], s2 = ti[3]; const float w1 = __builtin_bit_cast(float, ti[4]), w2 = __builtin_bit_cast(float, ti[5]);
        const GAS v2u* y1 = (const GAS v2u*)((const bf16*)(F.ws + WS_YS) + (size_t)(expert_base(cnt, e1) + s1) * DM) + F.lane;
        const GAS v2u* y2 = (const GAS v2u*)((const bf16*)(F.ws + WS_YS) + (size_t)(expert_base(cnt, e2) + s2) * DM) + F.lane;
#pragma unroll
        for (int j = 0; j < 4; ++j) { const v2u a = y1[64 * j], c = y2[64 * j];
            v[j].x += w1 * __builtin_bit_cast(float, a.x << 16) + w2 * __builtin_bit_cast(float, c.x << 16);
            v[j].y += w1 * __builtin_bit_cast(float, a.x & 0xffff0000u) + w2 * __builtin_bit_cast(float, c.x & 0xffff0000u);
            v[j].z += w1 * __builtin_bit_cast(float, a.y << 16) + w2 * __builtin_bit_cast(float, c.y << 16);
            v[j].w += w1 * __builtin_bit_cast(float, a.y & 0xffff0000u) + w2 * __builtin_bit_cast(float, c.y & 0xffff0000u);
            xr[64 * j] = v[j]; }
    }
}
__device__ __forceinline__ float row_rstd(const f32x4 (&v)[4]) { float s = 0.f;
#pragma unroll
    for (int j = 0; j < 4; ++j) s += (v[j].x * v[j].x + v[j].y * v[j].y) + (v[j].z * v[j].z + v[j].w * v[j].w);
    return __builtin_amdgcn_rsqf(wave_sum(s) * (1.0f / DM) + EPS); }
__device__ __forceinline__ void store_xn(Frame& F, int r, const f32x4 (&v)[4], float rstd) {
    GAS v2u* o = (GAS v2u*)((bf16*)(F.ws + WS_XN) + (size_t)r * DM) + F.lane;
#pragma unroll
    for (int j = 0; j < 4; ++j) { v2u w; w.x = pk2(v[j].x * rstd, v[j].y * rstd); w.y = pk2(v[j].z * rstd, v[j].w * rstd); o[64 * j] = w; }
}
__device__ __forceinline__ void norm_phase(Frame& F, bool moe_prev, const unsigned* cnt_prev) {
    const int gw = F.vcu * NWAVES + F.wave, NGW = F.G * NWAVES; float* hres = (float*)(F.ws + WS_HRES);
    for (int r = gw; r < M; r += NGW) { f32x4 v[4]; load_row(F, hres, r, moe_prev, cnt_prev, v); store_xn(F, r, v, row_rstd(v)); }
}
__device__ __forceinline__ void route_phase(Frame& F, const float* gain, const float* router_w, unsigned* cnt) {
    const int gw = F.vcu * NWAVES + F.wave, NGW = F.G * NWAVES; float* hres = (float*)(F.ws + WS_HRES);
    LAS float* rw = (LAS float*)F.lds;
    for (int i = F.tid; i < DM * NEXP / 4; i += NWAVES * 64) ((LAS f32x4*)rw)[i] = ((const f32x4*)router_w)[i];
    __syncthreads();
    for (int r = gw; r < M; r += NGW) {
        f32x4 v[4]; load_row(F, hres, r, false, cnt, v); const float rstd = row_rstd(v); store_xn(F, r, v, rstd);
        float lg[8];
#pragma unroll
        for (int e = 0; e < 8; ++e) lg[e] = 0.f;
#pragma unroll
        for (int j = 0; j < 4; ++j) { const int k0 = 4 * F.lane + 256 * j; const f32x4 g = *(const f32x4*)(gain + k0);
            const float hv[4] = {v[j].x * rstd * g.x, v[j].y * rstd * g.y, v[j].z * rstd * g.z, v[j].w * rstd * g.w};
#pragma unroll
            for (int t = 0; t < 4; ++t) { const f32x4 wa = *(const LAS f32x4*)(rw + (k0 + t) * 8), wb = *(const LAS f32x4*)(rw + (k0 + t) * 8 + 4);
                lg[0] += hv[t] * wa.x; lg[1] += hv[t] * wa.y; lg[2] += hv[t] * wa.z; lg[3] += hv[t] * wa.w; lg[4] += hv[t] * wb.x; lg[5] += hv[t] * wb.y; lg[6] += hv[t] * wb.z; lg[7] += hv[t] * wb.w; } }
#pragma unroll
        for (int e = 0; e < 8; ++e) lg[e] = wave_sum(lg[e]);
        int e1 = 0; float v1 = lg[0];
#pragma unroll
        for (int e = 1; e < 8; ++e) if (lg[e] > v1) { v1 = lg[e]; e1 = e; }
        int e2 = -1; float v2 = -3.0e38f;
#pragma unroll
        for (int e = 0; e < 8; ++e) if (e != e1 && (e2 < 0 || lg[e] > v2)) { v2 = lg[e]; e2 = e; }
        const float w2 = 1.0f / (1.0f + __expf(v1 - v2)), w1 = 1.0f - w2;
        if (F.lane == 0) { const int s1 = (int)__hip_atomic_fetch_add(cnt + e1, 1u, RLX_AGENT), s2 = (int)__hip_atomic_fetch_add(cnt + e2, 1u, RLX_AGENT);
            int* ti = (int*)(F.ws + WS_TOK) + (size_t)r * 8; ti[0] = e1; ti[1] = e2; ti[2] = s1; ti[3] = s2; ti[4] = __builtin_bit_cast(int, w1); ti[5] = __builtin_bit_cast(int, w2); }
    }
}
__device__ __forceinline__ void gather_phase(Frame& F, const unsigned* cnt) {
    const int gw = F.vcu * NWAVES + F.wave, NGW = F.G * NWAVES;
    for (int r = gw; r < M; r += NGW) {
        const int* ti = (const int*)(F.ws + WS_TOK) + (size_t)r * 8; const int e1 = ti[0], e2 = ti[1], s1 = ti[2], s2 = ti[3];
        const GAS v4u* src = (const GAS v4u*)((const bf16*)(F.ws + WS_XN) + (size_t)r * DM) + F.lane;
        GAS v4u* d1 = (GAS v4u*)((bf16*)(F.ws + WS_XS) + (size_t)(expert_base(cnt, e1) + s1) * DM) + F.lane;
        GAS v4u* d2 = (GAS v4u*)((bf16*)(F.ws + WS_XS) + (size_t)(expert_base(cnt, e2) + s2) * DM) + F.lane;
        const v4u a = src[0], c = src[64]; d1[0] = a; d1[64] = c; d2[0] = a; d2[64] = c;
    }
    for (int e = 0; e < 8; ++e) { const int c0 = (int)cnt[e], c1 = (c0 + 255) & ~255, b0 = expert_base(cnt, e);
        for (int q = c0 + gw; q < c1; q += NGW) { GAS v4u* d = (GAS v4u*)((bf16*)(F.ws + WS_XS) + (size_t)(b0 + q) * DM) + F.lane; d[0] = (v4u){0u, 0u, 0u, 0u}; d[64] = (v4u){0u, 0u, 0u, 0u}; } }
}
__device__ __forceinline__ void final_phase(Frame& F, const float* gain, float* out, const unsigned* cnt_prev) {
    const int gw = F.vcu * NWAVES + F.wave, NGW = F.G * NWAVES; float* hres = (float*)(F.ws + WS_HRES);
    for (int q = gw; q < NB * SEQ; q += NGW) { const int b = q >> 11, s = q & 2047, r = b * LSEQ + NMETA + s;
        f32x4 v[4]; load_row(F, hres, r, true, cnt_prev, v); const float rstd = row_rstd(v);
        GAS f32x4* o = (GAS f32x4*)(out + (size_t)q * DM) + F.lane;
#pragma unroll
        for (int j = 0; j < 4; ++j) { const f32x4 g = *(const f32x4*)(gain + 4 * F.lane + 256 * j); o[64 * j] = (f32x4){v[j].x * rstd * g.x, v[j].y * rstd * g.y, v[j].z * rstd * g.z, v[j].w * rstd * g.w}; }
    }
}

typedef short v4i16_t __attribute__((ext_vector_type(4)));
__device__ __forceinline__ s16x4 vtr(const LAS unsigned char* p) { return __builtin_bit_cast(s16x4, __builtin_amdgcn_ds_read_tr16_b64_v4i16((LAS v4i16_t*)p)); }
#define MFMA16(a, b, c) __builtin_amdgcn_mfma_f32_16x16x32_bf16((a), (b), (c), 0, 0, 0)
#define CAT8(L, H) (bf16x8){L[0], L[1], L[2], L[3], H[0], H[1], H[2], H[3]}
__device__ __forceinline__ void ret_state_unit(Frame& F, int unit) {
    const int b = unit >> 5, h = (unit >> 3) & 3, es = unit & 7;
    int tid_ = threadIdx.x; asm volatile("" : "+v"(tid_));
    const int tid = tid_, lane = tid & 63, w = __builtin_amdgcn_readfirstlane(tid >> 6), l15 = lane & 15, kg = lane >> 4, q = l15 >> 2, p_ = l15 & 3;
    const float g64 = exp2f(64.0f * log2_gamma(h));
    const bf16* rkz = (const bf16*)(F.ws + WS_R + R_RKZ) + (size_t)b * LSEQ * 512 + h * 128;
    const bf16* rv = (const bf16*)(F.ws + WS_R + R_RV) + (size_t)b * LSEQ * 512 + h * 128 + es * 16;
    bf16* ST = (bf16*)(F.ws + WS_R + R_ST) + (size_t)((b * 4 + h) * NCH) * 16384;
    LAS unsigned char* KZ = F.lds; LAS unsigned char* VS = F.lds + 32768;
    v4u k0r, k1r, vr;
#define RS_LOAD(c) do { const int p0 = (c) == 0 ? 0 : NMETA + 64 * ((c) - 1); \
        k0r = *(const GAS v4u*)(rkz + (size_t)(p0 + (tid >> 4)) * 512 + (tid & 15) * 8); k1r = *(const GAS v4u*)(rkz + (size_t)(p0 + 32 + (tid >> 4)) * 512 + (tid & 15) * 8); \
        vr = (v4u){0u, 0u, 0u, 0u}; if (tid < 128 && ((c) != 0 || (tid >> 1) < NMETA)) vr = *(const GAS v4u*)(rv + (size_t)(p0 + (tid >> 1)) * 512 + (tid & 1) * 8); } while (0)
#define RS_WRITE(buf) do { *(LAS v4u*)(KZ + (buf) * 16384 + (tid >> 4) * 256 + (tid & 15) * 16) = k0r; *(LAS v4u*)(KZ + (buf) * 16384 + (32 + (tid >> 4)) * 256 + (tid & 15) * 16) = k1r; \
        if (tid < 128) *(LAS v4u*)(VS + (buf) * 2048 + (tid >> 1) * 32 + (tid & 1) * 16) = vr; } while (0)
    RS_LOAD(0); RS_WRITE(0); __syncthreads();
    af4 S = {0.f, 0.f, 0.f, 0.f};
    for (int c = 0; c <= 32; ++c) {
        { v2u o; o.x = pk2(S[0], S[1]); o.y = pk2(S[2], S[3]); *(GAS v2u*)(ST + (size_t)c * 16384 + (es * 16 + l15) * 128 + w * 16 + 4 * kg) = o; }
        if (c == 32) break;
        if (c + 1 < 32) RS_LOAD(c + 1);
        const LAS unsigned char* kz = KZ + (c & 1) * 16384 + w * 32 + p_ * 8; const LAS unsigned char* vs = VS + (c & 1) * 2048 + p_ * 8;
        S *= g64;
#pragma unroll
        for (int u = 0; u < 2; ++u) { const int R0 = 32 * u + 8 * kg + q;
            const s16x4 a0 = vtr(kz + R0 * 256), a1 = vtr(kz + (R0 + 4) * 256), b0 = vtr(vs + R0 * 32), b1 = vtr(vs + (R0 + 4) * 32);
            S = MFMA16(CAT8(a0, a1), CAT8(b0, b1), S); }
        if (c + 1 < 32) RS_WRITE((c + 1) & 1);
        __syncthreads();
    }
    __syncthreads();
#undef RS_LOAD
#undef RS_WRITE
}
__device__ __forceinline__ void ret_out_unit(Frame& F, int unit, const float* gain) {
    const int c = unit % NCH, bh = unit / NCH, b = bh >> 2, h = bh & 3;
    int tid_ = threadIdx.x; asm volatile("" : "+v"(tid_));
    const int tid = tid_, lane = tid & 63, w = __builtin_amdgcn_readfirstlane(tid >> 6), l15 = lane & 15, kg = lane >> 4, q = l15 >> 2, p_ = l15 & 3, it = w & 3, eh = w >> 2;
    const float lg = log2_gamma(h);
    const int p0 = c == 0 ? 0 : NMETA + 64 * (c - 1); const size_t r0 = (size_t)b * LSEQ + p0;
    const bf16* rq = (const bf16*)(F.ws + WS_R + R_RQ) + r0 * 512 + h * 128;
    const bf16* rk = (const bf16*)(F.ws + WS_R + R_RK) + r0 * 512 + h * 128;
    const bf16* rv = (const bf16*)(F.ws + WS_R + R_RV) + r0 * 512 + h * 128;
    const bf16* sg = (const bf16*)(F.ws + WS_R + R_SG) + r0 * 512 + h * 128;
    const bf16* ST = (const bf16*)(F.ws + WS_R + R_ST) + (size_t)((b * 4 + h) * NCH + c) * 16384;
    bf16* Y = (bf16*)(F.ws + WS_R + R_Y) + r0 * DM + h * 128;
    LAS unsigned char* VL = F.lds; LAS float* red = (LAS float*)(F.lds + 16384);
#pragma unroll
    for (int i = 0; i < 2; ++i) { const int idx = tid + 512 * i; *(LAS v4u*)(VL + (idx >> 4) * 256 + (idx & 15) * 16) = *(const GAS v4u*)(rv + (size_t)(idx >> 4) * 512 + (idx & 15) * 8); }
    bf16x8 qf[4];
#pragma unroll
    for (int ks = 0; ks < 4; ++ks) qf[ks] = *(const GAS bf16x8*)(rq + (size_t)(16 * it + l15) * 512 + 32 * ks + 8 * kg);
    af4 pj[4];
#pragma unroll
    for (int jt = 0; jt < 4; ++jt) { pj[jt] = (af4){0.f, 0.f, 0.f, 0.f};
#pragma unroll
        for (int ks = 0; ks < 4; ++ks) { const bf16x8 kf = *(const GAS bf16x8*)(rk + (size_t)(16 * jt + l15) * 512 + 32 * ks + 8 * kg); pj[jt] = MFMA16(kf, qf[ks], pj[jt]); } }
    bf16x8 pa[2];
    { const int il = 16 * it + l15; unsigned pw[4][2];
#pragma unroll
      for (int jt = 0; jt < 4; ++jt) { float v[4];
#pragma unroll
          for (int r = 0; r < 4; ++r) { const int jl = 16 * jt + 4 * kg + r; const int dd = il > jl ? il - jl : jl - il; float wgt = __builtin_amdgcn_exp2f(lg * (float)dd); if (c == 0 && jl >= NMETA) wgt = 0.f; v[r] = pj[jt][r] * wgt; }
          pw[jt][0] = pk2(v[0], v[1]); pw[jt][1] = pk2(v[2], v[3]); }
      pa[0] = __builtin_bit_cast(bf16x8, (v4u){pw[0][0], pw[0][1], pw[1][0], pw[1][1]}); pa[1] = __builtin_bit_cast(bf16x8, (v4u){pw[2][0], pw[2][1], pw[3][0], pw[3][1]}); }
    af4 acc[4];
#pragma unroll
    for (int et = 0; et < 4; ++et) acc[et] = (af4){0.f, 0.f, 0.f, 0.f};
    if (c > 0) {
#pragma unroll
        for (int et = 0; et < 4; ++et)
#pragma unroll
            for (int ks = 0; ks < 4; ++ks) { const bf16x8 sf = *(const GAS bf16x8*)(ST + (size_t)(64 * eh + 16 * et + l15) * 128 + 32 * ks + 8 * kg); acc[et] = MFMA16(qf[ks], sf, acc[et]); }
        float xi[4];
#pragma unroll
        for (int r = 0; r < 4; ++r) xi[r] = __builtin_amdgcn_exp2f(lg * (float)(16 * it + 4 * kg + r + 1));
#pragma unroll
        for (int et = 0; et < 4; ++et)
#pragma unroll
            for (int r = 0; r < 4; ++r) acc[et][r] *= xi[r];
    }
    __syncthreads();
#pragma unroll
    for (int et = 0; et < 4; ++et)
#pragma unroll
        for (int u = 0; u < 2; ++u) { const LAS unsigned char* vb = VL + (size_t)(32 * u + 4 * kg + q) * 256 + (64 * eh + 16 * et + 4 * p_) * 2;
            const s16x4 b0 = vtr(vb), b1 = vtr(vb + 16 * 256); acc[et] = MFMA16(pa[u], CAT8(b0, b1), acc[et]); }
    float ss[4];
#pragma unroll
    for (int r = 0; r < 4; ++r) { float s = 0.f;
#pragma unroll
        for (int et = 0; et < 4; ++et) s += acc[et][r] * acc[et][r];
        s = xadd<1>(s); s = xadd<2>(s); s = xadd<4>(s); s = xadd<8>(s); ss[r] = s; }
    if (l15 == 0) {
#pragma unroll
        for (int r = 0; r < 4; ++r) red[eh * 64 + 16 * it + 4 * kg + r] = ss[r]; }
    __syncthreads();
#pragma unroll
    for (int r = 0; r < 4; ++r) { const int il = 16 * it + 4 * kg + r; const float rstd = __builtin_amdgcn_rsqf((red[il] + red[64 + il]) * (1.0f / 128.0f) + EPS);
        if (c > 0 || il < NMETA) {
#pragma unroll
            for (int et = 0; et < 4; ++et) { const int e = 64 * eh + 16 * et + l15; const float o = acc[et][r] * rstd * gain[h * 128 + e] * bf2f(sg[(size_t)il * 512 + e]); Y[(size_t)il * DM + e] = (bf16)f2bf(o); } }
    }
    __syncthreads();
}

#define KSWZ(row, colB) ((row) * 256 + ((colB) ^ (((row) & 7) << 4)))
#define KPSWZ(row, colB) ((row) * 128 + ((colB) ^ (((row) & 7) << 4)))
#define SBAR() __builtin_amdgcn_sched_barrier(0)
__device__ __forceinline__ int crow(int r, int hi) { return (r & 3) + 8 * (r >> 2) + 4 * hi; }
__device__ __forceinline__ int v_st(int k, int c) { const int kk = (k & ~0xC) | ((k & 4) << 1) | ((k & 8) >> 1); return ((kk >> 3) * 4 + (c >> 5)) * 512 + ((kk & 7) * 32 + (c & 31)) * 2; }
__device__ __forceinline__ int v_rd_base(int lane) { return ((lane & 3) << 3) | (((lane >> 2) & 3) << 6) | (((lane >> 4) & 1) << 5) | (((lane >> 5) & 1) << 8); }
constexpr int v_rd_off(int d0, int ks, int half) { return d0 * 512 + ks * 4096 + half * 2048; }
template <int OFF> __device__ __forceinline__ s16x4 tr_read(int vb) { s16x4 r; asm volatile("ds_read_b64_tr_b16 %0, %1 offset:%2" : "=&v"(r) : "v"(vb), "i"(OFF) : "memory"); return r; }
template <int D0> __device__ __forceinline__ void pv_one(f32x16& od, int vb, bf16x8 pa0, bf16x8 pa1, bf16x8 pa2, bf16x8 pa3) {
    const s16x4 l0 = tr_read<v_rd_off(D0, 0, 0)>(vb), h0 = tr_read<v_rd_off(D0, 0, 1)>(vb), l1 = tr_read<v_rd_off(D0, 1, 0)>(vb), h1 = tr_read<v_rd_off(D0, 1, 1)>(vb);
    const s16x4 l2 = tr_read<v_rd_off(D0, 2, 0)>(vb), h2 = tr_read<v_rd_off(D0, 2, 1)>(vb), l3 = tr_read<v_rd_off(D0, 3, 0)>(vb), h3 = tr_read<v_rd_off(D0, 3, 1)>(vb);
    asm volatile("s_waitcnt lgkmcnt(0)" ::: "memory"); SBAR();
    od = __builtin_amdgcn_mfma_f32_32x32x16_bf16(pa0, CAT8(l0, h0), od, 0, 0, 0);
    od = __builtin_amdgcn_mfma_f32_32x32x16_bf16(pa1, CAT8(l1, h1), od, 0, 0, 0);
    od = __builtin_amdgcn_mfma_f32_32x32x16_bf16(pa2, CAT8(l2, h2), od, 0, 0, 0);
    od = __builtin_amdgcn_mfma_f32_32x32x16_bf16(pa3, CAT8(l3, h3), od, 0, 0, 0);
}
__device__ __forceinline__ void attn_unit(Frame& F, int b, int h, int j, const float* gain, char* lds) {
    int tid_ = threadIdx.x; asm volatile("" : "+v"(tid_));
    const int tid = tid_, wid = __builtin_amdgcn_readfirstlane(tid >> 6), lane = tid & 63, r32 = lane & 31, hi = lane >> 5;
    const unsigned char* Rb = F.ws + WS_R;
    const bf16* QN = (const bf16*)(Rb + R_QN); const bf16* QPE = (const bf16*)(Rb + R_QPE); const bf16* KN = (const bf16*)(Rb + R_KN) + h * 128; const bf16* VV = (const bf16*)(Rb + R_V) + h * 128; const bf16* KPE = (const bf16*)(Rb + R_KPE);
    char* V_lds = lds; char* K_lds = lds + 32768; char* KP_lds = lds + 65536; float* wsf = (float*)(lds + 81920) + wid * 64; float* li_l = wsf; float* al_l = wsf + 32;
    const int p0 = j < 0 ? 0 : NMETA + 256 * j; const size_t rowq = (size_t)b * LSEQ + p0 + wid * 32 + r32;
    bf16x8 qr[12];
#pragma unroll
    for (int d0 = 0; d0 < 8; ++d0) qr[d0] = *(const GAS bf16x8*)(QN + rowq * 512 + h * 128 + d0 * 16 + hi * 8);
#pragma unroll
    for (int d0 = 0; d0 < 4; ++d0) qr[8 + d0] = *(const GAS bf16x8*)(QPE + rowq * 256 + h * 64 + d0 * 16 + hi * 8);
    const int NT = j < 0 ? 1 : 4 * j + 5, my_last = j < 0 ? 0 : 1 + 4 * j + (wid >> 1);
    const int sr = tid >> 4, sc = (tid & 15) * 8, vst0 = v_st(sr, sc), vst1 = v_st(32 + sr, sc), kpr = tid >> 3, kpc = (tid & 7) * 8;
    const int vb0 = (int)(uintptr_t)V_lds + v_rd_base(lane);
    v4u vs0, vs1, ks0, ks1, kp;
#define A_LOAD(t) do { const size_t kr = (size_t)b * LSEQ + ((t) == 0 ? 0 : NMETA + 64 * ((t) - 1)); \
        vs0 = *(const GAS v4u*)(VV + (kr + sr) * 512 + sc); vs1 = *(const GAS v4u*)(VV + (kr + 32 + sr) * 512 + sc); ks0 = *(const GAS v4u*)(KN + (kr + sr) * 512 + sc); ks1 = *(const GAS v4u*)(KN + (kr + 32 + sr) * 512 + sc); \
        kp = *(const GAS v4u*)(KPE + (kr + kpr) * 64 + kpc); } while (0)
#define A_WRITE(bf) do { *(v4u*)(V_lds + (bf) * 16384 + vst0) = vs0; *(v4u*)(V_lds + (bf) * 16384 + vst1) = vs1; *(v4u*)(K_lds + (bf) * 16384 + KSWZ(sr, sc * 2)) = ks0; *(v4u*)(K_lds + (bf) * 16384 + KSWZ(32 + sr, sc * 2)) = ks1; \
        *(v4u*)(KP_lds + (bf) * 8192 + KPSWZ(kpr, kpc * 2)) = kp; } while (0)
    float m_reg = -1e30f, l_reg = 0.f; f32x16 o[4];
#pragma unroll
    for (int d = 0; d < 4; ++d)
#pragma unroll
        for (int r = 0; r < 16; ++r) o[d][r] = 0.f;
    A_LOAD(0); A_WRITE(0); __syncthreads();
    for (int t = 0; t < NT; ++t) {
        if (t > my_last && t + 1 < NT) A_LOAD(t + 1);
        if (t <= my_last) {
            const char* Kt = K_lds + (t & 1) * 16384; const char* KPt = KP_lds + (t & 1) * 8192;
            f32x16 p0v, p1v;
#pragma unroll
            for (int r = 0; r < 16; ++r) { p0v[r] = 0.f; p1v[r] = 0.f; }
#pragma unroll
            for (int d0 = 0; d0 < 8; ++d0) { const int cb = (d0 * 16 + hi * 8) * 2;
                const bf16x8 b0 = *(const bf16x8*)(Kt + KSWZ(r32, cb)), b1 = *(const bf16x8*)(Kt + KSWZ(32 + r32, cb));
                p0v = __builtin_amdgcn_mfma_f32_32x32x16_bf16(b0, qr[d0], p0v, 0, 0, 0); p1v = __builtin_amdgcn_mfma_f32_32x32x16_bf16(b1, qr[d0], p1v, 0, 0, 0); }
#pragma unroll
            for (int d0 = 0; d0 < 4; ++d0) { const int cb = (d0 * 16 + hi * 8) * 2;
                const bf16x8 b0 = *(const bf16x8*)(KPt + KPSWZ(r32, cb)), b1 = *(const bf16x8*)(KPt + KPSWZ(32 + r32, cb));
                p0v = __builtin_amdgcn_mfma_f32_32x32x16_bf16(b0, qr[8 + d0], p0v, 0, 0, 0); p1v = __builtin_amdgcn_mfma_f32_32x32x16_bf16(b1, qr[8 + d0], p1v, 0, 0, 0); }
            if (t == 0) {
#pragma unroll
                for (int r = 8; r < 16; ++r) p0v[r] = -1e30f;
#pragma unroll
                for (int r = 0; r < 16; ++r) p1v[r] = -1e30f; }
            float pmax = p0v[0];
#pragma unroll
            for (int r = 1; r < 16; ++r) pmax = fmaxf(pmax, p0v[r]);
#pragma unroll
            for (int r = 0; r < 16; ++r) pmax = fmaxf(pmax, p1v[r]);
            { auto rr = __builtin_amdgcn_permlane32_swap(__float_as_uint(pmax), __float_as_uint(pmax), false, false); pmax = fmaxf(__uint_as_float(rr[0]), __uint_as_float(rr[1])); }
            const float mn = fmaxf(m_reg, pmax), alpha = __builtin_amdgcn_exp2f(m_reg - mn); m_reg = mn;
            float ps = 0.f;
#pragma unroll
            for (int r = 0; r < 16; ++r) { p0v[r] = __builtin_amdgcn_exp2f(p0v[r] - mn); p1v[r] = __builtin_amdgcn_exp2f(p1v[r] - mn); ps += p0v[r] + p1v[r]; }
            { auto rr = __builtin_amdgcn_permlane32_swap(__float_as_uint(ps), __float_as_uint(ps), false, false); ps = __uint_as_float(rr[0]) + __uint_as_float(rr[1]); }
            l_reg = l_reg * alpha + ps;
            if (__any(alpha < 1.f)) { if (hi == 0) al_l[r32] = alpha; asm volatile("s_waitcnt lgkmcnt(0)" ::: "memory");
#pragma unroll
                for (int r = 0; r < 16; ++r) { const float a = al_l[crow(r, hi)];
#pragma unroll
                    for (int d = 0; d < 4; ++d) o[d][r] *= a; } }
            bf16x8 pa0, pa1, pa2, pa3;
#define PK4(P, BASE, OUT) do { unsigned a0 = pk2(P[BASE + 0], P[BASE + 1]), a1 = pk2(P[BASE + 2], P[BASE + 3]); \
    unsigned b0_ = pk2(P[BASE + 4], P[BASE + 5]), b1_ = pk2(P[BASE + 6], P[BASE + 7]); \
    auto r0_ = __builtin_amdgcn_permlane32_swap(a0, b0_, false, false); auto r1_ = __builtin_amdgcn_permlane32_swap(a1, b1_, false, false); \
    v4u w_ = {r0_[0], r1_[0], r0_[1], r1_[1]}; OUT = __builtin_bit_cast(bf16x8, w_); } while (0)
            PK4(p0v, 0, pa0); PK4(p0v, 8, pa1); PK4(p1v, 0, pa2); PK4(p1v, 8, pa3);
#undef PK4
            if (t + 1 < NT) A_LOAD(t + 1);
            const int vb = vb0 + (t & 1) * 16384;
            pv_one<0>(o[0], vb, pa0, pa1, pa2, pa3); pv_one<1>(o[1], vb, pa0, pa1, pa2, pa3); pv_one<2>(o[2], vb, pa0, pa1, pa2, pa3); pv_one<3>(o[3], vb, pa0, pa1, pa2, pa3);
        }
        if (t + 1 < NT) A_WRITE((t + 1) & 1);
        __syncthreads();
    }
    if (hi == 0) li_l[r32] = l_reg; asm volatile("s_waitcnt lgkmcnt(0)" ::: "memory");
    bf16* Y = (bf16*)(F.ws + WS_R + R_Y) + ((size_t)b * LSEQ + p0 + wid * 32) * DM + 512 + h * 128;
    float gn[4];
#pragma unroll
    for (int d = 0; d < 4; ++d) gn[d] = gain[h * 128 + 32 * d + r32];
#pragma unroll
    for (int r = 0; r < 16; ++r) { const int orow = crow(r, hi); const float lr = li_l[orow];
        float s = (o[0][r] * o[0][r] + o[1][r] * o[1][r]) + (o[2][r] * o[2][r] + o[3][r] * o[3][r]);
        s = xadd<1>(s); s = xadd<2>(s); s = xadd<4>(s); s = xadd<8>(s); s = xadd<16>(s);
        const float rstd = __builtin_amdgcn_rsqf(s * (1.0f / 128.0f) + EPS * lr * lr);
        if (j >= 0 || (wid == 0 && orow < NMETA)) {
#pragma unroll
            for (int d = 0; d < 4; ++d) Y[(size_t)orow * DM + 32 * d + r32] = (bf16)f2bf(o[d][r] * rstd * gn[d]); } }
    __syncthreads();
#undef A_LOAD
#undef A_WRITE
}

struct Args { Inputs in; float* out; unsigned char* ws; int phase; int pad; };
constexpr int N_ATT_UNITS = 288, N_RO_UNITS = NB * 4 * NCH;
constexpr int PH_PER_LAYER = 9, N_PHASES = 1 + DEPTH * PH_PER_LAYER + 1;

__global__ void __launch_bounds__(NWAVES * 64, 2) mk_fwd(Args args) {
    extern __shared__ __attribute__((aligned(16))) unsigned char lds[];
    Frame F;
    F.lds = (LAS unsigned char*)lds; F.MISC = (volatile LAS unsigned*)(F.lds + MISC_OFF);
    F.tid = threadIdx.x; F.lane = F.tid & 63; F.wave = __builtin_amdgcn_readfirstlane(F.tid >> 6);
    F.G = gridDim.x; { const int bx = blockIdx.x; F.vcu = (F.G % 8 == 0) ? (bx % 8) * (F.G / 8) + bx / 8 : bx; }
    F.ws = args.ws; F.ctl = (gu32*)(args.ws + WS_CTL);
    for (int u = F.tid; u < (LDS_BYTES - LDSCTL_OFF) / 4; u += NWAVES * 64) ((LAS unsigned*)(F.lds + LDSCTL_OFF))[u] = 0u;
    __syncthreads();
    XcdBarrier bar; bar.bar = (unsigned*)(F.ctl + CW_BAR); bar.x = 0; bar.st = nullptr;
    if (!MK_MULTI) bar = xcd_barrier_post((unsigned*)(F.ctl + CW_BAR), F.MISC + 8);
#define R (F.ws + WS_R)
#define tab ((const float*)(F.ws + WS_TAB))
#define hres ((float*)(F.ws + WS_HRES))
#define XN ((const pg8::bf16_t*)(F.ws + WS_XN))
    int ph = 0;
#ifndef MK_ALIGN
#define MK_ALIGN true
#endif
#ifndef MK_SP2
#define MK_SP2 true
#endif
#ifndef MK_MASK
#define MK_MASK 0xFFFFFFFFu
#endif
#define ON(k) (((MK_MASK) >> (k)) & 1u)
#ifndef MK_REP_PH
#define MK_REP_PH (-1)
#endif
#ifndef MK_REP_N
#define MK_REP_N 1
#endif
#define RUN() (MK_MULTI ? (ph == args.phase) : true)
#define SEAM() do { if (!MK_MULTI) { asm volatile("" : "+s"(bar.x)); bar.bar = (unsigned*)(F.ctl + CW_BAR); xcd_barrier(bar); } ++ph; int z_ = 0; asm volatile("" : "+v"(F.tid), "+s"(z_)); F.lane = F.tid & 63; F.wave = __builtin_amdgcn_readfirstlane(F.tid >> 6); F.ws = args.ws + z_; F.ctl = (gu32*)(F.ws + WS_CTL); } while (0)
#define REPS(k) _Pragma("unroll 1") for (int rep_ = 0; rep_ < ((k) == MK_REP_PH ? MK_REP_N : 1); ++rep_, ((rep_ < ((k) == MK_REP_PH ? MK_REP_N : 1)) ? ({ SEAM(); --ph; 0; }) : 0))

    REPS(0) if (ON(0) && RUN()) p0_prologue(F);
    SEAM();
#pragma unroll 1
    for (int l = 0; l < DEPTH; ++l) {
        const bool moe = (l & 1) != 0; const int li = l >> 1;
        unsigned* cnt = (unsigned*)(F.ctl + CW_CNT) + li * 8;
        REPS(1) if (ON(1) && RUN()) norm_phase(F, l == 2 && rep_ == 0, (const unsigned*)(F.ctl + CW_CNT));
        SEAM();
        REPS(2) if (ON(2) && RUN()) {
            pg8::Gemm g{XN, (const pg8::bf16_t*)(F.ws + WS_WIN) + (size_t)l * DINP * DM, MP, DINP, DM, 0};
            pg8::StaticOrder S; S.init(MP, DINP, F.G, (int)blockIdx.x);
            EpiInProj E{R, (float*)(F.ws + CTL_SSQ), (float*)(F.ws + CTL_SSKV), tab, log2_gamma(0), log2_gamma(1), log2_gamma(2), log2_gamma(3)};
            pg8::gemm_phase<EpiInProj, pg8::StaticOrder, MK_ALIGN, MK_SP2>(F.lds, g, S, E);
        }
        SEAM();
        REPS(3) if (ON(3) && RUN()) {
            pg8::Gemm g{(const pg8::bf16_t*)(R + R_LAT), (const pg8::bf16_t*)(F.ws + WS_WUP) + (size_t)l * UPN * UPK, MP, UPN, UPK, 0};
            pg8::StaticOrder S; S.init(MP, UPN, F.G, (int)blockIdx.x);
            EpiUp E{R, (const float*)(F.ws + CTL_SSQ), (const float*)(F.ws + CTL_SSKV), tab};
            pg8::gemm_phase<EpiUp, pg8::StaticOrder, MK_ALIGN, MK_SP2>(F.lds, g, S, E);
            if (ON(4)) for (int u = blockIdx.x; u < NB * 4 * 8; u += F.G) ret_state_unit(F, u);
        }
        SEAM();
        REPS(5) if (RUN()) {
            gu32* qh = F.ctl + CW_QUEUE + 64 * l + 8 * rep_;
            for (;;) {
                if (F.tid == 0) F.MISC[16] = __hip_atomic_fetch_add(qh, 1u, RLX_AGENT);
                __syncthreads(); const int u = (int)F.MISC[16]; __syncthreads();
                if (u >= N_ATT_UNITS + N_RO_UNITS) break;
                if (u < N_ATT_UNITS) { if (ON(5)) { const int j = u < 256 ? 7 - (u >> 5) : -1, bh = u & 31; attn_unit(F, bh >> 2, bh & 3, j, ldin(I_MLAG) + l * 512, (char*)lds); } }
                else if (ON(6)) ret_out_unit(F, u - N_ATT_UNITS, ldin(I_RETG) + l * 512);
            }
        }
        SEAM();
        REPS(7) if (ON(7) && RUN()) {
            pg8::Gemm g{(const pg8::bf16_t*)(R + R_Y), (const pg8::bf16_t*)(F.ws + WS_WOUT) + (size_t)l * DM * DM, MP, DM, DM, 0};
            pg8::StaticOrder S; S.init(MP, DM, F.G, (int)blockIdx.x);
            EpiResid E{rep_ == 0 ? hres : (float*)(F.ws + WS_XS)};
            pg8::gemm_phase<EpiResid, pg8::StaticOrder, MK_ALIGN, MK_SP2>(F.lds, g, S, E);
        }
        SEAM();
        if (!moe) {
            REPS(8) if (ON(8) && RUN()) norm_phase(F, false, nullptr);
            SEAM();
            REPS(9) if (ON(9) && RUN()) {
                pg8::Gemm g{XN, (const pg8::bf16_t*)(F.ws + WS_WDGU) + (size_t)li * 2 * FF * DM, MP, 2 * FF, DM, 0};
                pg8::StaticOrder S; S.init(MP, 2 * FF, F.G, (int)blockIdx.x);
                EpiSwiGLU E{(bf16*)(R + R_ACT)};
                pg8::gemm_phase<EpiSwiGLU, pg8::StaticOrder, MK_ALIGN, MK_SP2>(F.lds, g, S, E);
            }
            SEAM();
            REPS(10) if (ON(10) && RUN()) {
                pg8::Gemm g{(const pg8::bf16_t*)(R + R_ACT), (const pg8::bf16_t*)(F.ws + WS_WDD) + (size_t)li * DM * FF, MP, DM, FF, 0};
                pg8::StaticOrder S; S.init(MP, DM, F.G, (int)blockIdx.x);
                EpiResid E{rep_ == 0 ? hres : (float*)(F.ws + WS_XS)};
                pg8::gemm_phase<EpiResid, pg8::StaticOrder, MK_ALIGN, MK_SP2>(F.lds, g, S, E);
            }
            SEAM();
            ++ph;
        } else {
            if (ON(11) && RUN()) route_phase(F, ldin(I_FFNNORM) + l * DM, ldin(I_ROUTER) + (size_t)li * DM * NEXP, cnt);
            SEAM();
            REPS(12) if (ON(12) && RUN()) gather_phase(F, cnt);
            SEAM();
            REPS(13) if (ON(13) && RUN()) {
                pg8::Gemm g{(const pg8::bf16_t*)(F.ws + WS_XS), (const pg8::bf16_t*)(F.ws + WS_WMGU) + (size_t)li * NEXP * 2 * FF * DM, XS_ROWS, 2 * FF, DM, (size_t)2 * FF * DM * 2};
                pg8::GroupedOrder S; S.init(cnt, 2 * FF, F.G, (int)blockIdx.x);
                EpiSwiGLU E{(bf16*)(R + R_ACT)};
                pg8::gemm_phase<EpiSwiGLU, pg8::GroupedOrder, MK_ALIGN, MK_SP2>(F.lds, g, S, E);
            }
            SEAM();
            REPS(14) if (ON(14) && RUN()) {
                pg8::Gemm g{(const pg8::bf16_t*)(R + R_ACT), (const pg8::bf16_t*)(F.ws + WS_WMD) + (size_t)li * NEXP * DM * FF, XS_ROWS, DM, FF, (size_t)DM * FF * 2};
                pg8::GroupedOrder S; S.init(cnt, DM, F.G, (int)blockIdx.x);
                EpiMoeDown E{(bf16*)(F.ws + WS_YS)};
                pg8::gemm_phase<EpiMoeDown, pg8::GroupedOrder, MK_ALIGN, MK_SP2>(F.lds, g, S, E);
            }
            SEAM();
        }
    }
    if (ON(15) && RUN()) final_phase(F, ldin(I_FINAL), args.out, (const unsigned*)(F.ctl + CW_CNT) + 8);
#undef RUN
#undef SEAM
#undef R
#undef tab
#undef hres
#undef XN
}

extern "C" void kernel_launch(void* const* d_in, const int* in_sizes, int n_in, void* d_out, int out_size, void* d_ws, size_t ws_size, hipStream_t stream) {
    static int grid = 0;
    if (grid == 0) {
        if (n_in != 20 || in_sizes[0] != NB * SEQ * DM || out_size != NB * SEQ * DM || ws_size < WS_END) {
            fprintf(stderr, "kernel_launch: shape mismatch: n_in %d in0 %d out %d ws %zu (need >= %zu)\n", n_in, n_in > 0 ? in_sizes[0] : -1, out_size, ws_size, (size_t)WS_END); grid = -1; return; }
        int dev = 0, cus = 0, per_cu = 0;
        if (hipGetDevice(&dev) != hipSuccess || hipDeviceGetAttribute(&cus, hipDeviceAttributeMultiprocessorCount, dev) != hipSuccess) { grid = -1; return; }
        if (hipFuncSetAttribute((const void*)mk_fwd, hipFuncAttributeMaxDynamicSharedMemorySize, LDS_BYTES) != hipSuccess) { fprintf(stderr, "kernel_launch: hipFuncSetAttribute failed\n"); grid = -1; return; }
        if (hipOccupancyMaxActiveBlocksPerMultiprocessor(&per_cu, (const void*)mk_fwd, NWAVES * 64, LDS_BYTES) != hipSuccess || per_cu < 1)
            fprintf(stderr, "kernel_launch: occupancy query reports %d workgroups per CU\n", per_cu);
        (void)hipGetLastError();
        grid = cus;
    }
    if (grid < 0) return;
    if (hipMemsetAsync((char*)d_ws + WS_CTL, 0, CTL_ZERO_BYTES, stream) != hipSuccess) { fprintf(stderr, "kernel_launch: memset failed\n"); return; }
    Args a{};
    for (int i = 0; i < 20; ++i) a.in.p[i] = (const float*)d_in[i];
    a.out = (float*)d_out; a.ws = (unsigned char*)d_ws; a.phase = 0; a.pad = 0;
#if MK_MULTI
    for (int ph = 0; ph < N_PHASES; ++ph) { a.phase = ph; hipLaunchKernelGGL(mk_fwd, dim3(grid), dim3(NWAVES * 64), LDS_BYTES, stream, a); }
#else
    hipLaunchKernelGGL(mk_fwd, dim3(grid), dim3(NWAVES * 64), LDS_BYTES, stream, a);
#endif
    const hipError_t le = hipPeekAtLastError();
    if (le != hipSuccess) fprintf(stderr, "kernel_launch: launch failed: %s\n", hipGetErrorName(le));
}
```

```cpp
#include <hip/hip_runtime.h>
#include <cstdio>
#include <cstdint>
namespace pg8 {
#define PG8_LAS __attribute__((address_space(3)))
typedef unsigned short bf16_t;
typedef short bf16x8 __attribute__((ext_vector_type(8)));
typedef float f32x4 __attribute__((ext_vector_type(4)));
typedef unsigned u32x4 __attribute__((ext_vector_type(4)));
constexpr int BM = 256, BK = 64, HALF = 128, HTB = HALF * BK * 2  , STAGE_BYTES = 8 * HTB, NXCD = 8, WGM = 8;

__host__ __device__ __forceinline__ int lds_byte(int r, int c) { const int st = (r >> 4) * 2 + (c >> 5), rr = r & 15, cc = c & 31, ob = rr * 64 + cc * 2; return st * 1024 + (ob ^ (((ob >> 9) & 1) << 5)); }
__host__ __device__ __forceinline__ void stage_rc(int b, int& R, int& C) { const int st = b / 1024, sb = b % 1024, swz = sb ^ (((sb >> 9) & 1) << 5); R = (st >> 1) * 16 + swz / 64; C = (st & 1) * 32 + (swz % 64) / 2; }
__host__ __device__ __forceinline__ int perm32(int rho) { const int n = rho >> 4, i = rho & 15; return 8 * (i >> 2) + 4 * n + (i & 3); }

struct Unit { int pm, pn, eb; };
struct Gemm { const bf16_t* A; const bf16_t* Bt; int M, N, K; size_t estride; };

struct StaticOrder {
    int nM, nN, nwg, G, c;
    __host__ __device__ void init(int M, int N, int G_, int c_) { nM = M / BM; nN = N / BM; nwg = nM * nN; G = G_; c = c_; }
    __host__ __device__ bool next(int i, Unit& u) const {
        const long L = (long)i * G + c; if (L >= nwg) return false;
        int wgid = (int)L; { const int q = nwg / NXCD, r = nwg % NXCD, xcd = wgid % NXCD, off = wgid / NXCD; wgid = (xcd < r ? xcd * (q + 1) : r * (q + 1) + (xcd - r) * q) + off; }
        const int nig = WGM * nN, gid = wgid / nig, fm = gid * WGM, gsz = (nM - fm) < WGM ? (nM - fm) : WGM;
        u.pm = fm + ((wgid % nig) % gsz); u.pn = (wgid % nig) / gsz; u.eb = 0; return true;
    }
    __device__ __forceinline__ void a_ready(const Unit&) const {}
    __device__ __forceinline__ void done(const Unit&) const {}
};
struct GroupedOrder {
    int nM, nN, nwg, G, c; int tp[9];
    __device__ __forceinline__ void init(const unsigned* cnt, int N, int G_, int c_) {
        tp[0] = 0;
#pragma unroll
        for (int e = 0; e < 8; ++e) tp[e + 1] = tp[e] + __builtin_amdgcn_readfirstlane((int)((cnt[e] + 255u) >> 8));
        nM = tp[8]; nN = N / BM; nwg = nM * nN; G = G_; c = c_; }
    __device__ __forceinline__ bool next(int i, Unit& u) const {
        const long L = (long)i * G + c; if (L >= nwg) return false;
        int wgid = (int)L; { const int q = nwg / NXCD, r = nwg % NXCD, xcd = wgid % NXCD, off = wgid / NXCD; wgid = (xcd < r ? xcd * (q + 1) : r * (q + 1) + (xcd - r) * q) + off; }
        const int nig = WGM * nN, gid = wgid / nig, fm = gid * WGM, gsz = (nM - fm) < WGM ? (nM - fm) : WGM;
        u.pm = fm + ((wgid % nig) % gsz); u.pn = (wgid % nig) / gsz;
        int e = 0;
#pragma unroll
        for (int k = 1; k < 8; ++k) e += (u.pm >= tp[k]) ? 1 : 0;
        u.eb = e; return true;
    }
    __device__ __forceinline__ void a_ready(const Unit&) const {}
    __device__ __forceinline__ void done(const Unit&) const {}
};
__device__ __forceinline__ unsigned cvt_pk_bf16(float lo, float hi) { unsigned r; asm volatile("v_cvt_pk_bf16_f32 %0, %1, %2" : "=v"(r) : "v"(lo), "v"(hi)); return r; }
template <class Epi, class Sched, bool ALIGN_EPI = false, bool SP2 = false>
__device__ __forceinline__ void gemm_phase(PG8_LAS unsigned char* lds, const Gemm g, const Sched& S, const Epi& E) {
    int tid_ = threadIdx.x; asm volatile("" : "+v"(tid_));
    const int tid = tid_, wid = __builtin_amdgcn_readfirstlane(tid >> 6), lane = tid & 63, wr = wid >> 2, wc = wid & 3, fr = lane & 15, fq = lane >> 4;
    const int K = g.K, nt = K / BK;
    unsigned voffA[2], voffB[2];
#pragma unroll
    for (int i = 0; i < 2; ++i) { int R, C; stage_rc(tid * 16 + i * 8192, R, C); const int Rb = Epi::PERM ? ((R & ~31) + perm32(R & 31)) : R;
        voffA[i] = (unsigned)(R * K + C) * 2u; voffB[i] = (unsigned)(Rb * K + C) * 2u; }
    const size_t kstep = (size_t)(BK * 2);
    const size_t hstep = (size_t)HALF * K * 2;
    const size_t tstep = 2 * hstep;
    const unsigned ldsw = (unsigned)wid * 1024u;
    const int aoff = lds_byte(wr * 64 + fr, fq * 8), boff = lds_byte(wc * 32 + fr, fq * 8);
#define PG8_SA(b, h) (((b) * 2 + (h)) * HTB)
#define PG8_SB(b, h) ((4 + (b) * 2 + (h)) * HTB)
#define PG8_STAGE(bufoff, gbase, voff) do { _Pragma("unroll") for (int _i = 0; _i < 2; ++_i) \
        __builtin_amdgcn_global_load_lds((const unsigned*)((const char*)(gbase) + (voff)[_i]), (PG8_LAS unsigned*)(lds + (bufoff) + ldsw + _i * 8192), 16, 0, 0); } while (0)
#define PG8_LDA(dst, b, h) do { _Pragma("unroll") for (int m = 0; m < 4; ++m) _Pragma("unroll") for (int k = 0; k < 2; ++k) dst[m][k] = *(const PG8_LAS bf16x8*)(lds + PG8_SA(b, h) + aoff + m * 2048 + k * 1024); } while (0)
#define PG8_LDB(dst, b, h) do { _Pragma("unroll") for (int n = 0; n < 2; ++n) _Pragma("unroll") for (int k = 0; k < 2; ++k) dst[n][k] = *(const PG8_LAS bf16x8*)(lds + PG8_SB(b, h) + boff + n * 2048 + k * 1024); } while (0)
#define PG8_MMA(ai, bj, At, Bt) do { __builtin_amdgcn_s_setprio(1); _Pragma("unroll") for (int m = 0; m < 4; ++m) _Pragma("unroll") for (int n = 0; n < 2; ++n) _Pragma("unroll") for (int k = 0; k < 2; ++k) \
        acc[ai][bj][m][n] = __builtin_amdgcn_mfma_f32_16x16x32_bf16(Bt[n][k], At[m][k], acc[ai][bj][m][n], 0, 0, 0); __builtin_amdgcn_s_setprio(0); } while (0)
#define PG8_WAIT_V(n) asm volatile("s_waitcnt vmcnt(" #n ")" ::: "memory")
#define PG8_WAIT_L(n) asm volatile("s_waitcnt lgkmcnt(" #n ")" ::: "memory")
#define PG8_BAR __builtin_amdgcn_s_barrier()
#define PG8_SCHED __builtin_amdgcn_sched_barrier(0)
    Unit cur, nxt; int ui = 0;
    if (!S.next(0, cur)) return;
    f32x4 acc[2][2][4][2];
#pragma unroll
    for (int a = 0; a < 2; ++a)
#pragma unroll
        for (int b = 0; b < 2; ++b)
#pragma unroll
            for (int m = 0; m < 4; ++m)
#pragma unroll
                for (int n = 0; n < 2; ++n) acc[a][b][m][n] = (f32x4){0.f, 0.f, 0.f, 0.f};
    bf16x8 At[4][2], B0[2][2], B1[2][2];
    const char* cA = (const char*)g.A + (size_t)cur.pm * tstep; const char* cB = (const char*)g.Bt + (size_t)cur.eb * g.estride + (size_t)cur.pn * tstep;
    S.a_ready(cur);
    if constexpr (SP2) {
        PG8_STAGE(PG8_SB(0, 0), cB, voffB); PG8_STAGE(PG8_SB(0, 1), cB + hstep, voffB); PG8_STAGE(PG8_SA(0, 0), cA, voffA); PG8_STAGE(PG8_SA(0, 1), cA + hstep, voffA);
        if (wr == 1) PG8_BAR;
        PG8_WAIT_V(2); PG8_BAR;
        PG8_STAGE(PG8_SB(1, 0), cB + kstep, voffB); PG8_STAGE(PG8_SA(1, 0), cA + kstep, voffA); PG8_STAGE(PG8_SB(1, 1), cB + hstep + kstep, voffB);
        PG8_WAIT_V(6); PG8_BAR;
    } else {
        PG8_STAGE(PG8_SB(0, 0), cB, voffB); PG8_STAGE(PG8_SA(0, 0), cA, voffA); PG8_STAGE(PG8_SB(0, 1), cB + hstep, voffB); PG8_STAGE(PG8_SA(0, 1), cA + hstep, voffA);
        if (wr == 1) PG8_BAR;
        PG8_WAIT_V(4); PG8_BAR;
        PG8_STAGE(PG8_SB(1, 0), cB + kstep, voffB); PG8_STAGE(PG8_SA(1, 0), cA + kstep, voffA); PG8_STAGE(PG8_SB(1, 1), cB + hstep + kstep, voffB);
        PG8_WAIT_V(6); PG8_BAR;
    }
    for (;;) {
        const bool has_next = S.next(ui + 1, nxt);
        const char* nA = has_next ? (const char*)g.A + (size_t)nxt.pm * tstep : cA; const char* nB = has_next ? (const char*)g.Bt + (size_t)nxt.eb * g.estride + (size_t)nxt.pn * tstep : cB;
        for (int t = 0; t < nt; t += 2) {
            const bool last = (t == nt - 2);
            const char* a1 = cA + (size_t)(t + 1) * kstep;
            const char* a2 = last ? nA : cA + (size_t)(t + 2) * kstep; const char* b2 = last ? nB : cB + (size_t)(t + 2) * kstep;
            const char* a3 = a2 + kstep; const char* b3 = b2 + kstep;
            if (last && has_next) S.a_ready(nxt);
            if constexpr (SP2) {
            PG8_LDB(B0, 0, 0); PG8_LDB(B1, 0, 1); PG8_SCHED; PG8_LDA(At, 0, 0); PG8_STAGE(PG8_SA(1, 1), a1 + hstep, voffA);
            PG8_WAIT_V(8); PG8_WAIT_L(0); PG8_BAR; PG8_MMA(0, 0, At, B0); PG8_MMA(0, 1, At, B1); PG8_BAR; PG8_SCHED;
            PG8_LDA(At, 0, 1); PG8_STAGE(PG8_SB(0, 0), b2, voffB); PG8_STAGE(PG8_SB(0, 1), b2 + hstep, voffB); PG8_STAGE(PG8_SA(0, 0), a2, voffA);
            PG8_WAIT_V(8); PG8_WAIT_L(0); PG8_BAR; PG8_MMA(1, 0, At, B0); PG8_MMA(1, 1, At, B1); PG8_BAR; PG8_SCHED;
            PG8_LDB(B0, 1, 0); PG8_LDB(B1, 1, 1); PG8_SCHED; PG8_LDA(At, 1, 0); PG8_STAGE(PG8_SA(0, 1), a2 + hstep, voffA);
            PG8_WAIT_V(8); PG8_WAIT_L(0); PG8_BAR; PG8_MMA(0, 0, At, B0); PG8_MMA(0, 1, At, B1); PG8_BAR; PG8_SCHED;
            PG8_LDA(At, 1, 1); PG8_STAGE(PG8_SB(1, 0), b3, voffB); PG8_STAGE(PG8_SB(1, 1), b3 + hstep, voffB); PG8_STAGE(PG8_SA(1, 0), a3, voffA);
            PG8_WAIT_V(8); PG8_WAIT_L(0); PG8_BAR; PG8_MMA(1, 0, At, B0); PG8_MMA(1, 1, At, B1); PG8_BAR; PG8_SCHED;
            } else {
            PG8_LDB(B0, 0, 0); PG8_SCHED; PG8_LDA(At, 0, 0); PG8_STAGE(PG8_SA(1, 1), a1 + hstep, voffA);
            PG8_WAIT_L(8); PG8_BAR; PG8_WAIT_L(0); PG8_MMA(0, 0, At, B0); PG8_BAR; PG8_SCHED;
            PG8_LDB(B1, 0, 1); PG8_STAGE(PG8_SB(0, 0), b2, voffB);
            PG8_BAR; PG8_WAIT_L(0); PG8_MMA(0, 1, At, B1); PG8_BAR;
            PG8_LDA(At, 0, 1); PG8_STAGE(PG8_SA(0, 0), a2, voffA);
            PG8_BAR; PG8_WAIT_L(0); PG8_MMA(1, 0, At, B0); PG8_BAR; PG8_SCHED;
            PG8_STAGE(PG8_SB(0, 1), b2 + hstep, voffB);
            PG8_WAIT_V(6); PG8_BAR; PG8_MMA(1, 1, At, B1); PG8_BAR;
            PG8_LDB(B0, 1, 0); PG8_SCHED; PG8_LDA(At, 1, 0); PG8_STAGE(PG8_SA(0, 1), a2 + hstep, voffA);
            PG8_WAIT_L(8); PG8_BAR; PG8_WAIT_L(0); PG8_MMA(0, 0, At, B0); PG8_BAR; PG8_SCHED;
            PG8_LDB(B1, 1, 1); PG8_STAGE(PG8_SB(1, 0), b3, voffB);
            PG8_BAR; PG8_WAIT_L(0); PG8_MMA(0, 1, At, B1); PG8_BAR;
            PG8_LDA(At, 1, 1); PG8_STAGE(PG8_SA(1, 0), a3, voffA);
            PG8_BAR; PG8_WAIT_L(0); PG8_MMA(1, 0, At, B0); PG8_BAR; PG8_SCHED;
            PG8_STAGE(PG8_SB(1, 1), b3 + hstep, voffB);
            PG8_WAIT_V(6); PG8_BAR; PG8_MMA(1, 1, At, B1); PG8_BAR;
            }
        }
        if constexpr (ALIGN_EPI) { if (wr == 0) PG8_BAR; }
        if constexpr (!Epi::AFTER_DRAIN) { E(acc, cur, wr, wc, fr, fq); S.done(cur); }
        if (!has_next) break;
#pragma unroll
        for (int a = 0; a < 2; ++a)
#pragma unroll
            for (int b = 0; b < 2; ++b)
#pragma unroll
                for (int m = 0; m < 4; ++m)
#pragma unroll
                    for (int n = 0; n < 2; ++n) acc[a][b][m][n] = (f32x4){0.f, 0.f, 0.f, 0.f};
        cur = nxt; cA = nA; cB = nB; ++ui;
        if constexpr (ALIGN_EPI) { if (wr == 1) PG8_BAR; }
    }
    PG8_WAIT_V(0);
    if constexpr (!ALIGN_EPI) { if (wr == 0) PG8_BAR; }
    PG8_BAR;
    if constexpr (Epi::AFTER_DRAIN) { E.fused(acc, cur, wr, wc, fr, fq, lds, wid, lane); S.done(cur); }
#undef PG8_SA
#undef PG8_SB
#undef PG8_STAGE
#undef PG8_LDA
#undef PG8_LDB
#undef PG8_MMA
#undef PG8_WAIT_V
#undef PG8_WAIT_L
#undef PG8_BAR
#undef PG8_SCHED
}
}

constexpr int NB = 8, SEQ = 2048, NMETA = 16, LSEQ = SEQ + NMETA;
constexpr int NMAIN = NB * SEQ, MTOK = NMAIN + NMETA, MP = 16640;
constexpr int DM = 1024, DINP = 2560, FF = 3584, NEXP = 8, DEPTH = 4;
constexpr int NCH = 33;
constexpr int UPN = 1792, UPK = 384;
constexpr int XS_ROWS = 35072;
constexpr float EPS = 1e-6f;
constexpr int NWAVES = 8;
#ifndef MK_MULTI
#define MK_MULTI 0
#endif

constexpr size_t MiB = 1u << 20;
constexpr size_t WS_CTL = 0, CTL_ZERO_BYTES = 2 * MiB;
constexpr size_t CTL_SSQ = 65536, CTL_SSKV = CTL_SSQ + (size_t)DEPTH * MP * 4;
static_assert(CTL_SSKV + (size_t)DEPTH * MP * 4 <= CTL_ZERO_BYTES, "ctl");
constexpr int CW_TMO = 0, CW_BAR = 4096, CW_CNT = 8192  , CW_QUEUE = 8320  ;
constexpr size_t WS_WIN = 2 * MiB;
constexpr size_t WS_WUP = WS_WIN + (size_t)DEPTH * DINP * DM * 2;
constexpr size_t WS_WOUT = WS_WUP + (size_t)DEPTH * UPN * UPK * 2;
constexpr size_t WS_WDGU = WS_WOUT + (size_t)DEPTH * DM * DM * 2;
constexpr size_t WS_WDD = WS_WDGU + (size_t)2 * 2 * FF * DM * 2;
constexpr size_t WS_WMGU = WS_WDD + (size_t)2 * DM * FF * 2;
constexpr size_t WS_WMD = WS_WMGU + (size_t)2 * NEXP * 2 * FF * DM * 2;
constexpr size_t WS_TAB = WS_WMD + (size_t)2 * NEXP * DM * FF * 2;
constexpr size_t TAB_RC = 0, TAB_RS = (size_t)LSEQ * 64 * 4, TAB_MC = 2 * TAB_RS, TAB_MS = TAB_MC + (size_t)LSEQ * 32 * 4;
constexpr size_t WS_HRES = WS_TAB + 2 * MiB;
constexpr size_t WS_XN = WS_HRES + (size_t)MP * DM * 4;
constexpr size_t WS_TOK = WS_XN + (size_t)MP * DM * 2;
constexpr size_t WS_SORT = WS_TOK + (size_t)MP * 32;
constexpr size_t WS_XS = WS_SORT + 1 * MiB;
constexpr size_t WS_YS = WS_XS;
constexpr size_t WS_R = WS_XS + (size_t)XS_ROWS * DM * 2;
constexpr size_t R_RQ = 0, R_RK = R_RQ + (size_t)MP * 512 * 2, R_RKZ = R_RK + (size_t)MP * 512 * 2, R_RV = R_RKZ + (size_t)MP * 512 * 2, R_SG = R_RV + (size_t)MP * 512 * 2;
constexpr size_t R_LAT = R_SG + (size_t)MP * 512 * 2, R_KPE = R_LAT + (size_t)MP * 384 * 2;
constexpr size_t R_QN = R_KPE + (size_t)MP * 64 * 2, R_QPE = R_QN + (size_t)MP * 512 * 2, R_KN = R_QPE + (size_t)MP * 256 * 2, R_V = R_KN + (size_t)MP * 512 * 2;
constexpr size_t R_ST = R_V + (size_t)MP * 512 * 2;
constexpr size_t R_Y = R_ST + (size_t)NB * 4 * NCH * 128 * 128 * 2;
constexpr size_t R_MIX_END = R_Y + (size_t)MP * DM * 2;
constexpr size_t R_ACT = 0;
constexpr size_t R_END = ((size_t)XS_ROWS * FF * 2 > R_MIX_END) ? (size_t)XS_ROWS * FF * 2 : R_MIX_END;
constexpr size_t WS_END = WS_R + R_END;

constexpr int RING_BYTES = 131072, LDSCTL_OFF = RING_BYTES, MISC_OFF = LDSCTL_OFF + 320, LDS_BYTES = 147456;

#define GAS __attribute__((address_space(1)))
#define LAS __attribute__((address_space(3)))
typedef unsigned short bf16;
typedef unsigned v4u __attribute__((ext_vector_type(4)));
typedef unsigned v2u __attribute__((ext_vector_type(2)));
typedef float f32x4 __attribute__((ext_vector_type(4)));
typedef float f32x16 __attribute__((ext_vector_type(16)));
typedef short bf16x8 __attribute__((ext_vector_type(8)));
typedef short s16x4 __attribute__((ext_vector_type(4)));
typedef GAS unsigned gu32;
#define RLX_AGENT __ATOMIC_RELAXED, __HIP_MEMORY_SCOPE_AGENT
#define LDS_WAIT() asm volatile("s_waitcnt lgkmcnt(0)" ::: "memory")
#define VM_WAIT() asm volatile("s_waitcnt vmcnt(0)" ::: "memory")
__device__ __forceinline__ unsigned f2bf(float f) { unsigned u = __builtin_bit_cast(unsigned, f); return (u + 0x7fffu + ((u >> 16) & 1u)) >> 16; }
__device__ __forceinline__ unsigned pk2(float lo, float hi) { return pg8::cvt_pk_bf16(lo, hi); }
__device__ __forceinline__ v4u zero4() { unsigned z; asm volatile("v_mov_b32 %0, 0" : "=v"(z)); return (v4u){z, z, z, z}; }
__device__ __forceinline__ float bf2f(unsigned short b) { return __builtin_bit_cast(float, (unsigned)b << 16); }
template <int X> __device__ __forceinline__ float xshfl(float v) {
    if constexpr (X < 32) return __builtin_bit_cast(float, __builtin_amdgcn_ds_swizzle(__builtin_bit_cast(int, v), (X << 10) | 0x1f));
    else { const unsigned u = __builtin_bit_cast(unsigned, v); auto r = __builtin_amdgcn_permlane32_swap(u, u, false, false); const unsigned a = r[0], b = r[1]; return __builtin_bit_cast(float, a == u ? b : a); }
}
template <int X> __device__ __forceinline__ float xadd(float v) {
    if constexpr (X < 32) return v + xshfl<X>(v);
    else { const unsigned u = __builtin_bit_cast(unsigned, v); auto r = __builtin_amdgcn_permlane32_swap(u, u, false, false); return __builtin_bit_cast(float, (unsigned)r[0]) + __builtin_bit_cast(float, (unsigned)r[1]); }
}
__device__ __forceinline__ float wave_sum(float v) { v = xadd<1>(v); v = xadd<2>(v); v = xadd<4>(v); v = xadd<8>(v); v = xadd<16>(v); v = xadd<32>(v); return v; }
#define XB_TMO      128
#define XB_XCNT(j)  (256  + 64 * (j))
#define XB_XSUB(j)  (1280 + 64 * (j))
#define XB_XGEN(j)  (2304 + 64 * (j))
#define XB_TOP      3328
#define XB_TOPGEN   3392
#define XCD_BAR_WORDS 3456
#define XB_SPIN_CAP (1u << 18)

__device__ __forceinline__ unsigned xb_ld(unsigned* p)              { return __hip_atomic_load(p, __ATOMIC_RELAXED, __HIP_MEMORY_SCOPE_AGENT); }
__device__ __forceinline__ unsigned xb_add(unsigned* p, unsigned v) { return __hip_atomic_fetch_add(p, v, __ATOMIC_RELAXED, __HIP_MEMORY_SCOPE_AGENT); }
__device__ __forceinline__ unsigned xb_xcc_id() { return (unsigned)__builtin_amdgcn_s_getreg((3 << 11) | 20) & 0xFu; }
#define XB_SPIN(cond, bar) do { unsigned _sp = 0; while (cond) { __builtin_amdgcn_s_sleep(1); \
    if ((++_sp & 255u) == 0u) { if (xb_ld(&(bar)[XB_TMO])) break; if (_sp > XB_SPIN_CAP) { atomicAdd(&(bar)[XB_TMO], 1u); break; } } } } while (0)

struct XcdBarrier {
    unsigned* bar; unsigned x;
    volatile LAS unsigned* st;
};

__device__ __forceinline__ XcdBarrier xcd_barrier_post(unsigned* bar, volatile LAS unsigned* st) {
    XcdBarrier b; b.bar = bar; b.x = xb_xcc_id(); b.st = st;
    if (threadIdx.x == 0) (void)xb_add(&bar[XB_XCNT(b.x)], 1u);
    return b;
}
__device__ __forceinline__ void xcd_barrier_complete(unsigned* bar, unsigned x, unsigned& nloc, unsigned& nx) {
    const unsigned G = gridDim.x * gridDim.y * gridDim.z;
    unsigned sum, cnt, mine, sp = 0u;
    for (;;) {
        sum = 0u; cnt = 0u; mine = 0u;
#pragma unroll
        for (unsigned j = 0; j < 16; ++j) { const unsigned c = xb_ld(&bar[XB_XCNT(j)]); sum += c; cnt += (c > 0u) ? 1u : 0u; }
        mine = xb_ld(&bar[XB_XCNT(x)]);
        if (sum == G) break;
        __builtin_amdgcn_s_sleep(1);
        if ((++sp & 255u) == 0u) { if (xb_ld(&bar[XB_TMO])) break; if (sp > XB_SPIN_CAP) { atomicAdd(&bar[XB_TMO], 1u); break; } }
    }
    nloc = mine > 0u ? mine : 1u; nx = cnt > 0u ? cnt : 1u;
}

__device__ __forceinline__ void xcd_barrier(const XcdBarrier& b) {
    asm volatile("s_waitcnt vmcnt(0)" ::: "memory");
    __syncthreads();
    if (threadIdx.x == 0) {
        unsigned* bar = b.bar;
        __builtin_amdgcn_s_waitcnt(0);
        unsigned nloc = b.st[0], nx = b.st[1];
        if (nloc == 0u) { xcd_barrier_complete(bar, b.x, nloc, nx); b.st[0] = nloc; b.st[1] = nx; }
        const unsigned old = xb_add(&bar[XB_XSUB(b.x)], 1u);
        const unsigned gen = old / nloc;
        if (old + 1u == (gen + 1u) * nloc) {
            __builtin_amdgcn_fence(__ATOMIC_RELEASE, "agent");
            asm volatile("s_waitcnt vmcnt(0)" ::: "memory");
            const unsigned og = xb_add(&bar[XB_TOP], 1u);
            const unsigned tg = og / nx;
            if (og + 1u == (tg + 1u) * nx) xb_add(&bar[XB_TOPGEN], 1u);
            else XB_SPIN(xb_ld(&bar[XB_TOPGEN]) == tg, bar);
            __builtin_amdgcn_fence(__ATOMIC_ACQUIRE, "agent");
            xb_add(&bar[XB_XGEN(b.x)], 1u);
            asm volatile("s_waitcnt vmcnt(0)" ::: "memory");
        } else {
            XB_SPIN(xb_ld(&bar[XB_XGEN(b.x)]) == gen, bar);
            __builtin_amdgcn_fence(__ATOMIC_ACQUIRE, "agent");
            asm volatile("s_waitcnt vmcnt(0)" ::: "memory");
        }
    }
    __syncthreads();
}

struct Frame {
    LAS unsigned char* lds;
    volatile LAS unsigned* MISC;
    gu32* ctl;
    int tid, lane, wave, vcu, G;
    unsigned char* ws;
};
struct Inputs { const float* p[20]; };
__device__ __forceinline__ const float* ldin(int k) { unsigned long long v = 0;
#if defined(__HIP_DEVICE_COMPILE__)
    auto ka = __builtin_amdgcn_kernarg_segment_ptr();
    asm volatile("s_load_dwordx2 %0, %1, %2\n\ts_waitcnt lgkmcnt(0)" : "=s"(v) : "s"(ka), "n"(k * 8));
#endif
    return (const float*)v; }
enum { I_X = 0, I_META, I_ATTN_NORM, I_WIN, I_QNORM, I_WUQ, I_KVNORM, I_WUKV, I_RETG, I_MLAG, I_WOUT, I_FFNNORM, I_DWG, I_DWU, I_DWD, I_ROUTER, I_MWG, I_MWU, I_MWD, I_FINAL };

__device__ __forceinline__ int chunk_idx(int p) { return p < NMETA ? 48 + p : ((p - NMETA) & 63); }
__device__ __forceinline__ float log2_gamma(int h) { return h == 0 ? -0.045803689613124755f : h == 1 ? -0.022720076500083562f : h == 2 ? -0.011315313227834085f : -0.005646563141142062f; }

__device__ __forceinline__ void transpose_item(const float* Wcol, int ldw, int krow0, const float* scale, bf16* WT, int Kdst, int k0dst, int n0, int lane) {
    const int sg = lane & 7, kr = lane >> 3;
    f32x4 v[8];
#pragma unroll
    for (int i = 0; i < 8; ++i) v[i] = (f32x4){0.f, 0.f, 0.f, 0.f};
    if (Wcol) {
        const GAS float* src = (const GAS float*)Wcol + (size_t)(krow0 + 8 * kr) * ldw;
#pragma unroll
        for (int i = 0; i < 8; ++i) v[i] = *(const GAS f32x4*)(src + (size_t)i * ldw);
        if (scale) { const f32x4 s0 = *(const GAS f32x4*)(scale + krow0 + 8 * kr), s1 = *(const GAS f32x4*)(scale + krow0 + 8 * kr + 4);
            v[0] *= s0.x; v[1] *= s0.y; v[2] *= s0.z; v[3] *= s0.w; v[4] *= s1.x; v[5] *= s1.y; v[6] *= s1.z; v[7] *= s1.w; }
    }
    GAS bf16* dst = (GAS bf16*)WT + (size_t)(n0 + 4 * sg) * Kdst + k0dst + 8 * kr;
#pragma unroll
    for (int q = 0; q < 4; ++q) { v4u o; o.x = pk2(v[0][q], v[1][q]); o.y = pk2(v[2][q], v[3][q]); o.z = pk2(v[4][q], v[5][q]); o.w = pk2(v[6][q], v[7][q]);
        *(GAS v4u*)(dst + (size_t)q * Kdst) = o; }
}
__device__ __forceinline__ int slot_o8(int t) { return (t & 0x60) | ((t & 0xC) << 1) | ((t & 0x10) >> 2) | (t & 3); }
__device__ __forceinline__ int win_col(int s) {
    const int pn = s >> 8, t = s & 255, bj = t >> 7, t7 = t & 127, wc = (t >> 5) & 3, n = (t >> 4) & 1, fq = (t >> 2) & 3, i = t & 3;
    if (pn < 4) return (pn >> 1) * 512 + (2 * (pn & 1) + bj) * 128 + 16 * wc + 4 * fq + i + 64 * n;
    if (pn < 8) return 1024 + ((pn - 4) >> 1) * 512 + (pn & 1) * 256 + 128 * bj + slot_o8(t7);
    if (pn == 8) return 2048 + 128 * bj + slot_o8(t7);
    if (bj == 0) return 2304 + slot_o8(t7);
    if (wc < 2) return 2432 + 16 * wc + 4 * fq + i + 32 * n;
    return -1;
}
__device__ __forceinline__ int wup_col(int s, bool& is_kv) {
    const int pn = s >> 8, t = s & 255, bj = t >> 7, t7 = t & 127, wc = (t >> 5) & 3, n = (t >> 4) & 1, fq = (t >> 2) & 3, i = t & 3;
    if (pn < 2) { is_kv = false; const int o = 256 * pn + 128 * bj + slot_o8(t7); return (o >> 7) * 192 + (o & 127); }
    if (pn == 2) { is_kv = false; const int hq = 2 * bj + (wc >> 1); return hq * 192 + 128 + 16 * (wc & 1) + 4 * fq + i + 32 * n; }
    is_kv = true;
    if (pn < 5) { const int o = 256 * (pn - 3) + 128 * bj + slot_o8(t7); return (o >> 7) * 256 + (o & 127); }
    { const int o = 256 * (pn - 5) + 128 * bj + slot_o8(t7); return (o >> 7) * 256 + 128 + (o & 127); }
}
__device__ __forceinline__ void sincos_d(double x, float& s, float& c) {
    const double k = __builtin_rint(x * 0.63661977236758134308);
    const double y = (x - k * 1.5707963267948966) - k * 6.123233995736766e-17;
    const double y2 = y * y;
    const double sn = y * (1.0 + y2 * (-1.0 / 6 + y2 * (1.0 / 120 + y2 * (-1.0 / 5040 + y2 * (1.0 / 362880 + y2 * (-1.0 / 39916800 + y2 * (1.0 / 6227020800.0)))))));
    const double cs = 1.0 + y2 * (-0.5 + y2 * (1.0 / 24 + y2 * (-1.0 / 720 + y2 * (1.0 / 40320 + y2 * (-1.0 / 3628800 + y2 * (1.0 / 479001600.0 + y2 * (-1.0 / 87178291200.0)))))));
    const int q = (int)((long long)k & 3);
    const double ss = (q & 1) ? cs : sn, cc = (q & 1) ? sn : cs;
    s = (float)((q & 2) ? -ss : ss); c = (float)(((q + 1) & 2) ? -cc : cc);
}
__device__ __forceinline__ void p0_prologue(Frame& F) {
    const int gw = F.vcu * NWAVES + F.wave, NGW = F.G * NWAVES, lane = F.lane;
    float* hres = (float*)(F.ws + WS_HRES);
    for (int r = gw; r < MP; r += NGW) {
        GAS f32x4* o = (GAS f32x4*)(hres + (size_t)r * DM) + lane;
        if (r < MTOK) {
            const GAS f32x4* src = (const GAS f32x4*)(r < NMAIN ? ldin(I_X) + (size_t)r * DM : ldin(I_META) + (size_t)(r - NMAIN) * DM) + lane;
#pragma unroll
            for (int j = 0; j < 4; ++j) o[64 * j] = src[64 * j]; }
        else {
#pragma unroll
            for (int j = 0; j < 4; ++j) o[64 * j] = (f32x4){0.f, 0.f, 0.f, 0.f}; }
    }
    { float* tab = (float*)(F.ws + WS_TAB);
      const int gt = gw * 64 + lane, NT = NGW * 64;
      for (int t = gt; t < LSEQ * 64; t += NT) { const int p = t >> 6, i = t & 63; const float inv = exp2f(-(float)(2 * i) * (13.287712379549449f / 128.0f)); const float ang = (float)p * inv;
          float s, c; sincos_d((double)ang, s, c); tab[TAB_RC / 4 + t] = c; tab[TAB_RS / 4 + t] = s; }
      for (int t = gt; t < LSEQ * 32; t += NT) { const int p = t >> 5, i = t & 31; const float inv = exp2f(-(float)(2 * i) * (13.287712379549449f / 64.0f)); const float ang = (float)p * inv;
          float s, c; sincos_d((double)ang, s, c); tab[TAB_MC / 4 + t] = c; tab[TAB_MS / 4 + t] = s; }
    }
    constexpr int I_IN = DEPTH * 16 * 80, I_UP = DEPTH * 6 * 56, I_OUT = DEPTH * 16 * 32, I_DGU = 2 * 16 * 224, I_DD = 2 * 56 * 32, I_MGU = 16 * 16 * 224, I_MD = 16 * 56 * 32;
    constexpr int NITEMS = I_IN + I_UP + I_OUT + I_DGU + I_DD + I_MGU + I_MD;
    for (int it = gw; it < NITEMS; it += NGW) {
        int r = it;
        if (r < I_IN) { const int l = r / 1280, q = r % 1280, kb = q / 80, nb = q % 80; const int col = win_col(nb * 32 + 4 * (lane & 7));
            const float* W = ldin(I_WIN) + (size_t)l * DM * 2496;
            transpose_item(col >= 0 ? W + col : nullptr, 2496, kb * 64, ldin(I_ATTN_NORM) + l * DM, (bf16*)(F.ws + WS_WIN) + (size_t)l * DINP * DM, DM, kb * 64, nb * 32, lane); continue; }
        r -= I_IN;
        if (r < I_UP) { const int l = r / 336, q = r % 336, kb = q / 56, nb = q % 56; bool is_kv; const int col = wup_col(nb * 32 + 4 * (lane & 7), is_kv);
            const float* Wc = nullptr; const float* sc = nullptr; int ldw = 0, k0 = 0;
            if (!is_kv && kb < 4) { Wc = ldin(I_WUQ) + (size_t)l * 256 * 768 + col; sc = ldin(I_QNORM) + l * 256; ldw = 768; k0 = kb * 64; }
            if (is_kv && kb >= 4) { Wc = ldin(I_WUKV) + (size_t)l * 128 * 1024 + col; sc = ldin(I_KVNORM) + l * 128; ldw = 1024; k0 = (kb - 4) * 64; }
            transpose_item(Wc, ldw, k0, sc, (bf16*)(F.ws + WS_WUP) + (size_t)l * UPN * UPK, UPK, kb * 64, nb * 32, lane); continue; }
        r -= I_UP;
        if (r < I_OUT) { const int l = r / 512, q = r % 512, kb = q / 32, nb = q % 32;
            transpose_item(ldin(I_WOUT) + (size_t)l * DM * DM + nb * 32 + 4 * (lane & 7), DM, kb * 64, nullptr, (bf16*)(F.ws + WS_WOUT) + (size_t)l * DM * DM, DM, kb * 64, nb * 32, lane); continue; }
        r -= I_OUT;
        if (r < I_DGU + 0) { const int l = r / 3584, q = r % 3584, kb = q / 224, nb = q % 224; const int s = nb * 32 + 4 * (lane & 7), pn = s >> 8, t = s & 255;
            const float* W = ((t >> 7) ? ldin(I_DWU) : ldin(I_DWG)) + (size_t)l * DM * FF + 128 * pn + slot_o8(t & 127);
            transpose_item(W, FF, kb * 64, ldin(I_FFNNORM) + (2 * l) * DM, (bf16*)(F.ws + WS_WDGU) + (size_t)l * 2 * FF * DM, DM, kb * 64, nb * 32, lane); continue; }
        r -= I_DGU;
        if (r < I_DD) { const int l = r / 1792, q = r % 1792, kb = q / 32, nb = q % 32;
            transpose_item(ldin(I_DWD) + (size_t)l * FF * DM + nb * 32 + 4 * (lane & 7), DM, kb * 64, nullptr, (bf16*)(F.ws + WS_WDD) + (size_t)l * DM * FF, FF, kb * 64, nb * 32, lane); continue; }
        r -= I_DD;
        if (r < I_MGU) { const int le = r / 3584, q = r % 3584, kb = q / 224, nb = q % 224; const int s = nb * 32 + 4 * (lane & 7), pn = s >> 8, t = s & 255;
            const float* W = ((t >> 7) ? ldin(I_MWU) : ldin(I_MWG)) + (size_t)le * DM * FF + 128 * pn + slot_o8(t & 127);
            transpose_item(W, FF, kb * 64, ldin(I_FFNNORM) + (2 * (le >> 3) + 1) * DM, (bf16*)(F.ws + WS_WMGU) + (size_t)le * 2 * FF * DM, DM, kb * 64, nb * 32, lane); continue; }
        r -= I_MGU;
        { const int le = r / 1792, q = r % 1792, kb = q / 32, nb = q % 32;
            transpose_item(ldin(I_MWD) + (size_t)le * FF * DM + nb * 32 + 4 * (lane & 7), DM, kb * 64, nullptr, (bf16*)(F.ws + WS_WMD) + (size_t)le * DM * FF, FF, kb * 64, nb * 32, lane); }
    }
}

typedef pg8::f32x4 af4;
__device__ __forceinline__ v4u pack8(af4 a, af4 b) { v4u w; w.x = pk2(a[0], a[1]); w.y = pk2(a[2], a[3]); w.z = pk2(b[0], b[1]); w.w = pk2(b[2], b[3]); return w; }
__device__ __forceinline__ float silu_f(float x) { return x * __builtin_amdgcn_rcpf(1.0f + __builtin_amdgcn_exp2f(-1.4426950408889634f * x)); }
__device__ __forceinline__ float sumsq8(af4 a, af4 c) { return (a[0] * a[0] + a[1] * a[1]) + (a[2] * a[2] + a[3] * a[3]) + (c[0] * c[0] + c[1] * c[1]) + (c[2] * c[2] + c[3] * c[3]); }
__device__ __forceinline__ int row_pos(int row) { return row < NMAIN ? NMETA + (row & (SEQ - 1)) : ((row - NMAIN) & (NMETA - 1)); }
#define EPI_MAIN_LOOP()                                                                                                                               \
    __device__ __forceinline__ void operator()(const af4 (&acc)[2][2][4][2], const pg8::Unit& u, int wr, int wc, int fr, int fq) const {             \
        _Pragma("unroll") for (int ai = 0; ai < 2; ++ai) _Pragma("unroll") for (int m = 0; m < 4; ++m) {                                             \
            row(u.pm * 256 + ai * 128 + wr * 64 + m * 16 + fr, u.pn, wc, fq, acc[ai][0][m][0], acc[ai][0][m][1], acc[ai][1][m][0], acc[ai][1][m][1]); \
            asm volatile("" ::: "memory"); } }

struct EpiInProj {
    static constexpr bool PERM = false, AFTER_DRAIN = false;
    unsigned char* R; float* ssq; float* sskv; const float* tab; float lg0, lg1, lg2, lg3;
    __device__ __forceinline__ void row(int row, int pn, int wc, int fq, af4 a00, af4 a01, af4 a10, af4 a11) const {
        const int pp = row_pos(row);
        if (pn < 4) {
            const af4 cs = *(const af4*)(tab + TAB_RC / 4 + pp * 64 + 16 * wc + 4 * fq), sn = *(const af4*)(tab + TAB_RS / 4 + pp * 64 + 16 * wc + 4 * fq);
            const size_t off = ((size_t)row * 512 + (2 * (pn & 1)) * 128 + 32 * wc + 8 * fq) * 2;
            af4 o1 = a00 * cs - a01 * sn, o2 = a00 * sn + a01 * cs, o3 = a10 * cs - a11 * sn, o4 = a10 * sn + a11 * cs;
            if (pn < 2) { o1 *= 0.08838834764831845f; o2 *= 0.08838834764831845f; o3 *= 0.08838834764831845f; o4 *= 0.08838834764831845f;
                *(v4u*)(R + R_RQ + off) = pack8(o1, o2); *(v4u*)(R + R_RQ + off + 256) = pack8(o3, o4); }
            else { *(v4u*)(R + R_RK + off) = pack8(o1, o2); *(v4u*)(R + R_RK + off + 256) = pack8(o3, o4);
                const float e = (float)(63 - chunk_idx(pp)); const float z0 = __builtin_amdgcn_exp2f(((pn & 1) ? lg2 : lg0) * e), z1 = __builtin_amdgcn_exp2f(((pn & 1) ? lg3 : lg1) * e);
                *(v4u*)(R + R_RKZ + off) = pack8(o1 * z0, o2 * z0); *(v4u*)(R + R_RKZ + off + 256) = pack8(o3 * z1, o4 * z1); }
        } else if (pn < 6) {
            const size_t off = ((size_t)row * 512 + (pn & 1) * 256 + 32 * wc + 8 * fq) * 2;
            *(v4u*)(R + R_RV + off) = pack8(a00, a01); *(v4u*)(R + R_RV + off + 256) = pack8(a10, a11);
        } else if (pn < 8) {
            const size_t off = ((size_t)row * 512 + (pn & 1) * 256 + 32 * wc + 8 * fq) * 2;
#pragma unroll
            for (int j = 0; j < 4; ++j) { a00[j] = silu_f(a00[j]); a01[j] = silu_f(a01[j]); a10[j] = silu_f(a10[j]); a11[j] = silu_f(a11[j]); }
            *(v4u*)(R + R_SG + off) = pack8(a00, a01); *(v4u*)(R + R_SG + off + 256) = pack8(a10, a11);
        } else if (pn == 8) {
            const size_t off = ((size_t)row * 384 + 32 * wc + 8 * fq) * 2;
            *(v4u*)(R + R_LAT + off) = pack8(a00, a01); *(v4u*)(R + R_LAT + off + 256) = pack8(a10, a11);
            float s = sumsq8(a00, a01) + sumsq8(a10, a11); s = xadd<16>(s); s = xadd<32>(s);
            if (fq == 0) ssq[row * 4 + wc] = s;
        } else {
            *(v4u*)(R + R_LAT + ((size_t)row * 384 + 256 + 32 * wc + 8 * fq) * 2) = pack8(a00, a01);
            float s = sumsq8(a00, a01); s = xadd<16>(s); s = xadd<32>(s);
            if (fq == 0) sskv[row * 4 + wc] = s;
            if (wc < 2) { const af4 cs = *(const af4*)(tab + TAB_MC / 4 + pp * 32 + 16 * wc + 4 * fq), sn = *(const af4*)(tab + TAB_MS / 4 + pp * 32 + 16 * wc + 4 * fq);
                *(v4u*)(R + R_KPE + ((size_t)row * 64 + 32 * wc + 8 * fq) * 2) = pack8(a10 * cs - a11 * sn, a10 * sn + a11 * cs); }
        }
    }
    EPI_MAIN_LOOP()
};
constexpr float QSCALE = 0.07216878364870323f * 1.4426950408889634f;
struct EpiUp {
    static constexpr bool PERM = false, AFTER_DRAIN = false;
    unsigned char* R; const float* ssq; const float* sskv; const float* tab;
    __device__ __forceinline__ void row(int row, int pn, int wc, int fq, af4 a00, af4 a01, af4 a10, af4 a11) const {
        if (pn < 3) { const af4 q4 = *(const af4*)(ssq + row * 4); const float sc = QSCALE * __builtin_amdgcn_rsqf(((q4[0] + q4[1]) + (q4[2] + q4[3])) * (1.0f / 256.0f) + EPS);
            a00 *= sc; a01 *= sc; a10 *= sc; a11 *= sc;
            if (pn < 2) { const size_t off = ((size_t)row * 512 + 256 * pn + 32 * wc + 8 * fq) * 2;
                *(v4u*)(R + R_QN + off) = pack8(a00, a01); *(v4u*)(R + R_QN + off + 256) = pack8(a10, a11);
            } else { const int pp = row_pos(row);
                const af4 cs = *(const af4*)(tab + TAB_MC / 4 + pp * 32 + 16 * (wc & 1) + 4 * fq), sn = *(const af4*)(tab + TAB_MS / 4 + pp * 32 + 16 * (wc & 1) + 4 * fq);
                const size_t off = ((size_t)row * 256 + (wc >> 1) * 64 + 32 * (wc & 1) + 8 * fq) * 2;
                *(v4u*)(R + R_QPE + off) = pack8(a00 * cs - a01 * sn, a00 * sn + a01 * cs); *(v4u*)(R + R_QPE + off + 256) = pack8(a10 * cs - a11 * sn, a10 * sn + a11 * cs); }
        } else { const af4 q4 = *(const af4*)(sskv + row * 4); const float sc = __builtin_amdgcn_rsqf(((q4[0] + q4[1]) + (q4[2] + q4[3])) * (1.0f / 128.0f) + EPS);
            const size_t off = (pn < 5 ? R_KN : R_V) + ((size_t)row * 512 + 256 * (pn < 5 ? pn - 3 : pn - 5) + 32 * wc + 8 * fq) * 2;
            *(v4u*)(R + off) = pack8(a00 * sc, a01 * sc); *(v4u*)(R + off + 256) = pack8(a10 * sc, a11 * sc);
        }
    }
    EPI_MAIN_LOOP()
};
struct EpiResid {
    static constexpr bool PERM = false, AFTER_DRAIN = false;
    float* H;
    __device__ __forceinline__ void row(int row, int pn, int wc, int fq, af4 a00, af4 a01, af4 a10, af4 a11) const {
        af4* q = (af4*)(H + (size_t)row * DM + pn * 256 + wc * 32 + 4 * fq);
        q[0] = q[0] + a00; q[4] = q[4] + a01; q[32] = q[32] + a10; q[36] = q[36] + a11;
    }
    EPI_MAIN_LOOP()
};
struct EpiSwiGLU {
    static constexpr bool PERM = false, AFTER_DRAIN = false;
    bf16* A;
    __device__ __forceinline__ void row(int row, int pn, int wc, int fq, af4 a00, af4 a01, af4 a10, af4 a11) const {
#pragma unroll
        for (int j = 0; j < 4; ++j) { a00[j] = silu_f(a00[j]) * a10[j]; a01[j] = silu_f(a01[j]) * a11[j]; }
        *(v4u*)(A + (size_t)row * FF + pn * 128 + wc * 32 + 8 * fq) = pack8(a00, a01);
    }
    EPI_MAIN_LOOP()
};
struct EpiMoeDown {
    static constexpr bool PERM = false, AFTER_DRAIN = false;
    bf16* Y;
    __device__ __forceinline__ void row(int row, int pn, int wc, int fq, af4 a00, af4 a01, af4 a10, af4 a11) const {
        v2u* q = (v2u*)(Y + (size_t)row * DM + pn * 256 + wc * 32 + 4 * fq);
        q[0] = (v2u){pk2(a00[0], a00[1]), pk2(a00[2], a00[3])}; q[4] = (v2u){pk2(a01[0], a01[1]), pk2(a01[2], a01[3])};
        q[32] = (v2u){pk2(a10[0], a10[1]), pk2(a10[2], a10[3])}; q[36] = (v2u){pk2(a11[0], a11[1]), pk2(a11[2], a11[3])};
    }
    EPI_MAIN_LOOP()
};

template <class Epi> __device__ __forceinline__ void meta_item(LAS unsigned char* lds, const bf16* A16, const bf16* Bt, int K, int item, const Epi& E) {
    int tid_ = threadIdx.x; asm volatile("" : "+v"(tid_));
    const int lane = tid_ & 63, w = __builtin_amdgcn_readfirstlane(tid_ >> 6), fr = lane & 15, fq = lane >> 4, pn = item >> 2, wc = item & 3;
    const int steps = K >> 5, spw = (steps + 7) >> 3, s0 = w * spw, s1 = (s0 + spw) < steps ? (s0 + spw) : steps;
    af4 acc[2][2];
#pragma unroll
    for (int bj = 0; bj < 2; ++bj)
#pragma unroll
        for (int n = 0; n < 2; ++n) acc[bj][n] = (af4){0.f, 0.f, 0.f, 0.f};
    const GAS bf16* ap = (const GAS bf16*)A16 + (size_t)fr * K + 8 * fq;
    const GAS bf16* bp = (const GAS bf16*)Bt + ((size_t)pn * 256 + 32 * wc + fr) * K + 8 * fq;
    for (int s = s0; s < s1; ++s) {
        const bf16x8 a = *(const GAS bf16x8*)(ap + 32 * s);
#pragma unroll
        for (int bj = 0; bj < 2; ++bj)
#pragma unroll
            for (int n = 0; n < 2; ++n) { const bf16x8 b = *(const GAS bf16x8*)(bp + (size_t)(128 * bj + 16 * n) * K + 32 * s); acc[bj][n] = __builtin_amdgcn_mfma_f32_16x16x32_bf16(b, a, acc[bj][n], 0, 0, 0); }
    }
    LAS af4* red = (LAS af4*)lds + (w * 64 + lane) * 4;
    red[0] = acc[0][0]; red[1] = acc[0][1]; red[2] = acc[1][0]; red[3] = acc[1][1];
    __syncthreads();
    if (w == 0) {
#pragma unroll
        for (int ww = 1; ww < 8; ++ww) { const LAS af4* r = (const LAS af4*)lds + (ww * 64 + lane) * 4; acc[0][0] += r[0]; acc[0][1] += r[1]; acc[1][0] += r[2]; acc[1][1] += r[3]; }
        E.row(NMAIN + fr, pn, wc, fq, acc[0][0], acc[0][1], acc[1][0], acc[1][1]);
    }
    __syncthreads();
}
template <class Epi> __device__ __forceinline__ void meta_gemm(Frame& F, const bf16* A16, const bf16* Bt, int N, int K, const Epi& E) {
    const int nit = (N >> 8) * 4;
    for (int it = F.G - 1 - (int)blockIdx.x; it < nit; it += F.G) meta_item<Epi>(F.lds, A16, Bt, K, it, E);
}

__device__ __forceinline__ int expert_base(const unsigned* cnt, int e) { int acc = 0;
#pragma unroll
    for (int k = 0; k < 7; ++k) acc += (k < e) ? (int)((cnt[k] + 255u) & ~255u) : 0;
    return acc; }
__device__ __forceinline__ void load_row(Frame& F, float* hres, int r, bool moe_prev, const unsigned* cnt, f32x4 (&v)[4]) {
    GAS f32x4* xr = (GAS f32x4*)(hres + (size_t)r * DM) + F.lane;
#pragma unroll
    for (int j = 0; j < 4; ++j) v[j] = xr[64 * j];
    if (moe_prev) {
        const int* ti = (const int*)(F.ws + WS_TOK) + (size_t)r * 8; const int e1 = ti[0], e2 = ti[1], s1 = ti[2], s2 = ti[3]; const float w1 = __builtin_bit_cast(float, ti[4]), w2 = __builtin_bit_cast(float, ti[5]);
        const GAS v2u* y1 = (const GAS v2u*)((const bf16*)(F.ws + WS_YS) + (size_t)(expert_base(cnt, e1) + s1) * DM) + F.lane;
        const GAS v2u* y2 = (const GAS v2u*)((const bf16*)(F.ws + WS_YS) + (size_t)(expert_base(cnt, e2) + s2) * DM) + F.lane;
#pragma unroll
        for (int j = 0; j < 4; ++j) { const v2u a = y1[64 * j], c = y2[64 * j];
            v[j].x += w1 * __builtin_bit_cast(float, a.x << 16) + w2 * __builtin_bit_cast(float, c.x << 16);
            v[j].y += w1 * __builtin_bit_cast(float, a.x & 0xffff0000u) + w2 * __builtin_bit_cast(float, c.x & 0xffff0000u);
            v[j].z += w1 * __builtin_bit_cast(float, a.y << 16) + w2 * __builtin_bit_cast(float, c.y << 16);
            v[j].w += w1 * __builtin_bit_cast(float, a.y & 0xffff0000u) + w2 * __builtin_bit_cast(float, c.y & 0xffff0000u);
            xr[64 * j] = v[j]; }
    }
}
__device__ __forceinline__ float row_rstd(const f32x4 (&v)[4]) { float s = 0.f;
#pragma unroll
    for (int j = 0; j < 4; ++j) s += (v[j].x * v[j].x + v[j].y * v[j].y) + (v[j].z * v[j].z + v[j].w * v[j].w);
    return __builtin_amdgcn_rsqf(wave_sum(s) * (1.0f / DM) + EPS); }
__device__ __forceinline__ void store_xn(Frame& F, int r, const f32x4 (&v)[4], float rstd) {
    GAS v2u* o = (GAS v2u*)((bf16*)(F.ws + WS_XN) + (size_t)r * DM) + F.lane;
#pragma unroll
    for (int j = 0; j < 4; ++j) { v2u w; w.x = pk2(v[j].x * rstd, v[j].y * rstd); w.y = pk2(v[j].z * rstd, v[j].w * rstd); o[64 * j] = w; }
}
__device__ __forceinline__ void norm_phase(Frame& F, bool moe_prev, const unsigned* cnt_prev) {
    const int gw = F.vcu * NWAVES + F.wave, NGW = F.G * NWAVES; float* hres = (float*)(F.ws + WS_HRES);
    for (int r = gw; r < MTOK; r += NGW) { f32x4 v[4]; load_row(F, hres, r, moe_prev, cnt_prev, v); store_xn(F, r, v, row_rstd(v)); }
}
__device__ __forceinline__ void route_phase(Frame& F, const float* gain, const float* router_w, unsigned* cnt) {
    const int gw = F.vcu * NWAVES + F.wave, NGW = F.G * NWAVES; float* hres = (float*)(F.ws + WS_HRES);
    LAS float* rw = (LAS float*)F.lds;
    for (int i = F.tid; i < DM * NEXP / 4; i += NWAVES * 64) ((LAS f32x4*)rw)[i] = ((const f32x4*)router_w)[i];
    __syncthreads();
    for (int r = gw; r < MTOK; r += NGW) {
        f32x4 v[4]; load_row(F, hres, r, false, cnt, v); const float rstd = row_rstd(v); store_xn(F, r, v, rstd);
        float lg[8];
#pragma unroll
        for (int e = 0; e < 8; ++e) lg[e] = 0.f;
#pragma unroll
        for (int j = 0; j < 4; ++j) { const int k0 = 4 * F.lane + 256 * j; const f32x4 g = *(const f32x4*)(gain + k0);
            const float hv[4] = {v[j].x * rstd * g.x, v[j].y * rstd * g.y, v[j].z * rstd * g.z, v[j].w * rstd * g.w};
#pragma unroll
            for (int t = 0; t < 4; ++t) { const f32x4 wa = *(const LAS f32x4*)(rw + (k0 + t) * 8), wb = *(const LAS f32x4*)(rw + (k0 + t) * 8 + 4);
                lg[0] += hv[t] * wa.x; lg[1] += hv[t] * wa.y; lg[2] += hv[t] * wa.z; lg[3] += hv[t] * wa.w; lg[4] += hv[t] * wb.x; lg[5] += hv[t] * wb.y; lg[6] += hv[t] * wb.z; lg[7] += hv[t] * wb.w; } }
#pragma unroll
        for (int e = 0; e < 8; ++e) lg[e] = wave_sum(lg[e]);
        int e1 = 0; float v1 = lg[0];
#pragma unroll
        for (int e = 1; e < 8; ++e) if (lg[e] > v1) { v1 = lg[e]; e1 = e; }
        int e2 = -1; float v2 = -3.0e38f;
#pragma unroll
        for (int e = 0; e < 8; ++e) if (e != e1 && (e2 < 0 || lg[e] > v2)) { v2 = lg[e]; e2 = e; }
        const float w2 = 1.0f / (1.0f + __expf(v1 - v2)), w1 = 1.0f - w2;
        if (F.lane == 0) { const int s1 = (int)__hip_atomic_fetch_add(cnt + e1, 1u, RLX_AGENT), s2 = (int)__hip_atomic_fetch_add(cnt + e2, 1u, RLX_AGENT);
            int* ti = (int*)(F.ws + WS_TOK) + (size_t)r * 8; ti[0] = e1; ti[1] = e2; ti[2] = s1; ti[3] = s2; ti[4] = __builtin_bit_cast(int, w1); ti[5] = __builtin_bit_cast(int, w2); }
    }
}
__device__ __forceinline__ void gather_phase(Frame& F, const unsigned* cnt) {
    const int gw = F.vcu * NWAVES + F.wave, NGW = F.G * NWAVES;
    for (int r = gw; r < MTOK; r += NGW) {
        const int* ti = (const int*)(F.ws + WS_TOK) + (size_t)r * 8; const int e1 = ti[0], e2 = ti[1], s1 = ti[2], s2 = ti[3];
        const GAS v4u* src = (const GAS v4u*)((const bf16*)(F.ws + WS_XN) + (size_t)r * DM) + F.lane;
        GAS v4u* d1 = (GAS v4u*)((bf16*)(F.ws + WS_XS) + (size_t)(expert_base(cnt, e1) + s1) * DM) + F.lane;
        GAS v4u* d2 = (GAS v4u*)((bf16*)(F.ws + WS_XS) + (size_t)(expert_base(cnt, e2) + s2) * DM) + F.lane;
        const v4u a = src[0], c = src[64]; d1[0] = a; d1[64] = c; d2[0] = a; d2[64] = c;
    }
    for (int e = 0; e < 8; ++e) { const int c0 = (int)cnt[e], c1 = (c0 + 255) & ~255, b0 = expert_base(cnt, e);
        for (int q = c0 + gw; q < c1; q += NGW) { GAS v4u* d = (GAS v4u*)((bf16*)(F.ws + WS_XS) + (size_t)(b0 + q) * DM) + F.lane; d[0] = (v4u){0u, 0u, 0u, 0u}; d[64] = (v4u){0u, 0u, 0u, 0u}; } }
}
__device__ __forceinline__ void final_phase(Frame& F, const float* gain, float* out, const unsigned* cnt_prev) {
    const int gw = F.vcu * NWAVES + F.wave, NGW = F.G * NWAVES; float* hres = (float*)(F.ws + WS_HRES);
    for (int q = gw; q < NMAIN; q += NGW) { const int r = q;
        f32x4 v[4]; load_row(F, hres, r, true, cnt_prev, v); const float rstd = row_rstd(v);
        GAS f32x4* o = (GAS f32x4*)(out + (size_t)q * DM) + F.lane;
#pragma unroll
        for (int j = 0; j < 4; ++j) { const f32x4 g = *(const f32x4*)(gain + 4 * F.lane + 256 * j); o[64 * j] = (f32x4){v[j].x * rstd * g.x, v[j].y * rstd * g.y, v[j].z * rstd * g.z, v[j].w * rstd * g.w}; }
    }
}

typedef short v4i16_t __attribute__((ext_vector_type(4)));
__device__ __forceinline__ s16x4 vtr(const LAS unsigned char* p) { return __builtin_bit_cast(s16x4, __builtin_amdgcn_ds_read_tr16_b64_v4i16((LAS v4i16_t*)p)); }
#define MFMA16(a, b, c) __builtin_amdgcn_mfma_f32_16x16x32_bf16((a), (b), (c), 0, 0, 0)
#define CAT8(L, H) (bf16x8){L[0], L[1], L[2], L[3], H[0], H[1], H[2], H[3]}
__device__ __forceinline__ void ret_state_unit(Frame& F, int unit) {
    const int b = unit >> 5, h = (unit >> 3) & 3, es = unit & 7;
    int tid_ = threadIdx.x; asm volatile("" : "+v"(tid_));
    const int tid = tid_, lane = tid & 63, w = __builtin_amdgcn_readfirstlane(tid >> 6), l15 = lane & 15, kg = lane >> 4, q = l15 >> 2, p_ = l15 & 3;
    const float g64 = exp2f(64.0f * log2_gamma(h));
    const bf16* rkz = (const bf16*)(F.ws + WS_R + R_RKZ) + h * 128;
    const bf16* rv = (const bf16*)(F.ws + WS_R + R_RV) + h * 128 + es * 16;
    bf16* ST = (bf16*)(F.ws + WS_R + R_ST) + (size_t)((b * 4 + h) * NCH) * 16384;
    LAS unsigned char* KZ = F.lds; LAS unsigned char* VS = F.lds + 32768;
    v4u k0r, k1r, vr;
#define RS_LOAD(c) do { const int p0 = (c) == 0 ? NMAIN : b * SEQ + 64 * ((c) - 1);          \
        k0r = zero4(); k1r = k0r; vr = k0r; \
        if ((c) != 0 || (tid >> 4) < NMETA) k0r = *(const GAS v4u*)(rkz + (size_t)(p0 + (tid >> 4)) * 512 + (tid & 15) * 8); \
        if ((c) != 0) k1r = *(const GAS v4u*)(rkz + (size_t)(p0 + 32 + (tid >> 4)) * 512 + (tid & 15) * 8); \
        if (tid < 128 && ((c) != 0 || (tid >> 1) < NMETA)) vr = *(const GAS v4u*)(rv + (size_t)(p0 + (tid >> 1)) * 512 + (tid & 1) * 8); } while (0)
#define RS_WRITE(buf) do { *(LAS v4u*)(KZ + (buf) * 16384 + (tid >> 4) * 256 + (tid & 15) * 16) = k0r; *(LAS v4u*)(KZ + (buf) * 16384 + (32 + (tid >> 4)) * 256 + (tid & 15) * 16) = k1r; \
        if (tid < 128) *(LAS v4u*)(VS + (buf) * 2048 + (tid >> 1) * 32 + (tid & 1) * 16) = vr; } while (0)
    RS_LOAD(0); RS_WRITE(0); __syncthreads();
    af4 S = {0.f, 0.f, 0.f, 0.f};
    for (int c = 0; c <= 32; ++c) {
        { v2u o; o.x = pk2(S[0], S[1]); o.y = pk2(S[2], S[3]); *(GAS v2u*)(ST + (size_t)c * 16384 + (es * 16 + l15) * 128 + w * 16 + 4 * kg) = o; }
        if (c == 32) break;
        if (c + 1 < 32) RS_LOAD(c + 1);
        const LAS unsigned char* kz = KZ + (c & 1) * 16384 + w * 32 + p_ * 8; const LAS unsigned char* vs = VS + (c & 1) * 2048 + p_ * 8;
        S *= g64;
#pragma unroll
        for (int u = 0; u < 2; ++u) { const int R0 = 32 * u + 8 * kg + q;
            const s16x4 a0 = vtr(kz + R0 * 256), a1 = vtr(kz + (R0 + 4) * 256), b0 = vtr(vs + R0 * 32), b1 = vtr(vs + (R0 + 4) * 32);
            S = MFMA16(CAT8(a0, a1), CAT8(b0, b1), S); }
        if (c + 1 < 32) RS_WRITE((c + 1) & 1);
        __syncthreads();
    }
    __syncthreads();
#undef RS_LOAD
#undef RS_WRITE
}
__device__ __forceinline__ void ret_out_unit(Frame& F, int unit, const float* gain) {
    const int c = unit < NB * 4 * 32 ? 1 + (unit & 31) : 0, b = unit < NB * 4 * 32 ? unit >> 7 : 0, h = unit < NB * 4 * 32 ? (unit >> 5) & 3 : unit - NB * 4 * 32;
    int tid_ = threadIdx.x; asm volatile("" : "+v"(tid_));
    const int tid = tid_, lane = tid & 63, w = __builtin_amdgcn_readfirstlane(tid >> 6), l15 = lane & 15, kg = lane >> 4, q = l15 >> 2, p_ = l15 & 3, it = w & 3, eh = w >> 2;
    const float lg = log2_gamma(h);
    const size_t r0 = c == 0 ? (size_t)NMAIN : (size_t)b * SEQ + 64 * (c - 1);
    const bf16* rq = (const bf16*)(F.ws + WS_R + R_RQ) + r0 * 512 + h * 128;
    const bf16* rk = (const bf16*)(F.ws + WS_R + R_RK) + r0 * 512 + h * 128;
    const bf16* rv = (const bf16*)(F.ws + WS_R + R_RV) + r0 * 512 + h * 128;
    const bf16* sg = (const bf16*)(F.ws + WS_R + R_SG) + r0 * 512 + h * 128;
    const bf16* ST = (const bf16*)(F.ws + WS_R + R_ST) + (size_t)((b * 4 + h) * NCH + c) * 16384;
    bf16* Y = (bf16*)(F.ws + WS_R + R_Y) + r0 * DM + h * 128;
    LAS unsigned char* VL = F.lds; LAS float* red = (LAS float*)(F.lds + 16384);
#pragma unroll
    for (int i = 0; i < 2; ++i) { const int idx = tid + 512 * i; v4u x = zero4(); if (c > 0 || (idx >> 4) < NMETA) x = *(const GAS v4u*)(rv + (size_t)(idx >> 4) * 512 + (idx & 15) * 8);
        *(LAS v4u*)(VL + (idx >> 4) * 256 + (idx & 15) * 16) = x; }
    bf16x8 qf[4];
#pragma unroll
    for (int ks = 0; ks < 4; ++ks) qf[ks] = *(const GAS bf16x8*)(rq + (size_t)(16 * it + l15) * 512 + 32 * ks + 8 * kg);
    af4 pj[4];
#pragma unroll
    for (int jt = 0; jt < 4; ++jt) { pj[jt] = (af4){0.f, 0.f, 0.f, 0.f};
#pragma unroll
        for (int ks = 0; ks < 4; ++ks) { const bf16x8 kf = *(const GAS bf16x8*)(rk + (size_t)(16 * jt + l15) * 512 + 32 * ks + 8 * kg); pj[jt] = MFMA16(kf, qf[ks], pj[jt]); } }
    bf16x8 pa[2];
    { const int il = 16 * it + l15; unsigned pw[4][2];
#pragma unroll
      for (int jt = 0; jt < 4; ++jt) { float v[4];
#pragma unroll
          for (int r = 0; r < 4; ++r) { const int jl = 16 * jt + 4 * kg + r; const int dd = il > jl ? il - jl : jl - il; const float wgt = __builtin_amdgcn_exp2f(lg * (float)dd); v[r] = (c == 0 && jl >= NMETA) ? 0.f : pj[jt][r] * wgt; }
          pw[jt][0] = pk2(v[0], v[1]); pw[jt][1] = pk2(v[2], v[3]); }
      pa[0] = __builtin_bit_cast(bf16x8, (v4u){pw[0][0], pw[0][1], pw[1][0], pw[1][1]}); pa[1] = __builtin_bit_cast(bf16x8, (v4u){pw[2][0], pw[2][1], pw[3][0], pw[3][1]}); }
    af4 acc[4];
#pragma unroll
    for (int et = 0; et < 4; ++et) acc[et] = (af4){0.f, 0.f, 0.f, 0.f};
    if (c > 0) {
#pragma unroll
        for (int et = 0; et < 4; ++et)
#pragma unroll
            for (int ks = 0; ks < 4; ++ks) { const bf16x8 sf = *(const GAS bf16x8*)(ST + (size_t)(64 * eh + 16 * et + l15) * 128 + 32 * ks + 8 * kg); acc[et] = MFMA16(qf[ks], sf, acc[et]); }
        float xi[4];
#pragma unroll
        for (int r = 0; r < 4; ++r) xi[r] = __builtin_amdgcn_exp2f(lg * (float)(16 * it + 4 * kg + r + 1));
#pragma unroll
        for (int et = 0; et < 4; ++et)
#pragma unroll
            for (int r = 0; r < 4; ++r) acc[et][r] *= xi[r];
    }
    __syncthreads();
#pragma unroll
    for (int et = 0; et < 4; ++et)
#pragma unroll
        for (int u = 0; u < 2; ++u) { const LAS unsigned char* vb = VL + (size_t)(32 * u + 4 * kg + q) * 256 + (64 * eh + 16 * et + 4 * p_) * 2;
            const s16x4 b0 = vtr(vb), b1 = vtr(vb + 16 * 256); acc[et] = MFMA16(pa[u], CAT8(b0, b1), acc[et]); }
    float ss[4];
#pragma unroll
    for (int r = 0; r < 4; ++r) { float s = 0.f;
#pragma unroll
        for (int et = 0; et < 4; ++et) s += acc[et][r] * acc[et][r];
        s = xadd<1>(s); s = xadd<2>(s); s = xadd<4>(s); s = xadd<8>(s); ss[r] = s; }
    if (l15 == 0) {
#pragma unroll
        for (int r = 0; r < 4; ++r) red[eh * 64 + 16 * it + 4 * kg + r] = ss[r]; }
    __syncthreads();
#pragma unroll
    for (int r = 0; r < 4; ++r) { const int il = 16 * it + 4 * kg + r; const float rstd = __builtin_amdgcn_rsqf((red[il] + red[64 + il]) * (1.0f / 128.0f) + EPS);
        if (c > 0 || il < NMETA) {
#pragma unroll
            for (int et = 0; et < 4; ++et) { const int e = 64 * eh + 16 * et + l15; const float o = acc[et][r] * rstd * gain[h * 128 + e] * bf2f(sg[(size_t)il * 512 + e]); Y[(size_t)il * DM + e] = (bf16)f2bf(o); } }
    }
    __syncthreads();
}

#define KSWZ(row, colB) ((row) * 256 + ((colB) ^ (((row) & 7) << 4)))
#define KPSWZ(row, colB) ((row) * 128 + ((colB) ^ (((row) & 7) << 4)))
#define SBAR() __builtin_amdgcn_sched_barrier(0)
__device__ __forceinline__ int crow(int r, int hi) { return (r & 3) + 8 * (r >> 2) + 4 * hi; }
__device__ __forceinline__ int v_st(int k, int c) { const int kk = (k & ~0xC) | ((k & 4) << 1) | ((k & 8) >> 1); return ((kk >> 3) * 4 + (c >> 5)) * 512 + ((kk & 7) * 32 + (c & 31)) * 2; }
__device__ __forceinline__ int v_rd_base(int lane) { return ((lane & 3) << 3) | (((lane >> 2) & 3) << 6) | (((lane >> 4) & 1) << 5) | (((lane >> 5) & 1) << 8); }
constexpr int v_rd_off(int d0, int ks, int half) { return d0 * 512 + ks * 4096 + half * 2048; }
template <int OFF> __device__ __forceinline__ s16x4 tr_read(int vb) { s16x4 r; asm volatile("ds_read_b64_tr_b16 %0, %1 offset:%2" : "=&v"(r) : "v"(vb), "i"(OFF) : "memory"); return r; }
template <int D0> __device__ __forceinline__ void pv_one(f32x16& od, int vb, bf16x8 pa0, bf16x8 pa1, bf16x8 pa2, bf16x8 pa3) {
    const s16x4 l0 = tr_read<v_rd_off(D0, 0, 0)>(vb), h0 = tr_read<v_rd_off(D0, 0, 1)>(vb), l1 = tr_read<v_rd_off(D0, 1, 0)>(vb), h1 = tr_read<v_rd_off(D0, 1, 1)>(vb);
    const s16x4 l2 = tr_read<v_rd_off(D0, 2, 0)>(vb), h2 = tr_read<v_rd_off(D0, 2, 1)>(vb), l3 = tr_read<v_rd_off(D0, 3, 0)>(vb), h3 = tr_read<v_rd_off(D0, 3, 1)>(vb);
    asm volatile("s_waitcnt lgkmcnt(0)" ::: "memory"); SBAR();
    od = __builtin_amdgcn_mfma_f32_32x32x16_bf16(pa0, CAT8(l0, h0), od, 0, 0, 0);
    od = __builtin_amdgcn_mfma_f32_32x32x16_bf16(pa1, CAT8(l1, h1), od, 0, 0, 0);
    od = __builtin_amdgcn_mfma_f32_32x32x16_bf16(pa2, CAT8(l2, h2), od, 0, 0, 0);
    od = __builtin_amdgcn_mfma_f32_32x32x16_bf16(pa3, CAT8(l3, h3), od, 0, 0, 0);
}
__device__ __forceinline__ void attn_unit(Frame& F, int b, int h, int j, const float* gain, char* lds) {
    int tid_ = threadIdx.x; asm volatile("" : "+v"(tid_));
    const int tid = tid_, wid = __builtin_amdgcn_readfirstlane(tid >> 6), lane = tid & 63, r32 = lane & 31, hi = lane >> 5;
    const unsigned char* Rb = F.ws + WS_R;
    const bf16* QN = (const bf16*)(Rb + R_QN); const bf16* QPE = (const bf16*)(Rb + R_QPE); const bf16* KN = (const bf16*)(Rb + R_KN) + h * 128; const bf16* VV = (const bf16*)(Rb + R_V) + h * 128; const bf16* KPE = (const bf16*)(Rb + R_KPE);
    char* V_lds = lds; char* K_lds = lds + 32768; char* KP_lds = lds + 65536; float* wsf = (float*)(lds + 81920) + wid * 64; float* li_l = wsf; float* al_l = wsf + 32;
    const size_t qbase = j < 0 ? (size_t)NMAIN : (size_t)b * SEQ + 256 * j; const size_t rowq = qbase + wid * 32 + r32;
    bf16x8 qr[12];
#pragma unroll
    for (int d0 = 0; d0 < 8; ++d0) qr[d0] = *(const GAS bf16x8*)(QN + rowq * 512 + h * 128 + d0 * 16 + hi * 8);
#pragma unroll
    for (int d0 = 0; d0 < 4; ++d0) qr[8 + d0] = *(const GAS bf16x8*)(QPE + rowq * 256 + h * 64 + d0 * 16 + hi * 8);
    const int NT = j < 0 ? 1 : 4 * j + 5, my_last = j < 0 ? 0 : 1 + 4 * j + (wid >> 1);
    const int sr = tid >> 4, sc = (tid & 15) * 8, vst0 = v_st(sr, sc), vst1 = v_st(32 + sr, sc), kpr = tid >> 3, kpc = (tid & 7) * 8;
    const int vb0 = (int)(uintptr_t)V_lds + v_rd_base(lane);
    v4u vs0, vs1, ks0, ks1, kp;
#define A_LOAD(t) do { const size_t kr = (t) == 0 ? (size_t)NMAIN : (size_t)b * SEQ + 64 * ((t) - 1);     \
        vs0 = zero4(); vs1 = vs0; ks0 = vs0; ks1 = vs0; kp = vs0; \
        if ((t) != 0 || sr < NMETA) { vs0 = *(const GAS v4u*)(VV + (kr + sr) * 512 + sc); ks0 = *(const GAS v4u*)(KN + (kr + sr) * 512 + sc); } \
        if ((t) != 0) { vs1 = *(const GAS v4u*)(VV + (kr + 32 + sr) * 512 + sc); ks1 = *(const GAS v4u*)(KN + (kr + 32 + sr) * 512 + sc); } \
        if ((t) != 0 || kpr < NMETA) kp = *(const GAS v4u*)(KPE + (kr + kpr) * 64 + kpc); } while (0)
#define A_WRITE(bf) do { *(v4u*)(V_lds + (bf) * 16384 + vst0) = vs0; *(v4u*)(V_lds + (bf) * 16384 + vst1) = vs1; *(v4u*)(K_lds + (bf) * 16384 + KSWZ(sr, sc * 2)) = ks0; *(v4u*)(K_lds + (bf) * 16384 + KSWZ(32 + sr, sc * 2)) = ks1; \
        *(v4u*)(KP_lds + (bf) * 8192 + KPSWZ(kpr, kpc * 2)) = kp; } while (0)
    float m_reg = -1e30f, l_reg = 0.f; f32x16 o[4];
#pragma unroll
    for (int d = 0; d < 4; ++d)
#pragma unroll
        for (int r = 0; r < 16; ++r) o[d][r] = 0.f;
    A_LOAD(0); A_WRITE(0); __syncthreads();
    for (int t = 0; t < NT; ++t) {
        if (t > my_last && t + 1 < NT) A_LOAD(t + 1);
        if (t <= my_last) {
            const char* Kt = K_lds + (t & 1) * 16384; const char* KPt = KP_lds + (t & 1) * 8192;
            f32x16 p0v, p1v;
#pragma unroll
            for (int r = 0; r < 16; ++r) { p0v[r] = 0.f; p1v[r] = 0.f; }
#pragma unroll
            for (int d0 = 0; d0 < 8; ++d0) { const int cb = (d0 * 16 + hi * 8) * 2;
                const bf16x8 b0 = *(const bf16x8*)(Kt + KSWZ(r32, cb)), b1 = *(const bf16x8*)(Kt + KSWZ(32 + r32, cb));
                p0v = __builtin_amdgcn_mfma_f32_32x32x16_bf16(b0, qr[d0], p0v, 0, 0, 0); p1v = __builtin_amdgcn_mfma_f32_32x32x16_bf16(b1, qr[d0], p1v, 0, 0, 0); }
#pragma unroll
            for (int d0 = 0; d0 < 4; ++d0) { const int cb = (d0 * 16 + hi * 8) * 2;
                const bf16x8 b0 = *(const bf16x8*)(KPt + KPSWZ(r32, cb)), b1 = *(const bf16x8*)(KPt + KPSWZ(32 + r32, cb));
                p0v = __builtin_amdgcn_mfma_f32_32x32x16_bf16(b0, qr[8 + d0], p0v, 0, 0, 0); p1v = __builtin_amdgcn_mfma_f32_32x32x16_bf16(b1, qr[8 + d0], p1v, 0, 0, 0); }
            if (t == 0) {
#pragma unroll
                for (int r = 8; r < 16; ++r) p0v[r] = -1e30f;
#pragma unroll
                for (int r = 0; r < 16; ++r) p1v[r] = -1e30f; }
            float pmax = p0v[0];
#pragma unroll
            for (int r = 1; r < 16; ++r) pmax = fmaxf(pmax, p0v[r]);
#pragma unroll
            for (int r = 0; r < 16; ++r) pmax = fmaxf(pmax, p1v[r]);
            { auto rr = __builtin_amdgcn_permlane32_swap(__float_as_uint(pmax), __float_as_uint(pmax), false, false); pmax = fmaxf(__uint_as_float(rr[0]), __uint_as_float(rr[1])); }
            const float mn = fmaxf(m_reg, pmax), alpha = __builtin_amdgcn_exp2f(m_reg - mn); m_reg = mn;
            float ps = 0.f;
#pragma unroll
            for (int r = 0; r < 16; ++r) { p0v[r] = __builtin_amdgcn_exp2f(p0v[r] - mn); p1v[r] = __builtin_amdgcn_exp2f(p1v[r] - mn); ps += p0v[r] + p1v[r]; }
            { auto rr = __builtin_amdgcn_permlane32_swap(__float_as_uint(ps), __float_as_uint(ps), false, false); ps = __uint_as_float(rr[0]) + __uint_as_float(rr[1]); }
            l_reg = l_reg * alpha + ps;
            if (__any(alpha < 1.f)) { if (hi == 0) al_l[r32] = alpha; asm volatile("s_waitcnt lgkmcnt(0)" ::: "memory");
#pragma unroll
                for (int r = 0; r < 16; ++r) { const float a = al_l[crow(r, hi)];
#pragma unroll
                    for (int d = 0; d < 4; ++d) o[d][r] *= a; } }
            bf16x8 pa0, pa1, pa2, pa3;
#define PK4(P, BASE, OUT) do { unsigned a0 = pk2(P[BASE + 0], P[BASE + 1]), a1 = pk2(P[BASE + 2], P[BASE + 3]); \
    unsigned b0_ = pk2(P[BASE + 4], P[BASE + 5]), b1_ = pk2(P[BASE + 6], P[BASE + 7]); \
    auto r0_ = __builtin_amdgcn_permlane32_swap(a0, b0_, false, false); auto r1_ = __builtin_amdgcn_permlane32_swap(a1, b1_, false, false); \
    v4u w_ = {r0_[0], r1_[0], r0_[1], r1_[1]}; OUT = __builtin_bit_cast(bf16x8, w_); } while (0)
            PK4(p0v, 0, pa0); PK4(p0v, 8, pa1); PK4(p1v, 0, pa2); PK4(p1v, 8, pa3);
#undef PK4
            if (t + 1 < NT) A_LOAD(t + 1);
            const int vb = vb0 + (t & 1) * 16384;
            pv_one<0>(o[0], vb, pa0, pa1, pa2, pa3); pv_one<1>(o[1], vb, pa0, pa1, pa2, pa3); pv_one<2>(o[2], vb, pa0, pa1, pa2, pa3); pv_one<3>(o[3], vb, pa0, pa1, pa2, pa3);
        }
        if (t + 1 < NT) A_WRITE((t + 1) & 1);
        __syncthreads();
    }
    if (hi == 0) li_l[r32] = l_reg; asm volatile("s_waitcnt lgkmcnt(0)" ::: "memory");
    bf16* Y = (bf16*)(F.ws + WS_R + R_Y) + (qbase + wid * 32) * DM + 512 + h * 128;
    float gn[4];
#pragma unroll
    for (int d = 0; d < 4; ++d) gn[d] = gain[h * 128 + 32 * d + r32];
#pragma unroll
    for (int r = 0; r < 16; ++r) { const int orow = crow(r, hi); const float lr = li_l[orow];
        float s = (o[0][r] * o[0][r] + o[1][r] * o[1][r]) + (o[2][r] * o[2][r] + o[3][r] * o[3][r]);
        s = xadd<1>(s); s = xadd<2>(s); s = xadd<4>(s); s = xadd<8>(s); s = xadd<16>(s);
        const float rstd = __builtin_amdgcn_rsqf(s * (1.0f / 128.0f) + EPS * lr * lr);
        if (j >= 0 || (wid == 0 && orow < NMETA)) {
#pragma unroll
            for (int d = 0; d < 4; ++d) Y[(size_t)orow * DM + 32 * d + r32] = (bf16)f2bf(o[d][r] * rstd * gn[d]); } }
    __syncthreads();
#undef A_LOAD
#undef A_WRITE
}

struct Args { Inputs in; float* out; unsigned char* ws; int phase; int pad; };
constexpr int N_ATT_UNITS = 260, N_RO_UNITS = NB * 4 * 32 + 4;
constexpr int PH_PER_LAYER = 9, N_PHASES = 1 + DEPTH * PH_PER_LAYER + 1;

__global__ void __launch_bounds__(NWAVES * 64, 2) mk_fwd(Args args) {
    extern __shared__ __attribute__((aligned(16))) unsigned char lds[];
    Frame F;
    F.lds = (LAS unsigned char*)lds; F.MISC = (volatile LAS unsigned*)(F.lds + MISC_OFF);
    F.tid = threadIdx.x; F.lane = F.tid & 63; F.wave = __builtin_amdgcn_readfirstlane(F.tid >> 6);
    F.G = gridDim.x; { const int bx = blockIdx.x; F.vcu = (F.G % 8 == 0) ? (bx % 8) * (F.G / 8) + bx / 8 : bx; }
    F.ws = args.ws; F.ctl = (gu32*)(args.ws + WS_CTL);
    for (int u = F.tid; u < (LDS_BYTES - LDSCTL_OFF) / 4; u += NWAVES * 64) ((LAS unsigned*)(F.lds + LDSCTL_OFF))[u] = 0u;
    __syncthreads();
    XcdBarrier bar; bar.bar = (unsigned*)(F.ctl + CW_BAR); bar.x = 0; bar.st = nullptr;
    if (!MK_MULTI) bar = xcd_barrier_post((unsigned*)(F.ctl + CW_BAR), F.MISC + 8);
#define R (F.ws + WS_R)
#define tab ((const float*)(F.ws + WS_TAB))
#define hres ((float*)(F.ws + WS_HRES))
#define XN ((const pg8::bf16_t*)(F.ws + WS_XN))
#define cnt ((unsigned*)(F.ctl + CW_CNT) + li * 8)
    int ph = 0;
#ifndef MK_ALIGN
#define MK_ALIGN true
#endif
#ifndef MK_SP2
#define MK_SP2 true
#endif
#ifndef MK_MASK
#define MK_MASK 0xFFFFFFFFu
#endif
#define ON(k) (((MK_MASK) >> (k)) & 1u)
#ifndef MK_ATT_REP
#define MK_ATT_REP 1
#endif
#ifndef MK_RO_REP
#define MK_RO_REP 1
#endif
#ifndef MK_REP_PH
#define MK_REP_PH (-1)
#endif
#ifndef MK_REP_N
#define MK_REP_N 1
#endif
#define RUN() (MK_MULTI ? (ph == args.phase) : true)
#define SEAM() do { if (!MK_MULTI) { asm volatile("" : "+s"(bar.x)); bar.bar = (unsigned*)(F.ctl + CW_BAR); xcd_barrier(bar); } ++ph; int z_ = 0; asm volatile("" : "+v"(F.tid), "+s"(z_)); F.lane = F.tid & 63; F.wave = __builtin_amdgcn_readfirstlane(F.tid >> 6); F.ws = args.ws + z_; F.ctl = (gu32*)(F.ws + WS_CTL); } while (0)
#define REPS(k) _Pragma("unroll 1") for (int rep_ = 0; rep_ < ((k) == MK_REP_PH ? MK_REP_N : 1); ++rep_, ((rep_ < ((k) == MK_REP_PH ? MK_REP_N : 1)) ? ({ SEAM(); --ph; 0; }) : 0))

    REPS(0) if (ON(0) && RUN()) p0_prologue(F);
    SEAM();
#pragma unroll 1
    for (int l = 0; l < DEPTH; ++l) {
        const bool moe = (l & 1) != 0; const int li = l >> 1;
        REPS(1) if (ON(1) && RUN()) norm_phase(F, l == 2 && rep_ == 0, (const unsigned*)(F.ctl + CW_CNT));
        SEAM();
        REPS(2) if (ON(2) && RUN()) {
            pg8::Gemm g{XN, (const pg8::bf16_t*)(F.ws + WS_WIN) + (size_t)l * DINP * DM, NMAIN, DINP, DM, 0};
            pg8::StaticOrder S; S.init(NMAIN, DINP, F.G, (int)blockIdx.x);
            EpiInProj E{R, (float*)(F.ws + CTL_SSQ), (float*)(F.ws + CTL_SSKV), tab, log2_gamma(0), log2_gamma(1), log2_gamma(2), log2_gamma(3)};
            meta_gemm<EpiInProj>(F, XN + (size_t)NMAIN * DM, g.Bt, DINP, DM, E);
            pg8::gemm_phase<EpiInProj, pg8::StaticOrder, MK_ALIGN, MK_SP2>(F.lds, g, S, E);
        }
        SEAM();
        REPS(3) if (ON(3) && RUN()) {
            pg8::Gemm g{(const pg8::bf16_t*)(R + R_LAT), (const pg8::bf16_t*)(F.ws + WS_WUP) + (size_t)l * UPN * UPK, NMAIN, UPN, UPK, 0};
            pg8::StaticOrder S; S.init(NMAIN, UPN, F.G, (int)blockIdx.x);
            EpiUp E{R, (const float*)(F.ws + CTL_SSQ), (const float*)(F.ws + CTL_SSKV), tab};
            meta_gemm<EpiUp>(F, g.A + (size_t)NMAIN * UPK, g.Bt, UPN, UPK, E);
            pg8::gemm_phase<EpiUp, pg8::StaticOrder, MK_ALIGN, MK_SP2>(F.lds, g, S, E);
            if (ON(4)) for (int u = blockIdx.x; u < NB * 4 * 8; u += F.G) ret_state_unit(F, u);
        }
        SEAM();
        REPS(5) if (RUN()) {
            gu32* qh = F.ctl + CW_QUEUE + 64 * l + 8 * rep_;
            for (;;) {
                if (F.tid == 0) F.MISC[16] = __hip_atomic_fetch_add(qh, 1u, RLX_AGENT);
                __syncthreads(); const int u = (int)F.MISC[16]; __syncthreads();
                if (u >= MK_ATT_REP * N_ATT_UNITS + MK_RO_REP * N_RO_UNITS) break;
                if (u < MK_ATT_REP * N_ATT_UNITS) { if (ON(5)) { const int v = u % N_ATT_UNITS; const int j = v < 256 ? 7 - (v >> 5) : -1, bh = v < 256 ? (v & 31) : (v - 256); attn_unit(F, bh >> 2, bh & 3, j, ldin(I_MLAG) + l * 512, (char*)lds); } }
                else if (ON(6)) ret_out_unit(F, (u - MK_ATT_REP * N_ATT_UNITS) % N_RO_UNITS, ldin(I_RETG) + l * 512);
            }
        }
        SEAM();
        REPS(7) if (ON(7) && RUN()) {
            pg8::Gemm g{(const pg8::bf16_t*)(R + R_Y), (const pg8::bf16_t*)(F.ws + WS_WOUT) + (size_t)l * DM * DM, NMAIN, DM, DM, 0};
            pg8::StaticOrder S; S.init(NMAIN, DM, F.G, (int)blockIdx.x);
            EpiResid E{rep_ == 0 ? hres : (float*)(F.ws + WS_XS)};
            meta_gemm<EpiResid>(F, g.A + (size_t)NMAIN * DM, g.Bt, DM, DM, E);
            pg8::gemm_phase<EpiResid, pg8::StaticOrder, MK_ALIGN, MK_SP2>(F.lds, g, S, E);
        }
        SEAM();
        if (!moe) {
            REPS(8) if (ON(8) && RUN()) norm_phase(F, false, nullptr);
            SEAM();
            REPS(9) if (ON(9) && RUN()) {
                pg8::Gemm g{XN, (const pg8::bf16_t*)(F.ws + WS_WDGU) + (size_t)li * 2 * FF * DM, NMAIN, 2 * FF, DM, 0};
                pg8::StaticOrder S; S.init(NMAIN, 2 * FF, F.G, (int)blockIdx.x);
                EpiSwiGLU E{(bf16*)(R + R_ACT)};
                meta_gemm<EpiSwiGLU>(F, XN + (size_t)NMAIN * DM, g.Bt, 2 * FF, DM, E);
                pg8::gemm_phase<EpiSwiGLU, pg8::StaticOrder, MK_ALIGN, MK_SP2>(F.lds, g, S, E);
            }
            SEAM();
            REPS(10) if (ON(10) && RUN()) {
                pg8::Gemm g{(const pg8::bf16_t*)(R + R_ACT), (const pg8::bf16_t*)(F.ws + WS_WDD) + (size_t)li * DM * FF, NMAIN, DM, FF, 0};
                pg8::StaticOrder S; S.init(NMAIN, DM, F.G, (int)blockIdx.x);
                EpiResid E{rep_ == 0 ? hres : (float*)(F.ws + WS_XS)};
                meta_gemm<EpiResid>(F, g.A + (size_t)NMAIN * FF, g.Bt, DM, FF, E);
                pg8::gemm_phase<EpiResid, pg8::StaticOrder, MK_ALIGN, MK_SP2>(F.lds, g, S, E);
            }
            SEAM();
            ++ph;
        } else {
            if (ON(11) && RUN()) route_phase(F, ldin(I_FFNNORM) + l * DM, ldin(I_ROUTER) + (size_t)li * DM * NEXP, cnt);
            SEAM();
            REPS(12) if (ON(12) && RUN()) gather_phase(F, cnt);
            SEAM();
            REPS(13) if (ON(13) && RUN()) {
                pg8::Gemm g{(const pg8::bf16_t*)(F.ws + WS_XS), (const pg8::bf16_t*)(F.ws + WS_WMGU) + (size_t)li * NEXP * 2 * FF * DM, XS_ROWS, 2 * FF, DM, (size_t)2 * FF * DM * 2};
                pg8::GroupedOrder S; S.init(cnt, 2 * FF, F.G, (int)blockIdx.x);
                EpiSwiGLU E{(bf16*)(R + R_ACT)};
                pg8::gemm_phase<EpiSwiGLU, pg8::GroupedOrder, MK_ALIGN, MK_SP2>(F.lds, g, S, E);
            }
            SEAM();
            REPS(14) if (ON(14) && RUN()) {
                pg8::Gemm g{(const pg8::bf16_t*)(R + R_ACT), (const pg8::bf16_t*)(F.ws + WS_WMD) + (size_t)li * NEXP * DM * FF, XS_ROWS, DM, FF, (size_t)DM * FF * 2};
                pg8::GroupedOrder S; S.init(cnt, DM, F.G, (int)blockIdx.x);
                EpiMoeDown E{(bf16*)(F.ws + WS_YS)};
                pg8::gemm_phase<EpiMoeDown, pg8::GroupedOrder, MK_ALIGN, MK_SP2>(F.lds, g, S, E);
            }
            SEAM();
        }
    }
    if (ON(15) && RUN()) final_phase(F, ldin(I_FINAL), args.out, (const unsigned*)(F.ctl + CW_CNT) + 8);
#undef RUN
#undef SEAM
#undef R
#undef tab
#undef hres
#undef XN
#undef cnt
}

extern "C" void kernel_launch(void* const* d_in, const int* in_sizes, int n_in, void* d_out, int out_size, void* d_ws, size_t ws_size, hipStream_t stream) {
    static int grid = 0;
    if (grid == 0) {
        if (n_in != 20 || in_sizes[0] != NB * SEQ * DM || out_size != NB * SEQ * DM || ws_size < WS_END) {
            fprintf(stderr, "kernel_launch: shape mismatch: n_in %d in0 %d out %d ws %zu (need >= %zu)\n", n_in, n_in > 0 ? in_sizes[0] : -1, out_size, ws_size, (size_t)WS_END); grid = -1; return; }
        int dev = 0, cus = 0, per_cu = 0;
        if (hipGetDevice(&dev) != hipSuccess || hipDeviceGetAttribute(&cus, hipDeviceAttributeMultiprocessorCount, dev) != hipSuccess) { grid = -1; return; }
        if (hipFuncSetAttribute((const void*)mk_fwd, hipFuncAttributeMaxDynamicSharedMemorySize, LDS_BYTES) != hipSuccess) { fprintf(stderr, "kernel_launch: hipFuncSetAttribute failed\n"); grid = -1; return; }
        if (hipOccupancyMaxActiveBlocksPerMultiprocessor(&per_cu, (const void*)mk_fwd, NWAVES * 64, LDS_BYTES) != hipSuccess || per_cu < 1)
            fprintf(stderr, "kernel_launch: occupancy query reports %d workgroups per CU\n", per_cu);
        (void)hipGetLastError();
        grid = cus;
    }
    if (grid < 0) return;
    if (hipMemsetAsync((char*)d_ws + WS_CTL, 0, CTL_ZERO_BYTES, stream) != hipSuccess) { fprintf(stderr, "kernel_launch: memset failed\n"); return; }
    Args a{};
    for (int i = 0; i < 20; ++i) a.in.p[i] = (const float*)d_in[i];
    a.out = (float*)d_out; a.ws = (unsigned char*)d_ws; a.phase = 0; a.pad = 0;
#if MK_MULTI
    for (int ph = 0; ph < N_PHASES; ++ph) { a.phase = ph; hipLaunchKernelGGL(mk_fwd, dim3(grid), dim3(NWAVES * 64), LDS_BYTES, stream, a); }
#else
    hipLaunchKernelGGL(mk_fwd, dim3(grid), dim3(NWAVES * 64), LDS_BYTES, stream, a);
#endif
    const hipError_t le = hipPeekAtLastError();
    if (le != hipSuccess) fprintf(stderr, "kernel_launch: launch failed: %s\n", hipGetErrorName(le));
}
```

```cpp
#include <hip/hip_runtime.h>
#include <cstdio>
#include <cstdint>
namespace pg8 {
#define PG8_LAS __attribute__((address_space(3)))
typedef unsigned short bf16_t;
typedef short bf16x8 __attribute__((ext_vector_type(8)));
typedef float f32x4 __attribute__((ext_vector_type(4)));
typedef unsigned u32x4 __attribute__((ext_vector_type(4)));
constexpr int BM = 256, BK = 64, HALF = 128, HTB = HALF * BK * 2  , STAGE_BYTES = 8 * HTB, NXCD = 8, WGM = 4;

__host__ __device__ __forceinline__ int lds_byte(int r, int c) { const int st = (r >> 4) * 2 + (c >> 5), rr = r & 15, cc = c & 31, ob = rr * 64 + cc * 2; return st * 1024 + (ob ^ (((ob >> 9) & 1) << 5)); }
__host__ __device__ __forceinline__ void stage_rc(int b, int& R, int& C) { const int st = b / 1024, sb = b % 1024, swz = sb ^ (((sb >> 9) & 1) << 5); R = (st >> 1) * 16 + swz / 64; C = (st & 1) * 32 + (swz % 64) / 2; }
__host__ __device__ __forceinline__ int perm32(int rho) { const int n = rho >> 4, i = rho & 15; return 8 * (i >> 2) + 4 * n + (i & 3); }

struct Unit { int pm, pn, eb; unsigned koff; int nt; };
struct Gemm { const bf16_t* A; const bf16_t* Bt; int M, N, K; size_t estride; int ld = 0; };

struct StaticOrder {
    int nM, nN, nwg, G, c, base, lim; int pnsplit = 1 << 30; unsigned koff_hi = 0u; int nt_lo = 0, nt_hi = 0;
    __host__ __device__ void init(int M, int N, int G_, int c_) { nM = M / BM; nN = N / BM; nwg = nM * nN; G = G_; c = c_; base = 0; lim = nwg; }
    __host__ __device__ void window(int base_, int G_, int c_, int lim_) { base = base_; G = G_; c = c_; lim = lim_; }
    __host__ __device__ bool next(int i, Unit& u) const {
        const long L = (long)i * G + c + base; if (L >= lim) return false;
        int wgid = (int)L; { const int q = nwg / NXCD, r = nwg % NXCD, xcd = wgid % NXCD, off = wgid / NXCD; wgid = (xcd < r ? xcd * (q + 1) : r * (q + 1) + (xcd - r) * q) + off; }
        const int nig = WGM * nN, gid = wgid / nig, fm = gid * WGM, gsz = (nM - fm) < WGM ? (nM - fm) : WGM;
        u.pm = fm + ((wgid % nig) % gsz); u.pn = (wgid % nig) / gsz; u.eb = 0; u.koff = u.pn >= pnsplit ? koff_hi : 0u; u.nt = u.pn >= pnsplit ? nt_hi : nt_lo; return true;
    }
    __device__ __forceinline__ void a_ready(const Unit&) const {}
    __device__ __forceinline__ void done(const Unit&) const {}
};
struct GroupedOrder {
    int nM, nN, nwg, G, c; int tp[9]; int pm0, nK; unsigned kbytes;
    __device__ __forceinline__ void init(const unsigned* cnt, int N, int G_, int c_, int pm_lo = 0, int pm_cap = 1 << 30, int nK_ = 1, unsigned kbytes_ = 0u) {
        tp[0] = 0;
#pragma unroll
        for (int e = 0; e < 8; ++e) tp[e + 1] = tp[e] + __builtin_amdgcn_readfirstlane((int)((cnt[e] + 255u) >> 8));
        const int hi = tp[8] < pm_cap ? tp[8] : pm_cap; pm0 = pm_lo; nM = hi > pm_lo ? hi - pm_lo : 0; nK = nK_; kbytes = kbytes_;
        nN = (N / BM) * nK; nwg = nM * nN; G = G_; c = c_; }
    __device__ __forceinline__ bool next(int i, Unit& u) const {
        const long L = (long)i * G + c; if (L >= nwg) return false;
        int wgid = (int)L; { const int q = nwg / NXCD, r = nwg % NXCD, xcd = wgid % NXCD, off = wgid / NXCD; wgid = (xcd < r ? xcd * (q + 1) : r * (q + 1) + (xcd - r) * q) + off; }
        const int nig = WGM * nN, gid = wgid / nig, fm = gid * WGM, gsz = (nM - fm) < WGM ? (nM - fm) : WGM;
        u.pm = pm0 + fm + ((wgid % nig) % gsz); const int pk = (wgid % nig) / gsz; u.pn = pk / nK; u.koff = (unsigned)(pk % nK) * kbytes; u.nt = 0;
        int e = 0;
#pragma unroll
        for (int k = 1; k < 8; ++k) e += (u.pm >= tp[k]) ? 1 : 0;
        u.eb = e; return true;
    }
    __device__ __forceinline__ void a_ready(const Unit&) const {}
    __device__ __forceinline__ void done(const Unit&) const {}
};
__device__ __forceinline__ unsigned cvt_pk_bf16(float lo, float hi) { unsigned r; asm volatile("v_cvt_pk_bf16_f32 %0, %1, %2" : "=v"(r) : "v"(lo), "v"(hi)); return r; }
typedef int i32x4 __attribute__((ext_vector_type(4)));
__device__ __forceinline__ f32x4 zero_acc() { float z; asm volatile("v_mov_b32 %0, 0" : "=v"(z)); return (f32x4){z, z, z, z}; }
template <bool I8> __device__ __forceinline__ f32x4 mma16(bf16x8 b, bf16x8 a, f32x4 c) {
    if constexpr (I8) return __builtin_bit_cast(f32x4, __builtin_amdgcn_mfma_i32_16x16x64_i8(__builtin_bit_cast(i32x4, b), __builtin_bit_cast(i32x4, a), __builtin_bit_cast(i32x4, c), 0, 0, 0));
    else return __builtin_amdgcn_mfma_f32_16x16x32_bf16(b, a, c, 0, 0, 0);
}
typedef int i32x8 __attribute__((ext_vector_type(8)));
__device__ __forceinline__ f32x4 mma_f8(bf16x8 b0, bf16x8 b1, bf16x8 a0, bf16x8 a1, f32x4 c) {
    const i32x8 B = __builtin_shufflevector(__builtin_bit_cast(i32x4, b0), __builtin_bit_cast(i32x4, b1), 0, 1, 2, 3, 4, 5, 6, 7), A = __builtin_shufflevector(__builtin_bit_cast(i32x4, a0), __builtin_bit_cast(i32x4, a1), 0, 1, 2, 3, 4, 5, 6, 7);
    asm volatile("v_mfma_f32_16x16x128_f8f6f4 %0, %1, %2, %0" : "+v"(c) : "v"(B), "v"(A));
    return c;
}
struct NoMeta { __device__ __forceinline__ void operator()() const {} };
template <class Epi, class Sched, bool ALIGN_EPI = false, bool SP2 = false, int QM = 0, class MetaF = NoMeta>
__device__ __forceinline__ void gemm_phase(PG8_LAS unsigned char* lds, const Gemm g, const Sched& S, const Epi& E, const MetaF& meta = MetaF()) {
    int tid_ = threadIdx.x; asm volatile("" : "+v"(tid_));
    const int tid = tid_, wid = __builtin_amdgcn_readfirstlane(tid >> 6), lane = tid & 63, wr = wid >> 2, wc = wid & 3, fr = lane & 15, fq = lane >> 4;
    const int K = g.ld ? g.ld : g.K, nt = g.K / BK;
    unsigned voffA[2], voffB[2];
#pragma unroll
    for (int i = 0; i < 2; ++i) { int R, C; stage_rc(tid * 16 + i * 8192, R, C); const int Rb = Epi::PERM ? ((R & ~31) + perm32(R & 31)) : R;
        voffA[i] = (unsigned)(R * K + C) * 2u; voffB[i] = (unsigned)(Rb * K + C) * 2u; }
    const size_t kstep = (size_t)(BK * 2);
    const size_t hstep = (size_t)HALF * K * 2;
    const size_t tstep = 2 * hstep;
    const unsigned ldsw = (unsigned)wid * 1024u;
    const int aoff = lds_byte(wr * 64 + fr, fq * 8), boff = lds_byte(wc * 32 + fr, fq * 8);
#define PG8_SA(b, h) (((b) * 2 + (h)) * HTB)
#define PG8_SB(b, h) ((4 + (b) * 2 + (h)) * HTB)
#define PG8_STAGE(bufoff, gbase, voff) do { _Pragma("unroll") for (int _i = 0; _i < 2; ++_i) \
        __builtin_amdgcn_global_load_lds((const unsigned*)((const char*)(gbase) + (voff)[_i]), (PG8_LAS unsigned*)(lds + (bufoff) + ldsw + _i * 8192), 16, 0, 0); } while (0)
#define PG8_LDA(dst, b, h) do { _Pragma("unroll") for (int m = 0; m < 4; ++m) _Pragma("unroll") for (int k = 0; k < 2; ++k) dst[m][k] = *(const PG8_LAS bf16x8*)(lds + PG8_SA(b, h) + aoff + m * 2048 + k * 1024); } while (0)
#define PG8_LDB(dst, b, h) do { _Pragma("unroll") for (int n = 0; n < 2; ++n) _Pragma("unroll") for (int k = 0; k < 2; ++k) dst[n][k] = *(const PG8_LAS bf16x8*)(lds + PG8_SB(b, h) + boff + n * 2048 + k * 1024); } while (0)
#define PG8_MMA(ai, bj, At, Bt) do { __builtin_amdgcn_s_setprio(1); _Pragma("unroll") for (int m = 0; m < 4; ++m) _Pragma("unroll") for (int n = 0; n < 2; ++n) { \
        if constexpr (QM == 2) acc[ai][bj][m][n] = mma_f8(Bt[n][0], Bt[n][1], At[m][0], At[m][1], acc[ai][bj][m][n]); \
        else { _Pragma("unroll") for (int k = 0; k < 2; ++k) acc[ai][bj][m][n] = mma16<QM == 1>(Bt[n][k], At[m][k], acc[ai][bj][m][n]); } } __builtin_amdgcn_s_setprio(0); } while (0)
#define PG8_WAIT_V(n) asm volatile("s_waitcnt vmcnt(" #n ")" ::: "memory")
#define PG8_WAIT_L(n) asm volatile("s_waitcnt lgkmcnt(" #n ")" ::: "memory")
#define PG8_BAR __builtin_amdgcn_s_barrier()
#define PG8_SCHED __builtin_amdgcn_sched_barrier(0)
    Unit cur, nxt; int ui = 0;
    if (!S.next(0, cur)) { meta(); return; }
    f32x4 acc[2][2][4][2];
    bf16x8 At[4][2], B0[2][2], B1[2][2];
    const char* cA = (const char*)g.A + (size_t)cur.pm * tstep + cur.koff; const char* cB = (const char*)g.Bt + (size_t)cur.eb * g.estride + (size_t)cur.pn * tstep + cur.koff;
    S.a_ready(cur);
    PG8_LAS unsigned char* const scl = lds + 143360;
    if constexpr (Epi::PRE_RS) E.pre(cur, scl, wid, lane);
    if constexpr (SP2) {
        PG8_STAGE(PG8_SB(0, 0), cB, voffB); PG8_STAGE(PG8_SB(0, 1), cB + hstep, voffB); PG8_STAGE(PG8_SA(0, 0), cA, voffA); PG8_STAGE(PG8_SA(0, 1), cA + hstep, voffA);
        meta();
        if (wr == 1) PG8_BAR;
        PG8_WAIT_V(2); PG8_BAR;
        PG8_STAGE(PG8_SB(1, 0), cB + kstep, voffB); PG8_STAGE(PG8_SA(1, 0), cA + kstep, voffA); PG8_STAGE(PG8_SB(1, 1), cB + hstep + kstep, voffB);
        PG8_WAIT_V(6); PG8_BAR;
    } else {
        PG8_STAGE(PG8_SB(0, 0), cB, voffB); PG8_STAGE(PG8_SA(0, 0), cA, voffA); PG8_STAGE(PG8_SB(0, 1), cB + hstep, voffB); PG8_STAGE(PG8_SA(0, 1), cA + hstep, voffA);
        meta();
        if (wr == 1) PG8_BAR;
        PG8_WAIT_V(4); PG8_BAR;
        PG8_STAGE(PG8_SB(1, 0), cB + kstep, voffB); PG8_STAGE(PG8_SA(1, 0), cA + kstep, voffA); PG8_STAGE(PG8_SB(1, 1), cB + hstep + kstep, voffB);
        PG8_WAIT_V(6); PG8_BAR;
    }
#pragma unroll
    for (int a = 0; a < 2; ++a)
#pragma unroll
        for (int b = 0; b < 2; ++b)
#pragma unroll
            for (int m = 0; m < 4; ++m)
#pragma unroll
                for (int n = 0; n < 2; ++n) acc[a][b][m][n] = zero_acc();
    for (;;) {
        const bool has_next = S.next(ui + 1, nxt);
        const char* nA = has_next ? (const char*)g.A + (size_t)nxt.pm * tstep + nxt.koff : cA; const char* nB = has_next ? (const char*)g.Bt + (size_t)nxt.eb * g.estride + (size_t)nxt.pn * tstep + nxt.koff : cB;
        const int nt_u = cur.nt ? cur.nt : nt;
        for (int t = 0; t < nt_u; t += 2) {
            const bool last = (t == nt_u - 2);
            const char* a1 = cA + (size_t)(t + 1) * kstep;
            const char* a2 = last ? nA : cA + (size_t)(t + 2) * kstep; const char* b2 = last ? nB : cB + (size_t)(t + 2) * kstep;
            const char* a3 = a2 + kstep; const char* b3 = b2 + kstep;
            if (last && has_next) S.a_ready(nxt);
            if constexpr (SP2) {
            PG8_LDB(B0, 0, 0); PG8_LDB(B1, 0, 1); PG8_SCHED; PG8_LDA(At, 0, 0); PG8_STAGE(PG8_SA(1, 1), a1 + hstep, voffA);
            PG8_WAIT_V(8); PG8_WAIT_L(0); PG8_BAR; PG8_MMA(0, 0, At, B0); PG8_MMA(0, 1, At, B1); PG8_BAR; PG8_SCHED;
            PG8_LDA(At, 0, 1); PG8_STAGE(PG8_SB(0, 0), b2, voffB); PG8_STAGE(PG8_SB(0, 1), b2 + hstep, voffB); PG8_STAGE(PG8_SA(0, 0), a2, voffA);
            PG8_WAIT_V(8); PG8_WAIT_L(0); PG8_BAR; PG8_MMA(1, 0, At, B0); PG8_MMA(1, 1, At, B1); PG8_BAR; PG8_SCHED;
            PG8_LDB(B0, 1, 0); PG8_LDB(B1, 1, 1); PG8_SCHED; PG8_LDA(At, 1, 0); PG8_STAGE(PG8_SA(0, 1), a2 + hstep, voffA);
            PG8_WAIT_V(8); PG8_WAIT_L(0); PG8_BAR; PG8_MMA(0, 0, At, B0); PG8_MMA(0, 1, At, B1); PG8_BAR; PG8_SCHED;
            PG8_LDA(At, 1, 1); PG8_STAGE(PG8_SB(1, 0), b3, voffB); PG8_STAGE(PG8_SB(1, 1), b3 + hstep, voffB); PG8_STAGE(PG8_SA(1, 0), a3, voffA);
            PG8_WAIT_V(8); PG8_WAIT_L(0); PG8_BAR; PG8_MMA(1, 0, At, B0); PG8_MMA(1, 1, At, B1); PG8_BAR; PG8_SCHED;
            } else {
            PG8_LDB(B0, 0, 0); PG8_SCHED; PG8_LDA(At, 0, 0); PG8_STAGE(PG8_SA(1, 1), a1 + hstep, voffA);
            PG8_WAIT_L(8); PG8_BAR; PG8_WAIT_L(0); PG8_MMA(0, 0, At, B0); PG8_BAR; PG8_SCHED;
            PG8_LDB(B1, 0, 1); PG8_STAGE(PG8_SB(0, 0), b2, voffB);
            PG8_BAR; PG8_WAIT_L(0); PG8_MMA(0, 1, At, B1); PG8_BAR;
            PG8_LDA(At, 0, 1); PG8_STAGE(PG8_SA(0, 0), a2, voffA);
            PG8_BAR; PG8_WAIT_L(0); PG8_MMA(1, 0, At, B0); PG8_BAR; PG8_SCHED;
            PG8_STAGE(PG8_SB(0, 1), b2 + hstep, voffB);
            PG8_WAIT_V(6); PG8_BAR; PG8_MMA(1, 1, At, B1); PG8_BAR;
            PG8_LDB(B0, 1, 0); PG8_SCHED; PG8_LDA(At, 1, 0); PG8_STAGE(PG8_SA(0, 1), a2 + hstep, voffA);
            PG8_WAIT_L(8); PG8_BAR; PG8_WAIT_L(0); PG8_MMA(0, 0, At, B0); PG8_BAR; PG8_SCHED;
            PG8_LDB(B1, 1, 1); PG8_STAGE(PG8_SB(1, 0), b3, voffB);
            PG8_BAR; PG8_WAIT_L(0); PG8_MMA(0, 1, At, B1); PG8_BAR;
            PG8_LDA(At, 1, 1); PG8_STAGE(PG8_SA(1, 0), a3, voffA);
            PG8_BAR; PG8_WAIT_L(0); PG8_MMA(1, 0, At, B0); PG8_BAR; PG8_SCHED;
            PG8_STAGE(PG8_SB(1, 1), b3 + hstep, voffB);
            PG8_WAIT_V(6); PG8_BAR; PG8_MMA(1, 1, At, B1); PG8_BAR;
            }
        }
        if constexpr (QM == 2) { asm volatile("s_nop 15\n\ts_nop 15"); }
        if constexpr (ALIGN_EPI) { if (wr == 0) PG8_BAR; }
        if constexpr (Epi::PRE_RS) { if (has_next) E.pre(nxt, scl + ((ui + 1) & 1) * 1024, wid, lane); }
        if constexpr (!Epi::AFTER_DRAIN) { if constexpr (Epi::PRE_RS) E(acc, cur, wr, wc, fr, fq, scl + (ui & 1) * 1024); else E(acc, cur, wr, wc, fr, fq); S.done(cur); }
        if (!has_next) break;
#pragma unroll
        for (int a = 0; a < 2; ++a)
#pragma unroll
            for (int b = 0; b < 2; ++b)
#pragma unroll
                for (int m = 0; m < 4; ++m)
#pragma unroll
                    for (int n = 0; n < 2; ++n) acc[a][b][m][n] = (f32x4){0.f, 0.f, 0.f, 0.f};
        cur = nxt; cA = nA; cB = nB; ++ui;
        if constexpr (ALIGN_EPI) { if (wr == 1) PG8_BAR; }
    }
    PG8_WAIT_V(0);
    if constexpr (!ALIGN_EPI) { if (wr == 0) PG8_BAR; }
    PG8_BAR;
    if constexpr (Epi::AFTER_DRAIN) { E.fused(acc, cur, wr, wc, fr, fq, lds, wid, lane); S.done(cur); }
#undef PG8_SA
#undef PG8_SB
#undef PG8_STAGE
#undef PG8_LDA
#undef PG8_LDB
#undef PG8_MMA
#undef PG8_WAIT_V
#undef PG8_WAIT_L
#undef PG8_BAR
#undef PG8_SCHED
}
}

constexpr int NB = 8, SEQ = 2048, NMETA = 16, LSEQ = SEQ + NMETA;
constexpr int NMAIN = NB * SEQ, MTOK = NMAIN + NMETA, MP = 16640;
constexpr int DM = 1024, DINP = 2560, FF = 3584, NEXP = 8, DEPTH = 4;
constexpr int NCH = 33;
constexpr int UPN = 1792, UPK = 384;
constexpr int XS_ROWS = 35072;
constexpr float EPS = 1e-6f;
constexpr int NWAVES = 8;
#ifndef MK_MULTI
#define MK_MULTI 0
#endif

constexpr size_t MiB = 1u << 20;
constexpr size_t WS_CTL = 0, CTL_ZERO_BYTES = 2 * MiB;
constexpr size_t CTL_SSQ = 65536, CTL_SSKV = CTL_SSQ + (size_t)DEPTH * MP * 4;
static_assert(CTL_SSKV + (size_t)DEPTH * MP * 4 <= CTL_ZERO_BYTES, "ctl");
constexpr int CW_TMO = 0, CW_BAR = 4096, CW_CNT = 8192  , CW_QUEUE = 8320  , CW_SPLIT = 9216  ;
constexpr size_t WS_WIN = 2 * MiB;
constexpr size_t WS_WUP = WS_WIN + (size_t)DEPTH * DINP * DM * 2;
constexpr size_t WS_WOUT = WS_WUP + (size_t)DEPTH * UPN * UPK * 2;
constexpr size_t WS_WDGU = WS_WOUT + (size_t)DEPTH * DM * DM * 2;
constexpr size_t WS_WDD = WS_WDGU + (size_t)2 * 2 * FF * DM * 2;
constexpr size_t WS_WMGU = WS_WDD + (size_t)2 * DM * FF * 2;
constexpr size_t WS_WMD = WS_WMGU + (size_t)2 * NEXP * 2 * FF * DM * 2;
constexpr size_t WS_TAB = WS_WMD + (size_t)2 * NEXP * DM * FF * 2;
constexpr size_t TAB_RC = 0, TAB_RS = (size_t)LSEQ * 64 * 4, TAB_MC = 2 * TAB_RS, TAB_MS = TAB_MC + (size_t)LSEQ * 32 * 4;
constexpr size_t WS_HRES = WS_TAB + 2 * MiB;
constexpr size_t WS_XN = WS_HRES + (size_t)MP * DM * 4;
constexpr size_t WS_TOK = WS_XN + (size_t)MP * DM * 2;
constexpr size_t WS_SORT = WS_TOK + (size_t)MP * 32;
constexpr size_t WS_RS = WS_SORT, WS_RSS = WS_SORT + 262144;
constexpr size_t WS_WGCNT = WS_SORT + 524288;
constexpr size_t WS_XS = WS_SORT + 1 * MiB;
constexpr size_t WS_YS = WS_XS;
constexpr size_t WS_R = WS_XS + (size_t)XS_ROWS * DM * 2;
constexpr size_t R_RQ = 0, R_RK = R_RQ + (size_t)MP * 512 * 2, R_RKZ = R_RK + (size_t)MP * 512 * 2, R_RV = R_RKZ + (size_t)MP * 512 * 2, R_SG = R_RV + (size_t)MP * 512 * 2;
constexpr size_t R_LAT = R_SG + (size_t)MP * 512 * 2, R_KPE = R_LAT + (size_t)MP * 384 * 2;
constexpr size_t R_QN = R_KPE + (size_t)MP * 64 * 2, R_QPE = R_QN + (size_t)MP * 512 * 2, R_KN = R_QPE + (size_t)MP * 256 * 2, R_V = R_KN + (size_t)MP * 512 * 2;
constexpr size_t R_ST = R_V + (size_t)MP * 512 * 2;
constexpr size_t R_Y = R_ST + (size_t)NB * 4 * NCH * 128 * 128 * 2;
constexpr size_t R_MIX_END = R_Y + (size_t)MP * DM * 2;
constexpr size_t R_ACT = 0;
constexpr size_t R_END = ((size_t)XS_ROWS * FF * 2 > R_MIX_END) ? (size_t)XS_ROWS * FF * 2 : R_MIX_END;
constexpr int MOE_FULL_TILES = 128, MOE_KSPLIT = 4;
constexpr size_t WS_PART = WS_R + R_END;
constexpr size_t WS_END = WS_PART + (size_t)9 * MOE_KSPLIT * 256 * DM * 4;

constexpr int MOE_KSPLIT8 = 2;
constexpr float S_A8 = 8.0f, S_WD8 = 512.0f;
constexpr float S_W8 = 1016.0f;
constexpr int RING_BYTES = 131072, LDSCTL_OFF = RING_BYTES, MISC_OFF = LDSCTL_OFF + 320, LDS_BYTES = 147456;

#define GAS __attribute__((address_space(1)))
#define LAS __attribute__((address_space(3)))
typedef unsigned short bf16;
typedef unsigned v4u __attribute__((ext_vector_type(4)));
typedef unsigned v2u __attribute__((ext_vector_type(2)));
typedef float f32x4 __attribute__((ext_vector_type(4)));
typedef float f32x16 __attribute__((ext_vector_type(16)));
typedef short bf16x8 __attribute__((ext_vector_type(8)));
typedef short s16x4 __attribute__((ext_vector_type(4)));
typedef GAS unsigned gu32;
#define RLX_AGENT __ATOMIC_RELAXED, __HIP_MEMORY_SCOPE_AGENT
#define LDS_WAIT() asm volatile("s_waitcnt lgkmcnt(0)" ::: "memory")
#define VM_WAIT() asm volatile("s_waitcnt vmcnt(0)" ::: "memory")
__device__ __forceinline__ unsigned f2bf(float f) { unsigned u = __builtin_bit_cast(unsigned, f); return (u + 0x7fffu + ((u >> 16) & 1u)) >> 16; }
__device__ __forceinline__ unsigned pk2(float lo, float hi) { return pg8::cvt_pk_bf16(lo, hi); }
__device__ __forceinline__ v4u zero4() { unsigned z; asm volatile("v_mov_b32 %0, 0" : "=v"(z)); return (v4u){z, z, z, z}; }
__device__ __forceinline__ float bf2f(unsigned short b) { return __builtin_bit_cast(float, (unsigned)b << 16); }
template <int X> __device__ __forceinline__ float xshfl(float v) {
    if constexpr (X < 32) return __builtin_bit_cast(float, __builtin_amdgcn_ds_swizzle(__builtin_bit_cast(int, v), (X << 10) | 0x1f));
    else { const unsigned u = __builtin_bit_cast(unsigned, v); auto r = __builtin_amdgcn_permlane32_swap(u, u, false, false); const unsigned a = r[0], b = r[1]; return __builtin_bit_cast(float, a == u ? b : a); }
}
template <int X> __device__ __forceinline__ float xadd(float v) {
    if constexpr (X < 32) return v + xshfl<X>(v);
    else { const unsigned u = __builtin_bit_cast(unsigned, v); auto r = __builtin_amdgcn_permlane32_swap(u, u, false, false); return __builtin_bit_cast(float, (unsigned)r[0]) + __builtin_bit_cast(float, (unsigned)r[1]); }
}
__device__ __forceinline__ float wave_max(float v) { v = fmaxf(v, xshfl<1>(v)); v = fmaxf(v, xshfl<2>(v)); v = fmaxf(v, xshfl<4>(v)); v = fmaxf(v, xshfl<8>(v)); v = fmaxf(v, xshfl<16>(v)); v = fmaxf(v, xshfl<32>(v)); return v; }
__device__ __forceinline__ float wave_sum(float v) { v = xadd<1>(v); v = xadd<2>(v); v = xadd<4>(v); v = xadd<8>(v); v = xadd<16>(v); v = xadd<32>(v); return v; }
#define XB_TMO      128
#define XB_XCNT(j)  (256  + 64 * (j))
#define XB_XSUB(j)  (1280 + 64 * (j))
#define XB_XGEN(j)  (2304 + 64 * (j))
#define XB_TOP      3328
#define XB_TOPGEN   3392
#define XCD_BAR_WORDS 3456
#define XB_SPIN_CAP (1u << 18)

__device__ __forceinline__ unsigned xb_ld(unsigned* p)              { return __hip_atomic_load(p, __ATOMIC_RELAXED, __HIP_MEMORY_SCOPE_AGENT); }
__device__ __forceinline__ unsigned xb_add(unsigned* p, unsigned v) { return __hip_atomic_fetch_add(p, v, __ATOMIC_RELAXED, __HIP_MEMORY_SCOPE_AGENT); }
__device__ __forceinline__ unsigned xb_xcc_id() { return (unsigned)__builtin_amdgcn_s_getreg((3 << 11) | 20) & 0xFu; }
#define XB_SPIN(cond, bar) do { unsigned _sp = 0; while (cond) { __builtin_amdgcn_s_sleep(1); \
    if ((++_sp & 255u) == 0u) { if (xb_ld(&(bar)[XB_TMO])) break; if (_sp > XB_SPIN_CAP) { atomicAdd(&(bar)[XB_TMO], 1u); break; } } } } while (0)

struct XcdBarrier {
    unsigned* bar; unsigned x;
    volatile LAS unsigned* st;
};

__device__ __forceinline__ XcdBarrier xcd_barrier_post(unsigned* bar, volatile LAS unsigned* st) {
    XcdBarrier b; b.bar = bar; b.x = xb_xcc_id(); b.st = st;
    if (threadIdx.x == 0) (void)xb_add(&bar[XB_XCNT(b.x)], 1u);
    return b;
}
__device__ __forceinline__ void xcd_barrier_complete(unsigned* bar, unsigned x, unsigned& nloc, unsigned& nx) {
    const unsigned G = gridDim.x * gridDim.y * gridDim.z;
    unsigned sum, cnt, mine, sp = 0u;
    for (;;) {
        sum = 0u; cnt = 0u; mine = 0u;
#pragma unroll
        for (unsigned j = 0; j < 16; ++j) { const unsigned c = xb_ld(&bar[XB_XCNT(j)]); sum += c; cnt += (c > 0u) ? 1u : 0u; }
        mine = xb_ld(&bar[XB_XCNT(x)]);
        if (sum == G) break;
        __builtin_amdgcn_s_sleep(1);
        if ((++sp & 255u) == 0u) { if (xb_ld(&bar[XB_TMO])) break; if (sp > XB_SPIN_CAP) { atomicAdd(&bar[XB_TMO], 1u); break; } }
    }
    nloc = mine > 0u ? mine : 1u; nx = cnt > 0u ? cnt : 1u;
}

__device__ __forceinline__ void xcd_barrier(const XcdBarrier& b) {
    asm volatile("s_waitcnt vmcnt(0)" ::: "memory");
    __syncthreads();
    if (threadIdx.x == 0) {
        unsigned* bar = b.bar;
        __builtin_amdgcn_s_waitcnt(0);
        unsigned nloc = b.st[0], nx = b.st[1];
        if (nloc == 0u) { xcd_barrier_complete(bar, b.x, nloc, nx); b.st[0] = nloc; b.st[1] = nx; }
        const unsigned old = xb_add(&bar[XB_XSUB(b.x)], 1u);
        const unsigned gen = old / nloc;
        if (old + 1u == (gen + 1u) * nloc) {
            __builtin_amdgcn_fence(__ATOMIC_RELEASE, "agent");
            asm volatile("s_waitcnt vmcnt(0)" ::: "memory");
            const unsigned og = xb_add(&bar[XB_TOP], 1u);
            const unsigned tg = og / nx;
            if (og + 1u == (tg + 1u) * nx) xb_add(&bar[XB_TOPGEN], 1u);
            else XB_SPIN(xb_ld(&bar[XB_TOPGEN]) == tg, bar);
            __builtin_amdgcn_fence(__ATOMIC_ACQUIRE, "agent");
            xb_add(&bar[XB_XGEN(b.x)], 1u);
            asm volatile("s_waitcnt vmcnt(0)" ::: "memory");
        } else {
            XB_SPIN(xb_ld(&bar[XB_XGEN(b.x)]) == gen, bar);
            __builtin_amdgcn_fence(__ATOMIC_ACQUIRE, "agent");
            asm volatile("s_waitcnt vmcnt(0)" ::: "memory");
        }
    }
    __syncthreads();
}

struct Frame {
    LAS unsigned char* lds;
    volatile LAS unsigned* MISC;
    gu32* ctl;
    int tid, lane, wave, vcu, G;
    unsigned char* ws;
};
struct Inputs { const float* p[20]; };
__device__ __forceinline__ const float* ldin(int k) { unsigned long long v = 0;
#if defined(__HIP_DEVICE_COMPILE__)
    auto ka = __builtin_amdgcn_kernarg_segment_ptr();
    asm volatile("s_load_dwordx2 %0, %1, %2\n\ts_waitcnt lgkmcnt(0)" : "=s"(v) : "s"(ka), "n"(k * 8));
#endif
    return (const float*)v; }
enum { I_X = 0, I_META, I_ATTN_NORM, I_WIN, I_QNORM, I_WUQ, I_KVNORM, I_WUKV, I_RETG, I_MLAG, I_WOUT, I_FFNNORM, I_DWG, I_DWU, I_DWD, I_ROUTER, I_MWG, I_MWU, I_MWD, I_FINAL };

__device__ __forceinline__ int chunk_idx(int p) { return p < NMETA ? 48 + p : ((p - NMETA) & 63); }
__device__ __forceinline__ float log2_gamma(int h) { return h == 0 ? -0.045803689613124755f : h == 1 ? -0.022720076500083562f : h == 2 ? -0.011315313227834085f : -0.005646563141142062f; }

__device__ __forceinline__ void tr_load8(f32x4 (&v)[8], const float* Wcol, int ldw, int krow, const float* scale, float smul, int kr) {
#pragma unroll
    for (int i = 0; i < 8; ++i) v[i] = (f32x4){0.f, 0.f, 0.f, 0.f};
    if (Wcol) {
        const GAS float* src = (const GAS float*)Wcol + (size_t)(krow + 8 * kr) * ldw;
#pragma unroll
        for (int i = 0; i < 8; ++i) v[i] = __builtin_nontemporal_load((const GAS f32x4*)(src + (size_t)i * ldw));
        if (scale) { const f32x4 s0 = *(const GAS f32x4*)(scale + krow + 8 * kr) * smul, s1 = *(const GAS f32x4*)(scale + krow + 8 * kr + 4) * smul;
            v[0] *= s0.x; v[1] *= s0.y; v[2] *= s0.z; v[3] *= s0.w; v[4] *= s1.x; v[5] *= s1.y; v[6] *= s1.z; v[7] *= s1.w; }
    }
}
__device__ __forceinline__ void tr_store_bf16(const f32x4 (&v)[8], GAS bf16* dst, int Kdst) {
#pragma unroll
    for (int q = 0; q < 4; ++q) { v4u o; o.x = pk2(v[0][q], v[1][q]); o.y = pk2(v[2][q], v[3][q]); o.z = pk2(v[4][q], v[5][q]); o.w = pk2(v[6][q], v[7][q]);
        *(GAS v4u*)(dst + (size_t)q * Kdst) = o; }
}
__device__ __forceinline__ v2u tr_pack_q8(const f32x4 (&v)[8], int q) { unsigned lo = 0u, hi = 0u;
#pragma unroll
    for (int i = 0; i < 4; ++i) { const int a = (int)__builtin_rintf(fminf(fmaxf(v[i][q], -127.f), 127.f)), c = (int)__builtin_rintf(fminf(fmaxf(v[4 + i][q], -127.f), 127.f));
        lo |= (unsigned)(a & 255) << (8 * i); hi |= (unsigned)(c & 255) << (8 * i); }
    return (v2u){lo, hi}; }
__device__ __forceinline__ void transpose_item(const float* Wcol, int ldw, int krow0, const float* scale, bf16* WT, int Kdst, int k0dst, int n0, int lane) {
    const int sg = lane & 7, kr = lane >> 3; f32x4 v0[8], v1[8];
    tr_load8(v0, Wcol, ldw, krow0, scale, 1.0f, kr); tr_load8(v1, Wcol, ldw, krow0 + 64, scale, 1.0f, kr);
    GAS bf16* dst = (GAS bf16*)WT + (size_t)(n0 + 4 * sg) * Kdst + k0dst + 8 * kr;
    tr_store_bf16(v0, dst, Kdst); tr_store_bf16(v1, dst + 64, Kdst);
}
__device__ __forceinline__ void transpose_item_q8(const float* Wcol, int ldw, int krow0, const float* scale, unsigned char* WT, int Kdst, int k0dst, int n0, int lane) {
    const int sg = lane & 7, kr = lane >> 3; f32x4 v0[8], v1[8];
    tr_load8(v0, Wcol, ldw, krow0, scale, S_W8, 2 * kr); tr_load8(v1, Wcol, ldw, krow0 + 8, scale, S_W8, 2 * kr);
    GAS unsigned char* dst = (GAS unsigned char*)WT + (size_t)(n0 + 4 * sg) * Kdst + k0dst + 16 * kr;
#pragma unroll
    for (int q = 0; q < 4; ++q) { const v2u a = tr_pack_q8(v0, q), c = tr_pack_q8(v1, q); *(GAS v4u*)(dst + (size_t)q * Kdst) = (v4u){a.x, a.y, c.x, c.y}; }
}
__device__ __forceinline__ v2u tr_pack_f8(const f32x4 (&v)[8], int q) { float t[8];
#pragma unroll
    for (int i = 0; i < 8; ++i) t[i] = fminf(fmaxf(v[i][q] * S_WD8, -448.f), 448.f);
    int lo = __builtin_amdgcn_cvt_pk_fp8_f32(t[0], t[1], 0, false); lo = __builtin_amdgcn_cvt_pk_fp8_f32(t[2], t[3], lo, true);
    int hi = __builtin_amdgcn_cvt_pk_fp8_f32(t[4], t[5], 0, false); hi = __builtin_amdgcn_cvt_pk_fp8_f32(t[6], t[7], hi, true);
    return (v2u){(unsigned)lo, (unsigned)hi}; }
__device__ __forceinline__ void transpose_item_f8(const float* Wcol, int ldw, int krow0, unsigned char* WT, int Kdst, int k0dst, int n0, int lane) {
    const int sg = lane & 7, kr = lane >> 3; f32x4 v0[8], v1[8];
    tr_load8(v0, Wcol, ldw, krow0, nullptr, 1.0f, 2 * kr); tr_load8(v1, Wcol, ldw, krow0 + 8, nullptr, 1.0f, 2 * kr);
    GAS unsigned char* dst = (GAS unsigned char*)WT + (size_t)(n0 + 4 * sg) * Kdst + k0dst + 16 * kr;
#pragma unroll
    for (int q = 0; q < 4; ++q) { const v2u a = tr_pack_f8(v0, q), c = tr_pack_f8(v1, q); *(GAS v4u*)(dst + (size_t)q * Kdst) = (v4u){a.x, a.y, c.x, c.y}; }
}
__device__ __forceinline__ int slot_o8(int t) { return (t & 0x60) | ((t & 0xC) << 1) | ((t & 0x10) >> 2) | (t & 3); }
__device__ __forceinline__ int win_col(int s) {
    const int pn = s >> 8, t = s & 255, bj = t >> 7, t7 = t & 127, wc = (t >> 5) & 3, n = (t >> 4) & 1, fq = (t >> 2) & 3, i = t & 3;
    if (pn < 4) return (pn >> 1) * 512 + (2 * (pn & 1) + bj) * 128 + 16 * wc + 4 * fq + i + 64 * n;
    if (pn < 6) return 1024 + (pn & 1) * 256 + 128 * bj + slot_o8(t7);
    if (pn >= 8) return 1536 + (pn & 1) * 256 + 128 * bj + slot_o8(t7);
    if (pn == 6) return 2048 + 128 * bj + slot_o8(t7);
    if (bj == 0) return 2304 + slot_o8(t7);
    if (wc < 2) return 2432 + 16 * wc + 4 * fq + i + 32 * n;
    return -1;
}
__device__ __forceinline__ int wup_col(int s, bool& is_kv) {
    const int pn = s >> 8, t = s & 255, bj = t >> 7, t7 = t & 127, wc = (t >> 5) & 3, n = (t >> 4) & 1, fq = (t >> 2) & 3, i = t & 3;
    if (pn < 2) { is_kv = false; const int o = 256 * pn + 128 * bj + slot_o8(t7); return (o >> 7) * 192 + (o & 127); }
    if (pn == 2) { is_kv = false; const int hq = 2 * bj + (wc >> 1); return hq * 192 + 128 + 16 * (wc & 1) + 4 * fq + i + 32 * n; }
    is_kv = true;
    if (pn < 5) { const int o = 256 * (pn - 3) + 128 * bj + slot_o8(t7); return (o >> 7) * 256 + (o & 127); }
    { const int o = 256 * (pn - 5) + 128 * bj + slot_o8(t7); return (o >> 7) * 256 + 128 + (o & 127); }
}
__device__ __forceinline__ void sincos_d(double x, float& s, float& c) {
    const double k = __builtin_rint(x * 0.63661977236758134308);
    const double y = (x - k * 1.5707963267948966) - k * 6.123233995736766e-17;
    const double y2 = y * y;
    const double sn = y * (1.0 + y2 * (-1.0 / 6 + y2 * (1.0 / 120 + y2 * (-1.0 / 5040 + y2 * (1.0 / 362880 + y2 * (-1.0 / 39916800 + y2 * (1.0 / 6227020800.0)))))));
    const double cs = 1.0 + y2 * (-0.5 + y2 * (1.0 / 24 + y2 * (-1.0 / 720 + y2 * (1.0 / 40320 + y2 * (-1.0 / 3628800 + y2 * (1.0 / 479001600.0 + y2 * (-1.0 / 87178291200.0)))))));
    const int q = (int)((long long)k & 3);
    const double ss = (q & 1) ? cs : sn, cc = (q & 1) ? sn : cs;
    s = (float)((q & 2) ? -ss : ss); c = (float)(((q + 1) & 2) ? -cc : cc);
}
__device__ __forceinline__ float row_rstd(const f32x4 (&v)[4]);
__device__ __forceinline__ void store_xq(Frame& F, int r, const f32x4 (&v)[4], float rstd);
__device__ __forceinline__ void p0_prologue(Frame& F) {
    const int gw = F.vcu * NWAVES + F.wave, NGW = F.G * NWAVES, lane = F.lane;
    float* hres = (float*)(F.ws + WS_HRES);
    for (int r = gw; r < MP; r += NGW) {
        GAS f32x4* o = (GAS f32x4*)(hres + (size_t)r * DM) + lane;
        if (r < MTOK) {
            const GAS f32x4* src = (const GAS f32x4*)(r < NMAIN ? ldin(I_X) + (size_t)r * DM : ldin(I_META) + (size_t)(r - NMAIN) * DM) + lane;
            f32x4 v[4];
#pragma unroll
            for (int j = 0; j < 4; ++j) v[j] = src[64 * j];
#pragma unroll
            for (int j = 0; j < 4; ++j) o[64 * j] = v[j];
            store_xq(F, r, v, row_rstd(v)); }
        else {
#pragma unroll
            for (int j = 0; j < 4; ++j) o[64 * j] = (f32x4){0.f, 0.f, 0.f, 0.f}; }
    }
    { float* tab = (float*)(F.ws + WS_TAB);
      const int gt = gw * 64 + lane, NT = NGW * 64;
      for (int t = gt; t < LSEQ * 64; t += NT) { const int p = t >> 6, i = t & 63; const float inv = exp2f(-(float)(2 * i) * (13.287712379549449f / 128.0f)); const float ang = (float)p * inv;
          float s, c; sincos_d((double)ang, s, c); tab[TAB_RC / 4 + t] = c; tab[TAB_RS / 4 + t] = s; }
      for (int t = gt; t < LSEQ * 32; t += NT) { const int p = t >> 5, i = t & 31; const float inv = exp2f(-(float)(2 * i) * (13.287712379549449f / 64.0f)); const float ang = (float)p * inv;
          float s, c; sincos_d((double)ang, s, c); tab[TAB_MC / 4 + t] = c; tab[TAB_MS / 4 + t] = s; }
    }
    constexpr int I_IN = DEPTH * 8 * 80, I_UP = DEPTH * 3 * 56, I_OUT = DEPTH * 8 * 32, I_DGU = 2 * 8 * 224, I_DD = 2 * 28 * 32, I_MGU = 16 * 8 * 224, I_MD = 16 * 28 * 32;
    constexpr int NITEMS = I_IN + I_UP + I_OUT + I_DGU + I_DD + I_MGU + I_MD;
    for (int it = gw; it < NITEMS; it += NGW) {
        int r = it;
        if (r < I_IN) { const int l = r / 640, q = r % 640, kb = q / 80, nb = q % 80; const int col = win_col(nb * 32 + 4 * (lane & 7));
            const float* W = ldin(I_WIN) + (size_t)l * DM * 2496;
            transpose_item_q8(col >= 0 ? W + col : nullptr, 2496, kb * 128, ldin(I_ATTN_NORM) + l * DM, F.ws + WS_WIN + (size_t)l * DINP * DM, DM, kb * 128, nb * 32, lane); continue; }
        r -= I_IN;
        if (r < I_UP) { const int l = r / 168, q = r % 168, kb = q / 56, nb = q % 56; bool is_kv; const int col = wup_col(nb * 32 + 4 * (lane & 7), is_kv);
            const float* Wc = nullptr; const float* sc = nullptr; int ldw = 0, k0 = 0;
            if (!is_kv && kb < 2) { Wc = ldin(I_WUQ) + (size_t)l * 256 * 768 + col; sc = ldin(I_QNORM) + l * 256; ldw = 768; k0 = kb * 128; }
            if (is_kv && kb >= 2) { Wc = ldin(I_WUKV) + (size_t)l * 128 * 1024 + col; sc = ldin(I_KVNORM) + l * 128; ldw = 1024; k0 = (kb - 2) * 128; }
            transpose_item(Wc, ldw, k0, sc, (bf16*)(F.ws + WS_WUP) + (size_t)l * UPN * UPK, UPK, kb * 128, nb * 32, lane); continue; }
        r -= I_UP;
        if (r < I_OUT) { const int l = r / 256, q = r % 256, kb = q / 32, nb = q % 32;
            transpose_item(ldin(I_WOUT) + (size_t)l * DM * DM + nb * 32 + 4 * (lane & 7), DM, kb * 128, nullptr, (bf16*)(F.ws + WS_WOUT) + (size_t)l * DM * DM, DM, kb * 128, nb * 32, lane); continue; }
        r -= I_OUT;
        if (r < I_DGU + 0) { const int l = r / 1792, q = r % 1792, kb = q / 224, nb = q % 224; const int s = nb * 32 + 4 * (lane & 7), pn = s >> 8, t = s & 255;
            const float* W = ((t >> 7) ? ldin(I_DWU) : ldin(I_DWG)) + (size_t)l * DM * FF + 128 * pn + slot_o8(t & 127);
            transpose_item_q8(W, FF, kb * 128, ldin(I_FFNNORM) + (2 * l) * DM, F.ws + WS_WDGU + (size_t)l * 2 * FF * DM, DM, kb * 128, nb * 32, lane); continue; }
        r -= I_DGU;
        if (r < I_DD) { const int l = r / 896, q = r % 896, kb = q / 32, nb = q % 32;
            transpose_item_f8(ldin(I_DWD) + (size_t)l * FF * DM + nb * 32 + 4 * (lane & 7), DM, kb * 128, F.ws + WS_WDD + (size_t)l * DM * FF, FF, kb * 128, nb * 32, lane); continue; }
        r -= I_DD;
        if (r < I_MGU) { const int le = r / 1792, q = r % 1792, kb = q / 224, nb = q % 224; const int s = nb * 32 + 4 * (lane & 7), pn = s >> 8, t = s & 255;
            const float* W = ((t >> 7) ? ldin(I_MWU) : ldin(I_MWG)) + (size_t)le * DM * FF + 128 * pn + slot_o8(t & 127);
            transpose_item_q8(W, FF, kb * 128, ldin(I_FFNNORM) + (2 * (le >> 3) + 1) * DM, F.ws + WS_WMGU + (size_t)le * 2 * FF * DM, DM, kb * 128, nb * 32, lane); continue; }
        r -= I_MGU;
        { const int le = r / 896, q = r % 896, kb = q / 32, nb = q % 32;
            transpose_item_f8(ldin(I_MWD) + (size_t)le * FF * DM + nb * 32 + 4 * (lane & 7), DM, kb * 128, F.ws + WS_WMD + (size_t)le * DM * FF, FF, kb * 128, nb * 32, lane); }
    }
}

typedef pg8::f32x4 af4;
__device__ __forceinline__ v4u pack8(af4 a, af4 b) { v4u w; w.x = pk2(a[0], a[1]); w.y = pk2(a[2], a[3]); w.z = pk2(b[0], b[1]); w.w = pk2(b[2], b[3]); return w; }
__device__ __forceinline__ float silu_f(float x) { return x * __builtin_amdgcn_rcpf(1.0f + __builtin_amdgcn_exp2f(-1.4426950408889634f * x)); }
__device__ __forceinline__ float sumsq8(af4 a, af4 c) { return (a[0] * a[0] + a[1] * a[1]) + (a[2] * a[2] + a[3] * a[3]) + (c[0] * c[0] + c[1] * c[1]) + (c[2] * c[2] + c[3] * c[3]); }
__device__ __forceinline__ int row_pos(int row) { return row < NMAIN ? NMETA + (row & (SEQ - 1)) : ((row - NMAIN) & (NMETA - 1)); }
__device__ __forceinline__ af4 cvt_i8acc(af4 a, float sc) { return __builtin_convertvector(__builtin_bit_cast(pg8::i32x4, a), af4) * sc; }
#define EPI_MAIN_LOOP()                                                                                                                               \
    const float* rs = nullptr;                                                                 \
    __device__ __forceinline__ void operator()(const af4 (&acc)[2][2][4][2], const pg8::Unit& u, int wr, int wc, int fr, int fq) const {             \
        float rsl[8];                                                 \
        if (rs) { _Pragma("unroll") for (int ai = 0; ai < 2; ++ai) _Pragma("unroll") for (int m = 0; m < 4; ++m) rsl[ai * 4 + m] = rs[u.pm * 256 + ai * 128 + wr * 64 + m * 16 + fr]; } \
        _Pragma("unroll") for (int ai = 0; ai < 2; ++ai) _Pragma("unroll") for (int m = 0; m < 4; ++m) {                                             \
            const int r_ = u.pm * 256 + ai * 128 + wr * 64 + m * 16 + fr;                                                                            \
            af4 a00 = acc[ai][0][m][0], a01 = acc[ai][0][m][1], a10 = acc[ai][1][m][0], a11 = acc[ai][1][m][1];                                      \
            if (rs) { const float sc = rsl[ai * 4 + m]; a00 = cvt_i8acc(a00, sc); a01 = cvt_i8acc(a01, sc); a10 = cvt_i8acc(a10, sc); a11 = cvt_i8acc(a11, sc); } \
            row(r_, u.pn, wc, fq, a00, a01, a10, a11);                                                                                               \
            if (m == 3) asm volatile("" ::: "memory"); } }

struct EpiInProj {
    static constexpr bool PERM = false, AFTER_DRAIN = false, PRE_RS = false;
    unsigned char* R; float* ssq; float* sskv; const float* tab; float lg0, lg1, lg2, lg3; int pn0;
    __device__ __forceinline__ void row(int row, int pn, int wc, int fq, af4 a00, af4 a01, af4 a10, af4 a11) const {
        pn += pn0; const int pp = row_pos(row);
        if (pn < 4) {
            const af4 cs = *(const af4*)(tab + TAB_RC / 4 + pp * 64 + 16 * wc + 4 * fq), sn = *(const af4*)(tab + TAB_RS / 4 + pp * 64 + 16 * wc + 4 * fq);
            const size_t off = ((size_t)row * 512 + (2 * (pn & 1)) * 128 + 32 * wc + 8 * fq) * 2;
            af4 o1 = a00 * cs - a01 * sn, o2 = a00 * sn + a01 * cs, o3 = a10 * cs - a11 * sn, o4 = a10 * sn + a11 * cs;
            if (pn < 2) { o1 *= 0.08838834764831845f; o2 *= 0.08838834764831845f; o3 *= 0.08838834764831845f; o4 *= 0.08838834764831845f;
                *(v4u*)(R + R_RQ + off) = pack8(o1, o2); *(v4u*)(R + R_RQ + off + 256) = pack8(o3, o4); }
            else { *(v4u*)(R + R_RK + off) = pack8(o1, o2); *(v4u*)(R + R_RK + off + 256) = pack8(o3, o4);
                const float e = (float)(63 - chunk_idx(pp)); const float z0 = __builtin_amdgcn_exp2f(((pn & 1) ? lg2 : lg0) * e), z1 = __builtin_amdgcn_exp2f(((pn & 1) ? lg3 : lg1) * e);
                *(v4u*)(R + R_RKZ + off) = pack8(o1 * z0, o2 * z0); *(v4u*)(R + R_RKZ + off + 256) = pack8(o3 * z1, o4 * z1); }
        } else if (pn < 6) {
            const size_t off = ((size_t)row * 512 + (pn & 1) * 256 + 32 * wc + 8 * fq) * 2;
            *(v4u*)(R + R_RV + off) = pack8(a00, a01); *(v4u*)(R + R_RV + off + 256) = pack8(a10, a11);
        } else if (pn >= 8) {
            const size_t off = ((size_t)row * 512 + (pn & 1) * 256 + 32 * wc + 8 * fq) * 2;
#pragma unroll
            for (int j = 0; j < 4; ++j) { a00[j] = silu_f(a00[j]); a01[j] = silu_f(a01[j]); a10[j] = silu_f(a10[j]); a11[j] = silu_f(a11[j]); }
            *(v4u*)(R + R_SG + off) = pack8(a00, a01); *(v4u*)(R + R_SG + off + 256) = pack8(a10, a11);
        } else if (pn == 6) {
            const size_t off = ((size_t)row * 384 + 32 * wc + 8 * fq) * 2;
            *(v4u*)(R + R_LAT + off) = pack8(a00, a01); *(v4u*)(R + R_LAT + off + 256) = pack8(a10, a11);
            float s = sumsq8(a00, a01) + sumsq8(a10, a11); s = xadd<16>(s); s = xadd<32>(s);
            if (fq == 0) ssq[row * 4 + wc] = s;
        } else {
            *(v4u*)(R + R_LAT + ((size_t)row * 384 + 256 + 32 * wc + 8 * fq) * 2) = pack8(a00, a01);
            float s = sumsq8(a00, a01); s = xadd<16>(s); s = xadd<32>(s);
            if (fq == 0) sskv[row * 4 + wc] = s;
            if (wc < 2) { const af4 cs = *(const af4*)(tab + TAB_MC / 4 + pp * 32 + 16 * wc + 4 * fq), sn = *(const af4*)(tab + TAB_MS / 4 + pp * 32 + 16 * wc + 4 * fq);
                *(v4u*)(R + R_KPE + ((size_t)row * 64 + 32 * wc + 8 * fq) * 2) = pack8(a10 * cs - a11 * sn, a10 * sn + a11 * cs); }
        }
    }
    EPI_MAIN_LOOP()
};
struct EpiGate {
    static constexpr bool PERM = false, AFTER_DRAIN = false, PRE_RS = false;
    unsigned char* SG;
    __device__ __forceinline__ void row(int row, int pn, int wc, int fq, af4 a00, af4 a01, af4 a10, af4 a11) const {
        const size_t off = ((size_t)row * 512 + pn * 256 + 32 * wc + 8 * fq) * 2;
#pragma unroll
        for (int j = 0; j < 4; ++j) { a00[j] = silu_f(a00[j]); a01[j] = silu_f(a01[j]); a10[j] = silu_f(a10[j]); a11[j] = silu_f(a11[j]); }
        *(v4u*)(SG + off) = pack8(a00, a01); *(v4u*)(SG + off + 256) = pack8(a10, a11);
    }
    EPI_MAIN_LOOP()
};
constexpr float QSCALE = 0.07216878364870323f * 1.4426950408889634f;
struct EpiUp {
    static constexpr bool PERM = false, AFTER_DRAIN = false, PRE_RS = false;
    unsigned char* R; const float* ssq; const float* sskv; const float* tab;
    __device__ __forceinline__ void row(int row, int pn, int wc, int fq, af4 a00, af4 a01, af4 a10, af4 a11) const {
        if (pn < 3) { const af4 q4 = *(const af4*)(ssq + row * 4); const float sc = QSCALE * __builtin_amdgcn_rsqf(((q4[0] + q4[1]) + (q4[2] + q4[3])) * (1.0f / 256.0f) + EPS);
            a00 *= sc; a01 *= sc; a10 *= sc; a11 *= sc;
            if (pn < 2) { const size_t off = ((size_t)row * 512 + 256 * pn + 32 * wc + 8 * fq) * 2;
                *(v4u*)(R + R_QN + off) = pack8(a00, a01); *(v4u*)(R + R_QN + off + 256) = pack8(a10, a11);
            } else { const int pp = row_pos(row);
                const af4 cs = *(const af4*)(tab + TAB_MC / 4 + pp * 32 + 16 * (wc & 1) + 4 * fq), sn = *(const af4*)(tab + TAB_MS / 4 + pp * 32 + 16 * (wc & 1) + 4 * fq);
                const size_t off = ((size_t)row * 256 + (wc >> 1) * 64 + 32 * (wc & 1) + 8 * fq) * 2;
                *(v4u*)(R + R_QPE + off) = pack8(a00 * cs - a01 * sn, a00 * sn + a01 * cs); *(v4u*)(R + R_QPE + off + 256) = pack8(a10 * cs - a11 * sn, a10 * sn + a11 * cs); }
        } else { const af4 q4 = *(const af4*)(sskv + row * 4); const float sc = __builtin_amdgcn_rsqf(((q4[0] + q4[1]) + (q4[2] + q4[3])) * (1.0f / 128.0f) + EPS);
            const size_t off = (pn < 5 ? R_KN : R_V) + ((size_t)row * 512 + 256 * (pn < 5 ? pn - 3 : pn - 5) + 32 * wc + 8 * fq) * 2;
            *(v4u*)(R + off) = pack8(a00 * sc, a01 * sc); *(v4u*)(R + off + 256) = pack8(a10 * sc, a11 * sc);
        }
    }
    EPI_MAIN_LOOP()
};
struct EpiResid {
    static constexpr bool PERM = false, AFTER_DRAIN = false, PRE_RS = false;
    float* H; float sc;
    __device__ __forceinline__ void row(int row, int pn, int wc, int fq, af4 a00, af4 a01, af4 a10, af4 a11) const {
        af4* q = (af4*)(H + (size_t)row * DM + pn * 256 + wc * 32 + 4 * fq);
        q[0] = q[0] + a00 * sc; q[4] = q[4] + a01 * sc; q[32] = q[32] + a10 * sc; q[36] = q[36] + a11 * sc;
    }
    EPI_MAIN_LOOP()
};
struct EpiSwiGLU {
    static constexpr bool PERM = false, AFTER_DRAIN = false, PRE_RS = true;
    bf16* A;
    __device__ __forceinline__ void row(int row, int pn, int wc, int fq, af4 a00, af4 a01, af4 a10, af4 a11) const {
#pragma unroll
        for (int j = 0; j < 4; ++j) { a00[j] = silu_f(a00[j]) * a10[j]; a01[j] = silu_f(a01[j]) * a11[j]; }
        if (f8) { float t[8];
#pragma unroll
            for (int j = 0; j < 4; ++j) { t[j] = fminf(fmaxf(a00[j] * S_A8, -448.f), 448.f); t[4 + j] = fminf(fmaxf(a01[j] * S_A8, -448.f), 448.f); }
            int lo = __builtin_amdgcn_cvt_pk_fp8_f32(t[0], t[1], 0, false); lo = __builtin_amdgcn_cvt_pk_fp8_f32(t[2], t[3], lo, true);
            int hi = __builtin_amdgcn_cvt_pk_fp8_f32(t[4], t[5], 0, false); hi = __builtin_amdgcn_cvt_pk_fp8_f32(t[6], t[7], hi, true);
            *(v2u*)((unsigned char*)A + (size_t)row * FF + pn * 128 + wc * 32 + 8 * fq) = (v2u){(unsigned)lo, (unsigned)hi}; }
        else *(v4u*)(A + (size_t)row * FF + pn * 128 + wc * 32 + 8 * fq) = pack8(a00, a01);
    }
    typedef float f2v __attribute__((ext_vector_type(2)));
    __device__ __forceinline__ af4 swi_i8(af4 gi, af4 ui, float c1, float sc2) const {
        const pg8::i32x4 g4 = __builtin_bit_cast(pg8::i32x4, gi), u4 = __builtin_bit_cast(pg8::i32x4, ui); af4 o;
#pragma unroll
        for (int h = 0; h < 2; ++h) { const f2v g = {(float)g4[2 * h], (float)g4[2 * h + 1]}, u = {(float)u4[2 * h], (float)u4[2 * h + 1]};
            const f2v t = g * c1, p = (g * u) * sc2; f2v d; d.x = __builtin_amdgcn_exp2f(t.x); d.y = __builtin_amdgcn_exp2f(t.y); d = d + 1.0f;
            o[2 * h] = p.x * __builtin_amdgcn_rcpf(d.x); o[2 * h + 1] = p.y * __builtin_amdgcn_rcpf(d.y); }
        return o; }
    const float* rs = nullptr; int f8 = 0;
    __device__ __forceinline__ void pre(const pg8::Unit& u, LAS unsigned char* buf, int wid, int lane) const {
        if (wid < 4) __builtin_amdgcn_global_load_lds((const GAS unsigned*)(rs + u.pm * 256 + wid * 64 + lane), (LAS unsigned*)(buf + wid * 256), 4, 0, 0); }
    __device__ __forceinline__ void operator()(const af4 (&acc)[2][2][4][2], const pg8::Unit& u, int wr, int wc, int fr, int fq, const LAS unsigned char* buf) const {
        float rsl[8];
#pragma unroll
        for (int i = 0; i < 8; ++i) rsl[i] = *(const LAS float*)(buf + ((i >> 2) * 128 + wr * 64 + (i & 3) * 16 + fr) * 4);
#pragma unroll
        for (int ai = 0; ai < 2; ++ai)
#pragma unroll
            for (int m = 0; m < 4; ++m) { const int r_ = u.pm * 256 + ai * 128 + wr * 64 + m * 16 + fr;
                if (rs) { const float sc = rsl[ai * 4 + m], c1 = -1.4426950408889634f * sc, sc2 = sc * sc * (f8 ? S_A8 : 1.0f);
                    const af4 o0 = swi_i8(acc[ai][0][m][0], acc[ai][1][m][0], c1, sc2), o1 = swi_i8(acc[ai][0][m][1], acc[ai][1][m][1], c1, sc2);
                    if (f8) { float t[8];
#pragma unroll
                        for (int j = 0; j < 4; ++j) { t[j] = fminf(fmaxf(o0[j], -448.f), 448.f); t[4 + j] = fminf(fmaxf(o1[j], -448.f), 448.f); }
                        int lo = __builtin_amdgcn_cvt_pk_fp8_f32(t[0], t[1], 0, false); lo = __builtin_amdgcn_cvt_pk_fp8_f32(t[2], t[3], lo, true);
                        int hi = __builtin_amdgcn_cvt_pk_fp8_f32(t[4], t[5], 0, false); hi = __builtin_amdgcn_cvt_pk_fp8_f32(t[6], t[7], hi, true);
                        *(v2u*)((unsigned char*)A + (size_t)r_ * FF + u.pn * 128 + wc * 32 + 8 * fq) = (v2u){(unsigned)lo, (unsigned)hi}; }
                    else *(v4u*)(A + (size_t)r_ * FF + u.pn * 128 + wc * 32 + 8 * fq) = pack8(o0, o1); }
                else row(r_, u.pn, wc, fq, acc[ai][0][m][0], acc[ai][0][m][1], acc[ai][1][m][0], acc[ai][1][m][1]); }
    }
};
struct EpiMoeDown {
    static constexpr bool PERM = false, AFTER_DRAIN = false, PRE_RS = false;
    bf16* Y; float sc;
    __device__ __forceinline__ void row(int row, int pn, int wc, int fq, af4 a00, af4 a01, af4 a10, af4 a11) const {
        a00 *= sc; a01 *= sc; a10 *= sc; a11 *= sc;
        v2u* q = (v2u*)(Y + (size_t)row * DM + pn * 256 + wc * 32 + 4 * fq);
        q[0] = (v2u){pk2(a00[0], a00[1]), pk2(a00[2], a00[3])}; q[4] = (v2u){pk2(a01[0], a01[1]), pk2(a01[2], a01[3])};
        q[32] = (v2u){pk2(a10[0], a10[1]), pk2(a10[2], a10[3])}; q[36] = (v2u){pk2(a11[0], a11[1]), pk2(a11[2], a11[3])};
    }
    EPI_MAIN_LOOP()
};

struct EpiNone {
    static constexpr bool PERM = false, AFTER_DRAIN = false, PRE_RS = false;
    __device__ __forceinline__ void operator()(const af4 (&acc)[2][2][4][2], const pg8::Unit&, int, int, int, int) const {
#pragma unroll
        for (int ai = 0; ai < 2; ++ai)
#pragma unroll
            for (int m = 0; m < 4; ++m) asm volatile("" :: "v"(acc[ai][0][m][0]), "v"(acc[ai][0][m][1]), "v"(acc[ai][1][m][0]), "v"(acc[ai][1][m][1])); }
};
struct EpiPartial {
    static constexpr bool PERM = false, AFTER_DRAIN = false, PRE_RS = false;
    float* P; unsigned kbytes; int ks; float sc;
    __device__ __forceinline__ void operator()(const af4 (&acc)[2][2][4][2], const pg8::Unit& u, int wr, int wc, int fr, int fq) const {
        const int tile = (u.pm - MOE_FULL_TILES) * ks + (int)(u.koff / kbytes);
#pragma unroll
        for (int ai = 0; ai < 2; ++ai)
#pragma unroll
            for (int m = 0; m < 4; ++m) { af4* q = (af4*)(P + ((size_t)tile * 256 + ai * 128 + wr * 64 + m * 16 + fr) * DM + u.pn * 256 + wc * 32 + 4 * fq);
                q[0] = acc[ai][0][m][0] * sc; q[4] = acc[ai][0][m][1] * sc; q[32] = acc[ai][1][m][0] * sc; q[36] = acc[ai][1][m][1] * sc; }
    }
};

template <class Epi, int QM> __device__ __forceinline__ void meta_item(LAS unsigned char* lds, const unsigned char* A16, const unsigned char* Bt, int Kb, int item, const Epi& E) {
    int tid_ = threadIdx.x; asm volatile("" : "+v"(tid_));
    const int lane = tid_ & 63, w = __builtin_amdgcn_readfirstlane(tid_ >> 6), fr = lane & 15, fq = lane >> 4, pn = item >> 2, wc = item & 3;
    const int steps = Kb >> 6, spw = (steps + 7) >> 3, s0 = w * spw, s1 = (s0 + spw) < steps ? (s0 + spw) : steps;
    af4 acc[2][2];
#pragma unroll
    for (int bj = 0; bj < 2; ++bj)
#pragma unroll
        for (int n = 0; n < 2; ++n) acc[bj][n] = (af4){0.f, 0.f, 0.f, 0.f};
    const GAS unsigned char* ap = (const GAS unsigned char*)A16 + (size_t)fr * Kb + 16 * fq;
    const GAS unsigned char* bp = (const GAS unsigned char*)Bt + ((size_t)pn * 256 + 32 * wc + fr) * Kb + 16 * fq;
    for (int s = s0; s < s1; s += 4) {
        bf16x8 a[4], b[4][4];
#pragma unroll
        for (int g = 0; g < 4; ++g) if (s + g < s1) { a[g] = *(const GAS bf16x8*)(ap + 64 * (s + g));
#pragma unroll
            for (int f = 0; f < 4; ++f) b[g][f] = *(const GAS bf16x8*)(bp + (size_t)(128 * (f >> 1) + 16 * (f & 1)) * Kb + 64 * (s + g)); }
#pragma unroll
        for (int g = 0; g < 4; ++g) if (s + g < s1) {
#pragma unroll
            for (int f = 0; f < 4; ++f) {
                if constexpr (QM == 2) { typedef long l2v __attribute__((ext_vector_type(2))); const l2v bb = __builtin_bit_cast(l2v, b[g][f]), aa = __builtin_bit_cast(l2v, a[g]);
                    acc[f >> 1][f & 1] = __builtin_amdgcn_mfma_f32_16x16x32_fp8_fp8(bb[0], aa[0], acc[f >> 1][f & 1], 0, 0, 0); acc[f >> 1][f & 1] = __builtin_amdgcn_mfma_f32_16x16x32_fp8_fp8(bb[1], aa[1], acc[f >> 1][f & 1], 0, 0, 0); }
                else acc[f >> 1][f & 1] = pg8::mma16<QM == 1>(b[g][f], a[g], acc[f >> 1][f & 1]); } }
    }
    if (QM == 1) {
#pragma unroll
        for (int f = 0; f < 4; ++f) acc[f >> 1][f & 1] = __builtin_convertvector(__builtin_bit_cast(pg8::i32x4, acc[f >> 1][f & 1]), af4); }
    LAS af4* red = (LAS af4*)lds + (w * 64 + lane) * 4;
    red[0] = acc[0][0]; red[1] = acc[0][1]; red[2] = acc[1][0]; red[3] = acc[1][1];
    __syncthreads();
    if (w == 0) {
#pragma unroll
        for (int ww = 1; ww < 8; ++ww) { const LAS af4* r = (const LAS af4*)lds + (ww * 64 + lane) * 4; acc[0][0] += r[0]; acc[0][1] += r[1]; acc[1][0] += r[2]; acc[1][1] += r[3]; }
        if (QM == 1) { const float sc = E.rs[NMAIN + fr]; acc[0][0] *= sc; acc[0][1] *= sc; acc[1][0] *= sc; acc[1][1] *= sc; }
        E.row(NMAIN + fr, pn, wc, fq, acc[0][0], acc[0][1], acc[1][0], acc[1][1]);
    }
    __syncthreads();
}
template <class Epi, int QM = 0> __device__ __forceinline__ void meta_gemm(Frame& F, const void* A16, const void* Bt, int N, int Kb, const Epi& E) {
    const int nit = (N >> 8) * 4;
    for (int it = F.G - 1 - (int)blockIdx.x; it < nit; it += F.G) meta_item<Epi, QM>(F.lds + 32768, (const unsigned char*)A16, (const unsigned char*)Bt, Kb, it, E);
}

__device__ __forceinline__ int expert_base(const unsigned* cnt, int e) { int acc = 0;
#pragma unroll
    for (int k = 0; k < 7; ++k) acc += (k < e) ? (int)((cnt[k] + 255u) & ~255u) : 0;
    return acc; }
template <int KS = MOE_KSPLIT8> __device__ __forceinline__ void load_row(Frame& F, float* hres, int r, bool moe_prev, const unsigned* cnt, f32x4 (&v)[4]) {
    GAS f32x4* xr = (GAS f32x4*)(hres + (size_t)r * DM) + F.lane;
#pragma unroll
    for (int j = 0; j < 4; ++j) v[j] = xr[64 * j];
    if (moe_prev) {
        const int* ti = (const int*)(F.ws + WS_TOK) + (size_t)r * 8; const int e1 = ti[0], e2 = ti[1], s1 = ti[2], s2 = ti[3]; const float w1 = __builtin_bit_cast(float, ti[4]), w2 = __builtin_bit_cast(float, ti[5]);
        const int r1 = s1, r2 = s2;
#pragma unroll
        for (int k = 0; k < 2; ++k) { const int rr = k ? r2 : r1; const float ww = k ? w2 : w1;
            if (rr < MOE_FULL_TILES * 256) { const GAS v2u* y = (const GAS v2u*)((const bf16*)(F.ws + WS_YS) + (size_t)rr * DM) + F.lane;
#pragma unroll
                for (int j = 0; j < 4; ++j) { const v2u a = y[64 * j];
                    v[j].x += ww * __builtin_bit_cast(float, a.x << 16); v[j].y += ww * __builtin_bit_cast(float, a.x & 0xffff0000u); v[j].z += ww * __builtin_bit_cast(float, a.y << 16); v[j].w += ww * __builtin_bit_cast(float, a.y & 0xffff0000u); }
            } else {
                const GAS f32x4* p = (const GAS f32x4*)((const float*)(F.ws + WS_PART) + ((size_t)((rr >> 8) - MOE_FULL_TILES) * KS * 256 + (rr & 255)) * DM) + F.lane;
#pragma unroll
                for (int j = 0; j < 4; ++j) { f32x4 s = p[64 * j];
#pragma unroll
                    for (int kc = 1; kc < KS; ++kc) s += p[(size_t)kc * 256 * (DM / 4) + 64 * j];
                    v[j] += s * ww; } } }
#pragma unroll
        for (int j = 0; j < 4; ++j) {
            xr[64 * j] = v[j]; }
    }
}
__device__ __forceinline__ float row_rstd(const f32x4 (&v)[4]) { float s = 0.f;
#pragma unroll
    for (int j = 0; j < 4; ++j) s += (v[j].x * v[j].x + v[j].y * v[j].y) + (v[j].z * v[j].z + v[j].w * v[j].w);
    return __builtin_amdgcn_rsqf(wave_sum(s) * (1.0f / DM) + EPS); }
__device__ __forceinline__ void store_xn(Frame& F, int r, const f32x4 (&v)[4], float rstd) {
    GAS v2u* o = (GAS v2u*)((bf16*)(F.ws + WS_XN) + (size_t)r * DM) + F.lane;
#pragma unroll
    for (int j = 0; j < 4; ++j) { v2u w; w.x = pk2(v[j].x * rstd, v[j].y * rstd); w.y = pk2(v[j].z * rstd, v[j].w * rstd); o[64 * j] = w; }
}
__device__ __forceinline__ void store_xq(Frame& F, int r, const f32x4 (&v)[4], float rstd) {
    float amax = 0.f;
#pragma unroll
    for (int j = 0; j < 4; ++j) amax = fmaxf(fmaxf(amax, fmaxf(fabsf(v[j].x), fabsf(v[j].y))), fmaxf(fabsf(v[j].z), fabsf(v[j].w)));
    amax = fmaxf(wave_max(amax) * rstd, 1e-20f);
    const float s = rstd * (127.0f / amax);
    GAS unsigned* o = (GAS unsigned*)(F.ws + WS_XN + (size_t)r * DM) + F.lane;
#pragma unroll
    for (int j = 0; j < 4; ++j) { const int q0 = (int)__builtin_rintf(v[j].x * s), q1 = (int)__builtin_rintf(v[j].y * s), q2 = (int)__builtin_rintf(v[j].z * s), q3 = (int)__builtin_rintf(v[j].w * s);
        o[64 * j] = (unsigned)(q0 & 255) | ((unsigned)(q1 & 255) << 8) | ((unsigned)(q2 & 255) << 16) | ((unsigned)q3 << 24); }
    if (F.lane == 0) ((float*)(F.ws + WS_RS))[r] = amax * (1.0f / (127.0f * S_W8));
}
__device__ __forceinline__ void norm_phase(Frame& F, bool moe_prev, const unsigned* cnt_prev, bool q8) {
    const int gw = F.vcu * NWAVES + F.wave, NGW = F.G * NWAVES; float* hres = (float*)(F.ws + WS_HRES);
    for (int r = gw; r < MTOK; r += NGW) { f32x4 v[4]; load_row(F, hres, r, moe_prev, cnt_prev, v); const float rstd = row_rstd(v); if (q8) store_xq(F, r, v, rstd); else store_xn(F, r, v, rstd); }
}
__device__ __forceinline__ void route_phase(Frame& F, const float* gain, const float* router_w, unsigned* cnt) {
    const int gw = F.vcu * NWAVES + F.wave, NGW = F.G * NWAVES; float* hres = (float*)(F.ws + WS_HRES);
    LAS float* rw = (LAS float*)F.lds;
    LAS unsigned* lcnt = (LAS unsigned*)(F.lds + 32768);
    for (int i = F.tid; i < DM * NEXP / 4; i += NWAVES * 64) ((LAS f32x4*)rw)[i] = ((const f32x4*)router_w)[i];
    if (F.tid < 8) lcnt[F.tid] = 0u;
    __syncthreads();
    for (int r = gw; r < MTOK; r += NGW) {
        f32x4 v[4]; load_row(F, hres, r, false, cnt, v); const float rstd = row_rstd(v); store_xq(F, r, v, rstd);
        float lg[8];
#pragma unroll
        for (int e = 0; e < 8; ++e) lg[e] = 0.f;
#pragma unroll
        for (int j = 0; j < 4; ++j) { const int k0 = 4 * F.lane + 256 * j; const f32x4 g = *(const f32x4*)(gain + k0);
            const float hv[4] = {v[j].x * rstd * g.x, v[j].y * rstd * g.y, v[j].z * rstd * g.z, v[j].w * rstd * g.w};
#pragma unroll
            for (int t = 0; t < 4; ++t) { const f32x4 wa = *(const LAS f32x4*)(rw + (k0 + t) * 8), wb = *(const LAS f32x4*)(rw + (k0 + t) * 8 + 4);
                lg[0] += hv[t] * wa.x; lg[1] += hv[t] * wa.y; lg[2] += hv[t] * wa.z; lg[3] += hv[t] * wa.w; lg[4] += hv[t] * wb.x; lg[5] += hv[t] * wb.y; lg[6] += hv[t] * wb.z; lg[7] += hv[t] * wb.w; } }
        { float a4[4];
#pragma unroll
          for (int e = 0; e < 4; ++e) { auto rr = __builtin_amdgcn_permlane32_swap(__builtin_bit_cast(unsigned, lg[e]), __builtin_bit_cast(unsigned, lg[e + 4]), false, false); a4[e] = __builtin_bit_cast(float, (unsigned)rr[0]) + __builtin_bit_cast(float, (unsigned)rr[1]); }
          const bool b4 = (F.lane & 16) != 0, b3 = (F.lane & 8) != 0; float b2[2];
#pragma unroll
          for (int k = 0; k < 2; ++k) { const float keep = b4 ? a4[k + 2] : a4[k], send = b4 ? a4[k] : a4[k + 2]; b2[k] = keep + xshfl<16>(send); }
          float cc = (b3 ? b2[1] : b2[0]) + xshfl<8>(b3 ? b2[0] : b2[1]);
          cc = xadd<4>(cc); cc = xadd<2>(cc); cc = xadd<1>(cc);
#pragma unroll
          for (int e = 0; e < 8; ++e) lg[e] = __builtin_bit_cast(float, __builtin_amdgcn_readlane(__builtin_bit_cast(int, cc), 32 * (e >> 2) + 16 * ((e >> 1) & 1) + 8 * (e & 1))); }
        int e1 = 0; float v1 = lg[0];
#pragma unroll
        for (int e = 1; e < 8; ++e) if (lg[e] > v1) { v1 = lg[e]; e1 = e; }
        int e2 = -1; float v2 = -3.0e38f;
#pragma unroll
        for (int e = 0; e < 8; ++e) if (e != e1 && (e2 < 0 || lg[e] > v2)) { v2 = lg[e]; e2 = e; }
        const float w2 = 1.0f / (1.0f + __expf(v1 - v2)), w1 = 1.0f - w2;
        if (F.lane == 0) { __hip_atomic_fetch_add(lcnt + e1, 1u, __ATOMIC_RELAXED, __HIP_MEMORY_SCOPE_WORKGROUP); __hip_atomic_fetch_add(lcnt + e2, 1u, __ATOMIC_RELAXED, __HIP_MEMORY_SCOPE_WORKGROUP);
            int* ti = (int*)(F.ws + WS_TOK) + (size_t)r * 8; ti[0] = e1; ti[1] = e2; ti[4] = __builtin_bit_cast(int, w1); ti[5] = __builtin_bit_cast(int, w2); }
    }
    __syncthreads();
    if (F.tid < 8) { __hip_atomic_fetch_add(cnt + F.tid, lcnt[F.tid], RLX_AGENT); ((unsigned*)(F.ws + WS_WGCNT))[F.vcu * 8 + F.tid] = lcnt[F.tid]; }
    __syncthreads();
}
__device__ __forceinline__ void gather_phase(Frame& F, const unsigned* cnt) {
    const int gw = F.vcu * NWAVES + F.wave, NGW = F.G * NWAVES;
    LAS float* tb = (LAS float*)F.lds;
    LAS int* wgbase = (LAS int*)(F.lds + 8192); LAS int* wcnt = wgbase + 8; LAS int* run = wcnt + 64;
    for (int i = F.tid; i < 2048; i += NWAVES * 64) tb[i] = (i >> 3) < F.vcu ? (float)((const unsigned*)(F.ws + WS_WGCNT))[i] : 0.f;
    if (F.tid < 64) { wcnt[F.tid] = 0; }
    __syncthreads();
    { float s = 0.f;
#pragma unroll
      for (int k = 0; k < 4; ++k) s += tb[(F.lane + 64 * k) * 8 + F.wave];
      s = wave_sum(s); if (F.lane == 0) wgbase[F.wave] = expert_base(cnt, F.wave) + (int)s; }
    for (int r = gw; r < MTOK; r += NGW) if (F.lane == 0) { const int* ti = (const int*)(F.ws + WS_TOK) + (size_t)r * 8; wcnt[F.wave * 8 + ti[0]] += 1; wcnt[F.wave * 8 + ti[1]] += 1; }
    __syncthreads();
    if (F.lane < 8) { int a = 0; for (int ww = 0; ww < F.wave; ++ww) a += wcnt[ww * 8 + F.lane]; run[F.wave * 8 + F.lane] = wgbase[F.lane] + a; }
    asm volatile("s_waitcnt lgkmcnt(0)" ::: "memory");
    for (int r0 = gw; r0 < MTOK; r0 += 3 * NGW) {
        int d1[3], d2[3]; v4u a[3]; float sc[3];
#pragma unroll
        for (int k = 0; k < 3; ++k) { const int r = r0 + k * NGW; d1[k] = -1; d2[k] = -1;
            if (r < MTOK) { int* ti = (int*)(F.ws + WS_TOK) + (size_t)r * 8; const int e1 = ti[0], e2 = ti[1];
                a[k] = *((const GAS v4u*)(F.ws + WS_XN + (size_t)r * DM) + F.lane); sc[k] = ((const float*)(F.ws + WS_RS))[r];
                d1[k] = run[F.wave * 8 + e1]; d2[k] = run[F.wave * 8 + e2];
                asm volatile("s_waitcnt lgkmcnt(0)" ::: "memory");
                if (F.lane == 0) { run[F.wave * 8 + e1] = d1[k] + 1; run[F.wave * 8 + e2] = d2[k] + 1; ti[2] = d1[k]; ti[3] = d2[k]; }
                asm volatile("s_waitcnt lgkmcnt(0)" ::: "memory"); } }
#pragma unroll
        for (int k = 0; k < 3; ++k) if (d1[k] >= 0) {
            *((GAS v4u*)(F.ws + WS_XS + (size_t)d1[k] * DM) + F.lane) = a[k]; *((GAS v4u*)(F.ws + WS_XS + (size_t)d2[k] * DM) + F.lane) = a[k];
            if (F.lane == 0) { ((float*)(F.ws + WS_RSS))[d1[k]] = sc[k]; ((float*)(F.ws + WS_RSS))[d2[k]] = sc[k]; } }
    }
    for (int e = 0; e < 8; ++e) { const int c0 = (int)cnt[e], c1 = (c0 + 255) & ~255, b0 = expert_base(cnt, e);
        for (int q = c0 + gw; q < c1; q += NGW) { *((GAS v4u*)(F.ws + WS_XS + (size_t)(b0 + q) * DM) + F.lane) = zero4(); if (F.lane == 0) ((float*)(F.ws + WS_RSS))[b0 + q] = 0.f; } }
}
__device__ __forceinline__ void final_phase(Frame& F, const float* gain, float* out, const unsigned* cnt_prev) {
    const int gw = F.vcu * NWAVES + F.wave, NGW = F.G * NWAVES; float* hres = (float*)(F.ws + WS_HRES);
    for (int q = gw; q < NMAIN; q += NGW) { const int r = q;
        f32x4 v[4]; load_row<MOE_KSPLIT8>(F, hres, r, true, cnt_prev, v); const float rstd = row_rstd(v);
        GAS f32x4* o = (GAS f32x4*)(out + (size_t)q * DM) + F.lane;
#pragma unroll
        for (int j = 0; j < 4; ++j) { const f32x4 g = *(const f32x4*)(gain + 4 * F.lane + 256 * j); o[64 * j] = (f32x4){v[j].x * rstd * g.x, v[j].y * rstd * g.y, v[j].z * rstd * g.z, v[j].w * rstd * g.w}; }
    }
}

typedef short v4i16_t __attribute__((ext_vector_type(4)));
__device__ __forceinline__ s16x4 vtr(const LAS unsigned char* p) { return __builtin_bit_cast(s16x4, __builtin_amdgcn_ds_read_tr16_b64_v4i16((LAS v4i16_t*)p)); }
#define MFMA16(a, b, c) __builtin_amdgcn_mfma_f32_16x16x32_bf16((a), (b), (c), 0, 0, 0)
#define CAT8(L, H) (bf16x8){L[0], L[1], L[2], L[3], H[0], H[1], H[2], H[3]}
__device__ __forceinline__ void ret_state_unit(Frame& F, int unit) {
    const int b = unit >> 5, h = (unit >> 3) & 3, es = unit & 7;
    int tid_ = threadIdx.x; asm volatile("" : "+v"(tid_));
    const int tid = tid_, lane = tid & 63, w = __builtin_amdgcn_readfirstlane(tid >> 6), l15 = lane & 15, kg = lane >> 4, q = l15 >> 2, p_ = l15 & 3;
    const float g64 = exp2f(64.0f * log2_gamma(h));
    const bf16* rkz = (const bf16*)(F.ws + WS_R + R_RKZ) + h * 128;
    const bf16* rv = (const bf16*)(F.ws + WS_R + R_RV) + h * 128 + es * 16;
    bf16* ST = (bf16*)(F.ws + WS_R + R_ST) + (size_t)((b * 4 + h) * NCH) * 16384 + (es * 16 + l15) * 128 + w * 16 + 4 * kg;
    LAS unsigned char* KZ = F.lds; LAS unsigned char* VS = F.lds + 7 * 16384;
    const GAS unsigned char* zsrc = (const GAS unsigned char*)(F.ws + WS_CTL + 512);
#define RS_DMA(c, slot) do { const int cc = (c) < 31 ? (c) : 31; const size_t p0 = cc == 0 ? (size_t)NMAIN : (size_t)b * SEQ + 64 * (cc - 1); \
        _Pragma("unroll") for (int i_ = 0; i_ < 2; ++i_) { const int row = 4 * (2 * w + i_) + (lane >> 4); const GAS unsigned char* src = (const GAS unsigned char*)(rkz + (p0 + row) * 512 + (lane & 15) * 8); \
            if (cc == 0 && row >= NMETA) src = zsrc; __builtin_amdgcn_global_load_lds((const GAS unsigned*)src, (LAS unsigned*)(KZ + (slot) * 16384 + (2 * w + i_) * 1024), 16, 0, 0); } \
        if (w < 2) { const int row = 32 * w + (lane >> 1); const GAS unsigned char* src = (const GAS unsigned char*)(rv + (p0 + row) * 512 + (lane & 1) * 8); \
            if (cc == 0 && row >= NMETA) src = zsrc; __builtin_amdgcn_global_load_lds((const GAS unsigned*)src, (LAS unsigned*)(VS + (slot) * 2048 + w * 1024), 16, 0, 0); } } while (0)
    RS_DMA(0, 0); RS_DMA(1, 1); RS_DMA(2, 2); RS_DMA(3, 3); RS_DMA(4, 4); RS_DMA(5, 5);
    af4 S = {0.f, 0.f, 0.f, 0.f};
    int slot = 0;
#pragma unroll 1
    for (int c = 0; c <= 32; ++c) {
        { v2u o; o.x = pk2(S[0], S[1]); o.y = pk2(S[2], S[3]); *(GAS v2u*)(ST + (size_t)c * 16384) = o; }
        if (c == 32) break;
        if (w < 2) asm volatile("s_waitcnt vmcnt(15)" ::: "memory"); else asm volatile("s_waitcnt vmcnt(10)" ::: "memory");
        asm volatile("" ::: "memory"); __builtin_amdgcn_s_barrier(); asm volatile("" ::: "memory");
        { const int s6 = slot == 0 ? 6 : slot - 1; RS_DMA(c + 6, s6); }
        const int kza = (int)(size_t)(KZ + slot * 16384 + w * 32 + p_ * 8) + (8 * kg + q) * 256, vsa = (int)(size_t)(VS + slot * 2048 + p_ * 8) + (8 * kg + q) * 32;
        s16x4 a0, a1, a2, a3, b0, b1, b2, b3;
        asm volatile("ds_read_b64_tr_b16 %0, %8\n\tds_read_b64_tr_b16 %1, %8 offset:1024\n\tds_read_b64_tr_b16 %2, %8 offset:8192\n\tds_read_b64_tr_b16 %3, %8 offset:9216\n\t"
                     "ds_read_b64_tr_b16 %4, %9\n\tds_read_b64_tr_b16 %5, %9 offset:128\n\tds_read_b64_tr_b16 %6, %9 offset:1024\n\tds_read_b64_tr_b16 %7, %9 offset:1152\n\ts_waitcnt lgkmcnt(0)"
                     : "=&v"(a0), "=&v"(a1), "=&v"(a2), "=&v"(a3), "=&v"(b0), "=&v"(b1), "=&v"(b2), "=&v"(b3) : "v"(kza), "v"(vsa) : "memory");
        S *= g64;
        S = MFMA16(CAT8(a0, a1), CAT8(b0, b1), S); S = MFMA16(CAT8(a2, a3), CAT8(b2, b3), S);
        slot = slot == 6 ? 0 : slot + 1;
    }
    asm volatile("s_waitcnt vmcnt(0)" ::: "memory");
    __syncthreads();
#undef RS_DMA
}
__device__ __forceinline__ void ret_state64_unit(Frame& F, int unit) {
    asm volatile("" : "+s"(unit));
    const int b = unit >> 3, h = (unit >> 1) & 3, es = unit & 1;
    int tid_ = threadIdx.x; asm volatile("" : "+v"(tid_));
    const int tid = tid_, lane = tid & 63, w = __builtin_amdgcn_readfirstlane(tid >> 6), l15 = lane & 15, kg = lane >> 4, q = l15 >> 2, p_ = l15 & 3;
    const float g64 = exp2f(64.0f * log2_gamma(h));
    const bf16* rkz = (const bf16*)(F.ws + WS_R + R_RKZ) + h * 128;
    const bf16* rv = (const bf16*)(F.ws + WS_R + R_RV) + h * 128 + es * 64;
    bf16* ST = (bf16*)(F.ws + WS_R + R_ST) + (size_t)((b * 4 + h) * NCH) * 16384 + (es * 64 + l15) * 128 + w * 16 + 4 * kg;
    LAS unsigned char* KZ = F.lds; LAS unsigned char* VS = F.lds + 5 * 16384;
    const GAS unsigned char* zsrc = (const GAS unsigned char*)(F.ws + WS_CTL + 512);
#define RS_DMA(c, slot) do { const int cc = (c) < 31 ? (c) : 31; const size_t p0 = cc == 0 ? (size_t)NMAIN : (size_t)b * SEQ + 64 * (cc - 1); \
        _Pragma("unroll") for (int i_ = 0; i_ < 2; ++i_) { const int row = 4 * (2 * w + i_) + (lane >> 4); const GAS unsigned char* src = (const GAS unsigned char*)(rkz + (p0 + row) * 512 + (lane & 15) * 8); \
            if (cc == 0 && row >= NMETA) src = zsrc; __builtin_amdgcn_global_load_lds((const GAS unsigned*)src, (LAS unsigned*)(KZ + (slot) * 16384 + (2 * w + i_) * 1024), 16, 0, 0); } \
        { const int row = 8 * w + (lane >> 3); const GAS unsigned char* src = (const GAS unsigned char*)(rv + (p0 + row) * 512 + (lane & 7) * 8); \
            if (cc == 0 && row >= NMETA) src = zsrc; __builtin_amdgcn_global_load_lds((const GAS unsigned*)src, (LAS unsigned*)(VS + (slot) * 8192 + w * 1024), 16, 0, 0); } } while (0)
    RS_DMA(0, 0); RS_DMA(1, 1); RS_DMA(2, 2); RS_DMA(3, 3);
    af4 S[4];
#pragma unroll
    for (int vg = 0; vg < 4; ++vg) S[vg] = (af4){0.f, 0.f, 0.f, 0.f};
    int slot = 0;
#pragma unroll 1
    for (int c = 0; c <= 32; ++c) {
#pragma unroll
        for (int vg = 0; vg < 4; ++vg) { v2u o; o.x = pk2(S[vg][0], S[vg][1]); o.y = pk2(S[vg][2], S[vg][3]); *(GAS v2u*)(ST + (size_t)c * 16384 + vg * 2048) = o; }
        if (c == 32) break;
        asm volatile("s_waitcnt vmcnt(9)" ::: "memory");
        asm volatile("" ::: "memory"); __builtin_amdgcn_s_barrier(); asm volatile("" ::: "memory");
        { const int s4 = slot == 0 ? 4 : slot - 1; RS_DMA(c + 4, s4); }
        const int kza = (int)(size_t)(KZ + slot * 16384 + w * 32 + p_ * 8) + (8 * kg + q) * 256, vsa = (int)(size_t)(VS + slot * 8192 + p_ * 8) + (8 * kg + q) * 128;
        s16x4 a0, a1, a2, a3, bv[4][4];
        asm volatile("ds_read_b64_tr_b16 %0, %20\n\tds_read_b64_tr_b16 %1, %20 offset:1024\n\tds_read_b64_tr_b16 %2, %20 offset:8192\n\tds_read_b64_tr_b16 %3, %20 offset:9216\n\tds_read_b64_tr_b16 %4, %21\n\tds_read_b64_tr_b16 %5, %21 offset:512\n\tds_read_b64_tr_b16 %6, %21 offset:4096\n\tds_read_b64_tr_b16 %7, %21 offset:4608\n\tds_read_b64_tr_b16 %8, %21 offset:32\n\tds_read_b64_tr_b16 %9, %21 offset:544\n\tds_read_b64_tr_b16 %10, %21 offset:4128\n\tds_read_b64_tr_b16 %11, %21 offset:4640\n\tds_read_b64_tr_b16 %12, %21 offset:64\n\tds_read_b64_tr_b16 %13, %21 offset:576\n\tds_read_b64_tr_b16 %14, %21 offset:4160\n\tds_read_b64_tr_b16 %15, %21 offset:4672\n\tds_read_b64_tr_b16 %16, %21 offset:96\n\tds_read_b64_tr_b16 %17, %21 offset:608\n\tds_read_b64_tr_b16 %18, %21 offset:4192\n\tds_read_b64_tr_b16 %19, %21 offset:4704\n\ts_waitcnt lgkmcnt(0)"
                     : "=&v"(a0), "=&v"(a1), "=&v"(a2), "=&v"(a3), "=&v"(bv[0][0]), "=&v"(bv[0][1]), "=&v"(bv[0][2]), "=&v"(bv[0][3]), "=&v"(bv[1][0]), "=&v"(bv[1][1]), "=&v"(bv[1][2]), "=&v"(bv[1][3]), "=&v"(bv[2][0]), "=&v"(bv[2][1]), "=&v"(bv[2][2]), "=&v"(bv[2][3]), "=&v"(bv[3][0]), "=&v"(bv[3][1]), "=&v"(bv[3][2]), "=&v"(bv[3][3]) : "v"(kza), "v"(vsa) : "memory");
#pragma unroll
        for (int vg = 0; vg < 4; ++vg) { S[vg] *= g64;
            S[vg] = MFMA16(CAT8(a0, a1), CAT8(bv[vg][0], bv[vg][1]), S[vg]); S[vg] = MFMA16(CAT8(a2, a3), CAT8(bv[vg][2], bv[vg][3]), S[vg]); }
        slot = slot == 4 ? 0 : slot + 1;
    }
    asm volatile("s_waitcnt vmcnt(0)" ::: "memory");
    __syncthreads();
#undef RS_DMA
}
__device__ __forceinline__ void ret_out_unit(Frame& F, int unit, const float* gain) {
    const int c = unit < NB * 4 * 32 ? 1 + (unit & 31) : 0, b = unit < NB * 4 * 32 ? unit >> 7 : 0, h = unit < NB * 4 * 32 ? (unit >> 5) & 3 : unit - NB * 4 * 32;
    int tid_ = threadIdx.x; asm volatile("" : "+v"(tid_));
    const int tid = tid_, lane = tid & 63, w = __builtin_amdgcn_readfirstlane(tid >> 6), l15 = lane & 15, kg = lane >> 4, q = l15 >> 2, p_ = l15 & 3, it = w & 3, eh = w >> 2;
    const float lg = log2_gamma(h);
    const size_t r0 = c == 0 ? (size_t)NMAIN : (size_t)b * SEQ + 64 * (c - 1);
    const bf16* rq = (const bf16*)(F.ws + WS_R + R_RQ) + r0 * 512 + h * 128;
    const bf16* rk = (const bf16*)(F.ws + WS_R + R_RK) + r0 * 512 + h * 128;
    const bf16* rv = (const bf16*)(F.ws + WS_R + R_RV) + r0 * 512 + h * 128;
    const bf16* sg = (const bf16*)(F.ws + WS_R + R_SG) + r0 * 512 + h * 128;
    const bf16* ST = (const bf16*)(F.ws + WS_R + R_ST) + (size_t)((b * 4 + h) * NCH + c) * 16384;
    bf16* Y = (bf16*)(F.ws + WS_R + R_Y) + r0 * DM + h * 128;
    LAS unsigned char* VL = F.lds; LAS unsigned char* SGL = F.lds + 16384; LAS unsigned char* YL = F.lds + 32768; LAS float* red = (LAS float*)(F.lds + 49152);
    v4u vst[2], gst[2];
#pragma unroll
    for (int i = 0; i < 2; ++i) { const int idx = tid + 512 * i; vst[i] = zero4(); gst[i] = vst[i];
        if (c > 0 || (idx >> 4) < NMETA) { vst[i] = *(const GAS v4u*)(rv + (size_t)(idx >> 4) * 512 + (idx & 15) * 8); gst[i] = *(const GAS v4u*)(sg + (size_t)(idx >> 4) * 512 + (idx & 15) * 8); } }
    float gn[4];
#pragma unroll
    for (int et = 0; et < 4; ++et) gn[et] = gain[h * 128 + 64 * eh + 16 * et + l15];
    bf16x8 qf[4];
#pragma unroll
    for (int ks = 0; ks < 4; ++ks) qf[ks] = *(const GAS bf16x8*)(rq + (size_t)(16 * it + l15) * 512 + 32 * ks + 8 * kg);
    af4 pj[4];
#pragma unroll
    for (int jt = 0; jt < 4; ++jt) { pj[jt] = (af4){0.f, 0.f, 0.f, 0.f};
#pragma unroll
        for (int ks = 0; ks < 4; ++ks) { const bf16x8 kf = *(const GAS bf16x8*)(rk + (size_t)(16 * jt + l15) * 512 + 32 * ks + 8 * kg); pj[jt] = MFMA16(kf, qf[ks], pj[jt]); } }
#pragma unroll
    for (int i = 0; i < 2; ++i) { const int idx = tid + 512 * i; *(LAS v4u*)(VL + (idx >> 4) * 256 + (idx & 15) * 16) = vst[i]; *(LAS v4u*)(SGL + (idx >> 4) * 256 + (idx & 15) * 16) = gst[i]; }
    bf16x8 pa[2];
    { const int il = 16 * it + l15; unsigned pw[4][2];
#pragma unroll
      for (int jt = 0; jt < 4; ++jt) { float v[4];
#pragma unroll
          for (int r = 0; r < 4; ++r) { const int jl = 16 * jt + 4 * kg + r; const int dd = il > jl ? il - jl : jl - il; const float wgt = __builtin_amdgcn_exp2f(lg * (float)dd); v[r] = (c == 0 && jl >= NMETA) ? 0.f : pj[jt][r] * wgt; }
          pw[jt][0] = pk2(v[0], v[1]); pw[jt][1] = pk2(v[2], v[3]); }
      pa[0] = __builtin_bit_cast(bf16x8, (v4u){pw[0][0], pw[0][1], pw[1][0], pw[1][1]}); pa[1] = __builtin_bit_cast(bf16x8, (v4u){pw[2][0], pw[2][1], pw[3][0], pw[3][1]}); }
    af4 acc[4];
#pragma unroll
    for (int et = 0; et < 4; ++et) acc[et] = (af4){0.f, 0.f, 0.f, 0.f};
    if (c > 0) {
#pragma unroll
        for (int et = 0; et < 4; ++et)
#pragma unroll
            for (int ks = 0; ks < 4; ++ks) { const bf16x8 sf = *(const GAS bf16x8*)(ST + (size_t)(64 * eh + 16 * et + l15) * 128 + 32 * ks + 8 * kg); acc[et] = MFMA16(qf[ks], sf, acc[et]); }
        float xi[4];
#pragma unroll
        for (int r = 0; r < 4; ++r) xi[r] = __builtin_amdgcn_exp2f(lg * (float)(16 * it + 4 * kg + r + 1));
#pragma unroll
        for (int et = 0; et < 4; ++et)
#pragma unroll
            for (int r = 0; r < 4; ++r) acc[et][r] *= xi[r];
    }
    __syncthreads();
#pragma unroll
    for (int et = 0; et < 4; ++et)
#pragma unroll
        for (int u = 0; u < 2; ++u) { const LAS unsigned char* vb = VL + (size_t)(32 * u + 4 * kg + q) * 256 + (64 * eh + 16 * et + 4 * p_) * 2;
            const s16x4 b0 = vtr(vb), b1 = vtr(vb + 16 * 256); acc[et] = MFMA16(pa[u], CAT8(b0, b1), acc[et]); }
    float ss[4];
#pragma unroll
    for (int r = 0; r < 4; ++r) { float s = 0.f;
#pragma unroll
        for (int et = 0; et < 4; ++et) s += acc[et][r] * acc[et][r];
        s = xadd<1>(s); s = xadd<2>(s); s = xadd<4>(s); s = xadd<8>(s); ss[r] = s; }
    if (l15 == 0) {
#pragma unroll
        for (int r = 0; r < 4; ++r) red[eh * 64 + 16 * it + 4 * kg + r] = ss[r]; }
    __syncthreads();
#pragma unroll
    for (int r = 0; r < 4; ++r) { const int il = 16 * it + 4 * kg + r; const float rstd = __builtin_amdgcn_rsqf((red[il] + red[64 + il]) * (1.0f / 128.0f) + EPS);
#pragma unroll
        for (int et = 0; et < 4; ++et) { const int e = 64 * eh + 16 * et + l15; const float o = acc[et][r] * rstd * gn[et] * bf2f(*(const LAS bf16*)(SGL + il * 256 + e * 2)); *(LAS bf16*)(YL + il * 256 + e * 2) = (bf16)f2bf(o); } }
    __syncthreads();
#pragma unroll
    for (int i = 0; i < 2; ++i) { const int idx = tid + 512 * i; if (c > 0 || (idx >> 4) < NMETA) *(GAS v4u*)(Y + (size_t)(idx >> 4) * DM + (idx & 15) * 8) = *(const LAS v4u*)(YL + (idx >> 4) * 256 + (idx & 15) * 16); }
    asm volatile("s_waitcnt lgkmcnt(0)" ::: "memory"); __builtin_amdgcn_s_barrier(); asm volatile("" ::: "memory");
}

__device__ __forceinline__ void ret_out4_unit(Frame& F, int unit, const float* gain) {
    const int g = unit & 7, h = (unit >> 3) & 3, b = unit >> 5;
    int tid_ = threadIdx.x; asm volatile("" : "+v"(tid_));
    const int tid = tid_, lane = tid & 63, w = __builtin_amdgcn_readfirstlane(tid >> 6), l15 = lane & 15, kg = lane >> 4, q = l15 >> 2, p_ = l15 & 3, ci = w >> 1, hf = w & 1;
    const float lg = log2_gamma(h);
    const size_t r0 = (size_t)b * SEQ + 256 * g;
    const bf16* rq = (const bf16*)(F.ws + WS_R + R_RQ) + (r0 + 64 * ci) * 512 + h * 128;
    const bf16* rk = (const bf16*)(F.ws + WS_R + R_RK) + (r0 + 64 * ci) * 512 + h * 128;
    const bf16* rv = (const bf16*)(F.ws + WS_R + R_RV) + r0 * 512 + h * 128;
    const bf16* sg = (const bf16*)(F.ws + WS_R + R_SG) + r0 * 512 + h * 128;
    const bf16* ST = (const bf16*)(F.ws + WS_R + R_ST) + (size_t)((b * 4 + h) * NCH + 1 + 4 * g + ci) * 16384;
    bf16* Y = (bf16*)(F.ws + WS_R + R_Y) + r0 * DM + h * 128;
    LAS unsigned char* VL = F.lds; LAS unsigned char* SGL = F.lds + 65536;
#pragma unroll
    for (int i = 0; i < 8; ++i) { const int pc = 8 * w + i; const size_t go = (size_t)(4 * pc + (lane >> 4)) * 512 + (lane & 15) * 8;
        __builtin_amdgcn_global_load_lds((const GAS unsigned*)(rv + go), (LAS unsigned*)(VL + pc * 1024), 16, 0, 0);
        __builtin_amdgcn_global_load_lds((const GAS unsigned*)(sg + go), (LAS unsigned*)(SGL + pc * 1024), 16, 0, 0); }
    float gn[8];
#pragma unroll
    for (int et = 0; et < 8; ++et) gn[et] = gain[h * 128 + 16 * et + l15];
    bf16x8 qf[2][4];
#pragma unroll
    for (int rt = 0; rt < 2; ++rt)
#pragma unroll
        for (int ks = 0; ks < 4; ++ks) qf[rt][ks] = *(const GAS bf16x8*)(rq + (size_t)(16 * (2 * hf + rt) + l15) * 512 + 32 * ks + 8 * kg);
    af4 acc[2][8];
    { bf16x8 sf[8][4];
#pragma unroll
      for (int et = 0; et < 8; ++et)
#pragma unroll
          for (int ks = 0; ks < 4; ++ks) sf[et][ks] = *(const GAS bf16x8*)(ST + (size_t)(16 * et + l15) * 128 + 32 * ks + 8 * kg);
      asm volatile("" ::: "memory");
#pragma unroll
      for (int et = 0; et < 8; ++et) { acc[0][et] = (af4){0.f, 0.f, 0.f, 0.f}; acc[1][et] = acc[0][et];
#pragma unroll
          for (int ks = 0; ks < 4; ++ks) { acc[0][et] = MFMA16(qf[0][ks], sf[et][ks], acc[0][et]); acc[1][et] = MFMA16(qf[1][ks], sf[et][ks], acc[1][et]); } } }
#pragma unroll
    for (int rt = 0; rt < 2; ++rt) { float xi[4];
#pragma unroll
        for (int r = 0; r < 4; ++r) xi[r] = __builtin_amdgcn_exp2f(lg * (float)(16 * (2 * hf + rt) + 4 * kg + r + 1));
#pragma unroll
        for (int et = 0; et < 8; ++et)
#pragma unroll
            for (int r = 0; r < 4; ++r) acc[rt][et][r] *= xi[r]; }
    af4 pj[2][4];
    { bf16x8 kf[4][4];
#pragma unroll
      for (int jt = 0; jt < 4; ++jt)
#pragma unroll
          for (int ks = 0; ks < 4; ++ks) kf[jt][ks] = *(const GAS bf16x8*)(rk + (size_t)(16 * jt + l15) * 512 + 32 * ks + 8 * kg);
      asm volatile("" ::: "memory");
#pragma unroll
      for (int jt = 0; jt < 4; ++jt) { pj[0][jt] = (af4){0.f, 0.f, 0.f, 0.f}; pj[1][jt] = pj[0][jt];
#pragma unroll
          for (int ks = 0; ks < 4; ++ks) { pj[0][jt] = MFMA16(kf[jt][ks], qf[0][ks], pj[0][jt]); pj[1][jt] = MFMA16(kf[jt][ks], qf[1][ks], pj[1][jt]); } } }
    bf16x8 pa[2][2];
#pragma unroll
    for (int rt = 0; rt < 2; ++rt) { const int il = 16 * (2 * hf + rt) + l15; unsigned pw[4][2];
#pragma unroll
        for (int jt = 0; jt < 4; ++jt) { float v[4];
#pragma unroll
            for (int r = 0; r < 4; ++r) { const int jl = 16 * jt + 4 * kg + r; const int dd = il > jl ? il - jl : jl - il; v[r] = pj[rt][jt][r] * __builtin_amdgcn_exp2f(lg * (float)dd); }
            pw[jt][0] = pk2(v[0], v[1]); pw[jt][1] = pk2(v[2], v[3]); }
        pa[rt][0] = __builtin_bit_cast(bf16x8, (v4u){pw[0][0], pw[0][1], pw[1][0], pw[1][1]}); pa[rt][1] = __builtin_bit_cast(bf16x8, (v4u){pw[2][0], pw[2][1], pw[3][0], pw[3][1]}); }
    asm volatile("s_waitcnt vmcnt(0)" ::: "memory");
    __syncthreads();
#pragma unroll
    for (int et = 0; et < 8; ++et)
#pragma unroll
        for (int u = 0; u < 2; ++u) { const LAS unsigned char* vb = VL + (size_t)(64 * ci + 32 * u + 4 * kg + q) * 256 + (16 * et + 4 * p_) * 2;
            const s16x4 b0 = vtr(vb), b1 = vtr(vb + 16 * 256); const bf16x8 vf = CAT8(b0, b1); acc[0][et] = MFMA16(pa[0][u], vf, acc[0][et]); acc[1][et] = MFMA16(pa[1][u], vf, acc[1][et]); }
    float rstd[2][4];
#pragma unroll
    for (int rt = 0; rt < 2; ++rt)
#pragma unroll
        for (int r = 0; r < 4; ++r) { float s = 0.f;
#pragma unroll
            for (int et = 0; et < 8; ++et) s += acc[rt][et][r] * acc[rt][et][r];
            s = xadd<1>(s); s = xadd<2>(s); s = xadd<4>(s); s = xadd<8>(s); rstd[rt][r] = __builtin_amdgcn_rsqf(s * (1.0f / 128.0f) + EPS); }
    __syncthreads();
#pragma unroll
    for (int rt = 0; rt < 2; ++rt)
#pragma unroll
        for (int r = 0; r < 4; ++r) { const int row = 64 * ci + 16 * (2 * hf + rt) + 4 * kg + r;
#pragma unroll
            for (int et = 0; et < 8; ++et) { const int e = 16 * et + l15; const float o = acc[rt][et][r] * rstd[rt][r] * gn[et] * bf2f(*(const LAS bf16*)(SGL + row * 256 + e * 2)); *(LAS bf16*)(VL + row * 256 + e * 2) = (bf16)f2bf(o); } }
    __syncthreads();
#pragma unroll
    for (int i = 0; i < 8; ++i) { const int idx = tid + 512 * i; *(GAS v4u*)(Y + (size_t)(idx >> 4) * DM + (idx & 15) * 8) = *(const LAS v4u*)(VL + (idx >> 4) * 256 + (idx & 15) * 16); }
    asm volatile("s_waitcnt lgkmcnt(0)" ::: "memory"); __builtin_amdgcn_s_barrier(); asm volatile("" ::: "memory");
}

#define KSWZ(row, colB) ((row) * 256 + ((colB) ^ (((row) & 7) << 4)))
#define KPSWZ(row, colB) ((row) * 128 + ((colB) ^ (((row) & 7) << 4)))
#define SBAR() __builtin_amdgcn_sched_barrier(0)
__device__ __forceinline__ int crow(int r, int hi) { return (r & 3) + 8 * (r >> 2) + 4 * hi; }
__device__ __forceinline__ int v_st(int k, int c) { const int kk = (k & ~0xC) | ((k & 4) << 1) | ((k & 8) >> 1); return ((kk >> 3) * 4 + (c >> 5)) * 512 + ((kk & 7) * 32 + (c & 31)) * 2; }
__device__ __forceinline__ int v_rd_base(int lane) { return ((lane & 3) << 3) | (((lane >> 2) & 3) << 6) | (((lane >> 4) & 1) << 5) | (((lane >> 5) & 1) << 8); }
constexpr int v_rd_off(int d0, int ks, int half) { return d0 * 512 + ks * 4096 + half * 2048; }
template <int OFF> __device__ __forceinline__ s16x4 tr_read(int vb) { s16x4 r; asm volatile("ds_read_b64_tr_b16 %0, %1 offset:%2" : "=&v"(r) : "v"(vb), "i"(OFF) : "memory"); return r; }
template <int D0> __device__ __forceinline__ void pv_one(f32x16& od, int vb, bf16x8 pa0, bf16x8 pa1, bf16x8 pa2, bf16x8 pa3) {
    const s16x4 l0 = tr_read<v_rd_off(D0, 0, 0)>(vb), h0 = tr_read<v_rd_off(D0, 0, 1)>(vb), l1 = tr_read<v_rd_off(D0, 1, 0)>(vb), h1 = tr_read<v_rd_off(D0, 1, 1)>(vb);
    const s16x4 l2 = tr_read<v_rd_off(D0, 2, 0)>(vb), h2 = tr_read<v_rd_off(D0, 2, 1)>(vb), l3 = tr_read<v_rd_off(D0, 3, 0)>(vb), h3 = tr_read<v_rd_off(D0, 3, 1)>(vb);
    asm volatile("s_waitcnt lgkmcnt(0)" ::: "memory"); SBAR();
    od = __builtin_amdgcn_mfma_f32_32x32x16_bf16(pa0, CAT8(l0, h0), od, 0, 0, 0);
    od = __builtin_amdgcn_mfma_f32_32x32x16_bf16(pa1, CAT8(l1, h1), od, 0, 0, 0);
    od = __builtin_amdgcn_mfma_f32_32x32x16_bf16(pa2, CAT8(l2, h2), od, 0, 0, 0);
    od = __builtin_amdgcn_mfma_f32_32x32x16_bf16(pa3, CAT8(l3, h3), od, 0, 0, 0);
}
__device__ __forceinline__ void attn_unit(Frame& F, int b, int h, int j, const float* gain, char* lds) {
    int tid_ = threadIdx.x; asm volatile("" : "+v"(tid_));
    const int tid = tid_, wid = __builtin_amdgcn_readfirstlane(tid >> 6), lane = tid & 63, r32 = lane & 31, hi = lane >> 5;
    const unsigned char* Rb = F.ws + WS_R;
    const bf16* QN = (const bf16*)(Rb + R_QN); const bf16* QPE = (const bf16*)(Rb + R_QPE); const bf16* KN = (const bf16*)(Rb + R_KN) + h * 128; const bf16* VV = (const bf16*)(Rb + R_V) + h * 128; const bf16* KPE = (const bf16*)(Rb + R_KPE);
    char* V_lds = lds; char* K_lds = lds + 32768; char* KP_lds = lds + 65536; float* wsf = (float*)(lds + 81920) + wid * 64; float* li_l = wsf; float* al_l = wsf + 32;
    const size_t qbase = j < 0 ? (size_t)NMAIN : (size_t)b * SEQ + 256 * j; const size_t rowq = qbase + wid * 32 + r32;
    bf16x8 qr[12];
#pragma unroll
    for (int d0 = 0; d0 < 8; ++d0) qr[d0] = *(const GAS bf16x8*)(QN + rowq * 512 + h * 128 + d0 * 16 + hi * 8);
#pragma unroll
    for (int d0 = 0; d0 < 4; ++d0) qr[8 + d0] = *(const GAS bf16x8*)(QPE + rowq * 256 + h * 64 + d0 * 16 + hi * 8);
    const int NT = j < 0 ? 1 : 4 * j + 5, my_last = j < 0 ? 0 : 1 + 4 * j + (wid >> 1);
    const int vb0 = (int)(uintptr_t)V_lds + v_rd_base(lane);
    const int k_row = (lane >> 4), k_cb = ((lane & 15) * 16) ^ 0;
    const int kp_row = (lane >> 3), kp_cb = (lane & 7) * 16;
    const int v_kklo = (lane & 31) >> 2, v_cin = (lane & 3) * 8, v_sub = lane >> 5;
    const GAS unsigned char* zsrc = (const GAS unsigned char*)(F.ws + WS_CTL + 512);
#define A_DMA(t, bf) do { const size_t kr = (t) == 0 ? (size_t)NMAIN : (size_t)b * SEQ + 64 * ((t) - 1); const bool meta_ = (t) == 0; \
        _Pragma("unroll") for (int i_ = 0; i_ < 2; ++i_) { const int pc = 2 * wid + i_; \
            { const int row = 4 * pc + k_row, cb = k_cb ^ ((row & 7) << 4); const GAS unsigned char* src = (const GAS unsigned char*)(KN + (kr + row) * 512) + cb; if (meta_ && row >= NMETA) src = zsrc; \
              __builtin_amdgcn_global_load_lds((const GAS unsigned*)src, (LAS unsigned*)(F.lds + 32768 + (bf) * 16384 + pc * 1024), 16, 0, 0); } \
            { const int sub = 2 * pc + v_sub, kk = (sub >> 2) * 8 + v_kklo, k = (kk & ~0xC) | ((kk & 4) << 1) | ((kk & 8) >> 1), c = (sub & 3) * 32 + v_cin; \
              const GAS unsigned char* src = (const GAS unsigned char*)(VV + (kr + k) * 512 + c); if (meta_ && k >= NMETA) src = zsrc; \
              __builtin_amdgcn_global_load_lds((const GAS unsigned*)src, (LAS unsigned*)(F.lds + (bf) * 16384 + pc * 1024), 16, 0, 0); } } \
        { const int row = 8 * wid + kp_row, cb = kp_cb ^ ((row & 7) << 4); const GAS unsigned char* src = (const GAS unsigned char*)(KPE + (kr + row) * 64) + cb; if (meta_ && row >= NMETA) src = zsrc; \
          __builtin_amdgcn_global_load_lds((const GAS unsigned*)src, (LAS unsigned*)(F.lds + 65536 + (bf) * 8192 + wid * 1024), 16, 0, 0); } } while (0)
    float m_reg = -1e30f, l_reg = 0.f; f32x16 o[4];
#pragma unroll
    for (int d = 0; d < 4; ++d)
#pragma unroll
        for (int r = 0; r < 16; ++r) o[d][r] = 0.f;
    A_DMA(0, 0); asm volatile("s_waitcnt vmcnt(0)" ::: "memory"); __syncthreads();
    for (int t = 0; t < NT; ++t) {
        if (t + 1 < NT) A_DMA(t + 1, (t + 1) & 1);
        if (t <= my_last) {
            const char* Kt = K_lds + (t & 1) * 16384; const char* KPt = KP_lds + (t & 1) * 8192;
            f32x16 p0v, p1v;
#pragma unroll
            for (int r = 0; r < 16; ++r) { p0v[r] = 0.f; p1v[r] = 0.f; }
#define A_KLD(d0, B0, B1) do { if ((d0) < 8) { const int cb_ = ((d0) * 16 + hi * 8) * 2; B0 = *(const bf16x8*)(Kt + KSWZ(r32, cb_)); B1 = *(const bf16x8*)(Kt + KSWZ(32 + r32, cb_)); } \
                                else { const int cb_ = (((d0) - 8) * 16 + hi * 8) * 2; B0 = *(const bf16x8*)(KPt + KPSWZ(r32, cb_)); B1 = *(const bf16x8*)(KPt + KPSWZ(32 + r32, cb_)); } } while (0)
            { bf16x8 ka[3], kb[3];
              A_KLD(0, ka[0], kb[0]); A_KLD(1, ka[1], kb[1]); SBAR();
#pragma unroll
              for (int d0 = 0; d0 < 12; ++d0) {
                  if (d0 + 2 < 12) A_KLD(d0 + 2, ka[(d0 + 2) % 3], kb[(d0 + 2) % 3]);
                  SBAR();
                  p0v = __builtin_amdgcn_mfma_f32_32x32x16_bf16(ka[d0 % 3], qr[d0], p0v, 0, 0, 0); p1v = __builtin_amdgcn_mfma_f32_32x32x16_bf16(kb[d0 % 3], qr[d0], p1v, 0, 0, 0);
                  SBAR(); } }
#undef A_KLD
            if (t == 0) {
#pragma unroll
                for (int r = 8; r < 16; ++r) p0v[r] = -1e30f;
#pragma unroll
                for (int r = 0; r < 16; ++r) p1v[r] = -1e30f; }
            float pmax = p0v[0];
#pragma unroll
            for (int r = 1; r < 16; ++r) pmax = fmaxf(pmax, p0v[r]);
#pragma unroll
            for (int r = 0; r < 16; ++r) pmax = fmaxf(pmax, p1v[r]);
            { auto rr = __builtin_amdgcn_permlane32_swap(__float_as_uint(pmax), __float_as_uint(pmax), false, false); pmax = fmaxf(__uint_as_float(rr[0]), __uint_as_float(rr[1])); }
            const float mn = fmaxf(m_reg, pmax), alpha = __builtin_amdgcn_exp2f(m_reg - mn); m_reg = mn;
            float ps = 0.f;
#pragma unroll
            for (int r = 0; r < 16; ++r) { p0v[r] = __builtin_amdgcn_exp2f(p0v[r] - mn); p1v[r] = __builtin_amdgcn_exp2f(p1v[r] - mn); ps += p0v[r] + p1v[r]; }
            { auto rr = __builtin_amdgcn_permlane32_swap(__float_as_uint(ps), __float_as_uint(ps), false, false); ps = __uint_as_float(rr[0]) + __uint_as_float(rr[1]); }
            l_reg = l_reg * alpha + ps;
            if (__any(alpha < 1.f)) { if (hi == 0) al_l[r32] = alpha; asm volatile("s_waitcnt lgkmcnt(0)" ::: "memory");
#pragma unroll
                for (int r = 0; r < 16; ++r) { const float a = al_l[crow(r, hi)];
#pragma unroll
                    for (int d = 0; d < 4; ++d) o[d][r] *= a; } }
            bf16x8 pa0, pa1, pa2, pa3;
#define PK4(P, BASE, OUT) do { unsigned a0 = pk2(P[BASE + 0], P[BASE + 1]), a1 = pk2(P[BASE + 2], P[BASE + 3]); \
    unsigned b0_ = pk2(P[BASE + 4], P[BASE + 5]), b1_ = pk2(P[BASE + 6], P[BASE + 7]); \
    auto r0_ = __builtin_amdgcn_permlane32_swap(a0, b0_, false, false); auto r1_ = __builtin_amdgcn_permlane32_swap(a1, b1_, false, false); \
    v4u w_ = {r0_[0], r1_[0], r0_[1], r1_[1]}; OUT = __builtin_bit_cast(bf16x8, w_); } while (0)
            PK4(p0v, 0, pa0); PK4(p0v, 8, pa1); PK4(p1v, 0, pa2); PK4(p1v, 8, pa3);
#undef PK4
            const int vb = vb0 + (t & 1) * 16384;
            pv_one<0>(o[0], vb, pa0, pa1, pa2, pa3); pv_one<1>(o[1], vb, pa0, pa1, pa2, pa3); pv_one<2>(o[2], vb, pa0, pa1, pa2, pa3); pv_one<3>(o[3], vb, pa0, pa1, pa2, pa3);
        }
        asm volatile("s_waitcnt vmcnt(0)" ::: "memory");
        __syncthreads();
    }
    if (hi == 0) li_l[r32] = l_reg; asm volatile("s_waitcnt lgkmcnt(0)" ::: "memory");
    bf16* Y = (bf16*)(F.ws + WS_R + R_Y) + (qbase + wid * 32) * DM + 512 + h * 128;
    float gn[4];
#pragma unroll
    for (int d = 0; d < 4; ++d) gn[d] = gain[h * 128 + 32 * d + r32];
#pragma unroll
    for (int r = 0; r < 16; ++r) { const int orow = crow(r, hi); const float lr = li_l[orow];
        float s = (o[0][r] * o[0][r] + o[1][r] * o[1][r]) + (o[2][r] * o[2][r] + o[3][r] * o[3][r]);
        s = xadd<1>(s); s = xadd<2>(s); s = xadd<4>(s); s = xadd<8>(s); s = xadd<16>(s);
        const float rstd = __builtin_amdgcn_rsqf(s * (1.0f / 128.0f) + EPS * lr * lr);
        if (j >= 0 || (wid == 0 && orow < NMETA)) {
#pragma unroll
            for (int d = 0; d < 4; ++d) Y[(size_t)orow * DM + 32 * d + r32] = (bf16)f2bf(o[d][r] * rstd * gn[d]); } }
    asm volatile("s_waitcnt lgkmcnt(0)" ::: "memory"); __builtin_amdgcn_s_barrier(); asm volatile("" ::: "memory");
#undef A_DMA
}

struct Args { Inputs in; float* out; unsigned char* ws; int phase; int pad; };
constexpr int N_ATT_UNITS = 260, N_RO_UNITS = NB * 4 * 8 + 4;
constexpr int PH_PER_LAYER = 9, N_PHASES = 1 + DEPTH * PH_PER_LAYER + 1;

__global__ void __launch_bounds__(NWAVES * 64, 2) mk_fwd(Args args) {
    extern __shared__ __attribute__((aligned(16))) unsigned char lds[];
    Frame F;
    F.lds = (LAS unsigned char*)lds; F.MISC = (volatile LAS unsigned*)(F.lds + MISC_OFF);
    F.tid = threadIdx.x; F.lane = F.tid & 63; F.wave = __builtin_amdgcn_readfirstlane(F.tid >> 6);
    F.G = gridDim.x; { const int bx = blockIdx.x; F.vcu = (F.G % 8 == 0) ? (bx % 8) * (F.G / 8) + bx / 8 : bx; }
    F.ws = args.ws; F.ctl = (gu32*)(args.ws + WS_CTL);
    for (int u = F.tid; u < (LDS_BYTES - LDSCTL_OFF) / 4; u += NWAVES * 64) ((LAS unsigned*)(F.lds + LDSCTL_OFF))[u] = 0u;
    __syncthreads();
    XcdBarrier bar; bar.bar = (unsigned*)(F.ctl + CW_BAR); bar.x = 0; bar.st = nullptr;
    if (!MK_MULTI) bar = xcd_barrier_post((unsigned*)(F.ctl + CW_BAR), F.MISC + 8);
#define META_FRAME() Frame Fm_ = F; { int z2_ = 0; asm volatile("" : "+s"(z2_)); Fm_.ws = F.ws + z2_; } Frame& F = Fm_
#define R (F.ws + WS_R)
#define tab ((const float*)(F.ws + WS_TAB))
#define hres ((float*)(F.ws + WS_HRES))
#define XN ((const pg8::bf16_t*)(F.ws + WS_XN))
#define cnt ((unsigned*)(F.ctl + CW_CNT) + li * 8)
    int ph = 0;
#ifndef MK_ALIGN
#define MK_ALIGN true
#endif
#ifndef MK_SP2
#define MK_SP2 true
#endif
#ifndef MK_MASK
#define MK_MASK 0xFFFFFFFFu
#endif
#define ON(k) (((MK_MASK) >> (k)) & 1u)
#ifndef MK_STAMP_A
#define MK_STAMP_A (-1)
#define MK_STAMP_B (-1)
#endif
#ifndef MK_ATT_REP
#define MK_ATT_REP 1
#endif
#ifndef MK_RO_REP
#define MK_RO_REP 1
#endif
#ifndef MK_REP_PH
#define MK_REP_PH (-1)
#endif
#ifndef MK_REP_N
#define MK_REP_N 1
#endif
#define RUN() (MK_MULTI ? (ph == args.phase) : true)
#define SEAM() do { if (!MK_MULTI) { asm volatile("" : "+s"(bar.x)); bar.bar = (unsigned*)(F.ctl + CW_BAR); xcd_barrier(bar); } if (MK_STAMP_A >= 0 && blockIdx.x == 0 && F.tid == 0) ((unsigned long long*)(F.ws + WS_CTL + 1572864))[ph] = __builtin_amdgcn_s_memrealtime();   ++ph; int z_ = 0; F.tid = threadIdx.x; asm volatile("" : "+v"(F.tid), "+s"(z_));     F.lane = F.tid & 63; F.wave = __builtin_amdgcn_readfirstlane(F.tid >> 6); F.ws = args.ws + z_; F.ctl = (gu32*)(F.ws + WS_CTL); } while (0)
#define REPS(k) _Pragma("unroll 1") for (int rep_ = 0; rep_ < ((k) == MK_REP_PH ? MK_REP_N : 1); ++rep_, ((rep_ < ((k) == MK_REP_PH ? MK_REP_N : 1)) ? ({ SEAM(); --ph; 0; }) : 0))

    REPS(0) if (ON(0) && RUN()) p0_prologue(F);
    SEAM();
#if defined(MK_PROBE_GEMM)
    {
        pg8::Gemm g{XN, (const pg8::bf16_t*)(F.ws + WS_WDGU), NMAIN, 2 * FF, DM / 2, 0};
        pg8::StaticOrder S; S.init(NMAIN, 2 * FF, F.G, (int)blockIdx.x);
#if MK_PROBE_GEMM == 1
        EpiSwiGLU E{(bf16*)(R + R_ACT)}; E.rs = (const float*)(F.ws + WS_TAB);
        pg8::gemm_phase<EpiSwiGLU, pg8::StaticOrder, MK_ALIGN, MK_SP2, true>(F.lds, g, S, E);
#else
        EpiNone E{};
        pg8::gemm_phase<EpiNone, pg8::StaticOrder, MK_ALIGN, MK_SP2, true>(F.lds, g, S, E);
#endif
        if (!MK_MULTI) { asm volatile("" : "+s"(bar.x)); bar.bar = (unsigned*)(F.ctl + CW_BAR); xcd_barrier(bar); }
    }
#endif
#pragma unroll 1
    for (int l = 0; l < DEPTH; ++l) {
        const bool moe = (l & 1) != 0; const int li = l >> 1;
        REPS(1) if (ON(1) && RUN() && l > 0) norm_phase(F, l == 2 && rep_ == 0, (const unsigned*)(F.ctl + CW_CNT), true);
        SEAM();
        REPS(2) if (ON(2) && RUN()) {
            pg8::Gemm g{XN, (const pg8::bf16_t*)(F.ws + WS_WIN + (size_t)l * DINP * DM), NMAIN, DINP - 512, DM / 2, 0};
            pg8::StaticOrder S; S.init(NMAIN, DINP - 512, F.G, (int)blockIdx.x);
            EpiInProj E{R, (float*)(F.ws + CTL_SSQ), (float*)(F.ws + CTL_SSKV), tab, log2_gamma(0), log2_gamma(1), log2_gamma(2), log2_gamma(3), 0}; E.rs = (const float*)(F.ws + WS_RS);
            auto meta = [&]() __attribute__((always_inline)) { META_FRAME(); EpiInProj Em{R, (float*)(F.ws + CTL_SSQ), (float*)(F.ws + CTL_SSKV), tab, log2_gamma(0), log2_gamma(1), log2_gamma(2), log2_gamma(3), 0}; Em.rs = (const float*)(F.ws + WS_RS);
                meta_gemm<EpiInProj, 1>(F, F.ws + WS_XN + (size_t)NMAIN * DM, g.Bt, DINP, DM, Em); };
            pg8::gemm_phase<EpiInProj, pg8::StaticOrder, MK_ALIGN, MK_SP2, 1>(F.lds, g, S, E, meta);
        }
        SEAM();
        REPS(3) if (ON(3) && RUN()) {
            const int c_ = (int)blockIdx.x, hG = F.G >> 1;
            {
                pg8::Gemm g{XN, (const pg8::bf16_t*)(F.ws + WS_WIN + (size_t)l * DINP * DM + (size_t)(DINP - 512) * DM), NMAIN, 512, DM / 2, 0};
                pg8::StaticOrder S; S.init(NMAIN, 512, F.G, c_);
                if (F.G == 256) { if (c_ >= 64 && c_ < 192) S.window(0, 128, c_ - 64, 128); else S.window(128, 128, 0, 128); }
                EpiGate E{R + R_SG}; E.rs = (const float*)(F.ws + WS_RS);
                pg8::gemm_phase<EpiGate, pg8::StaticOrder, MK_ALIGN, MK_SP2, 1>(F.lds, g, S, E);
            }
            pg8::Gemm g{(const pg8::bf16_t*)(R + R_LAT), (const pg8::bf16_t*)(F.ws + WS_WUP) + (size_t)l * UPN * UPK, NMAIN, UPN, UPK, 0};
            pg8::StaticOrder S; S.init(NMAIN, UPN, F.G, c_);
            S.pnsplit = 3; S.nt_lo = 4; S.koff_hi = 512u; S.nt_hi = 2;
            if (F.G == 256) { if (c_ >= 192) S.window(256, 64, c_ - 192, 448); else if (c_ >= 64) S.window(0, 128, c_ - 64, 256); else S.window(448, hG, 0, 448); }
            EpiUp E{R, (const float*)(F.ws + CTL_SSQ), (const float*)(F.ws + CTL_SSKV), tab};
            auto meta = [&]() __attribute__((always_inline)) { META_FRAME(); EpiUp Em{R, (const float*)(F.ws + CTL_SSQ), (const float*)(F.ws + CTL_SSKV), tab};
                meta_gemm<EpiUp>(F, (const pg8::bf16_t*)(R + R_LAT) + (size_t)NMAIN * UPK, g.Bt, UPN, UPK * 2, Em); };
            pg8::gemm_phase<EpiUp, pg8::StaticOrder, MK_ALIGN, MK_SP2, 0>(F.lds, g, S, E, meta);
            if (ON(4)) { if (F.G == 256) { if (c_ < 64) ret_state64_unit(F, c_); } else for (int u = c_; u < NB * 4 * 2; u += F.G) ret_state64_unit(F, u); }
        }
        SEAM();
        REPS(5) if (RUN()) {
            gu32* qh = F.ctl + CW_QUEUE + 64 * l + 8 * rep_;
            for (;;) {
                if (F.tid == 0) F.MISC[16] = __hip_atomic_fetch_add(qh, 1u, RLX_AGENT);
                asm volatile("s_waitcnt lgkmcnt(0)" ::: "memory"); __builtin_amdgcn_s_barrier(); asm volatile("" ::: "memory"); const int u = (int)F.MISC[16]; asm volatile("s_waitcnt lgkmcnt(0)" ::: "memory"); __builtin_amdgcn_s_barrier(); asm volatile("" ::: "memory");
                if (u >= N_ATT_UNITS + N_RO_UNITS) break;
                const bool is_ro = u >= 192 && u < 192 + N_RO_UNITS;
                if (!is_ro) { if (ON(5)) { const int v = u < 192 ? u : u - N_RO_UNITS; const int j = v < 256 ? 7 - (v >> 5) : -1, bh = v < 256 ? (v & 31) : (v - 256); attn_unit(F, bh >> 2, bh & 3, j, ldin(I_MLAG) + l * 512, (char*)lds); } }
                else if (ON(6)) { const int v = u - 192; if (v < NB * 4 * 8) ret_out4_unit(F, v, ldin(I_RETG) + l * 512); else ret_out_unit(F, NB * 4 * 32 + (v - NB * 4 * 8), ldin(I_RETG) + l * 512); }
            }
        }
        SEAM();
        REPS(7) if (ON(7) && RUN()) {
            pg8::Gemm g{(const pg8::bf16_t*)(R + R_Y), (const pg8::bf16_t*)(F.ws + WS_WOUT) + (size_t)l * DM * DM, NMAIN, DM, DM, 0};
            pg8::StaticOrder S; S.init(NMAIN, DM, F.G, (int)blockIdx.x);
            EpiResid E{rep_ == 0 ? hres : (float*)(F.ws + WS_XS), 1.0f};
            auto meta = [&]() __attribute__((always_inline)) { META_FRAME(); EpiResid Em{hres, 1.0f};
                meta_gemm<EpiResid>(F, (const pg8::bf16_t*)(R + R_Y) + (size_t)NMAIN * DM, g.Bt, DM, DM * 2, Em); };
            pg8::gemm_phase<EpiResid, pg8::StaticOrder, MK_ALIGN, MK_SP2, 0>(F.lds, g, S, E, meta);
        }
        SEAM();
        if (!moe) {
            REPS(8) if (ON(8) && RUN()) norm_phase(F, false, nullptr, true);
            SEAM();
            REPS(9) if (ON(9) && RUN()) {
                pg8::Gemm g{XN, (const pg8::bf16_t*)(F.ws + WS_WDGU + (size_t)li * 2 * FF * DM), NMAIN, 2 * FF, DM / 2, 0};
                pg8::StaticOrder S; S.init(NMAIN, 2 * FF, F.G, (int)blockIdx.x);
                EpiSwiGLU E{(bf16*)(R + R_ACT)}; E.rs = (const float*)(F.ws + WS_RS); E.f8 = 1;
                auto meta = [&]() __attribute__((always_inline)) { META_FRAME(); EpiSwiGLU Em{(bf16*)(R + R_ACT)}; Em.rs = (const float*)(F.ws + WS_RS); Em.f8 = 1;
                    meta_gemm<EpiSwiGLU, true>(F, F.ws + WS_XN + (size_t)NMAIN * DM, g.Bt, 2 * FF, DM, Em); };
                pg8::gemm_phase<EpiSwiGLU, pg8::StaticOrder, MK_ALIGN, MK_SP2, 1>(F.lds, g, S, E, meta);
            }
            SEAM();
            REPS(10) if (ON(10) && RUN()) {
                pg8::Gemm g{(const pg8::bf16_t*)(R + R_ACT), (const pg8::bf16_t*)(F.ws + WS_WDD + (size_t)li * DM * FF), NMAIN, DM, FF / 2, 0};
                pg8::StaticOrder S; S.init(NMAIN, DM, F.G, (int)blockIdx.x);
                EpiResid E{rep_ == 0 ? hres : (float*)(F.ws + WS_XS), 1.0f / (S_A8 * S_WD8)};
                auto meta = [&]() __attribute__((always_inline)) { META_FRAME(); EpiResid Em{hres, 1.0f / (S_A8 * S_WD8)};
                    meta_gemm<EpiResid, 2>(F, R + R_ACT + (size_t)NMAIN * FF, g.Bt, DM, FF, Em); };
                pg8::gemm_phase<EpiResid, pg8::StaticOrder, MK_ALIGN, MK_SP2, 2>(F.lds, g, S, E, meta);
            }
            SEAM();
            ++ph;
        } else {
            if (ON(11) && RUN()) route_phase(F, ldin(I_FFNNORM) + l * DM, ldin(I_ROUTER) + (size_t)li * DM * NEXP, cnt);
            SEAM();
            REPS(12) if (ON(12) && RUN()) gather_phase(F, cnt);
            SEAM();
            REPS(13) if (ON(13) && RUN()) {
                pg8::Gemm g{(const pg8::bf16_t*)(F.ws + WS_XS), (const pg8::bf16_t*)(F.ws + WS_WMGU + (size_t)li * NEXP * 2 * FF * DM), XS_ROWS, 2 * FF, DM / 2, (size_t)2 * FF * DM};
                pg8::GroupedOrder S; S.init(cnt, 2 * FF, F.G, (int)blockIdx.x);
                EpiSwiGLU E{(bf16*)(R + R_ACT)}; E.rs = (const float*)(F.ws + WS_RSS); E.f8 = 1;
                pg8::gemm_phase<EpiSwiGLU, pg8::GroupedOrder, MK_ALIGN, MK_SP2, true>(F.lds, g, S, E);
            }
            SEAM();
            REPS(14) if (ON(14) && RUN()) {
                pg8::Gemm g{(const pg8::bf16_t*)(R + R_ACT), (const pg8::bf16_t*)(F.ws + WS_WMD + (size_t)li * NEXP * DM * FF), XS_ROWS, DM, FF / 2, (size_t)DM * FF};
                { asm volatile("" ::: "memory"); pg8::GroupedOrder S; S.init(cnt, DM, F.G, (int)blockIdx.x, 0, MOE_FULL_TILES);
                  EpiMoeDown E{(bf16*)(F.ws + WS_YS), 1.0f / (S_A8 * S_WD8)};
                  pg8::gemm_phase<EpiMoeDown, pg8::GroupedOrder, MK_ALIGN, MK_SP2, 2>(F.lds, g, S, E); }
                { pg8::Gemm g2 = g; g2.K = FF / 2 / MOE_KSPLIT8; g2.ld = FF / 2;
                  asm volatile("" ::: "memory"); pg8::GroupedOrder S; S.init(cnt, DM, F.G, (int)blockIdx.x, MOE_FULL_TILES, 1 << 30, MOE_KSPLIT8, (unsigned)(FF / MOE_KSPLIT8));
                  EpiPartial E{(float*)(F.ws + WS_PART), (unsigned)(FF / MOE_KSPLIT8), MOE_KSPLIT8, 1.0f / (S_A8 * S_WD8)};
                  pg8::gemm_phase<EpiPartial, pg8::GroupedOrder, MK_ALIGN, MK_SP2, 2>(F.lds, g2, S, E); }
            }
            SEAM();
        }
    }
    if (ON(15) && RUN()) final_phase(F, ldin(I_FINAL), args.out, (const unsigned*)(F.ctl + CW_CNT) + 8);
    if (MK_STAMP_A >= 0 && blockIdx.x == 0 && F.tid == 0) {
        unsigned long long* st = (unsigned long long*)(F.ws + WS_CTL + 1572864); st[ph] = __builtin_amdgcn_s_memrealtime();
        const unsigned long long d = 8ull * (st[MK_STAMP_B] - st[MK_STAMP_A]), t0 = __builtin_amdgcn_s_memrealtime();
        while (__builtin_amdgcn_s_memrealtime() - t0 < d) __builtin_amdgcn_s_sleep(8);
    }
#undef RUN
#undef SEAM
#undef R
#undef tab
#undef hres
#undef XN
#undef cnt
}

extern "C" void kernel_launch(void* const* d_in, const int* in_sizes, int n_in, void* d_out, int out_size, void* d_ws, size_t ws_size, hipStream_t stream) {
    static int grid = 0;
    if (grid == 0) {
        if (n_in != 20 || in_sizes[0] != NB * SEQ * DM || out_size != NB * SEQ * DM || ws_size < WS_END) {
            fprintf(stderr, "kernel_launch: shape mismatch: n_in %d in0 %d out %d ws %zu (need >= %zu)\n", n_in, n_in > 0 ? in_sizes[0] : -1, out_size, ws_size, (size_t)WS_END); grid = -1; return; }
        int dev = 0, cus = 0, per_cu = 0;
        if (hipGetDevice(&dev) != hipSuccess || hipDeviceGetAttribute(&cus, hipDeviceAttributeMultiprocessorCount, dev) != hipSuccess) { grid = -1; return; }
        if (hipFuncSetAttribute((const void*)mk_fwd, hipFuncAttributeMaxDynamicSharedMemorySize, LDS_BYTES) != hipSuccess) { fprintf(stderr, "kernel_launch: hipFuncSetAttribute failed\n"); grid = -1; return; }
        if (hipOccupancyMaxActiveBlocksPerMultiprocessor(&per_cu, (const void*)mk_fwd, NWAVES * 64, LDS_BYTES) != hipSuccess || per_cu < 1)
            fprintf(stderr, "kernel_launch: occupancy query reports %d workgroups per CU\n", per_cu);
        (void)hipGetLastError();
        grid = cus < 256 ? cus : 256;
    }
    if (grid < 0) return;
    if (hipMemsetAsync((char*)d_ws + WS_CTL, 0, CTL_ZERO_BYTES, stream) != hipSuccess) { fprintf(stderr, "kernel_launch: memset failed\n"); return; }
    Args a{};
    for (int i = 0; i < 20; ++i) a.in.p[i] = (const float*)d_in[i];
    a.out = (float*)d_out; a.ws = (unsigned char*)d_ws; a.phase = 0; a.pad = 0;
#if MK_MULTI
    for (int ph = 0; ph < N_PHASES; ++ph) { a.phase = ph; hipLaunchKernelGGL(mk_fwd, dim3(grid), dim3(NWAVES * 64), LDS_BYTES, stream, a); }
#else
    hipLaunchKernelGGL(mk_fwd, dim3(grid), dim3(NWAVES * 64), LDS_BYTES, stream, a);
#endif
    const hipError_t le = hipPeekAtLastError();
    if (le != hipSuccess) fprintf(stderr, "kernel_launch: launch failed: %s\n", hipGetErrorName(le));
}
```

```cpp
#include <hip/hip_runtime.h>
#include <cstdio>
#include <cstdint>
namespace pg8 {
#define PG8_LAS __attribute__((address_space(3)))
typedef unsigned short bf16_t;
typedef short bf16x8 __attribute__((ext_vector_type(8)));
typedef float f32x4 __attribute__((ext_vector_type(4)));
typedef unsigned u32x4 __attribute__((ext_vector_type(4)));
constexpr int BM = 256, BK = 64, HALF = 128, HTB = HALF * BK * 2  , STAGE_BYTES = 8 * HTB, NXCD = 8, WGM = 4;

__host__ __device__ __forceinline__ int lds_byte(int r, int c) { const int st = (r >> 4) * 2 + (c >> 5), rr = r & 15, cc = c & 31, ob = rr * 64 + cc * 2; return st * 1024 + (ob ^ (((ob >> 9) & 1) << 5)); }
__host__ __device__ __forceinline__ void stage_rc(int b, int& R, int& C) { const int st = b / 1024, sb = b % 1024, swz = sb ^ (((sb >> 9) & 1) << 5); R = (st >> 1) * 16 + swz / 64; C = (st & 1) * 32 + (swz % 64) / 2; }
__host__ __device__ __forceinline__ int perm32(int rho) { const int n = rho >> 4, i = rho & 15; return 8 * (i >> 2) + 4 * n + (i & 3); }

struct Unit { int pm, pn, eb; unsigned koff; int nt; };
struct Gemm { const bf16_t* A; const bf16_t* Bt; int M, N, K; size_t estride; int ld = 0; };

struct StaticOrder {
    int nM, nN, nwg, G, c, base, lim; int pnsplit = 1 << 30; unsigned koff_hi = 0u; int nt_lo = 0, nt_hi = 0;
    __host__ __device__ void init(int M, int N, int G_, int c_) { nM = M / BM; nN = N / BM; nwg = nM * nN; G = G_; c = c_; base = 0; lim = nwg; }
    __host__ __device__ void window(int base_, int G_, int c_, int lim_) { base = base_; G = G_; c = c_; lim = lim_; }
    __host__ __device__ bool next(int i, Unit& u) const {
        const long L = (long)i * G + c + base; if (L >= lim) return false;
        int wgid = (int)L; { const int q = nwg / NXCD, r = nwg % NXCD, xcd = wgid % NXCD, off = wgid / NXCD; wgid = (xcd < r ? xcd * (q + 1) : r * (q + 1) + (xcd - r) * q) + off; }
        const int nig = WGM * nN, gid = wgid / nig, fm = gid * WGM, gsz = (nM - fm) < WGM ? (nM - fm) : WGM;
        u.pm = fm + ((wgid % nig) % gsz); u.pn = (wgid % nig) / gsz; u.eb = 0; u.koff = u.pn >= pnsplit ? koff_hi : 0u; u.nt = u.pn >= pnsplit ? nt_hi : nt_lo; return true;
    }
    __device__ __forceinline__ void a_ready(const Unit&) const {}
    __device__ __forceinline__ void done(const Unit&) const {}
};
struct GroupedOrder {
    int nM, nN, nwg, G, c; int tp[9]; int pm0, nK; unsigned kbytes;
    __device__ __forceinline__ void init(const unsigned* cnt, int N, int G_, int c_, int pm_lo = 0, int pm_cap = 1 << 30, int nK_ = 1, unsigned kbytes_ = 0u) {
        tp[0] = 0;
#pragma unroll
        for (int e = 0; e < 8; ++e) tp[e + 1] = tp[e] + __builtin_amdgcn_readfirstlane((int)((cnt[e] + 255u) >> 8));
        const int hi = tp[8] < pm_cap ? tp[8] : pm_cap; pm0 = pm_lo; nM = hi > pm_lo ? hi - pm_lo : 0; nK = nK_; kbytes = kbytes_;
        nN = (N / BM) * nK; nwg = nM * nN; G = G_; c = c_; }
    __device__ __forceinline__ bool next(int i, Unit& u) const {
        const long L = (long)i * G + c; if (L >= nwg) return false;
        int wgid = (int)L; { const int q = nwg / NXCD, r = nwg % NXCD, xcd = wgid % NXCD, off = wgid / NXCD; wgid = (xcd < r ? xcd * (q + 1) : r * (q + 1) + (xcd - r) * q) + off; }
        const int nig = WGM * nN, gid = wgid / nig, fm = gid * WGM, gsz = (nM - fm) < WGM ? (nM - fm) : WGM;
        u.pm = pm0 + fm + ((wgid % nig) % gsz); const int pk = (wgid % nig) / gsz; u.pn = pk / nK; u.koff = (unsigned)(pk % nK) * kbytes; u.nt = 0;
        int e = 0;
#pragma unroll
        for (int k = 1; k < 8; ++k) e += (u.pm >= tp[k]) ? 1 : 0;
        u.eb = e; return true;
    }
    __device__ __forceinline__ void a_ready(const Unit&) const {}
    __device__ __forceinline__ void done(const Unit&) const {}
};
__device__ __forceinline__ unsigned cvt_pk_bf16(float lo, float hi) { unsigned r; asm volatile("v_cvt_pk_bf16_f32 %0, %1, %2" : "=v"(r) : "v"(lo), "v"(hi)); return r; }
typedef int i32x4 __attribute__((ext_vector_type(4)));
__device__ __forceinline__ f32x4 zero_acc() { float z; asm volatile("v_mov_b32 %0, 0" : "=v"(z)); return (f32x4){z, z, z, z}; }
template <bool I8> __device__ __forceinline__ f32x4 mma16(bf16x8 b, bf16x8 a, f32x4 c) {
    if constexpr (I8) return __builtin_bit_cast(f32x4, __builtin_amdgcn_mfma_i32_16x16x64_i8(__builtin_bit_cast(i32x4, b), __builtin_bit_cast(i32x4, a), __builtin_bit_cast(i32x4, c), 0, 0, 0));
    else return __builtin_amdgcn_mfma_f32_16x16x32_bf16(b, a, c, 0, 0, 0);
}
typedef int i32x8 __attribute__((ext_vector_type(8)));
__device__ __forceinline__ f32x4 mma_f8(bf16x8 b0, bf16x8 b1, bf16x8 a0, bf16x8 a1, f32x4 c) {
    const i32x8 B = __builtin_shufflevector(__builtin_bit_cast(i32x4, b0), __builtin_bit_cast(i32x4, b1), 0, 1, 2, 3, 4, 5, 6, 7), A = __builtin_shufflevector(__builtin_bit_cast(i32x4, a0), __builtin_bit_cast(i32x4, a1), 0, 1, 2, 3, 4, 5, 6, 7);
    asm volatile("v_mfma_f32_16x16x128_f8f6f4 %0, %1, %2, %0" : "+v"(c) : "v"(B), "v"(A));
    return c;
}
template <class Epi, class Sched, bool ALIGN_EPI = false, bool SP2 = false, int QM = 0>
__device__ __forceinline__ void gemm_phase(PG8_LAS unsigned char* lds, const Gemm g, const Sched& S, const Epi& E) {
    int tid_ = threadIdx.x; asm volatile("" : "+v"(tid_));
    const int tid = tid_, wid = __builtin_amdgcn_readfirstlane(tid >> 6), lane = tid & 63, wr = wid >> 2, wc = wid & 3, fr = lane & 15, fq = lane >> 4;
    const int K = g.ld ? g.ld : g.K, nt = g.K / BK;
    unsigned voffA[2], voffB[2];
#pragma unroll
    for (int i = 0; i < 2; ++i) { int R, C; stage_rc(tid * 16 + i * 8192, R, C); const int Rb = Epi::PERM ? ((R & ~31) + perm32(R & 31)) : R;
        voffA[i] = (unsigned)(R * K + C) * 2u; voffB[i] = (unsigned)(Rb * K + C) * 2u; }
    const size_t kstep = (size_t)(BK * 2);
    const size_t hstep = (size_t)HALF * K * 2;
    const size_t tstep = 2 * hstep;
    const unsigned ldsw = (unsigned)wid * 1024u;
    const int aoff = lds_byte(wr * 64 + fr, fq * 8), boff = lds_byte(wc * 32 + fr, fq * 8);
#define PG8_SA(b, h) (((b) * 2 + (h)) * HTB)
#define PG8_SB(b, h) ((4 + (b) * 2 + (h)) * HTB)
#define PG8_STAGE(bufoff, gbase, voff) do { _Pragma("unroll") for (int _i = 0; _i < 2; ++_i) \
        __builtin_amdgcn_global_load_lds((const unsigned*)((const char*)(gbase) + (voff)[_i]), (PG8_LAS unsigned*)(lds + (bufoff) + ldsw + _i * 8192), 16, 0, 0); } while (0)
#define PG8_LDA(dst, b, h) do { _Pragma("unroll") for (int m = 0; m < 4; ++m) _Pragma("unroll") for (int k = 0; k < 2; ++k) dst[m][k] = *(const PG8_LAS bf16x8*)(lds + PG8_SA(b, h) + aoff + m * 2048 + k * 1024); } while (0)
#define PG8_LDB(dst, b, h) do { _Pragma("unroll") for (int n = 0; n < 2; ++n) _Pragma("unroll") for (int k = 0; k < 2; ++k) dst[n][k] = *(const PG8_LAS bf16x8*)(lds + PG8_SB(b, h) + boff + n * 2048 + k * 1024); } while (0)
#define PG8_MMA(ai, bj, At, Bt) do { __builtin_amdgcn_s_setprio(1); _Pragma("unroll") for (int m = 0; m < 4; ++m) _Pragma("unroll") for (int n = 0; n < 2; ++n) { \
        if constexpr (QM == 2) acc[ai][bj][m][n] = mma_f8(Bt[n][0], Bt[n][1], At[m][0], At[m][1], acc[ai][bj][m][n]); \
        else { _Pragma("unroll") for (int k = 0; k < 2; ++k) acc[ai][bj][m][n] = mma16<QM == 1>(Bt[n][k], At[m][k], acc[ai][bj][m][n]); } } __builtin_amdgcn_s_setprio(0); } while (0)
#define PG8_WAIT_V(n) asm volatile("s_waitcnt vmcnt(" #n ")" ::: "memory")
#define PG8_WAIT_L(n) asm volatile("s_waitcnt lgkmcnt(" #n ")" ::: "memory")
#define PG8_BAR __builtin_amdgcn_s_barrier()
#define PG8_SCHED __builtin_amdgcn_sched_barrier(0)
    Unit cur, nxt; int ui = 0;
    if (!S.next(0, cur)) return;
    f32x4 acc[2][2][4][2];
#pragma unroll
    for (int a = 0; a < 2; ++a)
#pragma unroll
        for (int b = 0; b < 2; ++b)
#pragma unroll
            for (int m = 0; m < 4; ++m)
#pragma unroll
                for (int n = 0; n < 2; ++n) acc[a][b][m][n] = (f32x4){0.f, 0.f, 0.f, 0.f};
    bf16x8 At[4][2], B0[2][2], B1[2][2];
    const char* cA = (const char*)g.A + (size_t)cur.pm * tstep + cur.koff; const char* cB = (const char*)g.Bt + (size_t)cur.eb * g.estride + (size_t)cur.pn * tstep + cur.koff;
    S.a_ready(cur);
    PG8_LAS unsigned char* const scl = lds + 143360;
    if constexpr (Epi::PRE_RS) E.pre(cur, scl, wid, lane);
    if constexpr (SP2) {
        PG8_STAGE(PG8_SB(0, 0), cB, voffB); PG8_STAGE(PG8_SB(0, 1), cB + hstep, voffB); PG8_STAGE(PG8_SA(0, 0), cA, voffA); PG8_STAGE(PG8_SA(0, 1), cA + hstep, voffA);
        if (wr == 1) PG8_BAR;
        PG8_WAIT_V(2); PG8_BAR;
        PG8_STAGE(PG8_SB(1, 0), cB + kstep, voffB); PG8_STAGE(PG8_SA(1, 0), cA + kstep, voffA); PG8_STAGE(PG8_SB(1, 1), cB + hstep + kstep, voffB);
        PG8_WAIT_V(6); PG8_BAR;
    } else {
        PG8_STAGE(PG8_SB(0, 0), cB, voffB); PG8_STAGE(PG8_SA(0, 0), cA, voffA); PG8_STAGE(PG8_SB(0, 1), cB + hstep, voffB); PG8_STAGE(PG8_SA(0, 1), cA + hstep, voffA);
        if (wr == 1) PG8_BAR;
        PG8_WAIT_V(4); PG8_BAR;
        PG8_STAGE(PG8_SB(1, 0), cB + kstep, voffB); PG8_STAGE(PG8_SA(1, 0), cA + kstep, voffA); PG8_STAGE(PG8_SB(1, 1), cB + hstep + kstep, voffB);
        PG8_WAIT_V(6); PG8_BAR;
    }
    for (;;) {
        const bool has_next = S.next(ui + 1, nxt);
        const char* nA = has_next ? (const char*)g.A + (size_t)nxt.pm * tstep + nxt.koff : cA; const char* nB = has_next ? (const char*)g.Bt + (size_t)nxt.eb * g.estride + (size_t)nxt.pn * tstep + nxt.koff : cB;
        const int nt_u = cur.nt ? cur.nt : nt;
        for (int t = 0; t < nt_u; t += 2) {
            const bool last = (t == nt_u - 2);
            const char* a1 = cA + (size_t)(t + 1) * kstep;
            const char* a2 = last ? nA : cA + (size_t)(t + 2) * kstep; const char* b2 = last ? nB : cB + (size_t)(t + 2) * kstep;
            const char* a3 = a2 + kstep; const char* b3 = b2 + kstep;
            if (last && has_next) S.a_ready(nxt);
            if constexpr (SP2) {
            PG8_LDB(B0, 0, 0); PG8_LDB(B1, 0, 1); PG8_SCHED; PG8_LDA(At, 0, 0); PG8_STAGE(PG8_SA(1, 1), a1 + hstep, voffA);
            PG8_WAIT_V(8); PG8_WAIT_L(0); PG8_BAR; PG8_MMA(0, 0, At, B0); PG8_MMA(0, 1, At, B1); PG8_BAR; PG8_SCHED;
            PG8_LDA(At, 0, 1); PG8_STAGE(PG8_SB(0, 0), b2, voffB); PG8_STAGE(PG8_SB(0, 1), b2 + hstep, voffB); PG8_STAGE(PG8_SA(0, 0), a2, voffA);
            PG8_WAIT_V(8); PG8_WAIT_L(0); PG8_BAR; PG8_MMA(1, 0, At, B0); PG8_MMA(1, 1, At, B1); PG8_BAR; PG8_SCHED;
            PG8_LDB(B0, 1, 0); PG8_LDB(B1, 1, 1); PG8_SCHED; PG8_LDA(At, 1, 0); PG8_STAGE(PG8_SA(0, 1), a2 + hstep, voffA);
            PG8_WAIT_V(8); PG8_WAIT_L(0); PG8_BAR; PG8_MMA(0, 0, At, B0); PG8_MMA(0, 1, At, B1); PG8_BAR; PG8_SCHED;
            PG8_LDA(At, 1, 1); PG8_STAGE(PG8_SB(1, 0), b3, voffB); PG8_STAGE(PG8_SB(1, 1), b3 + hstep, voffB); PG8_STAGE(PG8_SA(1, 0), a3, voffA);
            PG8_WAIT_V(8); PG8_WAIT_L(0); PG8_BAR; PG8_MMA(1, 0, At, B0); PG8_MMA(1, 1, At, B1); PG8_BAR; PG8_SCHED;
            } else {
            PG8_LDB(B0, 0, 0); PG8_SCHED; PG8_LDA(At, 0, 0); PG8_STAGE(PG8_SA(1, 1), a1 + hstep, voffA);
            PG8_WAIT_L(8); PG8_BAR; PG8_WAIT_L(0); PG8_MMA(0, 0, At, B0); PG8_BAR; PG8_SCHED;
            PG8_LDB(B1, 0, 1); PG8_STAGE(PG8_SB(0, 0), b2, voffB);
            PG8_BAR; PG8_WAIT_L(0); PG8_MMA(0, 1, At, B1); PG8_BAR;
            PG8_LDA(At, 0, 1); PG8_STAGE(PG8_SA(0, 0), a2, voffA);
            PG8_BAR; PG8_WAIT_L(0); PG8_MMA(1, 0, At, B0); PG8_BAR; PG8_SCHED;
            PG8_STAGE(PG8_SB(0, 1), b2 + hstep, voffB);
            PG8_WAIT_V(6); PG8_BAR; PG8_MMA(1, 1, At, B1); PG8_BAR;
            PG8_LDB(B0, 1, 0); PG8_SCHED; PG8_LDA(At, 1, 0); PG8_STAGE(PG8_SA(0, 1), a2 + hstep, voffA);
            PG8_WAIT_L(8); PG8_BAR; PG8_WAIT_L(0); PG8_MMA(0, 0, At, B0); PG8_BAR; PG8_SCHED;
            PG8_LDB(B1, 1, 1); PG8_STAGE(PG8_SB(1, 0), b3, voffB);
            PG8_BAR; PG8_WAIT_L(0); PG8_MMA(0, 1, At, B1); PG8_BAR;
            PG8_LDA(At, 1, 1); PG8_STAGE(PG8_SA(1, 0), a3, voffA);
            PG8_BAR; PG8_WAIT_L(0); PG8_MMA(1, 0, At, B0); PG8_BAR; PG8_SCHED;
            PG8_STAGE(PG8_SB(1, 1), b3 + hstep, voffB);
            PG8_WAIT_V(6); PG8_BAR; PG8_MMA(1, 1, At, B1); PG8_BAR;
            }
        }
        if constexpr (QM == 2) { asm volatile("s_nop 15\n\ts_nop 15"); }
        if constexpr (ALIGN_EPI) { if (wr == 0) PG8_BAR; }
        if constexpr (Epi::PRE_RS) { if (has_next) E.pre(nxt, scl + ((ui + 1) & 1) * 1024, wid, lane); }
        if constexpr (!Epi::AFTER_DRAIN) { if constexpr (Epi::PRE_RS) E(acc, cur, wr, wc, fr, fq, scl + (ui & 1) * 1024); else E(acc, cur, wr, wc, fr, fq); S.done(cur); }
        if (!has_next) break;
#pragma unroll
        for (int a = 0; a < 2; ++a)
#pragma unroll
            for (int b = 0; b < 2; ++b)
#pragma unroll
                for (int m = 0; m < 4; ++m)
#pragma unroll
                    for (int n = 0; n < 2; ++n) acc[a][b][m][n] = (f32x4){0.f, 0.f, 0.f, 0.f};
        cur = nxt; cA = nA; cB = nB; ++ui;
        if constexpr (ALIGN_EPI) { if (wr == 1) PG8_BAR; }
    }
    PG8_WAIT_V(0);
    if constexpr (!ALIGN_EPI) { if (wr == 0) PG8_BAR; }
    PG8_BAR;
    if constexpr (Epi::AFTER_DRAIN) { E.fused(acc, cur, wr, wc, fr, fq, lds, wid, lane); S.done(cur); }
#undef PG8_SA
#undef PG8_SB
#undef PG8_STAGE
#undef PG8_LDA
#undef PG8_LDB
#undef PG8_MMA
#undef PG8_WAIT_V
#undef PG8_WAIT_L
#undef PG8_BAR
#undef PG8_SCHED
}
}

constexpr int NB = 8, SEQ = 2048, NMETA = 16, LSEQ = SEQ + NMETA;
constexpr int NMAIN = NB * SEQ, MTOK = NMAIN + NMETA, MP = 16640;
constexpr int DM = 1024, DINP = 2560, FF = 3584, NEXP = 8, DEPTH = 4;
constexpr int NCH = 33;
constexpr int UPN = 1792, UPK = 384;
constexpr int XS_ROWS = 35072;
constexpr float EPS = 1e-6f;
constexpr int NWAVES = 8;
#ifndef MK_MULTI
#define MK_MULTI 0
#endif

constexpr size_t MiB = 1u << 20;
constexpr size_t WS_CTL = 0, CTL_ZERO_BYTES = 2 * MiB;
constexpr size_t CTL_SSQ = 65536, CTL_SSKV = CTL_SSQ + (size_t)DEPTH * MP * 4;
static_assert(CTL_SSKV + (size_t)DEPTH * MP * 4 <= CTL_ZERO_BYTES, "ctl");
constexpr int CW_TMO = 0, CW_BAR = 4096, CW_CNT = 8192  , CW_QUEUE = 8320  , CW_SPLIT = 9216  ;
constexpr size_t WS_WIN = 2 * MiB;
constexpr size_t WS_WUP = WS_WIN + (size_t)DEPTH * DINP * DM * 2;
constexpr size_t WS_WOUT = WS_WUP + (size_t)DEPTH * UPN * UPK * 2;
constexpr size_t WS_WDGU = WS_WOUT + (size_t)DEPTH * DM * DM * 2;
constexpr size_t WS_WDD = WS_WDGU + (size_t)2 * 2 * FF * DM * 2;
constexpr size_t WS_WMGU = WS_WDD + (size_t)2 * DM * FF * 2;
constexpr size_t WS_WMD = WS_WMGU + (size_t)2 * NEXP * 2 * FF * DM * 2;
constexpr size_t WS_TAB = WS_WMD + (size_t)2 * NEXP * DM * FF * 2;
constexpr size_t TAB_RC = 0, TAB_RS = (size_t)LSEQ * 64 * 4, TAB_MC = 2 * TAB_RS, TAB_MS = TAB_MC + (size_t)LSEQ * 32 * 4;
constexpr size_t WS_HRES = WS_TAB + 2 * MiB;
constexpr size_t WS_XN = WS_HRES + (size_t)MP * DM * 4;
constexpr size_t WS_TOK = WS_XN + (size_t)MP * DM * 2;
constexpr size_t WS_SORT = WS_TOK + (size_t)MP * 32;
constexpr size_t WS_RS = WS_SORT, WS_RSS = WS_SORT + 262144;
constexpr size_t WS_WGCNT = WS_SORT + 524288;
constexpr size_t WS_XS = WS_SORT + 1 * MiB;
constexpr size_t WS_YS = WS_XS;
constexpr size_t WS_R = WS_XS + (size_t)XS_ROWS * DM * 2;
constexpr size_t R_RQ = 0, R_RK = R_RQ + (size_t)MP * 512 * 2, R_RKZ = R_RK + (size_t)MP * 512 * 2, R_RV = R_RKZ + (size_t)MP * 512 * 2, R_SG = R_RV + (size_t)MP * 512 * 2;
constexpr size_t R_LAT = R_SG + (size_t)MP * 512 * 2, R_KPE = R_LAT + (size_t)MP * 384 * 2;
constexpr size_t R_QN = R_KPE + (size_t)MP * 64 * 2, R_QPE = R_QN + (size_t)MP * 512 * 2, R_KN = R_QPE + (size_t)MP * 256 * 2, R_V = R_KN + (size_t)MP * 512 * 2;
constexpr size_t R_ST = R_V + (size_t)MP * 512 * 2;
constexpr size_t R_Y = R_ST + (size_t)NB * 4 * NCH * 128 * 128 * 2;
constexpr size_t R_MIX_END = R_Y + (size_t)MP * DM * 2;
constexpr size_t R_ACT = 0;
constexpr size_t R_END = ((size_t)XS_ROWS * FF * 2 > R_MIX_END) ? (size_t)XS_ROWS * FF * 2 : R_MIX_END;
constexpr int MOE_FULL_TILES = 128, MOE_KSPLIT = 4;
constexpr size_t WS_PART = WS_R + R_END;
constexpr size_t WS_END = WS_PART + (size_t)9 * MOE_KSPLIT * 256 * DM * 4;

constexpr int MOE_KSPLIT8 = 2;
constexpr float S_A8 = 8.0f, S_WD8 = 512.0f;
constexpr float S_W8 = 1016.0f;
constexpr int RING_BYTES = 131072, LDSCTL_OFF = RING_BYTES, MISC_OFF = LDSCTL_OFF + 320, LDS_BYTES = 147456;

#define GAS __attribute__((address_space(1)))
#define LAS __attribute__((address_space(3)))
typedef unsigned short bf16;
typedef unsigned v4u __attribute__((ext_vector_type(4)));
typedef unsigned v2u __attribute__((ext_vector_type(2)));
typedef float f32x4 __attribute__((ext_vector_type(4)));
typedef float f32x16 __attribute__((ext_vector_type(16)));
typedef short bf16x8 __attribute__((ext_vector_type(8)));
typedef short s16x4 __attribute__((ext_vector_type(4)));
typedef GAS unsigned gu32;
#define RLX_AGENT __ATOMIC_RELAXED, __HIP_MEMORY_SCOPE_AGENT
#define LDS_WAIT() asm volatile("s_waitcnt lgkmcnt(0)" ::: "memory")
#define VM_WAIT() asm volatile("s_waitcnt vmcnt(0)" ::: "memory")
__device__ __forceinline__ unsigned f2bf(float f) { unsigned u = __builtin_bit_cast(unsigned, f); return (u + 0x7fffu + ((u >> 16) & 1u)) >> 16; }
__device__ __forceinline__ unsigned pk2(float lo, float hi) { return pg8::cvt_pk_bf16(lo, hi); }
__device__ __forceinline__ v4u zero4() { unsigned z; asm volatile("v_mov_b32 %0, 0" : "=v"(z)); return (v4u){z, z, z, z}; }
__device__ __forceinline__ float bf2f(unsigned short b) { return __builtin_bit_cast(float, (unsigned)b << 16); }
template <int X> __device__ __forceinline__ float xshfl(float v) {
    if constexpr (X < 32) return __builtin_bit_cast(float, __builtin_amdgcn_ds_swizzle(__builtin_bit_cast(int, v), (X << 10) | 0x1f));
    else { const unsigned u = __builtin_bit_cast(unsigned, v); auto r = __builtin_amdgcn_permlane32_swap(u, u, false, false); const unsigned a = r[0], b = r[1]; return __builtin_bit_cast(float, a == u ? b : a); }
}
template <int X> __device__ __forceinline__ float xadd(float v) {
    if constexpr (X < 32) return v + xshfl<X>(v);
    else { const unsigned u = __builtin_bit_cast(unsigned, v); auto r = __builtin_amdgcn_permlane32_swap(u, u, false, false); return __builtin_bit_cast(float, (unsigned)r[0]) + __builtin_bit_cast(float, (unsigned)r[1]); }
}
__device__ __forceinline__ float wave_max(float v) { v = fmaxf(v, xshfl<1>(v)); v = fmaxf(v, xshfl<2>(v)); v = fmaxf(v, xshfl<4>(v)); v = fmaxf(v, xshfl<8>(v)); v = fmaxf(v, xshfl<16>(v)); v = fmaxf(v, xshfl<32>(v)); return v; }
__device__ __forceinline__ float wave_sum(float v) { v = xadd<1>(v); v = xadd<2>(v); v = xadd<4>(v); v = xadd<8>(v); v = xadd<16>(v); v = xadd<32>(v); return v; }
#define XB_TMO      128
#define XB_XCNT(j)  (256  + 64 * (j))
#define XB_XSUB(j)  (1280 + 64 * (j))
#define XB_XGEN(j)  (2304 + 64 * (j))
#define XB_TOP      3328
#define XB_TOPGEN   3392
#define XCD_BAR_WORDS 3456
#define XB_SPIN_CAP (1u << 18)

__device__ __forceinline__ unsigned xb_ld(unsigned* p)              { return __hip_atomic_load(p, __ATOMIC_RELAXED, __HIP_MEMORY_SCOPE_AGENT); }
__device__ __forceinline__ unsigned xb_add(unsigned* p, unsigned v) { return __hip_atomic_fetch_add(p, v, __ATOMIC_RELAXED, __HIP_MEMORY_SCOPE_AGENT); }
__device__ __forceinline__ unsigned xb_xcc_id() { return (unsigned)__builtin_amdgcn_s_getreg((3 << 11) | 20) & 0xFu; }
#define XB_SPIN(cond, bar) do { unsigned _sp = 0; while (cond) { __builtin_amdgcn_s_sleep(1); \
    if ((++_sp & 255u) == 0u) { if (xb_ld(&(bar)[XB_TMO])) break; if (_sp > XB_SPIN_CAP) { atomicAdd(&(bar)[XB_TMO], 1u); break; } } } } while (0)

struct XcdBarrier {
    unsigned* bar; unsigned x;
    volatile LAS unsigned* st;
};

__device__ __forceinline__ XcdBarrier xcd_barrier_post(unsigned* bar, volatile LAS unsigned* st) {
    XcdBarrier b; b.bar = bar; b.x = xb_xcc_id(); b.st = st;
    if (threadIdx.x == 0) (void)xb_add(&bar[XB_XCNT(b.x)], 1u);
    return b;
}
__device__ __forceinline__ void xcd_barrier_complete(unsigned* bar, unsigned x, unsigned& nloc, unsigned& nx) {
    const unsigned G = gridDim.x * gridDim.y * gridDim.z;
    unsigned sum, cnt, mine, sp = 0u;
    for (;;) {
        sum = 0u; cnt = 0u; mine = 0u;
#pragma unroll
        for (unsigned j = 0; j < 16; ++j) { const unsigned c = xb_ld(&bar[XB_XCNT(j)]); sum += c; cnt += (c > 0u) ? 1u : 0u; }
        mine = xb_ld(&bar[XB_XCNT(x)]);
        if (sum == G) break;
        __builtin_amdgcn_s_sleep(1);
        if ((++sp & 255u) == 0u) { if (xb_ld(&bar[XB_TMO])) break; if (sp > XB_SPIN_CAP) { atomicAdd(&bar[XB_TMO], 1u); break; } }
    }
    nloc = mine > 0u ? mine : 1u; nx = cnt > 0u ? cnt : 1u;
}

__device__ __forceinline__ void xcd_barrier(const XcdBarrier& b) {
    asm volatile("s_waitcnt vmcnt(0)" ::: "memory");
    __syncthreads();
    if (threadIdx.x == 0) {
        unsigned* bar = b.bar;
        __builtin_amdgcn_s_waitcnt(0);
        unsigned nloc = b.st[0], nx = b.st[1];
        if (nloc == 0u) { xcd_barrier_complete(bar, b.x, nloc, nx); b.st[0] = nloc; b.st[1] = nx; }
        const unsigned old = xb_add(&bar[XB_XSUB(b.x)], 1u);
        const unsigned gen = old / nloc;
        if (old + 1u == (gen + 1u) * nloc) {
            __builtin_amdgcn_fence(__ATOMIC_RELEASE, "agent");
            asm volatile("s_waitcnt vmcnt(0)" ::: "memory");
            const unsigned og = xb_add(&bar[XB_TOP], 1u);
            const unsigned tg = og / nx;
            if (og + 1u == (tg + 1u) * nx) xb_add(&bar[XB_TOPGEN], 1u);
            else XB_SPIN(xb_ld(&bar[XB_TOPGEN]) == tg, bar);
            __builtin_amdgcn_fence(__ATOMIC_ACQUIRE, "agent");
            xb_add(&bar[XB_XGEN(b.x)], 1u);
            asm volatile("s_waitcnt vmcnt(0)" ::: "memory");
        } else {
            XB_SPIN(xb_ld(&bar[XB_XGEN(b.x)]) == gen, bar);
            __builtin_amdgcn_fence(__ATOMIC_ACQUIRE, "agent");
            asm volatile("s_waitcnt vmcnt(0)" ::: "memory");
        }
    }
    __syncthreads();
}

struct Frame {
    LAS unsigned char* lds;
    volatile LAS unsigned* MISC;
    gu32* ctl;
    int tid, lane, wave, vcu, G;
    unsigned char* ws;
};
struct Inputs { const float* p[20]; };
__device__ __forceinline__ const float* ldin(int k) { unsigned long long v = 0;
#if defined(__HIP_DEVICE_COMPILE__)
    auto ka = __builtin_amdgcn_kernarg_segment_ptr();
    asm volatile("s_load_dwordx2 %0, %1, %2\n\ts_waitcnt lgkmcnt(0)" : "=s"(v) : "s"(ka), "n"(k * 8));
#endif
    return (const float*)v; }
enum { I_X = 0, I_META, I_ATTN_NORM, I_WIN, I_QNORM, I_WUQ, I_KVNORM, I_WUKV, I_RETG, I_MLAG, I_WOUT, I_FFNNORM, I_DWG, I_DWU, I_DWD, I_ROUTER, I_MWG, I_MWU, I_MWD, I_FINAL };

__device__ __forceinline__ int chunk_idx(int p) { return p < NMETA ? 48 + p : ((p - NMETA) & 63); }
__device__ __forceinline__ float log2_gamma(int h) { return h == 0 ? -0.045803689613124755f : h == 1 ? -0.022720076500083562f : h == 2 ? -0.011315313227834085f : -0.005646563141142062f; }

__device__ __forceinline__ void tr_load8(f32x4 (&v)[8], const float* Wcol, int ldw, int krow, const float* scale, float smul, int kr) {
#pragma unroll
    for (int i = 0; i < 8; ++i) v[i] = (f32x4){0.f, 0.f, 0.f, 0.f};
    if (Wcol) {
        const GAS float* src = (const GAS float*)Wcol + (size_t)(krow + 8 * kr) * ldw;
#pragma unroll
        for (int i = 0; i < 8; ++i) v[i] = __builtin_nontemporal_load((const GAS f32x4*)(src + (size_t)i * ldw));
        if (scale) { const f32x4 s0 = *(const GAS f32x4*)(scale + krow + 8 * kr) * smul, s1 = *(const GAS f32x4*)(scale + krow + 8 * kr + 4) * smul;
            v[0] *= s0.x; v[1] *= s0.y; v[2] *= s0.z; v[3] *= s0.w; v[4] *= s1.x; v[5] *= s1.y; v[6] *= s1.z; v[7] *= s1.w; }
    }
}
__device__ __forceinline__ void tr_store_bf16(const f32x4 (&v)[8], GAS bf16* dst, int Kdst) {
#pragma unroll
    for (int q = 0; q < 4; ++q) { v4u o; o.x = pk2(v[0][q], v[1][q]); o.y = pk2(v[2][q], v[3][q]); o.z = pk2(v[4][q], v[5][q]); o.w = pk2(v[6][q], v[7][q]);
        *(GAS v4u*)(dst + (size_t)q * Kdst) = o; }
}
__device__ __forceinline__ v2u tr_pack_q8(const f32x4 (&v)[8], int q) { unsigned lo = 0u, hi = 0u;
#pragma unroll
    for (int i = 0; i < 4; ++i) { const int a = (int)__builtin_rintf(fminf(fmaxf(v[i][q], -127.f), 127.f)), c = (int)__builtin_rintf(fminf(fmaxf(v[4 + i][q], -127.f), 127.f));
        lo |= (unsigned)(a & 255) << (8 * i); hi |= (unsigned)(c & 255) << (8 * i); }
    return (v2u){lo, hi}; }
__device__ __forceinline__ void transpose_item(const float* Wcol, int ldw, int krow0, const float* scale, bf16* WT, int Kdst, int k0dst, int n0, int lane) {
    const int sg = lane & 7, kr = lane >> 3; f32x4 v0[8], v1[8];
    tr_load8(v0, Wcol, ldw, krow0, scale, 1.0f, kr); tr_load8(v1, Wcol, ldw, krow0 + 64, scale, 1.0f, kr);
    GAS bf16* dst = (GAS bf16*)WT + (size_t)(n0 + 4 * sg) * Kdst + k0dst + 8 * kr;
    tr_store_bf16(v0, dst, Kdst); tr_store_bf16(v1, dst + 64, Kdst);
}
__device__ __forceinline__ void transpose_item_q8(const float* Wcol, int ldw, int krow0, const float* scale, unsigned char* WT, int Kdst, int k0dst, int n0, int lane) {
    const int sg = lane & 7, kr = lane >> 3; f32x4 v0[8], v1[8];
    tr_load8(v0, Wcol, ldw, krow0, scale, S_W8, 2 * kr); tr_load8(v1, Wcol, ldw, krow0 + 8, scale, S_W8, 2 * kr);
    GAS unsigned char* dst = (GAS unsigned char*)WT + (size_t)(n0 + 4 * sg) * Kdst + k0dst + 16 * kr;
#pragma unroll
    for (int q = 0; q < 4; ++q) { const v2u a = tr_pack_q8(v0, q), c = tr_pack_q8(v1, q); *(GAS v4u*)(dst + (size_t)q * Kdst) = (v4u){a.x, a.y, c.x, c.y}; }
}
__device__ __forceinline__ v2u tr_pack_f8(const f32x4 (&v)[8], int q) { float t[8];
#pragma unroll
    for (int i = 0; i < 8; ++i) t[i] = fminf(fmaxf(v[i][q] * S_WD8, -448.f), 448.f);
    int lo = __builtin_amdgcn_cvt_pk_fp8_f32(t[0], t[1], 0, false); lo = __builtin_amdgcn_cvt_pk_fp8_f32(t[2], t[3], lo, true);
    int hi = __builtin_amdgcn_cvt_pk_fp8_f32(t[4], t[5], 0, false); hi = __builtin_amdgcn_cvt_pk_fp8_f32(t[6], t[7], hi, true);
    return (v2u){(unsigned)lo, (unsigned)hi}; }
__device__ __forceinline__ void transpose_item_f8(const float* Wcol, int ldw, int krow0, unsigned char* WT, int Kdst, int k0dst, int n0, int lane) {
    const int sg = lane & 7, kr = lane >> 3; f32x4 v0[8], v1[8];
    tr_load8(v0, Wcol, ldw, krow0, nullptr, 1.0f, 2 * kr); tr_load8(v1, Wcol, ldw, krow0 + 8, nullptr, 1.0f, 2 * kr);
    GAS unsigned char* dst = (GAS unsigned char*)WT + (size_t)(n0 + 4 * sg) * Kdst + k0dst + 16 * kr;
#pragma unroll
    for (int q = 0; q < 4; ++q) { const v2u a = tr_pack_f8(v0, q), c = tr_pack_f8(v1, q); *(GAS v4u*)(dst + (size_t)q * Kdst) = (v4u){a.x, a.y, c.x, c.y}; }
}
__device__ __forceinline__ int slot_o8(int t) { return (t & 0x60) | ((t & 0xC) << 1) | ((t & 0x10) >> 2) | (t & 3); }
__device__ __forceinline__ int win_col(int s) {
    const int pn = s >> 8, t = s & 255, bj = t >> 7, t7 = t & 127, wc = (t >> 5) & 3, n = (t >> 4) & 1, fq = (t >> 2) & 3, i = t & 3;
    if (pn < 4) return (pn >> 1) * 512 + (2 * (pn & 1) + bj) * 128 + 16 * wc + 4 * fq + i + 64 * n;
    if (pn < 6) return 1024 + (pn & 1) * 256 + 128 * bj + slot_o8(t7);
    if (pn >= 8) return 1536 + (pn & 1) * 256 + 128 * bj + slot_o8(t7);
    if (pn == 6) return 2048 + 128 * bj + slot_o8(t7);
    if (bj == 0) return 2304 + slot_o8(t7);
    if (wc < 2) return 2432 + 16 * wc + 4 * fq + i + 32 * n;
    return -1;
}
__device__ __forceinline__ int wup_col(int s, bool& is_kv) {
    const int pn = s >> 8, t = s & 255, bj = t >> 7, t7 = t & 127, wc = (t >> 5) & 3, n = (t >> 4) & 1, fq = (t >> 2) & 3, i = t & 3;
    if (pn < 2) { is_kv = false; const int o = 256 * pn + 128 * bj + slot_o8(t7); return (o >> 7) * 192 + (o & 127); }
    if (pn == 2) { is_kv = false; const int hq = 2 * bj + (wc >> 1); return hq * 192 + 128 + 16 * (wc & 1) + 4 * fq + i + 32 * n; }
    is_kv = true;
    if (pn < 5) { const int o = 256 * (pn - 3) + 128 * bj + slot_o8(t7); return (o >> 7) * 256 + (o & 127); }
    { const int o = 256 * (pn - 5) + 128 * bj + slot_o8(t7); return (o >> 7) * 256 + 128 + (o & 127); }
}
__device__ __forceinline__ void sincos_d(double x, float& s, float& c) {
    const double k = __builtin_rint(x * 0.63661977236758134308);
    const double y = (x - k * 1.5707963267948966) - k * 6.123233995736766e-17;
    const double y2 = y * y;
    const double sn = y * (1.0 + y2 * (-1.0 / 6 + y2 * (1.0 / 120 + y2 * (-1.0 / 5040 + y2 * (1.0 / 362880 + y2 * (-1.0 / 39916800 + y2 * (1.0 / 6227020800.0)))))));
    const double cs = 1.0 + y2 * (-0.5 + y2 * (1.0 / 24 + y2 * (-1.0 / 720 + y2 * (1.0 / 40320 + y2 * (-1.0 / 3628800 + y2 * (1.0 / 479001600.0 + y2 * (-1.0 / 87178291200.0)))))));
    const int q = (int)((long long)k & 3);
    const double ss = (q & 1) ? cs : sn, cc = (q & 1) ? sn : cs;
    s = (float)((q & 2) ? -ss : ss); c = (float)(((q + 1) & 2) ? -cc : cc);
}
__device__ __forceinline__ float row_rstd(const f32x4 (&v)[4]);
__device__ __forceinline__ void store_xq(Frame& F, int r, const f32x4 (&v)[4], float rstd);
__device__ __forceinline__ void p0_prologue(Frame& F) {
    const int gw = F.vcu * NWAVES + F.wave, NGW = F.G * NWAVES, lane = F.lane;
    float* hres = (float*)(F.ws + WS_HRES);
    for (int r = gw; r < MP; r += NGW) {
        GAS f32x4* o = (GAS f32x4*)(hres + (size_t)r * DM) + lane;
        if (r < MTOK) {
            const GAS f32x4* src = (const GAS f32x4*)(r < NMAIN ? ldin(I_X) + (size_t)r * DM : ldin(I_META) + (size_t)(r - NMAIN) * DM) + lane;
            f32x4 v[4];
#pragma unroll
            for (int j = 0; j < 4; ++j) v[j] = src[64 * j];
#pragma unroll
            for (int j = 0; j < 4; ++j) o[64 * j] = v[j];
            store_xq(F, r, v, row_rstd(v)); }
        else {
#pragma unroll
            for (int j = 0; j < 4; ++j) o[64 * j] = (f32x4){0.f, 0.f, 0.f, 0.f}; }
    }
    { float* tab = (float*)(F.ws + WS_TAB);
      const int gt = gw * 64 + lane, NT = NGW * 64;
      for (int t = gt; t < LSEQ * 64; t += NT) { const int p = t >> 6, i = t & 63; const float inv = exp2f(-(float)(2 * i) * (13.287712379549449f / 128.0f)); const float ang = (float)p * inv;
          float s, c; sincos_d((double)ang, s, c); tab[TAB_RC / 4 + t] = c; tab[TAB_RS / 4 + t] = s; }
      for (int t = gt; t < LSEQ * 32; t += NT) { const int p = t >> 5, i = t & 31; const float inv = exp2f(-(float)(2 * i) * (13.287712379549449f / 64.0f)); const float ang = (float)p * inv;
          float s, c; sincos_d((double)ang, s, c); tab[TAB_MC / 4 + t] = c; tab[TAB_MS / 4 + t] = s; }
    }
    constexpr int I_IN = DEPTH * 8 * 80, I_UP = DEPTH * 3 * 56, I_OUT = DEPTH * 8 * 32, I_DGU = 2 * 8 * 224, I_DD = 2 * 28 * 32, I_MGU = 16 * 8 * 224, I_MD = 16 * 28 * 32;
    constexpr int NITEMS = I_IN + I_UP + I_OUT + I_DGU + I_DD + I_MGU + I_MD;
    for (int it = gw; it < NITEMS; it += NGW) {
        int r = it;
        if (r < I_IN) { const int l = r / 640, q = r % 640, kb = q / 80, nb = q % 80; const int col = win_col(nb * 32 + 4 * (lane & 7));
            const float* W = ldin(I_WIN) + (size_t)l * DM * 2496;
            transpose_item_q8(col >= 0 ? W + col : nullptr, 2496, kb * 128, ldin(I_ATTN_NORM) + l * DM, F.ws + WS_WIN + (size_t)l * DINP * DM, DM, kb * 128, nb * 32, lane); continue; }
        r -= I_IN;
        if (r < I_UP) { const int l = r / 168, q = r % 168, kb = q / 56, nb = q % 56; bool is_kv; const int col = wup_col(nb * 32 + 4 * (lane & 7), is_kv);
            const float* Wc = nullptr; const float* sc = nullptr; int ldw = 0, k0 = 0;
            if (!is_kv && kb < 2) { Wc = ldin(I_WUQ) + (size_t)l * 256 * 768 + col; sc = ldin(I_QNORM) + l * 256; ldw = 768; k0 = kb * 128; }
            if (is_kv && kb >= 2) { Wc = ldin(I_WUKV) + (size_t)l * 128 * 1024 + col; sc = ldin(I_KVNORM) + l * 128; ldw = 1024; k0 = (kb - 2) * 128; }
            transpose_item(Wc, ldw, k0, sc, (bf16*)(F.ws + WS_WUP) + (size_t)l * UPN * UPK, UPK, kb * 128, nb * 32, lane); continue; }
        r -= I_UP;
        if (r < I_OUT) { const int l = r / 256, q = r % 256, kb = q / 32, nb = q % 32;
            transpose_item(ldin(I_WOUT) + (size_t)l * DM * DM + nb * 32 + 4 * (lane & 7), DM, kb * 128, nullptr, (bf16*)(F.ws + WS_WOUT) + (size_t)l * DM * DM, DM, kb * 128, nb * 32, lane); continue; }
        r -= I_OUT;
        if (r < I_DGU + 0) { const int l = r / 1792, q = r % 1792, kb = q / 224, nb = q % 224; const int s = nb * 32 + 4 * (lane & 7), pn = s >> 8, t = s & 255;
            const float* W = ((t >> 7) ? ldin(I_DWU) : ldin(I_DWG)) + (size_t)l * DM * FF + 128 * pn + slot_o8(t & 127);
            transpose_item_q8(W, FF, kb * 128, ldin(I_FFNNORM) + (2 * l) * DM, F.ws + WS_WDGU + (size_t)l * 2 * FF * DM, DM, kb * 128, nb * 32, lane); continue; }
        r -= I_DGU;
        if (r < I_DD) { const int l = r / 896, q = r % 896, kb = q / 32, nb = q % 32;
            transpose_item_f8(ldin(I_DWD) + (size_t)l * FF * DM + nb * 32 + 4 * (lane & 7), DM, kb * 128, F.ws + WS_WDD + (size_t)l * DM * FF, FF, kb * 128, nb * 32, lane); continue; }
        r -= I_DD;
        if (r < I_MGU) { const int le = r / 1792, q = r % 1792, kb = q / 224, nb = q % 224; const int s = nb * 32 + 4 * (lane & 7), pn = s >> 8, t = s & 255;
            const float* W = ((t >> 7) ? ldin(I_MWU) : ldin(I_MWG)) + (size_t)le * DM * FF + 128 * pn + slot_o8(t & 127);
            transpose_item_q8(W, FF, kb * 128, ldin(I_FFNNORM) + (2 * (le >> 3) + 1) * DM, F.ws + WS_WMGU + (size_t)le * 2 * FF * DM, DM, kb * 128, nb * 32, lane); continue; }
        r -= I_MGU;
        { const int le = r / 896, q = r % 896, kb = q / 32, nb = q % 32;
            transpose_item_f8(ldin(I_MWD) + (size_t)le * FF * DM + nb * 32 + 4 * (lane & 7), DM, kb * 128, F.ws + WS_WMD + (size_t)le * DM * FF, FF, kb * 128, nb * 32, lane); }
    }
}

typedef pg8::f32x4 af4;
__device__ __forceinline__ v4u pack8(af4 a, af4 b) { v4u w; w.x = pk2(a[0], a[1]); w.y = pk2(a[2], a[3]); w.z = pk2(b[0], b[1]); w.w = pk2(b[2], b[3]); return w; }
__device__ __forceinline__ float silu_f(float x) { return x * __builtin_amdgcn_rcpf(1.0f + __builtin_amdgcn_exp2f(-1.4426950408889634f * x)); }
__device__ __forceinline__ float sumsq8(af4 a, af4 c) { return (a[0] * a[0] + a[1] * a[1]) + (a[2] * a[2] + a[3] * a[3]) + (c[0] * c[0] + c[1] * c[1]) + (c[2] * c[2] + c[3] * c[3]); }
__device__ __forceinline__ int row_pos(int row) { return row < NMAIN ? NMETA + (row & (SEQ - 1)) : ((row - NMAIN) & (NMETA - 1)); }
__device__ __forceinline__ af4 cvt_i8acc(af4 a, float sc) { return __builtin_convertvector(__builtin_bit_cast(pg8::i32x4, a), af4) * sc; }
#define EPI_MAIN_LOOP()                                                                                                                               \
    const float* rs = nullptr;                                                                 \
    __device__ __forceinline__ void operator()(const af4 (&acc)[2][2][4][2], const pg8::Unit& u, int wr, int wc, int fr, int fq) const {             \
        float rsl[8];                                                 \
        if (rs) { _Pragma("unroll") for (int ai = 0; ai < 2; ++ai) _Pragma("unroll") for (int m = 0; m < 4; ++m) rsl[ai * 4 + m] = rs[u.pm * 256 + ai * 128 + wr * 64 + m * 16 + fr]; } \
        _Pragma("unroll") for (int ai = 0; ai < 2; ++ai) _Pragma("unroll") for (int m = 0; m < 4; ++m) {                                             \
            const int r_ = u.pm * 256 + ai * 128 + wr * 64 + m * 16 + fr;                                                                            \
            af4 a00 = acc[ai][0][m][0], a01 = acc[ai][0][m][1], a10 = acc[ai][1][m][0], a11 = acc[ai][1][m][1];                                      \
            if (rs) { const float sc = rsl[ai * 4 + m]; a00 = cvt_i8acc(a00, sc); a01 = cvt_i8acc(a01, sc); a10 = cvt_i8acc(a10, sc); a11 = cvt_i8acc(a11, sc); } \
            row(r_, u.pn, wc, fq, a00, a01, a10, a11);                                                                                               \
            if (m == 3) asm volatile("" ::: "memory"); } }

struct EpiInProj {
    static constexpr bool PERM = false, AFTER_DRAIN = false, PRE_RS = false;
    unsigned char* R; float* ssq; float* sskv; const float* tab; float lg0, lg1, lg2, lg3; int pn0;
    __device__ __forceinline__ void row(int row, int pn, int wc, int fq, af4 a00, af4 a01, af4 a10, af4 a11) const {
        pn += pn0; const int pp = row_pos(row);
        if (pn < 4) {
            const af4 cs = *(const af4*)(tab + TAB_RC / 4 + pp * 64 + 16 * wc + 4 * fq), sn = *(const af4*)(tab + TAB_RS / 4 + pp * 64 + 16 * wc + 4 * fq);
            const size_t off = ((size_t)row * 512 + (2 * (pn & 1)) * 128 + 32 * wc + 8 * fq) * 2;
            af4 o1 = a00 * cs - a01 * sn, o2 = a00 * sn + a01 * cs, o3 = a10 * cs - a11 * sn, o4 = a10 * sn + a11 * cs;
            if (pn < 2) { o1 *= 0.08838834764831845f; o2 *= 0.08838834764831845f; o3 *= 0.08838834764831845f; o4 *= 0.08838834764831845f;
                *(v4u*)(R + R_RQ + off) = pack8(o1, o2); *(v4u*)(R + R_RQ + off + 256) = pack8(o3, o4); }
            else { *(v4u*)(R + R_RK + off) = pack8(o1, o2); *(v4u*)(R + R_RK + off + 256) = pack8(o3, o4);
                const float e = (float)(63 - chunk_idx(pp)); const float z0 = __builtin_amdgcn_exp2f(((pn & 1) ? lg2 : lg0) * e), z1 = __builtin_amdgcn_exp2f(((pn & 1) ? lg3 : lg1) * e);
                *(v4u*)(R + R_RKZ + off) = pack8(o1 * z0, o2 * z0); *(v4u*)(R + R_RKZ + off + 256) = pack8(o3 * z1, o4 * z1); }
        } else if (pn < 6) {
            const size_t off = ((size_t)row * 512 + (pn & 1) * 256 + 32 * wc + 8 * fq) * 2;
            *(v4u*)(R + R_RV + off) = pack8(a00, a01); *(v4u*)(R + R_RV + off + 256) = pack8(a10, a11);
        } else if (pn >= 8) {
            const size_t off = ((size_t)row * 512 + (pn & 1) * 256 + 32 * wc + 8 * fq) * 2;
#pragma unroll
            for (int j = 0; j < 4; ++j) { a00[j] = silu_f(a00[j]); a01[j] = silu_f(a01[j]); a10[j] = silu_f(a10[j]); a11[j] = silu_f(a11[j]); }
            *(v4u*)(R + R_SG + off) = pack8(a00, a01); *(v4u*)(R + R_SG + off + 256) = pack8(a10, a11);
        } else if (pn == 6) {
            const size_t off = ((size_t)row * 384 + 32 * wc + 8 * fq) * 2;
            *(v4u*)(R + R_LAT + off) = pack8(a00, a01); *(v4u*)(R + R_LAT + off + 256) = pack8(a10, a11);
            float s = sumsq8(a00, a01) + sumsq8(a10, a11); s = xadd<16>(s); s = xadd<32>(s);
            if (fq == 0) ssq[row * 4 + wc] = s;
        } else {
            *(v4u*)(R + R_LAT + ((size_t)row * 384 + 256 + 32 * wc + 8 * fq) * 2) = pack8(a00, a01);
            float s = sumsq8(a00, a01); s = xadd<16>(s); s = xadd<32>(s);
            if (fq == 0) sskv[row * 4 + wc] = s;
            if (wc < 2) { const af4 cs = *(const af4*)(tab + TAB_MC / 4 + pp * 32 + 16 * wc + 4 * fq), sn = *(const af4*)(tab + TAB_MS / 4 + pp * 32 + 16 * wc + 4 * fq);
                *(v4u*)(R + R_KPE + ((size_t)row * 64 + 32 * wc + 8 * fq) * 2) = pack8(a10 * cs - a11 * sn, a10 * sn + a11 * cs); }
        }
    }
    EPI_MAIN_LOOP()
};
struct EpiGate {
    static constexpr bool PERM = false, AFTER_DRAIN = false, PRE_RS = false;
    unsigned char* SG;
    __device__ __forceinline__ void row(int row, int pn, int wc, int fq, af4 a00, af4 a01, af4 a10, af4 a11) const {
        const size_t off = ((size_t)row * 512 + pn * 256 + 32 * wc + 8 * fq) * 2;
#pragma unroll
        for (int j = 0; j < 4; ++j) { a00[j] = silu_f(a00[j]); a01[j] = silu_f(a01[j]); a10[j] = silu_f(a10[j]); a11[j] = silu_f(a11[j]); }
        *(v4u*)(SG + off) = pack8(a00, a01); *(v4u*)(SG + off + 256) = pack8(a10, a11);
    }
    EPI_MAIN_LOOP()
};
constexpr float QSCALE = 0.07216878364870323f * 1.4426950408889634f;
struct EpiUp {
    static constexpr bool PERM = false, AFTER_DRAIN = false, PRE_RS = false;
    unsigned char* R; const float* ssq; const float* sskv; const float* tab;
    __device__ __forceinline__ void row(int row, int pn, int wc, int fq, af4 a00, af4 a01, af4 a10, af4 a11) const {
        if (pn < 3) { const af4 q4 = *(const af4*)(ssq + row * 4); const float sc = QSCALE * __builtin_amdgcn_rsqf(((q4[0] + q4[1]) + (q4[2] + q4[3])) * (1.0f / 256.0f) + EPS);
            a00 *= sc; a01 *= sc; a10 *= sc; a11 *= sc;
            if (pn < 2) { const size_t off = ((size_t)row * 512 + 256 * pn + 32 * wc + 8 * fq) * 2;
                *(v4u*)(R + R_QN + off) = pack8(a00, a01); *(v4u*)(R + R_QN + off + 256) = pack8(a10, a11);
            } else { const int pp = row_pos(row);
                const af4 cs = *(const af4*)(tab + TAB_MC / 4 + pp * 32 + 16 * (wc & 1) + 4 * fq), sn = *(const af4*)(tab + TAB_MS / 4 + pp * 32 + 16 * (wc & 1) + 4 * fq);
                const size_t off = ((size_t)row * 256 + (wc >> 1) * 64 + 32 * (wc & 1) + 8 * fq) * 2;
                *(v4u*)(R + R_QPE + off) = pack8(a00 * cs - a01 * sn, a00 * sn + a01 * cs); *(v4u*)(R + R_QPE + off + 256) = pack8(a10 * cs - a11 * sn, a10 * sn + a11 * cs); }
        } else { const af4 q4 = *(const af4*)(sskv + row * 4); const float sc = __builtin_amdgcn_rsqf(((q4[0] + q4[1]) + (q4[2] + q4[3])) * (1.0f / 128.0f) + EPS);
            const size_t off = (pn < 5 ? R_KN : R_V) + ((size_t)row * 512 + 256 * (pn < 5 ? pn - 3 : pn - 5) + 32 * wc + 8 * fq) * 2;
            *(v4u*)(R + off) = pack8(a00 * sc, a01 * sc); *(v4u*)(R + off + 256) = pack8(a10 * sc, a11 * sc);
        }
    }
    EPI_MAIN_LOOP()
};
struct EpiResid {
    static constexpr bool PERM = false, AFTER_DRAIN = false, PRE_RS = false;
    float* H; float sc;
    __device__ __forceinline__ void row(int row, int pn, int wc, int fq, af4 a00, af4 a01, af4 a10, af4 a11) const {
        af4* q = (af4*)(H + (size_t)row * DM + pn * 256 + wc * 32 + 4 * fq);
        q[0] = q[0] + a00 * sc; q[4] = q[4] + a01 * sc; q[32] = q[32] + a10 * sc; q[36] = q[36] + a11 * sc;
    }
    EPI_MAIN_LOOP()
};
struct EpiSwiGLU {
    static constexpr bool PERM = false, AFTER_DRAIN = false, PRE_RS = true;
    bf16* A;
    __device__ __forceinline__ void row(int row, int pn, int wc, int fq, af4 a00, af4 a01, af4 a10, af4 a11) const {
#pragma unroll
        for (int j = 0; j < 4; ++j) { a00[j] = silu_f(a00[j]) * a10[j]; a01[j] = silu_f(a01[j]) * a11[j]; }
        if (f8) { float t[8];
#pragma unroll
            for (int j = 0; j < 4; ++j) { t[j] = fminf(fmaxf(a00[j] * S_A8, -448.f), 448.f); t[4 + j] = fminf(fmaxf(a01[j] * S_A8, -448.f), 448.f); }
            int lo = __builtin_amdgcn_cvt_pk_fp8_f32(t[0], t[1], 0, false); lo = __builtin_amdgcn_cvt_pk_fp8_f32(t[2], t[3], lo, true);
            int hi = __builtin_amdgcn_cvt_pk_fp8_f32(t[4], t[5], 0, false); hi = __builtin_amdgcn_cvt_pk_fp8_f32(t[6], t[7], hi, true);
            *(v2u*)((unsigned char*)A + (size_t)row * FF + pn * 128 + wc * 32 + 8 * fq) = (v2u){(unsigned)lo, (unsigned)hi}; }
        else *(v4u*)(A + (size_t)row * FF + pn * 128 + wc * 32 + 8 * fq) = pack8(a00, a01);
    }
    typedef float f2v __attribute__((ext_vector_type(2)));
    __device__ __forceinline__ af4 swi_i8(af4 gi, af4 ui, float c1, float sc2) const {
        const pg8::i32x4 g4 = __builtin_bit_cast(pg8::i32x4, gi), u4 = __builtin_bit_cast(pg8::i32x4, ui); af4 o;
#pragma unroll
        for (int h = 0; h < 2; ++h) { const f2v g = {(float)g4[2 * h], (float)g4[2 * h + 1]}, u = {(float)u4[2 * h], (float)u4[2 * h + 1]};
            const f2v t = g * c1, p = (g * u) * sc2; f2v d; d.x = __builtin_amdgcn_exp2f(t.x); d.y = __builtin_amdgcn_exp2f(t.y); d = d + 1.0f;
            o[2 * h] = p.x * __builtin_amdgcn_rcpf(d.x); o[2 * h + 1] = p.y * __builtin_amdgcn_rcpf(d.y); }
        return o; }
    const float* rs = nullptr; int f8 = 0;
    __device__ __forceinline__ void pre(const pg8::Unit& u, LAS unsigned char* buf, int wid, int lane) const {
        if (wid < 4) __builtin_amdgcn_global_load_lds((const GAS unsigned*)(rs + u.pm * 256 + wid * 64 + lane), (LAS unsigned*)(buf + wid * 256), 4, 0, 0); }
    __device__ __forceinline__ void operator()(const af4 (&acc)[2][2][4][2], const pg8::Unit& u, int wr, int wc, int fr, int fq, const LAS unsigned char* buf) const {
        float rsl[8];
#pragma unroll
        for (int i = 0; i < 8; ++i) rsl[i] = *(const LAS float*)(buf + ((i >> 2) * 128 + wr * 64 + (i & 3) * 16 + fr) * 4);
#pragma unroll
        for (int ai = 0; ai < 2; ++ai)
#pragma unroll
            for (int m = 0; m < 4; ++m) { const int r_ = u.pm * 256 + ai * 128 + wr * 64 + m * 16 + fr;
                if (rs) { const float sc = rsl[ai * 4 + m], c1 = -1.4426950408889634f * sc, sc2 = sc * sc * (f8 ? S_A8 : 1.0f);
                    const af4 o0 = swi_i8(acc[ai][0][m][0], acc[ai][1][m][0], c1, sc2), o1 = swi_i8(acc[ai][0][m][1], acc[ai][1][m][1], c1, sc2);
                    if (f8) { float t[8];
#pragma unroll
                        for (int j = 0; j < 4; ++j) { t[j] = fminf(fmaxf(o0[j], -448.f), 448.f); t[4 + j] = fminf(fmaxf(o1[j], -448.f), 448.f); }
                        int lo = __builtin_amdgcn_cvt_pk_fp8_f32(t[0], t[1], 0, false); lo = __builtin_amdgcn_cvt_pk_fp8_f32(t[2], t[3], lo, true);
                        int hi = __builtin_amdgcn_cvt_pk_fp8_f32(t[4], t[5], 0, false); hi = __builtin_amdgcn_cvt_pk_fp8_f32(t[6], t[7], hi, true);
                        *(v2u*)((unsigned char*)A + (size_t)r_ * FF + u.pn * 128 + wc * 32 + 8 * fq) = (v2u){(unsigned)lo, (unsigned)hi}; }
                    else *(v4u*)(A + (size_t)r_ * FF + u.pn * 128 + wc * 32 + 8 * fq) = pack8(o0, o1); }
                else row(r_, u.pn, wc, fq, acc[ai][0][m][0], acc[ai][0][m][1], acc[ai][1][m][0], acc[ai][1][m][1]); }
    }
};
struct EpiMoeDown {
    static constexpr bool PERM = false, AFTER_DRAIN = false, PRE_RS = false;
    bf16* Y; float sc;
    __device__ __forceinline__ void row(int row, int pn, int wc, int fq, af4 a00, af4 a01, af4 a10, af4 a11) const {
        a00 *= sc; a01 *= sc; a10 *= sc; a11 *= sc;
        v2u* q = (v2u*)(Y + (size_t)row * DM + pn * 256 + wc * 32 + 4 * fq);
        q[0] = (v2u){pk2(a00[0], a00[1]), pk2(a00[2], a00[3])}; q[4] = (v2u){pk2(a01[0], a01[1]), pk2(a01[2], a01[3])};
        q[32] = (v2u){pk2(a10[0], a10[1]), pk2(a10[2], a10[3])}; q[36] = (v2u){pk2(a11[0], a11[1]), pk2(a11[2], a11[3])};
    }
    EPI_MAIN_LOOP()
};

struct EpiNone {
    static constexpr bool PERM = false, AFTER_DRAIN = false, PRE_RS = false;
    __device__ __forceinline__ void operator()(const af4 (&acc)[2][2][4][2], const pg8::Unit&, int, int, int, int) const {
#pragma unroll
        for (int ai = 0; ai < 2; ++ai)
#pragma unroll
            for (int m = 0; m < 4; ++m) asm volatile("" :: "v"(acc[ai][0][m][0]), "v"(acc[ai][0][m][1]), "v"(acc[ai][1][m][0]), "v"(acc[ai][1][m][1])); }
};
struct EpiPartial {
    static constexpr bool PERM = false, AFTER_DRAIN = false, PRE_RS = false;
    float* P; unsigned kbytes; int ks; float sc;
    __device__ __forceinline__ void operator()(const af4 (&acc)[2][2][4][2], const pg8::Unit& u, int wr, int wc, int fr, int fq) const {
        const int tile = (u.pm - MOE_FULL_TILES) * ks + (int)(u.koff / kbytes);
#pragma unroll
        for (int ai = 0; ai < 2; ++ai)
#pragma unroll
            for (int m = 0; m < 4; ++m) { af4* q = (af4*)(P + ((size_t)tile * 256 + ai * 128 + wr * 64 + m * 16 + fr) * DM + u.pn * 256 + wc * 32 + 4 * fq);
                q[0] = acc[ai][0][m][0] * sc; q[4] = acc[ai][0][m][1] * sc; q[32] = acc[ai][1][m][0] * sc; q[36] = acc[ai][1][m][1] * sc; }
    }
};

template <class Epi, int QM> __device__ __forceinline__ void meta_item(LAS unsigned char* lds, const unsigned char* A16, const unsigned char* Bt, int Kb, int item, const Epi& E) {
    int tid_ = threadIdx.x; asm volatile("" : "+v"(tid_));
    const int lane = tid_ & 63, w = __builtin_amdgcn_readfirstlane(tid_ >> 6), fr = lane & 15, fq = lane >> 4, pn = item >> 2, wc = item & 3;
    const int steps = Kb >> 6, spw = (steps + 7) >> 3, s0 = w * spw, s1 = (s0 + spw) < steps ? (s0 + spw) : steps;
    af4 acc[2][2];
#pragma unroll
    for (int bj = 0; bj < 2; ++bj)
#pragma unroll
        for (int n = 0; n < 2; ++n) acc[bj][n] = (af4){0.f, 0.f, 0.f, 0.f};
    const GAS unsigned char* ap = (const GAS unsigned char*)A16 + (size_t)fr * Kb + 16 * fq;
    const GAS unsigned char* bp = (const GAS unsigned char*)Bt + ((size_t)pn * 256 + 32 * wc + fr) * Kb + 16 * fq;
    for (int s = s0; s < s1; s += 4) {
        bf16x8 a[4], b[4][4];
#pragma unroll
        for (int g = 0; g < 4; ++g) if (s + g < s1) { a[g] = *(const GAS bf16x8*)(ap + 64 * (s + g));
#pragma unroll
            for (int f = 0; f < 4; ++f) b[g][f] = *(const GAS bf16x8*)(bp + (size_t)(128 * (f >> 1) + 16 * (f & 1)) * Kb + 64 * (s + g)); }
#pragma unroll
        for (int g = 0; g < 4; ++g) if (s + g < s1) {
#pragma unroll
            for (int f = 0; f < 4; ++f) {
                if constexpr (QM == 2) { typedef long l2v __attribute__((ext_vector_type(2))); const l2v bb = __builtin_bit_cast(l2v, b[g][f]), aa = __builtin_bit_cast(l2v, a[g]);
                    acc[f >> 1][f & 1] = __builtin_amdgcn_mfma_f32_16x16x32_fp8_fp8(bb[0], aa[0], acc[f >> 1][f & 1], 0, 0, 0); acc[f >> 1][f & 1] = __builtin_amdgcn_mfma_f32_16x16x32_fp8_fp8(bb[1], aa[1], acc[f >> 1][f & 1], 0, 0, 0); }
                else acc[f >> 1][f & 1] = pg8::mma16<QM == 1>(b[g][f], a[g], acc[f >> 1][f & 1]); } }
    }
    if (QM == 1) {
#pragma unroll
        for (int f = 0; f < 4; ++f) acc[f >> 1][f & 1] = __builtin_convertvector(__builtin_bit_cast(pg8::i32x4, acc[f >> 1][f & 1]), af4); }
    LAS af4* red = (LAS af4*)lds + (w * 64 + lane) * 4;
    red[0] = acc[0][0]; red[1] = acc[0][1]; red[2] = acc[1][0]; red[3] = acc[1][1];
    __syncthreads();
    if (w == 0) {
#pragma unroll
        for (int ww = 1; ww < 8; ++ww) { const LAS af4* r = (const LAS af4*)lds + (ww * 64 + lane) * 4; acc[0][0] += r[0]; acc[0][1] += r[1]; acc[1][0] += r[2]; acc[1][1] += r[3]; }
        if (QM == 1) { const float sc = E.rs[NMAIN + fr]; acc[0][0] *= sc; acc[0][1] *= sc; acc[1][0] *= sc; acc[1][1] *= sc; }
        E.row(NMAIN + fr, pn, wc, fq, acc[0][0], acc[0][1], acc[1][0], acc[1][1]);
    }
    __syncthreads();
}
template <class Epi, int QM = 0> __device__ __forceinline__ void meta_gemm(Frame& F, const void* A16, const void* Bt, int N, int Kb, const Epi& E) {
    const int nit = (N >> 8) * 4;
    for (int it = F.G - 1 - (int)blockIdx.x; it < nit; it += F.G) meta_item<Epi, QM>(F.lds, (const unsigned char*)A16, (const unsigned char*)Bt, Kb, it, E);
}

__device__ __forceinline__ int expert_base(const unsigned* cnt, int e) { int acc = 0;
#pragma unroll
    for (int k = 0; k < 7; ++k) acc += (k < e) ? (int)((cnt[k] + 255u) & ~255u) : 0;
    return acc; }
template <int KS = MOE_KSPLIT8> __device__ __forceinline__ void load_row(Frame& F, float* hres, int r, bool moe_prev, const unsigned* cnt, f32x4 (&v)[4]) {
    GAS f32x4* xr = (GAS f32x4*)(hres + (size_t)r * DM) + F.lane;
#pragma unroll
    for (int j = 0; j < 4; ++j) v[j] = xr[64 * j];
    if (moe_prev) {
        const int* ti = (const int*)(F.ws + WS_TOK) + (size_t)r * 8; const int e1 = ti[0], e2 = ti[1], s1 = ti[2], s2 = ti[3]; const float w1 = __builtin_bit_cast(float, ti[4]), w2 = __builtin_bit_cast(float, ti[5]);
        const int r1 = s1, r2 = s2;
#pragma unroll
        for (int k = 0; k < 2; ++k) { const int rr = k ? r2 : r1; const float ww = k ? w2 : w1;
            if (rr < MOE_FULL_TILES * 256) { const GAS v2u* y = (const GAS v2u*)((const bf16*)(F.ws + WS_YS) + (size_t)rr * DM) + F.lane;
#pragma unroll
                for (int j = 0; j < 4; ++j) { const v2u a = y[64 * j];
                    v[j].x += ww * __builtin_bit_cast(float, a.x << 16); v[j].y += ww * __builtin_bit_cast(float, a.x & 0xffff0000u); v[j].z += ww * __builtin_bit_cast(float, a.y << 16); v[j].w += ww * __builtin_bit_cast(float, a.y & 0xffff0000u); }
            } else {
                const GAS f32x4* p = (const GAS f32x4*)((const float*)(F.ws + WS_PART) + ((size_t)((rr >> 8) - MOE_FULL_TILES) * KS * 256 + (rr & 255)) * DM) + F.lane;
#pragma unroll
                for (int j = 0; j < 4; ++j) { f32x4 s = p[64 * j];
#pragma unroll
                    for (int kc = 1; kc < KS; ++kc) s += p[(size_t)kc * 256 * (DM / 4) + 64 * j];
                    v[j] += s * ww; } } }
#pragma unroll
        for (int j = 0; j < 4; ++j) {
            xr[64 * j] = v[j]; }
    }
}
__device__ __forceinline__ float row_rstd(const f32x4 (&v)[4]) { float s = 0.f;
#pragma unroll
    for (int j = 0; j < 4; ++j) s += (v[j].x * v[j].x + v[j].y * v[j].y) + (v[j].z * v[j].z + v[j].w * v[j].w);
    return __builtin_amdgcn_rsqf(wave_sum(s) * (1.0f / DM) + EPS); }
__device__ __forceinline__ void store_xn(Frame& F, int r, const f32x4 (&v)[4], float rstd) {
    GAS v2u* o = (GAS v2u*)((bf16*)(F.ws + WS_XN) + (size_t)r * DM) + F.lane;
#pragma unroll
    for (int j = 0; j < 4; ++j) { v2u w; w.x = pk2(v[j].x * rstd, v[j].y * rstd); w.y = pk2(v[j].z * rstd, v[j].w * rstd); o[64 * j] = w; }
}
__device__ __forceinline__ void store_xq(Frame& F, int r, const f32x4 (&v)[4], float rstd) {
    float amax = 0.f;
#pragma unroll
    for (int j = 0; j < 4; ++j) amax = fmaxf(fmaxf(amax, fmaxf(fabsf(v[j].x), fabsf(v[j].y))), fmaxf(fabsf(v[j].z), fabsf(v[j].w)));
    amax = fmaxf(wave_max(amax) * rstd, 1e-20f);
    const float s = rstd * (127.0f / amax);
    GAS unsigned* o = (GAS unsigned*)(F.ws + WS_XN + (size_t)r * DM) + F.lane;
#pragma unroll
    for (int j = 0; j < 4; ++j) { const int q0 = (int)__builtin_rintf(v[j].x * s), q1 = (int)__builtin_rintf(v[j].y * s), q2 = (int)__builtin_rintf(v[j].z * s), q3 = (int)__builtin_rintf(v[j].w * s);
        o[64 * j] = (unsigned)(q0 & 255) | ((unsigned)(q1 & 255) << 8) | ((unsigned)(q2 & 255) << 16) | ((unsigned)q3 << 24); }
    if (F.lane == 0) ((float*)(F.ws + WS_RS))[r] = amax * (1.0f / (127.0f * S_W8));
}
__device__ __forceinline__ void norm_phase(Frame& F, bool moe_prev, const unsigned* cnt_prev, bool q8) {
    const int gw = F.vcu * NWAVES + F.wave, NGW = F.G * NWAVES; float* hres = (float*)(F.ws + WS_HRES);
    for (int r = gw; r < MTOK; r += NGW) { f32x4 v[4]; load_row(F, hres, r, moe_prev, cnt_prev, v); const float rstd = row_rstd(v); if (q8) store_xq(F, r, v, rstd); else store_xn(F, r, v, rstd); }
}
__device__ __forceinline__ void route_phase(Frame& F, const float* gain, const float* router_w, unsigned* cnt) {
    const int gw = F.vcu * NWAVES + F.wave, NGW = F.G * NWAVES; float* hres = (float*)(F.ws + WS_HRES);
    LAS float* rw = (LAS float*)F.lds;
    LAS unsigned* lcnt = (LAS unsigned*)(F.lds + 32768);
    for (int i = F.tid; i < DM * NEXP / 4; i += NWAVES * 64) { const f32x4 w4 = ((const f32x4*)router_w)[i]; const int k = i >> 1, e0 = (i & 1) * 4;
        rw[(e0 + 0) * DM + k] = w4.x; rw[(e0 + 1) * DM + k] = w4.y; rw[(e0 + 2) * DM + k] = w4.z; rw[(e0 + 3) * DM + k] = w4.w; }
    if (F.tid < 8) lcnt[F.tid] = 0u;
    __syncthreads();
    for (int r = gw; r < MTOK; r += NGW) {
        f32x4 v[4]; load_row(F, hres, r, false, cnt, v); const float rstd = row_rstd(v); store_xq(F, r, v, rstd);
        float lg[8];
#pragma unroll
        for (int e = 0; e < 8; ++e) lg[e] = 0.f;
#pragma unroll
        for (int j = 0; j < 4; ++j) { const int k0 = 4 * F.lane + 256 * j; const f32x4 g = *(const f32x4*)(gain + k0);
            const float hv[4] = {v[j].x * rstd * g.x, v[j].y * rstd * g.y, v[j].z * rstd * g.z, v[j].w * rstd * g.w};
#pragma unroll
            for (int e = 0; e < 8; ++e) { const f32x4 w4 = *(const LAS f32x4*)(rw + e * DM + k0);
                lg[e] += hv[0] * w4.x; lg[e] += hv[1] * w4.y; lg[e] += hv[2] * w4.z; lg[e] += hv[3] * w4.w; } }
        { float a4[4];
#pragma unroll
          for (int e = 0; e < 4; ++e) { auto rr = __builtin_amdgcn_permlane32_swap(__builtin_bit_cast(unsigned, lg[e]), __builtin_bit_cast(unsigned, lg[e + 4]), false, false); a4[e] = __builtin_bit_cast(float, (unsigned)rr[0]) + __builtin_bit_cast(float, (unsigned)rr[1]); }
          const bool b4 = (F.lane & 16) != 0, b3 = (F.lane & 8) != 0; float b2[2];
#pragma unroll
          for (int k = 0; k < 2; ++k) { const float keep = b4 ? a4[k + 2] : a4[k], send = b4 ? a4[k] : a4[k + 2]; b2[k] = keep + xshfl<16>(send); }
          float cc = (b3 ? b2[1] : b2[0]) + xshfl<8>(b3 ? b2[0] : b2[1]);
          cc = xadd<4>(cc); cc = xadd<2>(cc); cc = xadd<1>(cc);
#pragma unroll
          for (int e = 0; e < 8; ++e) lg[e] = __builtin_bit_cast(float, __builtin_amdgcn_readlane(__builtin_bit_cast(int, cc), 32 * (e >> 2) + 16 * ((e >> 1) & 1) + 8 * (e & 1))); }
        int e1 = 0; float v1 = lg[0];
#pragma unroll
        for (int e = 1; e < 8; ++e) if (lg[e] > v1) { v1 = lg[e]; e1 = e; }
        int e2 = -1; float v2 = -3.0e38f;
#pragma unroll
        for (int e = 0; e < 8; ++e) if (e != e1 && (e2 < 0 || lg[e] > v2)) { v2 = lg[e]; e2 = e; }
        const float w2 = 1.0f / (1.0f + __expf(v1 - v2)), w1 = 1.0f - w2;
        if (F.lane == 0) { __hip_atomic_fetch_add(lcnt + e1, 1u, __ATOMIC_RELAXED, __HIP_MEMORY_SCOPE_WORKGROUP); __hip_atomic_fetch_add(lcnt + e2, 1u, __ATOMIC_RELAXED, __HIP_MEMORY_SCOPE_WORKGROUP);
            int* ti = (int*)(F.ws + WS_TOK) + (size_t)r * 8; ti[0] = e1; ti[1] = e2; ti[4] = __builtin_bit_cast(int, w1); ti[5] = __builtin_bit_cast(int, w2); }
    }
    __syncthreads();
    if (F.tid < 8) { __hip_atomic_fetch_add(cnt + F.tid, lcnt[F.tid], RLX_AGENT); ((unsigned*)(F.ws + WS_WGCNT))[F.vcu * 8 + F.tid] = lcnt[F.tid]; }
    __syncthreads();
}
__device__ __forceinline__ void gather_phase(Frame& F, const unsigned* cnt) {
    const int gw = F.vcu * NWAVES + F.wave, NGW = F.G * NWAVES;
    LAS float* tb = (LAS float*)F.lds;
    LAS int* wgbase = (LAS int*)(F.lds + 8192); LAS int* wcnt = wgbase + 8; LAS int* run = wcnt + 64;
    for (int i = F.tid; i < 2048; i += NWAVES * 64) tb[i] = (i >> 3) < F.vcu ? (float)((const unsigned*)(F.ws + WS_WGCNT))[i] : 0.f;
    if (F.tid < 64) { wcnt[F.tid] = 0; }
    __syncthreads();
    { float s = 0.f;
#pragma unroll
      for (int k = 0; k < 4; ++k) s += tb[(F.lane + 64 * k) * 8 + F.wave];
      s = wave_sum(s); if (F.lane == 0) wgbase[F.wave] = expert_base(cnt, F.wave) + (int)s; }
    for (int r = gw; r < MTOK; r += NGW) if (F.lane == 0) { const int* ti = (const int*)(F.ws + WS_TOK) + (size_t)r * 8; wcnt[F.wave * 8 + ti[0]] += 1; wcnt[F.wave * 8 + ti[1]] += 1; }
    __syncthreads();
    if (F.lane < 8) { int a = 0; for (int ww = 0; ww < F.wave; ++ww) a += wcnt[ww * 8 + F.lane]; run[F.wave * 8 + F.lane] = wgbase[F.lane] + a; }
    asm volatile("s_waitcnt lgkmcnt(0)" ::: "memory");
    for (int r0 = gw; r0 < MTOK; r0 += 3 * NGW) {
        int d1[3], d2[3]; v4u a[3]; float sc[3];
#pragma unroll
        for (int k = 0; k < 3; ++k) { const int r = r0 + k * NGW; d1[k] = -1; d2[k] = -1;
            if (r < MTOK) { int* ti = (int*)(F.ws + WS_TOK) + (size_t)r * 8; const int e1 = ti[0], e2 = ti[1];
                a[k] = *((const GAS v4u*)(F.ws + WS_XN + (size_t)r * DM) + F.lane); sc[k] = ((const float*)(F.ws + WS_RS))[r];
                d1[k] = run[F.wave * 8 + e1]; d2[k] = run[F.wave * 8 + e2];
                asm volatile("s_waitcnt lgkmcnt(0)" ::: "memory");
                if (F.lane == 0) { run[F.wave * 8 + e1] = d1[k] + 1; run[F.wave * 8 + e2] = d2[k] + 1; ti[2] = d1[k]; ti[3] = d2[k]; }
                asm volatile("s_waitcnt lgkmcnt(0)" ::: "memory"); } }
#pragma unroll
        for (int k = 0; k < 3; ++k) if (d1[k] >= 0) {
            *((GAS v4u*)(F.ws + WS_XS + (size_t)d1[k] * DM) + F.lane) = a[k]; *((GAS v4u*)(F.ws + WS_XS + (size_t)d2[k] * DM) + F.lane) = a[k];
            if (F.lane == 0) { ((float*)(F.ws + WS_RSS))[d1[k]] = sc[k]; ((float*)(F.ws + WS_RSS))[d2[k]] = sc[k]; } }
    }
    for (int e = 0; e < 8; ++e) { const int c0 = (int)cnt[e], c1 = (c0 + 255) & ~255, b0 = expert_base(cnt, e);
        for (int q = c0 + gw; q < c1; q += NGW) { *((GAS v4u*)(F.ws + WS_XS + (size_t)(b0 + q) * DM) + F.lane) = zero4(); if (F.lane == 0) ((float*)(F.ws + WS_RSS))[b0 + q] = 0.f; } }
}
__device__ __forceinline__ void final_phase(Frame& F, const float* gain, float* out, const unsigned* cnt_prev) {
    const int gw = F.vcu * NWAVES + F.wave, NGW = F.G * NWAVES; float* hres = (float*)(F.ws + WS_HRES);
    for (int q = gw; q < NMAIN; q += NGW) { const int r = q;
        f32x4 v[4]; load_row<MOE_KSPLIT8>(F, hres, r, true, cnt_prev, v); const float rstd = row_rstd(v);
        GAS f32x4* o = (GAS f32x4*)(out + (size_t)q * DM) + F.lane;
#pragma unroll
        for (int j = 0; j < 4; ++j) { const f32x4 g = *(const f32x4*)(gain + 4 * F.lane + 256 * j); o[64 * j] = (f32x4){v[j].x * rstd * g.x, v[j].y * rstd * g.y, v[j].z * rstd * g.z, v[j].w * rstd * g.w}; }
    }
}

typedef short v4i16_t __attribute__((ext_vector_type(4)));
__device__ __forceinline__ s16x4 vtr(const LAS unsigned char* p) { return __builtin_bit_cast(s16x4, __builtin_amdgcn_ds_read_tr16_b64_v4i16((LAS v4i16_t*)p)); }
#define MFMA16(a, b, c) __builtin_amdgcn_mfma_f32_16x16x32_bf16((a), (b), (c), 0, 0, 0)
#define CAT8(L, H) (bf16x8){L[0], L[1], L[2], L[3], H[0], H[1], H[2], H[3]}
__device__ __forceinline__ void ret_state_unit(Frame& F, int unit) {
    const int b = unit >> 5, h = (unit >> 3) & 3, es = unit & 7;
    int tid_ = threadIdx.x; asm volatile("" : "+v"(tid_));
    const int tid = tid_, lane = tid & 63, w = __builtin_amdgcn_readfirstlane(tid >> 6), l15 = lane & 15, kg = lane >> 4, q = l15 >> 2, p_ = l15 & 3;
    const float g64 = exp2f(64.0f * log2_gamma(h));
    const bf16* rkz = (const bf16*)(F.ws + WS_R + R_RKZ) + h * 128;
    const bf16* rv = (const bf16*)(F.ws + WS_R + R_RV) + h * 128 + es * 16;
    bf16* ST = (bf16*)(F.ws + WS_R + R_ST) + (size_t)((b * 4 + h) * NCH) * 16384 + (es * 16 + l15) * 128 + w * 16 + 4 * kg;
    LAS unsigned char* KZ = F.lds; LAS unsigned char* VS = F.lds + 7 * 16384;
    const GAS unsigned char* zsrc = (const GAS unsigned char*)(F.ws + WS_CTL + 512);
#define RS_DMA(c, slot) do { const int cc = (c) < 31 ? (c) : 31; const size_t p0 = cc == 0 ? (size_t)NMAIN : (size_t)b * SEQ + 64 * (cc - 1); \
        _Pragma("unroll") for (int i_ = 0; i_ < 2; ++i_) { const int row = 4 * (2 * w + i_) + (lane >> 4); const GAS unsigned char* src = (const GAS unsigned char*)(rkz + (p0 + row) * 512 + (lane & 15) * 8); \
            if (cc == 0 && row >= NMETA) src = zsrc; __builtin_amdgcn_global_load_lds((const GAS unsigned*)src, (LAS unsigned*)(KZ + (slot) * 16384 + (2 * w + i_) * 1024), 16, 0, 0); } \
        if (w < 2) { const int row = 32 * w + (lane >> 1); const GAS unsigned char* src = (const GAS unsigned char*)(rv + (p0 + row) * 512 + (lane & 1) * 8); \
            if (cc == 0 && row >= NMETA) src = zsrc; __builtin_amdgcn_global_load_lds((const GAS unsigned*)src, (LAS unsigned*)(VS + (slot) * 2048 + w * 1024), 16, 0, 0); } } while (0)
    RS_DMA(0, 0); RS_DMA(1, 1); RS_DMA(2, 2); RS_DMA(3, 3); RS_DMA(4, 4); RS_DMA(5, 5);
    af4 S = {0.f, 0.f, 0.f, 0.f};
    int slot = 0;
#pragma unroll 1
    for (int c = 0; c <= 32; ++c) {
        { v2u o; o.x = pk2(S[0], S[1]); o.y = pk2(S[2], S[3]); *(GAS v2u*)(ST + (size_t)c * 16384) = o; }
        if (c == 32) break;
        if (w < 2) asm volatile("s_waitcnt vmcnt(15)" ::: "memory"); else asm volatile("s_waitcnt vmcnt(10)" ::: "memory");
        asm volatile("" ::: "memory"); __builtin_amdgcn_s_barrier(); asm volatile("" ::: "memory");
        { const int s6 = slot == 0 ? 6 : slot - 1; RS_DMA(c + 6, s6); }
        const int kza = (int)(size_t)(KZ + slot * 16384 + w * 32 + p_ * 8) + (8 * kg + q) * 256, vsa = (int)(size_t)(VS + slot * 2048 + p_ * 8) + (8 * kg + q) * 32;
        s16x4 a0, a1, a2, a3, b0, b1, b2, b3;
        asm volatile("ds_read_b64_tr_b16 %0, %8\n\tds_read_b64_tr_b16 %1, %8 offset:1024\n\tds_read_b64_tr_b16 %2, %8 offset:8192\n\tds_read_b64_tr_b16 %3, %8 offset:9216\n\t"
                     "ds_read_b64_tr_b16 %4, %9\n\tds_read_b64_tr_b16 %5, %9 offset:128\n\tds_read_b64_tr_b16 %6, %9 offset:1024\n\tds_read_b64_tr_b16 %7, %9 offset:1152\n\ts_waitcnt lgkmcnt(0)"
                     : "=&v"(a0), "=&v"(a1), "=&v"(a2), "=&v"(a3), "=&v"(b0), "=&v"(b1), "=&v"(b2), "=&v"(b3) : "v"(kza), "v"(vsa) : "memory");
        S *= g64;
        S = MFMA16(CAT8(a0, a1), CAT8(b0, b1), S); S = MFMA16(CAT8(a2, a3), CAT8(b2, b3), S);
        slot = slot == 6 ? 0 : slot + 1;
    }
    asm volatile("s_waitcnt vmcnt(0)" ::: "memory");
    __syncthreads();
#undef RS_DMA
}
__device__ __forceinline__ void ret_state64_unit(Frame& F, int unit) {
    asm volatile("" : "+s"(unit));
    const int b = unit >> 3, h = (unit >> 1) & 3, es = unit & 1;
    int tid_ = threadIdx.x; asm volatile("" : "+v"(tid_));
    const int tid = tid_, lane = tid & 63, w = __builtin_amdgcn_readfirstlane(tid >> 6), l15 = lane & 15, kg = lane >> 4, q = l15 >> 2, p_ = l15 & 3;
    const float g64 = exp2f(64.0f * log2_gamma(h));
    const bf16* rkz = (const bf16*)(F.ws + WS_R + R_RKZ) + h * 128;
    const bf16* rv = (const bf16*)(F.ws + WS_R + R_RV) + h * 128 + es * 64;
    bf16* ST = (bf16*)(F.ws + WS_R + R_ST) + (size_t)((b * 4 + h) * NCH) * 16384 + (es * 64 + l15) * 128 + w * 16 + 4 * kg;
    LAS unsigned char* KZ = F.lds; LAS unsigned char* VS = F.lds + 5 * 16384;
    const GAS unsigned char* zsrc = (const GAS unsigned char*)(F.ws + WS_CTL + 512);
#define RS_DMA(c, slot) do { const int cc = (c) < 31 ? (c) : 31; const size_t p0 = cc == 0 ? (size_t)NMAIN : (size_t)b * SEQ + 64 * (cc - 1); \
        _Pragma("unroll") for (int i_ = 0; i_ < 2; ++i_) { const int row = 4 * (2 * w + i_) + (lane >> 4); const GAS unsigned char* src = (const GAS unsigned char*)(rkz + (p0 + row) * 512 + (lane & 15) * 8); \
            if (cc == 0 && row >= NMETA) src = zsrc; __builtin_amdgcn_global_load_lds((const GAS unsigned*)src, (LAS unsigned*)(KZ + (slot) * 16384 + (2 * w + i_) * 1024), 16, 0, 0); } \
        { const int row = 8 * w + (lane >> 3); const GAS unsigned char* src = (const GAS unsigned char*)(rv + (p0 + row) * 512 + (lane & 7) * 8); \
            if (cc == 0 && row >= NMETA) src = zsrc; __builtin_amdgcn_global_load_lds((const GAS unsigned*)src, (LAS unsigned*)(VS + (slot) * 8192 + w * 1024), 16, 0, 0); } } while (0)
    RS_DMA(0, 0); RS_DMA(1, 1); RS_DMA(2, 2); RS_DMA(3, 3);
    af4 S[4];
#pragma unroll
    for (int vg = 0; vg < 4; ++vg) S[vg] = (af4){0.f, 0.f, 0.f, 0.f};
    int slot = 0;
#pragma unroll 1
    for (int c = 0; c <= 32; ++c) {
#pragma unroll
        for (int vg = 0; vg < 4; ++vg) { v2u o; o.x = pk2(S[vg][0], S[vg][1]); o.y = pk2(S[vg][2], S[vg][3]); *(GAS v2u*)(ST + (size_t)c * 16384 + vg * 2048) = o; }
        if (c == 32) break;
        asm volatile("s_waitcnt vmcnt(9)" ::: "memory");
        asm volatile("" ::: "memory"); __builtin_amdgcn_s_barrier(); asm volatile("" ::: "memory");
        { const int s4 = slot == 0 ? 4 : slot - 1; RS_DMA(c + 4, s4); }
        const int kza = (int)(size_t)(KZ + slot * 16384 + w * 32 + p_ * 8) + (8 * kg + q) * 256, vsa = (int)(size_t)(VS + slot * 8192 + p_ * 8) + (8 * kg + q) * 128;
        s16x4 a0, a1, a2, a3, bv[4][4];
        asm volatile("ds_read_b64_tr_b16 %0, %20\n\tds_read_b64_tr_b16 %1, %20 offset:1024\n\tds_read_b64_tr_b16 %2, %20 offset:8192\n\tds_read_b64_tr_b16 %3, %20 offset:9216\n\tds_read_b64_tr_b16 %4, %21\n\tds_read_b64_tr_b16 %5, %21 offset:512\n\tds_read_b64_tr_b16 %6, %21 offset:4096\n\tds_read_b64_tr_b16 %7, %21 offset:4608\n\tds_read_b64_tr_b16 %8, %21 offset:32\n\tds_read_b64_tr_b16 %9, %21 offset:544\n\tds_read_b64_tr_b16 %10, %21 offset:4128\n\tds_read_b64_tr_b16 %11, %21 offset:4640\n\tds_read_b64_tr_b16 %12, %21 offset:64\n\tds_read_b64_tr_b16 %13, %21 offset:576\n\tds_read_b64_tr_b16 %14, %21 offset:4160\n\tds_read_b64_tr_b16 %15, %21 offset:4672\n\tds_read_b64_tr_b16 %16, %21 offset:96\n\tds_read_b64_tr_b16 %17, %21 offset:608\n\tds_read_b64_tr_b16 %18, %21 offset:4192\n\tds_read_b64_tr_b16 %19, %21 offset:4704\n\ts_waitcnt lgkmcnt(0)"
                     : "=&v"(a0), "=&v"(a1), "=&v"(a2), "=&v"(a3), "=&v"(bv[0][0]), "=&v"(bv[0][1]), "=&v"(bv[0][2]), "=&v"(bv[0][3]), "=&v"(bv[1][0]), "=&v"(bv[1][1]), "=&v"(bv[1][2]), "=&v"(bv[1][3]), "=&v"(bv[2][0]), "=&v"(bv[2][1]), "=&v"(bv[2][2]), "=&v"(bv[2][3]), "=&v"(bv[3][0]), "=&v"(bv[3][1]), "=&v"(bv[3][2]), "=&v"(bv[3][3]) : "v"(kza), "v"(vsa) : "memory");
#pragma unroll
        for (int vg = 0; vg < 4; ++vg) { S[vg] *= g64;
            S[vg] = MFMA16(CAT8(a0, a1), CAT8(bv[vg][0], bv[vg][1]), S[vg]); S[vg] = MFMA16(CAT8(a2, a3), CAT8(bv[vg][2], bv[vg][3]), S[vg]); }
        slot = slot == 4 ? 0 : slot + 1;
    }
    asm volatile("s_waitcnt vmcnt(0)" ::: "memory");
    __syncthreads();
#undef RS_DMA
}
__device__ __forceinline__ void ret_out_unit(Frame& F, int unit, const float* gain) {
    const int c = unit < NB * 4 * 32 ? 1 + (unit & 31) : 0, b = unit < NB * 4 * 32 ? unit >> 7 : 0, h = unit < NB * 4 * 32 ? (unit >> 5) & 3 : unit - NB * 4 * 32;
    int tid_ = threadIdx.x; asm volatile("" : "+v"(tid_));
    const int tid = tid_, lane = tid & 63, w = __builtin_amdgcn_readfirstlane(tid >> 6), l15 = lane & 15, kg = lane >> 4, q = l15 >> 2, p_ = l15 & 3, it = w & 3, eh = w >> 2;
    const float lg = log2_gamma(h);
    const size_t r0 = c == 0 ? (size_t)NMAIN : (size_t)b * SEQ + 64 * (c - 1);
    const bf16* rq = (const bf16*)(F.ws + WS_R + R_RQ) + r0 * 512 + h * 128;
    const bf16* rk = (const bf16*)(F.ws + WS_R + R_RK) + r0 * 512 + h * 128;
    const bf16* rv = (const bf16*)(F.ws + WS_R + R_RV) + r0 * 512 + h * 128;
    const bf16* sg = (const bf16*)(F.ws + WS_R + R_SG) + r0 * 512 + h * 128;
    const bf16* ST = (const bf16*)(F.ws + WS_R + R_ST) + (size_t)((b * 4 + h) * NCH + c) * 16384;
    bf16* Y = (bf16*)(F.ws + WS_R + R_Y) + r0 * DM + h * 128;
    LAS unsigned char* VL = F.lds; LAS unsigned char* SGL = F.lds + 16384; LAS unsigned char* YL = F.lds + 32768; LAS float* red = (LAS float*)(F.lds + 49152);
    v4u vst[2], gst[2];
#pragma unroll
    for (int i = 0; i < 2; ++i) { const int idx = tid + 512 * i; vst[i] = zero4(); gst[i] = vst[i];
        if (c > 0 || (idx >> 4) < NMETA) { vst[i] = *(const GAS v4u*)(rv + (size_t)(idx >> 4) * 512 + (idx & 15) * 8); gst[i] = *(const GAS v4u*)(sg + (size_t)(idx >> 4) * 512 + (idx & 15) * 8); } }
    float gn[4];
#pragma unroll
    for (int et = 0; et < 4; ++et) gn[et] = gain[h * 128 + 64 * eh + 16 * et + l15];
    bf16x8 qf[4];
#pragma unroll
    for (int ks = 0; ks < 4; ++ks) qf[ks] = *(const GAS bf16x8*)(rq + (size_t)(16 * it + l15) * 512 + 32 * ks + 8 * kg);
    af4 pj[4];
#pragma unroll
    for (int jt = 0; jt < 4; ++jt) { pj[jt] = (af4){0.f, 0.f, 0.f, 0.f};
#pragma unroll
        for (int ks = 0; ks < 4; ++ks) { const bf16x8 kf = *(const GAS bf16x8*)(rk + (size_t)(16 * jt + l15) * 512 + 32 * ks + 8 * kg); pj[jt] = MFMA16(kf, qf[ks], pj[jt]); } }
#pragma unroll
    for (int i = 0; i < 2; ++i) { const int idx = tid + 512 * i; *(LAS v4u*)(VL + (idx >> 4) * 256 + (idx & 15) * 16) = vst[i]; *(LAS v4u*)(SGL + (idx >> 4) * 256 + (idx & 15) * 16) = gst[i]; }
    bf16x8 pa[2];
    { const int il = 16 * it + l15; unsigned pw[4][2];
#pragma unroll
      for (int jt = 0; jt < 4; ++jt) { float v[4];
#pragma unroll
          for (int r = 0; r < 4; ++r) { const int jl = 16 * jt + 4 * kg + r; const int dd = il > jl ? il - jl : jl - il; const float wgt = __builtin_amdgcn_exp2f(lg * (float)dd); v[r] = (c == 0 && jl >= NMETA) ? 0.f : pj[jt][r] * wgt; }
          pw[jt][0] = pk2(v[0], v[1]); pw[jt][1] = pk2(v[2], v[3]); }
      pa[0] = __builtin_bit_cast(bf16x8, (v4u){pw[0][0], pw[0][1], pw[1][0], pw[1][1]}); pa[1] = __builtin_bit_cast(bf16x8, (v4u){pw[2][0], pw[2][1], pw[3][0], pw[3][1]}); }
    af4 acc[4];
#pragma unroll
    for (int et = 0; et < 4; ++et) acc[et] = (af4){0.f, 0.f, 0.f, 0.f};
    if (c > 0) {
#pragma unroll
        for (int et = 0; et < 4; ++et)
#pragma unroll
            for (int ks = 0; ks < 4; ++ks) { const bf16x8 sf = *(const GAS bf16x8*)(ST + (size_t)(64 * eh + 16 * et + l15) * 128 + 32 * ks + 8 * kg); acc[et] = MFMA16(qf[ks], sf, acc[et]); }
        float xi[4];
#pragma unroll
        for (int r = 0; r < 4; ++r) xi[r] = __builtin_amdgcn_exp2f(lg * (float)(16 * it + 4 * kg + r + 1));
#pragma unroll
        for (int et = 0; et < 4; ++et)
#pragma unroll
            for (int r = 0; r < 4; ++r) acc[et][r] *= xi[r];
    }
    __syncthreads();
#pragma unroll
    for (int et = 0; et < 4; ++et)
#pragma unroll
        for (int u = 0; u < 2; ++u) { const LAS unsigned char* vb = VL + (size_t)(32 * u + 4 * kg + q) * 256 + (64 * eh + 16 * et + 4 * p_) * 2;
            const s16x4 b0 = vtr(vb), b1 = vtr(vb + 16 * 256); acc[et] = MFMA16(pa[u], CAT8(b0, b1), acc[et]); }
    float ss[4];
#pragma unroll
    for (int r = 0; r < 4; ++r) { float s = 0.f;
#pragma unroll
        for (int et = 0; et < 4; ++et) s += acc[et][r] * acc[et][r];
        s = xadd<1>(s); s = xadd<2>(s); s = xadd<4>(s); s = xadd<8>(s); ss[r] = s; }
    if (l15 == 0) {
#pragma unroll
        for (int r = 0; r < 4; ++r) red[eh * 64 + 16 * it + 4 * kg + r] = ss[r]; }
    __syncthreads();
#pragma unroll
    for (int r = 0; r < 4; ++r) { const int il = 16 * it + 4 * kg + r; const float rstd = __builtin_amdgcn_rsqf((red[il] + red[64 + il]) * (1.0f / 128.0f) + EPS);
#pragma unroll
        for (int et = 0; et < 4; ++et) { const int e = 64 * eh + 16 * et + l15; const float o = acc[et][r] * rstd * gn[et] * bf2f(*(const LAS bf16*)(SGL + il * 256 + e * 2)); *(LAS bf16*)(YL + il * 256 + e * 2) = (bf16)f2bf(o); } }
    __syncthreads();
#pragma unroll
    for (int i = 0; i < 2; ++i) { const int idx = tid + 512 * i; if (c > 0 || (idx >> 4) < NMETA) *(GAS v4u*)(Y + (size_t)(idx >> 4) * DM + (idx & 15) * 8) = *(const LAS v4u*)(YL + (idx >> 4) * 256 + (idx & 15) * 16); }
    asm volatile("s_waitcnt lgkmcnt(0)" ::: "memory"); __builtin_amdgcn_s_barrier(); asm volatile("" ::: "memory");
}

__device__ __forceinline__ void ret_out4_unit(Frame& F, int unit, const float* gain) {
    const int g = unit & 7, h = (unit >> 3) & 3, b = unit >> 5;
    int tid_ = threadIdx.x; asm volatile("" : "+v"(tid_));
    const int tid = tid_, lane = tid & 63, w = __builtin_amdgcn_readfirstlane(tid >> 6), l15 = lane & 15, kg = lane >> 4, q = l15 >> 2, p_ = l15 & 3, ci = w >> 1, hf = w & 1;
    const float lg = log2_gamma(h);
    const size_t r0 = (size_t)b * SEQ + 256 * g;
    const bf16* rq = (const bf16*)(F.ws + WS_R + R_RQ) + (r0 + 64 * ci) * 512 + h * 128;
    const bf16* rk = (const bf16*)(F.ws + WS_R + R_RK) + (r0 + 64 * ci) * 512 + h * 128;
    const bf16* rv = (const bf16*)(F.ws + WS_R + R_RV) + r0 * 512 + h * 128;
    const bf16* sg = (const bf16*)(F.ws + WS_R + R_SG) + r0 * 512 + h * 128;
    const bf16* ST = (const bf16*)(F.ws + WS_R + R_ST) + (size_t)((b * 4 + h) * NCH + 1 + 4 * g + ci) * 16384;
    bf16* Y = (bf16*)(F.ws + WS_R + R_Y) + r0 * DM + h * 128;
    LAS unsigned char* VL = F.lds; LAS unsigned char* SGL = F.lds + 65536;
#pragma unroll
    for (int i = 0; i < 8; ++i) { const int pc = 8 * w + i; const size_t go = (size_t)(4 * pc + (lane >> 4)) * 512 + (lane & 15) * 8;
        __builtin_amdgcn_global_load_lds((const GAS unsigned*)(rv + go), (LAS unsigned*)(VL + pc * 1024), 16, 0, 0);
        __builtin_amdgcn_global_load_lds((const GAS unsigned*)(sg + go), (LAS unsigned*)(SGL + pc * 1024), 16, 0, 0); }
    float gn[8];
#pragma unroll
    for (int et = 0; et < 8; ++et) gn[et] = gain[h * 128 + 16 * et + l15];
    bf16x8 qf[2][4];
#pragma unroll
    for (int rt = 0; rt < 2; ++rt)
#pragma unroll
        for (int ks = 0; ks < 4; ++ks) qf[rt][ks] = *(const GAS bf16x8*)(rq + (size_t)(16 * (2 * hf + rt) + l15) * 512 + 32 * ks + 8 * kg);
    af4 acc[2][8];
    { bf16x8 sf[8][4];
#pragma unroll
      for (int et = 0; et < 8; ++et)
#pragma unroll
          for (int ks = 0; ks < 4; ++ks) sf[et][ks] = *(const GAS bf16x8*)(ST + (size_t)(16 * et + l15) * 128 + 32 * ks + 8 * kg);
      asm volatile("" ::: "memory");
#pragma unroll
      for (int et = 0; et < 8; ++et) { acc[0][et] = (af4){0.f, 0.f, 0.f, 0.f}; acc[1][et] = acc[0][et];
#pragma unroll
          for (int ks = 0; ks < 4; ++ks) { acc[0][et] = MFMA16(qf[0][ks], sf[et][ks], acc[0][et]); acc[1][et] = MFMA16(qf[1][ks], sf[et][ks], acc[1][et]); } } }
#pragma unroll
    for (int rt = 0; rt < 2; ++rt) { float xi[4];
#pragma unroll
        for (int r = 0; r < 4; ++r) xi[r] = __builtin_amdgcn_exp2f(lg * (float)(16 * (2 * hf + rt) + 4 * kg + r + 1));
#pragma unroll
        for (int et = 0; et < 8; ++et)
#pragma unroll
            for (int r = 0; r < 4; ++r) acc[rt][et][r] *= xi[r]; }
    af4 pj[2][4];
    { bf16x8 kf[4][4];
#pragma unroll
      for (int jt = 0; jt < 4; ++jt)
#pragma unroll
          for (int ks = 0; ks < 4; ++ks) kf[jt][ks] = *(const GAS bf16x8*)(rk + (size_t)(16 * jt + l15) * 512 + 32 * ks + 8 * kg);
      asm volatile("" ::: "memory");
#pragma unroll
      for (int jt = 0; jt < 4; ++jt) { pj[0][jt] = (af4){0.f, 0.f, 0.f, 0.f}; pj[1][jt] = pj[0][jt];
#pragma unroll
          for (int ks = 0; ks < 4; ++ks) { pj[0][jt] = MFMA16(kf[jt][ks], qf[0][ks], pj[0][jt]); pj[1][jt] = MFMA16(kf[jt][ks], qf[1][ks], pj[1][jt]); } } }
    bf16x8 pa[2][2];
#pragma unroll
    for (int rt = 0; rt < 2; ++rt) { const int il = 16 * (2 * hf + rt) + l15; unsigned pw[4][2];
#pragma unroll
        for (int jt = 0; jt < 4; ++jt) { float v[4];
#pragma unroll
            for (int r = 0; r < 4; ++r) { const int jl = 16 * jt + 4 * kg + r; const int dd = il > jl ? il - jl : jl - il; v[r] = pj[rt][jt][r] * __builtin_amdgcn_exp2f(lg * (float)dd); }
            pw[jt][0] = pk2(v[0], v[1]); pw[jt][1] = pk2(v[2], v[3]); }
        pa[rt][0] = __builtin_bit_cast(bf16x8, (v4u){pw[0][0], pw[0][1], pw[1][0], pw[1][1]}); pa[rt][1] = __builtin_bit_cast(bf16x8, (v4u){pw[2][0], pw[2][1], pw[3][0], pw[3][1]}); }
    asm volatile("s_waitcnt vmcnt(0)" ::: "memory");
    __syncthreads();
#pragma unroll
    for (int et = 0; et < 8; ++et)
#pragma unroll
        for (int u = 0; u < 2; ++u) { const LAS unsigned char* vb = VL + (size_t)(64 * ci + 32 * u + 4 * kg + q) * 256 + (16 * et + 4 * p_) * 2;
            const s16x4 b0 = vtr(vb), b1 = vtr(vb + 16 * 256); const bf16x8 vf = CAT8(b0, b1); acc[0][et] = MFMA16(pa[0][u], vf, acc[0][et]); acc[1][et] = MFMA16(pa[1][u], vf, acc[1][et]); }
    float rstd[2][4];
#pragma unroll
    for (int rt = 0; rt < 2; ++rt)
#pragma unroll
        for (int r = 0; r < 4; ++r) { float s = 0.f;
#pragma unroll
            for (int et = 0; et < 8; ++et) s += acc[rt][et][r] * acc[rt][et][r];
            s = xadd<1>(s); s = xadd<2>(s); s = xadd<4>(s); s = xadd<8>(s); rstd[rt][r] = __builtin_amdgcn_rsqf(s * (1.0f / 128.0f) + EPS); }
    __syncthreads();
#pragma unroll
    for (int rt = 0; rt < 2; ++rt)
#pragma unroll
        for (int r = 0; r < 4; ++r) { const int row = 64 * ci + 16 * (2 * hf + rt) + 4 * kg + r;
#pragma unroll
            for (int et = 0; et < 8; ++et) { const int e = 16 * et + l15; const float o = acc[rt][et][r] * rstd[rt][r] * gn[et] * bf2f(*(const LAS bf16*)(SGL + row * 256 + e * 2)); *(LAS bf16*)(VL + row * 256 + e * 2) = (bf16)f2bf(o); } }
    __syncthreads();
#pragma unroll
    for (int i = 0; i < 8; ++i) { const int idx = tid + 512 * i; *(GAS v4u*)(Y + (size_t)(idx >> 4) * DM + (idx & 15) * 8) = *(const LAS v4u*)(VL + (idx >> 4) * 256 + (idx & 15) * 16); }
    asm volatile("s_waitcnt lgkmcnt(0)" ::: "memory"); __builtin_amdgcn_s_barrier(); asm volatile("" ::: "memory");
}

#define KSWZ(row, colB) ((row) * 256 + ((colB) ^ (((row) & 7) << 4)))
#define KPSWZ(row, colB) ((row) * 128 + ((colB) ^ (((row) & 7) << 4)))
#define SBAR() __builtin_amdgcn_sched_barrier(0)
__device__ __forceinline__ int crow(int r, int hi) { return (r & 3) + 8 * (r >> 2) + 4 * hi; }
__device__ __forceinline__ int v_st(int k, int c) { const int kk = (k & ~0xC) | ((k & 4) << 1) | ((k & 8) >> 1); return ((kk >> 3) * 4 + (c >> 5)) * 512 + ((kk & 7) * 32 + (c & 31)) * 2; }
__device__ __forceinline__ int v_rd_base(int lane) { return ((lane & 3) << 3) | (((lane >> 2) & 3) << 6) | (((lane >> 4) & 1) << 5) | (((lane >> 5) & 1) << 8); }
constexpr int v_rd_off(int d0, int ks, int half) { return d0 * 512 + ks * 4096 + half * 2048; }
template <int OFF> __device__ __forceinline__ s16x4 tr_read(int vb) { s16x4 r; asm volatile("ds_read_b64_tr_b16 %0, %1 offset:%2" : "=&v"(r) : "v"(vb), "i"(OFF) : "memory"); return r; }
template <int D0> __device__ __forceinline__ void pv_one(f32x16& od, int vb, bf16x8 pa0, bf16x8 pa1, bf16x8 pa2, bf16x8 pa3) {
    const s16x4 l0 = tr_read<v_rd_off(D0, 0, 0)>(vb), h0 = tr_read<v_rd_off(D0, 0, 1)>(vb), l1 = tr_read<v_rd_off(D0, 1, 0)>(vb), h1 = tr_read<v_rd_off(D0, 1, 1)>(vb);
    const s16x4 l2 = tr_read<v_rd_off(D0, 2, 0)>(vb), h2 = tr_read<v_rd_off(D0, 2, 1)>(vb), l3 = tr_read<v_rd_off(D0, 3, 0)>(vb), h3 = tr_read<v_rd_off(D0, 3, 1)>(vb);
    asm volatile("s_waitcnt lgkmcnt(0)" ::: "memory"); SBAR();
    od = __builtin_amdgcn_mfma_f32_32x32x16_bf16(pa0, CAT8(l0, h0), od, 0, 0, 0);
    od = __builtin_amdgcn_mfma_f32_32x32x16_bf16(pa1, CAT8(l1, h1), od, 0, 0, 0);
    od = __builtin_amdgcn_mfma_f32_32x32x16_bf16(pa2, CAT8(l2, h2), od, 0, 0, 0);
    od = __builtin_amdgcn_mfma_f32_32x32x16_bf16(pa3, CAT8(l3, h3), od, 0, 0, 0);
}
__device__ __forceinline__ void attn_unit(Frame& F, int b, int h, int j, const float* gain, char* lds) {
    int tid_ = threadIdx.x; asm volatile("" : "+v"(tid_));
    const int tid = tid_, wid = __builtin_amdgcn_readfirstlane(tid >> 6), lane = tid & 63, r32 = lane & 31, hi = lane >> 5;
    const unsigned char* Rb = F.ws + WS_R;
    const bf16* QN = (const bf16*)(Rb + R_QN); const bf16* QPE = (const bf16*)(Rb + R_QPE); const bf16* KN = (const bf16*)(Rb + R_KN) + h * 128; const bf16* VV = (const bf16*)(Rb + R_V) + h * 128; const bf16* KPE = (const bf16*)(Rb + R_KPE);
    char* V_lds = lds; char* K_lds = lds + 32768; char* KP_lds = lds + 65536; float* wsf = (float*)(lds + 81920) + wid * 64; float* li_l = wsf; float* al_l = wsf + 32;
    const size_t qbase = j < 0 ? (size_t)NMAIN : (size_t)b * SEQ + 256 * j; const size_t rowq = qbase + wid * 32 + r32;
    bf16x8 qr[12];
#pragma unroll
    for (int d0 = 0; d0 < 8; ++d0) qr[d0] = *(const GAS bf16x8*)(QN + rowq * 512 + h * 128 + d0 * 16 + hi * 8);
#pragma unroll
    for (int d0 = 0; d0 < 4; ++d0) qr[8 + d0] = *(const GAS bf16x8*)(QPE + rowq * 256 + h * 64 + d0 * 16 + hi * 8);
    const int NT = j < 0 ? 1 : 4 * j + 5, my_last = j < 0 ? 0 : 1 + 4 * j + (wid >> 1);
    const int vb0 = (int)(uintptr_t)V_lds + v_rd_base(lane);
    const int k_row = (lane >> 4), k_cb = ((lane & 15) * 16) ^ 0;
    const int kp_row = (lane >> 3), kp_cb = (lane & 7) * 16;
    const int v_kklo = (lane & 31) >> 2, v_cin = (lane & 3) * 8, v_sub = lane >> 5;
    const GAS unsigned char* zsrc = (const GAS unsigned char*)(F.ws + WS_CTL + 512);
#define A_DMA(t, bf) do { const size_t kr = (t) == 0 ? (size_t)NMAIN : (size_t)b * SEQ + 64 * ((t) - 1); const bool meta_ = (t) == 0; \
        _Pragma("unroll") for (int i_ = 0; i_ < 2; ++i_) { const int pc = 2 * wid + i_; \
            { const int row = 4 * pc + k_row, cb = k_cb ^ ((row & 7) << 4); const GAS unsigned char* src = (const GAS unsigned char*)(KN + (kr + row) * 512) + cb; if (meta_ && row >= NMETA) src = zsrc; \
              __builtin_amdgcn_global_load_lds((const GAS unsigned*)src, (LAS unsigned*)(F.lds + 32768 + (bf) * 16384 + pc * 1024), 16, 0, 0); } \
            { const int sub = 2 * pc + v_sub, kk = (sub >> 2) * 8 + v_kklo, k = (kk & ~0xC) | ((kk & 4) << 1) | ((kk & 8) >> 1), c = (sub & 3) * 32 + v_cin; \
              const GAS unsigned char* src = (const GAS unsigned char*)(VV + (kr + k) * 512 + c); if (meta_ && k >= NMETA) src = zsrc; \
              __builtin_amdgcn_global_load_lds((const GAS unsigned*)src, (LAS unsigned*)(F.lds + (bf) * 16384 + pc * 1024), 16, 0, 0); } } \
        { const int row = 8 * wid + kp_row, cb = kp_cb ^ ((row & 7) << 4); const GAS unsigned char* src = (const GAS unsigned char*)(KPE + (kr + row) * 64) + cb; if (meta_ && row >= NMETA) src = zsrc; \
          __builtin_amdgcn_global_load_lds((const GAS unsigned*)src, (LAS unsigned*)(F.lds + 65536 + (bf) * 8192 + wid * 1024), 16, 0, 0); } } while (0)
    float m_reg = -1e30f, l_reg = 0.f; f32x16 o[4];
#pragma unroll
    for (int d = 0; d < 4; ++d)
#pragma unroll
        for (int r = 0; r < 16; ++r) o[d][r] = 0.f;
    A_DMA(0, 0); asm volatile("s_waitcnt vmcnt(0)" ::: "memory"); __syncthreads();
    for (int t = 0; t < NT; ++t) {
        if (t + 1 < NT) A_DMA(t + 1, (t + 1) & 1);
        if (t <= my_last) {
            const char* Kt = K_lds + (t & 1) * 16384; const char* KPt = KP_lds + (t & 1) * 8192;
            f32x16 p0v, p1v;
#pragma unroll
            for (int r = 0; r < 16; ++r) { p0v[r] = 0.f; p1v[r] = 0.f; }
#define A_KLD(d0, B0, B1) do { if ((d0) < 8) { const int cb_ = ((d0) * 16 + hi * 8) * 2; B0 = *(const bf16x8*)(Kt + KSWZ(r32, cb_)); B1 = *(const bf16x8*)(Kt + KSWZ(32 + r32, cb_)); } \
                                else { const int cb_ = (((d0) - 8) * 16 + hi * 8) * 2; B0 = *(const bf16x8*)(KPt + KPSWZ(r32, cb_)); B1 = *(const bf16x8*)(KPt + KPSWZ(32 + r32, cb_)); } } while (0)
            { bf16x8 ka[3], kb[3];
              A_KLD(0, ka[0], kb[0]); A_KLD(1, ka[1], kb[1]); SBAR();
#pragma unroll
              for (int d0 = 0; d0 < 12; ++d0) {
                  if (d0 + 2 < 12) A_KLD(d0 + 2, ka[(d0 + 2) % 3], kb[(d0 + 2) % 3]);
                  SBAR();
                  p0v = __builtin_amdgcn_mfma_f32_32x32x16_bf16(ka[d0 % 3], qr[d0], p0v, 0, 0, 0); p1v = __builtin_amdgcn_mfma_f32_32x32x16_bf16(kb[d0 % 3], qr[d0], p1v, 0, 0, 0);
                  SBAR(); } }
#undef A_KLD
            if (t == 0) {
#pragma unroll
                for (int r = 8; r < 16; ++r) p0v[r] = -1e30f;
#pragma unroll
                for (int r = 0; r < 16; ++r) p1v[r] = -1e30f; }
            float pmax = p0v[0];
#pragma unroll
            for (int r = 1; r < 16; ++r) pmax = fmaxf(pmax, p0v[r]);
#pragma unroll
            for (int r = 0; r < 16; ++r) pmax = fmaxf(pmax, p1v[r]);
            { auto rr = __builtin_amdgcn_permlane32_swap(__float_as_uint(pmax), __float_as_uint(pmax), false, false); pmax = fmaxf(__uint_as_float(rr[0]), __uint_as_float(rr[1])); }
            const float mn = fmaxf(m_reg, pmax), alpha = __builtin_amdgcn_exp2f(m_reg - mn); m_reg = mn;
            float ps = 0.f;
#pragma unroll
            for (int r = 0; r < 16; ++r) { p0v[r] = __builtin_amdgcn_exp2f(p0v[r] - mn); p1v[r] = __builtin_amdgcn_exp2f(p1v[r] - mn); ps += p0v[r] + p1v[r]; }
            { auto rr = __builtin_amdgcn_permlane32_swap(__float_as_uint(ps), __float_as_uint(ps), false, false); ps = __uint_as_float(rr[0]) + __uint_as_float(rr[1]); }
            l_reg = l_reg * alpha + ps;
            if (__any(alpha < 1.f)) { if (hi == 0) al_l[r32] = alpha; asm volatile("s_waitcnt lgkmcnt(0)" ::: "memory");
#pragma unroll
                for (int r = 0; r < 16; ++r) { const float a = al_l[crow(r, hi)];
#pragma unroll
                    for (int d = 0; d < 4; ++d) o[d][r] *= a; } }
            bf16x8 pa0, pa1, pa2, pa3;
#define PK4(P, BASE, OUT) do { unsigned a0 = pk2(P[BASE + 0], P[BASE + 1]), a1 = pk2(P[BASE + 2], P[BASE + 3]); \
    unsigned b0_ = pk2(P[BASE + 4], P[BASE + 5]), b1_ = pk2(P[BASE + 6], P[BASE + 7]); \
    auto r0_ = __builtin_amdgcn_permlane32_swap(a0, b0_, false, false); auto r1_ = __builtin_amdgcn_permlane32_swap(a1, b1_, false, false); \
    v4u w_ = {r0_[0], r1_[0], r0_[1], r1_[1]}; OUT = __builtin_bit_cast(bf16x8, w_); } while (0)
            PK4(p0v, 0, pa0); PK4(p0v, 8, pa1); PK4(p1v, 0, pa2); PK4(p1v, 8, pa3);
#undef PK4
            const int vb = vb0 + (t & 1) * 16384;
            pv_one<0>(o[0], vb, pa0, pa1, pa2, pa3); pv_one<1>(o[1], vb, pa0, pa1, pa2, pa3); pv_one<2>(o[2], vb, pa0, pa1, pa2, pa3); pv_one<3>(o[3], vb, pa0, pa1, pa2, pa3);
        }
        asm volatile("s_waitcnt vmcnt(0)" ::: "memory");
        __syncthreads();
    }
    if (hi == 0) li_l[r32] = l_reg; asm volatile("s_waitcnt lgkmcnt(0)" ::: "memory");
    bf16* Y = (bf16*)(F.ws + WS_R + R_Y) + (qbase + wid * 32) * DM + 512 + h * 128;
    float gn[4];
#pragma unroll
    for (int d = 0; d < 4; ++d) gn[d] = gain[h * 128 + 32 * d + r32];
#pragma unroll
    for (int r = 0; r < 16; ++r) { const int orow = crow(r, hi); const float lr = li_l[orow];
        float s = (o[0][r] * o[0][r] + o[1][r] * o[1][r]) + (o[2][r] * o[2][r] + o[3][r] * o[3][r]);
        s = xadd<1>(s); s = xadd<2>(s); s = xadd<4>(s); s = xadd<8>(s); s = xadd<16>(s);
        const float rstd = __builtin_amdgcn_rsqf(s * (1.0f / 128.0f) + EPS * lr * lr);
        if (j >= 0 || (wid == 0 && orow < NMETA)) {
#pragma unroll
            for (int d = 0; d < 4; ++d) Y[(size_t)orow * DM + 32 * d + r32] = (bf16)f2bf(o[d][r] * rstd * gn[d]); } }
    asm volatile("s_waitcnt lgkmcnt(0)" ::: "memory"); __builtin_amdgcn_s_barrier(); asm volatile("" ::: "memory");
#undef A_DMA
}

struct Args { Inputs in; float* out; unsigned char* ws; int phase; int pad; };
constexpr int N_ATT_UNITS = 260, N_RO_UNITS = NB * 4 * 8 + 4;
constexpr int PH_PER_LAYER = 9, N_PHASES = 1 + DEPTH * PH_PER_LAYER + 1;

__global__ void __launch_bounds__(NWAVES * 64, 2) mk_fwd(Args args) {
    extern __shared__ __attribute__((aligned(16))) unsigned char lds[];
    Frame F;
    F.lds = (LAS unsigned char*)lds; F.MISC = (volatile LAS unsigned*)(F.lds + MISC_OFF);
    F.tid = threadIdx.x; F.lane = F.tid & 63; F.wave = __builtin_amdgcn_readfirstlane(F.tid >> 6);
    F.G = gridDim.x; { const int bx = blockIdx.x; F.vcu = (F.G % 8 == 0) ? (bx % 8) * (F.G / 8) + bx / 8 : bx; }
    F.ws = args.ws; F.ctl = (gu32*)(args.ws + WS_CTL);
    for (int u = F.tid; u < (LDS_BYTES - LDSCTL_OFF) / 4; u += NWAVES * 64) ((LAS unsigned*)(F.lds + LDSCTL_OFF))[u] = 0u;
    __syncthreads();
    XcdBarrier bar; bar.bar = (unsigned*)(F.ctl + CW_BAR); bar.x = 0; bar.st = nullptr;
    if (!MK_MULTI) bar = xcd_barrier_post((unsigned*)(F.ctl + CW_BAR), F.MISC + 8);
#define R (F.ws + WS_R)
#define tab ((const float*)(F.ws + WS_TAB))
#define hres ((float*)(F.ws + WS_HRES))
#define XN ((const pg8::bf16_t*)(F.ws + WS_XN))
#define cnt ((unsigned*)(F.ctl + CW_CNT) + li * 8)
    int ph = 0;
#ifndef MK_ALIGN
#define MK_ALIGN true
#endif
#ifndef MK_SP2
#define MK_SP2 true
#endif
#ifndef MK_MASK
#define MK_MASK 0xFFFFFFFFu
#endif
#define ON(k) (((MK_MASK) >> (k)) & 1u)
#ifndef MK_STAMP_A
#define MK_STAMP_A (-1)
#define MK_STAMP_B (-1)
#endif
#ifndef MK_ATT_REP
#define MK_ATT_REP 1
#endif
#ifndef MK_RO_REP
#define MK_RO_REP 1
#endif
#ifndef MK_REP_PH
#define MK_REP_PH (-1)
#endif
#ifndef MK_REP_N
#define MK_REP_N 1
#endif
#define RUN() (MK_MULTI ? (ph == args.phase) : true)
#define SEAM() do { if (!MK_MULTI) { asm volatile("" : "+s"(bar.x)); bar.bar = (unsigned*)(F.ctl + CW_BAR); xcd_barrier(bar); } if (MK_STAMP_A >= 0 && blockIdx.x == 0 && F.tid == 0) ((unsigned long long*)(F.ws + WS_CTL + 1572864))[ph] = __builtin_amdgcn_s_memrealtime();   ++ph; int z_ = 0; F.tid = threadIdx.x; asm volatile("" : "+v"(F.tid), "+s"(z_));     F.lane = F.tid & 63; F.wave = __builtin_amdgcn_readfirstlane(F.tid >> 6); F.ws = args.ws + z_; F.ctl = (gu32*)(F.ws + WS_CTL); } while (0)
#define REPS(k) _Pragma("unroll 1") for (int rep_ = 0; rep_ < ((k) == MK_REP_PH ? MK_REP_N : 1); ++rep_, ((rep_ < ((k) == MK_REP_PH ? MK_REP_N : 1)) ? ({ SEAM(); --ph; 0; }) : 0))

    REPS(0) if (ON(0) && RUN()) p0_prologue(F);
    SEAM();
#if defined(MK_PROBE_GEMM)
    {
        pg8::Gemm g{XN, (const pg8::bf16_t*)(F.ws + WS_WDGU), NMAIN, 2 * FF, DM / 2, 0};
        pg8::StaticOrder S; S.init(NMAIN, 2 * FF, F.G, (int)blockIdx.x);
#if MK_PROBE_GEMM == 1
        EpiSwiGLU E{(bf16*)(R + R_ACT)}; E.rs = (const float*)(F.ws + WS_TAB);
        pg8::gemm_phase<EpiSwiGLU, pg8::StaticOrder, MK_ALIGN, MK_SP2, true>(F.lds, g, S, E);
#else
        EpiNone E{};
        pg8::gemm_phase<EpiNone, pg8::StaticOrder, MK_ALIGN, MK_SP2, true>(F.lds, g, S, E);
#endif
        if (!MK_MULTI) { asm volatile("" : "+s"(bar.x)); bar.bar = (unsigned*)(F.ctl + CW_BAR); xcd_barrier(bar); }
    }
#endif
#pragma unroll 1
    for (int l = 0; l < DEPTH; ++l) {
        const bool moe = (l & 1) != 0; const int li = l >> 1;
        REPS(1) if (ON(1) && RUN() && l > 0) norm_phase(F, l == 2 && rep_ == 0, (const unsigned*)(F.ctl + CW_CNT), true);
        SEAM();
        REPS(2) if (ON(2) && RUN()) {
            pg8::Gemm g{XN, (const pg8::bf16_t*)(F.ws + WS_WIN + (size_t)l * DINP * DM), NMAIN, DINP - 512, DM / 2, 0};
            pg8::StaticOrder S; S.init(NMAIN, DINP - 512, F.G, (int)blockIdx.x);
            EpiInProj E{R, (float*)(F.ws + CTL_SSQ), (float*)(F.ws + CTL_SSKV), tab, log2_gamma(0), log2_gamma(1), log2_gamma(2), log2_gamma(3), 0}; E.rs = (const float*)(F.ws + WS_RS);
            meta_gemm<EpiInProj, 1>(F, F.ws + WS_XN + (size_t)NMAIN * DM, g.Bt, DINP, DM, E);
            pg8::gemm_phase<EpiInProj, pg8::StaticOrder, MK_ALIGN, MK_SP2, 1>(F.lds, g, S, E);
        }
        SEAM();
        REPS(3) if (ON(3) && RUN()) {
            const int c_ = (int)blockIdx.x, hG = F.G >> 1;
            {
                pg8::Gemm g{XN, (const pg8::bf16_t*)(F.ws + WS_WIN + (size_t)l * DINP * DM + (size_t)(DINP - 512) * DM), NMAIN, 512, DM / 2, 0};
                pg8::StaticOrder S; S.init(NMAIN, 512, F.G, c_);
                if (F.G == 256) { if (c_ >= 64 && c_ < 192) S.window(0, 128, c_ - 64, 128); else S.window(128, 128, 0, 128); }
                EpiGate E{R + R_SG}; E.rs = (const float*)(F.ws + WS_RS);
                pg8::gemm_phase<EpiGate, pg8::StaticOrder, MK_ALIGN, MK_SP2, 1>(F.lds, g, S, E);
            }
            pg8::Gemm g{(const pg8::bf16_t*)(R + R_LAT), (const pg8::bf16_t*)(F.ws + WS_WUP) + (size_t)l * UPN * UPK, NMAIN, UPN, UPK, 0};
            pg8::StaticOrder S; S.init(NMAIN, UPN, F.G, c_);
            S.pnsplit = 3; S.nt_lo = 4; S.koff_hi = 512u; S.nt_hi = 2;
            if (F.G == 256) { if (c_ >= 192) S.window(256, 64, c_ - 192, 448); else if (c_ >= 64) S.window(0, 128, c_ - 64, 256); else S.window(448, hG, 0, 448); }
            EpiUp E{R, (const float*)(F.ws + CTL_SSQ), (const float*)(F.ws + CTL_SSKV), tab};
            meta_gemm<EpiUp>(F, g.A + (size_t)NMAIN * UPK, g.Bt, UPN, UPK * 2, E);
            pg8::gemm_phase<EpiUp, pg8::StaticOrder, MK_ALIGN, MK_SP2>(F.lds, g, S, E);
            if (ON(4)) { if (F.G == 256) { if (c_ < 64) ret_state64_unit(F, c_); } else for (int u = c_; u < NB * 4 * 2; u += F.G) ret_state64_unit(F, u); }
        }
        SEAM();
        REPS(5) if (RUN()) {
            gu32* qh = F.ctl + CW_QUEUE + 64 * l + 8 * rep_;
            for (;;) {
                if (F.tid == 0) F.MISC[16] = __hip_atomic_fetch_add(qh, 1u, RLX_AGENT);
                asm volatile("s_waitcnt lgkmcnt(0)" ::: "memory"); __builtin_amdgcn_s_barrier(); asm volatile("" ::: "memory"); const int u = (int)F.MISC[16]; asm volatile("s_waitcnt lgkmcnt(0)" ::: "memory"); __builtin_amdgcn_s_barrier(); asm volatile("" ::: "memory");
                if (u >= N_ATT_UNITS + N_RO_UNITS) break;
                const bool is_ro = u >= 192 && u < 192 + N_RO_UNITS;
                if (!is_ro) { if (ON(5)) { const int v = u < 192 ? u : u - N_RO_UNITS; const int j = v < 256 ? 7 - (v >> 5) : -1, bh = v < 256 ? (v & 31) : (v - 256); attn_unit(F, bh >> 2, bh & 3, j, ldin(I_MLAG) + l * 512, (char*)lds); } }
                else if (ON(6)) { const int v = u - 192; if (v < NB * 4 * 8) ret_out4_unit(F, v, ldin(I_RETG) + l * 512); else ret_out_unit(F, NB * 4 * 32 + (v - NB * 4 * 8), ldin(I_RETG) + l * 512); }
            }
        }
        SEAM();
        REPS(7) if (ON(7) && RUN()) {
            pg8::Gemm g{(const pg8::bf16_t*)(R + R_Y), (const pg8::bf16_t*)(F.ws + WS_WOUT) + (size_t)l * DM * DM, NMAIN, DM, DM, 0};
            pg8::StaticOrder S; S.init(NMAIN, DM, F.G, (int)blockIdx.x);
            EpiResid E{rep_ == 0 ? hres : (float*)(F.ws + WS_XS), 1.0f};
            meta_gemm<EpiResid>(F, g.A + (size_t)NMAIN * DM, g.Bt, DM, DM * 2, E);
            pg8::gemm_phase<EpiResid, pg8::StaticOrder, MK_ALIGN, MK_SP2>(F.lds, g, S, E);
        }
        SEAM();
        if (!moe) {
            REPS(8) if (ON(8) && RUN()) norm_phase(F, false, nullptr, true);
            SEAM();
            REPS(9) if (ON(9) && RUN()) {
                pg8::Gemm g{XN, (const pg8::bf16_t*)(F.ws + WS_WDGU + (size_t)li * 2 * FF * DM), NMAIN, 2 * FF, DM / 2, 0};
                pg8::StaticOrder S; S.init(NMAIN, 2 * FF, F.G, (int)blockIdx.x);
                EpiSwiGLU E{(bf16*)(R + R_ACT)}; E.rs = (const float*)(F.ws + WS_RS); E.f8 = 1;
                meta_gemm<EpiSwiGLU, true>(F, F.ws + WS_XN + (size_t)NMAIN * DM, g.Bt, 2 * FF, DM, E);
                pg8::gemm_phase<EpiSwiGLU, pg8::StaticOrder, MK_ALIGN, MK_SP2, true>(F.lds, g, S, E);
            }
            SEAM();
            REPS(10) if (ON(10) && RUN()) {
                pg8::Gemm g{(const pg8::bf16_t*)(R + R_ACT), (const pg8::bf16_t*)(F.ws + WS_WDD + (size_t)li * DM * FF), NMAIN, DM, FF / 2, 0};
                pg8::StaticOrder S; S.init(NMAIN, DM, F.G, (int)blockIdx.x);
                EpiResid E{rep_ == 0 ? hres : (float*)(F.ws + WS_XS), 1.0f / (S_A8 * S_WD8)};
                meta_gemm<EpiResid, 2>(F, R + R_ACT + (size_t)NMAIN * FF, g.Bt, DM, FF, E);
                pg8::gemm_phase<EpiResid, pg8::StaticOrder, MK_ALIGN, MK_SP2, 2>(F.lds, g, S, E);
            }
            SEAM();
            ++ph;
        } else {
            if (ON(11) && RUN()) route_phase(F, ldin(I_FFNNORM) + l * DM, ldin(I_ROUTER) + (size_t)li * DM * NEXP, cnt);
            SEAM();
            REPS(12) if (ON(12) && RUN()) gather_phase(F, cnt);
            SEAM();
            REPS(13) if (ON(13) && RUN()) {
                pg8::Gemm g{(const pg8::bf16_t*)(F.ws + WS_XS), (const pg8::bf16_t*)(F.ws + WS_WMGU + (size_t)li * NEXP * 2 * FF * DM), XS_ROWS, 2 * FF, DM / 2, (size_t)2 * FF * DM};
                pg8::GroupedOrder S; S.init(cnt, 2 * FF, F.G, (int)blockIdx.x);
                EpiSwiGLU E{(bf16*)(R + R_ACT)}; E.rs = (const float*)(F.ws + WS_RSS); E.f8 = 1;
                pg8::gemm_phase<EpiSwiGLU, pg8::GroupedOrder, MK_ALIGN, MK_SP2, true>(F.lds, g, S, E);
            }
            SEAM();
            REPS(14) if (ON(14) && RUN()) {
                pg8::Gemm g{(const pg8::bf16_t*)(R + R_ACT), (const pg8::bf16_t*)(F.ws + WS_WMD + (size_t)li * NEXP * DM * FF), XS_ROWS, DM, FF / 2, (size_t)DM * FF};
                { asm volatile("" ::: "memory"); pg8::GroupedOrder S; S.init(cnt, DM, F.G, (int)blockIdx.x, 0, MOE_FULL_TILES);
                  EpiMoeDown E{(bf16*)(F.ws + WS_YS), 1.0f / (S_A8 * S_WD8)};
                  pg8::gemm_phase<EpiMoeDown, pg8::GroupedOrder, MK_ALIGN, MK_SP2, 2>(F.lds, g, S, E); }
                { pg8::Gemm g2 = g; g2.K = FF / 2 / MOE_KSPLIT8; g2.ld = FF / 2;
                  asm volatile("" ::: "memory"); pg8::GroupedOrder S; S.init(cnt, DM, F.G, (int)blockIdx.x, MOE_FULL_TILES, 1 << 30, MOE_KSPLIT8, (unsigned)(FF / MOE_KSPLIT8));
                  EpiPartial E{(float*)(F.ws + WS_PART), (unsigned)(FF / MOE_KSPLIT8), MOE_KSPLIT8, 1.0f / (S_A8 * S_WD8)};
                  pg8::gemm_phase<EpiPartial, pg8::GroupedOrder, MK_ALIGN, MK_SP2, 2>(F.lds, g2, S, E); }
            }
            SEAM();
        }
    }
    if (ON(15) && RUN()) final_phase(F, ldin(I_FINAL), args.out, (const unsigned*)(F.ctl + CW_CNT) + 8);
    if (MK_STAMP_A >= 0 && blockIdx.x == 0 && F.tid == 0) {
        unsigned long long* st = (unsigned long long*)(F.ws + WS_CTL + 1572864); st[ph] = __builtin_amdgcn_s_memrealtime();
        const unsigned long long d = 8ull * (st[MK_STAMP_B] - st[MK_STAMP_A]), t0 = __builtin_amdgcn_s_memrealtime();
        while (__builtin_amdgcn_s_memrealtime() - t0 < d) __builtin_amdgcn_s_sleep(8);
    }
#undef RUN
#undef SEAM
#undef R
#undef tab
#undef hres
#undef XN
#undef cnt
}

extern "C" void kernel_launch(void* const* d_in, const int* in_sizes, int n_in, void* d_out, int out_size, void* d_ws, size_t ws_size, hipStream_t stream) {
    static int grid = 0;
    if (grid == 0) {
        if (n_in != 20 || in_sizes[0] != NB * SEQ * DM || out_size != NB * SEQ * DM || ws_size < WS_END) {
            fprintf(stderr, "kernel_launch: shape mismatch: n_in %d in0 %d out %d ws %zu (need >= %zu)\n", n_in, n_in > 0 ? in_sizes[0] : -1, out_size, ws_size, (size_t)WS_END); grid = -1; return; }
        int dev = 0, cus = 0, per_cu = 0;
        if (hipGetDevice(&dev) != hipSuccess || hipDeviceGetAttribute(&cus, hipDeviceAttributeMultiprocessorCount, dev) != hipSuccess) { grid = -1; return; }
        if (hipFuncSetAttribute((const void*)mk_fwd, hipFuncAttributeMaxDynamicSharedMemorySize, LDS_BYTES) != hipSuccess) { fprintf(stderr, "kernel_launch: hipFuncSetAttribute failed\n"); grid = -1; return; }
        if (hipOccupancyMaxActiveBlocksPerMultiprocessor(&per_cu, (const void*)mk_fwd, NWAVES * 64, LDS_BYTES) != hipSuccess || per_cu < 1)
            fprintf(stderr, "kernel_launch: occupancy query reports %d workgroups per CU\n", per_cu);
        (void)hipGetLastError();
        grid = cus < 256 ? cus : 256;
    }
    if (grid < 0) return;
    if (hipMemsetAsync((char*)d_ws + WS_CTL, 0, CTL_ZERO_BYTES, stream) != hipSuccess) { fprintf(stderr, "kernel_launch: memset failed\n"); return; }
    Args a{};
    for (int i = 0; i < 20; ++i) a.in.p[i] = (const float*)d_in[i];
    a.out = (float*)d_out; a.ws = (unsigned char*)d_ws; a.phase = 0; a.pad = 0;
#if MK_MULTI
    for (int ph = 0; ph < N_PHASES; ++ph) { a.phase = ph; hipLaunchKernelGGL(mk_fwd, dim3(grid), dim3(NWAVES * 64), LDS_BYTES, stream, a); }
#else
    hipLaunchKernelGGL(mk_fwd, dim3(grid), dim3(NWAVES * 64), LDS_BYTES, stream, a);
#endif
    const hipError_t le = hipPeekAtLastError();
    if (le != hipSuccess) fprintf(stderr, "kernel_launch: launch failed: %s\n", hipGetErrorName(le));
}
```

```cpp
#include <hip/hip_runtime.h>
#include <cstdio>
#include <cstdint>
namespace pg8 {
#define PG8_LAS __attribute__((address_space(3)))
typedef unsigned short bf16_t;
typedef short bf16x8 __attribute__((ext_vector_type(8)));
typedef float f32x4 __attribute__((ext_vector_type(4)));
typedef unsigned u32x4 __attribute__((ext_vector_type(4)));
constexpr int BM = 256, BK = 64, HALF = 128, HTB = HALF * BK * 2  , STAGE_BYTES = 8 * HTB, NXCD = 8, WGM = 4;

__host__ __device__ __forceinline__ int lds_byte(int r, int c) { const int st = (r >> 4) * 2 + (c >> 5), rr = r & 15, cc = c & 31, ob = rr * 64 + cc * 2; return st * 1024 + (ob ^ (((ob >> 9) & 1) << 5)); }
__host__ __device__ __forceinline__ void stage_rc(int b, int& R, int& C) { const int st = b / 1024, sb = b % 1024, swz = sb ^ (((sb >> 9) & 1) << 5); R = (st >> 1) * 16 + swz / 64; C = (st & 1) * 32 + (swz % 64) / 2; }
__host__ __device__ __forceinline__ int perm32(int rho) { const int n = rho >> 4, i = rho & 15; return 8 * (i >> 2) + 4 * n + (i & 3); }

struct Unit { int pm, pn, eb; unsigned koff; int nt; };
struct Gemm { const bf16_t* A; const bf16_t* Bt; int M, N, K; size_t estride; int ld = 0; };

struct StaticOrder {
    int nM, nN, nwg, G, c, base, lim; int pnsplit = 1 << 30; unsigned koff_hi = 0u; int nt_lo = 0, nt_hi = 0;
    __host__ __device__ void init(int M, int N, int G_, int c_) { nM = M / BM; nN = N / BM; nwg = nM * nN; G = G_; c = c_; base = 0; lim = nwg; }
    __host__ __device__ void window(int base_, int G_, int c_, int lim_) { base = base_; G = G_; c = c_; lim = lim_; }
    __host__ __device__ bool next(int i, Unit& u) const {
        const long L = (long)i * G + c + base; if (L >= lim) return false;
        int wgid = (int)L; { const int q = nwg / NXCD, r = nwg % NXCD, xcd = wgid % NXCD, off = wgid / NXCD; wgid = (xcd < r ? xcd * (q + 1) : r * (q + 1) + (xcd - r) * q) + off; }
        const int nig = WGM * nN, gid = wgid / nig, fm = gid * WGM, gsz = (nM - fm) < WGM ? (nM - fm) : WGM;
        u.pm = fm + ((wgid % nig) % gsz); u.pn = (wgid % nig) / gsz; u.eb = 0; u.koff = u.pn >= pnsplit ? koff_hi : 0u; u.nt = u.pn >= pnsplit ? nt_hi : nt_lo; return true;
    }
    __device__ __forceinline__ void a_ready(const Unit&) const {}
    __device__ __forceinline__ void done(const Unit&) const {}
};
struct GroupedOrder {
    int nM, nN, nwg, G, c; int tp[9]; int pm0, nK; unsigned kbytes;
    __device__ __forceinline__ void init(const unsigned* cnt, int N, int G_, int c_, int pm_lo = 0, int pm_cap = 1 << 30, int nK_ = 1, unsigned kbytes_ = 0u) {
        tp[0] = 0;
#pragma unroll
        for (int e = 0; e < 8; ++e) tp[e + 1] = tp[e] + __builtin_amdgcn_readfirstlane((int)((cnt[e] + 255u) >> 8));
        const int hi = tp[8] < pm_cap ? tp[8] : pm_cap; pm0 = pm_lo; nM = hi > pm_lo ? hi - pm_lo : 0; nK = nK_; kbytes = kbytes_;
        nN = (N / BM) * nK; nwg = nM * nN; G = G_; c = c_; }
    __device__ __forceinline__ bool next(int i, Unit& u) const {
        const long L = (long)i * G + c; if (L >= nwg) return false;
        int wgid = (int)L; { const int q = nwg / NXCD, r = nwg % NXCD, xcd = wgid % NXCD, off = wgid / NXCD; wgid = (xcd < r ? xcd * (q + 1) : r * (q + 1) + (xcd - r) * q) + off; }
        const int nig = WGM * nN, gid = wgid / nig, fm = gid * WGM, gsz = (nM - fm) < WGM ? (nM - fm) : WGM;
        u.pm = pm0 + fm + ((wgid % nig) % gsz); const int pk = (wgid % nig) / gsz; u.pn = pk / nK; u.koff = (unsigned)(pk % nK) * kbytes; u.nt = 0;
        int e = 0;
#pragma unroll
        for (int k = 1; k < 8; ++k) e += (u.pm >= tp[k]) ? 1 : 0;
        u.eb = e; return true;
    }
    __device__ __forceinline__ void a_ready(const Unit&) const {}
    __device__ __forceinline__ void done(const Unit&) const {}
};
__device__ __forceinline__ unsigned cvt_pk_bf16(float lo, float hi) { unsigned r; asm volatile("v_cvt_pk_bf16_f32 %0, %1, %2" : "=v"(r) : "v"(lo), "v"(hi)); return r; }
typedef int i32x4 __attribute__((ext_vector_type(4)));
__device__ __forceinline__ f32x4 zero_acc() { float z; asm volatile("v_mov_b32 %0, 0" : "=v"(z)); return (f32x4){z, z, z, z}; }
template <bool I8> __device__ __forceinline__ f32x4 mma16(bf16x8 b, bf16x8 a, f32x4 c) {
    if constexpr (I8) return __builtin_bit_cast(f32x4, __builtin_amdgcn_mfma_i32_16x16x64_i8(__builtin_bit_cast(i32x4, b), __builtin_bit_cast(i32x4, a), __builtin_bit_cast(i32x4, c), 0, 0, 0));
    else return __builtin_amdgcn_mfma_f32_16x16x32_bf16(b, a, c, 0, 0, 0);
}
typedef int i32x8 __attribute__((ext_vector_type(8)));
__device__ __forceinline__ f32x4 mma_f8(bf16x8 b0, bf16x8 b1, bf16x8 a0, bf16x8 a1, f32x4 c) {
    const i32x8 B = __builtin_shufflevector(__builtin_bit_cast(i32x4, b0), __builtin_bit_cast(i32x4, b1), 0, 1, 2, 3, 4, 5, 6, 7), A = __builtin_shufflevector(__builtin_bit_cast(i32x4, a0), __builtin_bit_cast(i32x4, a1), 0, 1, 2, 3, 4, 5, 6, 7);
    asm volatile("v_mfma_f32_16x16x128_f8f6f4 %0, %1, %2, %0" : "+v"(c) : "v"(B), "v"(A));
    return c;
}
template <class Epi, class Sched, bool ALIGN_EPI = false, bool SP2 = false, int QM = 0>
__device__ __forceinline__ void gemm_phase(PG8_LAS unsigned char* lds, const Gemm g, const Sched& S, const Epi& E) {
    int tid_ = threadIdx.x; asm volatile("" : "+v"(tid_));
    const int tid = tid_, wid = __builtin_amdgcn_readfirstlane(tid >> 6), lane = tid & 63, wr = wid >> 2, wc = wid & 3, fr = lane & 15, fq = lane >> 4;
    const int K = g.ld ? g.ld : g.K, nt = g.K / BK;
    unsigned voffA[2], voffB[2];
#pragma unroll
    for (int i = 0; i < 2; ++i) { int R, C; stage_rc(tid * 16 + i * 8192, R, C); const int Rb = Epi::PERM ? ((R & ~31) + perm32(R & 31)) : R;
        voffA[i] = (unsigned)(R * K + C) * 2u; voffB[i] = (unsigned)(Rb * K + C) * 2u; }
    const size_t kstep = (size_t)(BK * 2);
    const size_t hstep = (size_t)HALF * K * 2;
    const size_t tstep = 2 * hstep;
    const unsigned ldsw = (unsigned)wid * 1024u;
    const int aoff = lds_byte(wr * 64 + fr, fq * 8), boff = lds_byte(wc * 32 + fr, fq * 8);
#define PG8_SA(b, h) (((b) * 2 + (h)) * HTB)
#define PG8_SB(b, h) ((4 + (b) * 2 + (h)) * HTB)
#define PG8_STAGE(bufoff, gbase, voff) do { _Pragma("unroll") for (int _i = 0; _i < 2; ++_i) \
        __builtin_amdgcn_global_load_lds((const unsigned*)((const char*)(gbase) + (voff)[_i]), (PG8_LAS unsigned*)(lds + (bufoff) + ldsw + _i * 8192), 16, 0, 0); } while (0)
#define PG8_LDA(dst, b, h) do { _Pragma("unroll") for (int m = 0; m < 4; ++m) _Pragma("unroll") for (int k = 0; k < 2; ++k) dst[m][k] = *(const PG8_LAS bf16x8*)(lds + PG8_SA(b, h) + aoff + m * 2048 + k * 1024); } while (0)
#define PG8_LDB(dst, b, h) do { _Pragma("unroll") for (int n = 0; n < 2; ++n) _Pragma("unroll") for (int k = 0; k < 2; ++k) dst[n][k] = *(const PG8_LAS bf16x8*)(lds + PG8_SB(b, h) + boff + n * 2048 + k * 1024); } while (0)
#define PG8_MMA(ai, bj, At, Bt) do { __builtin_amdgcn_s_setprio(1); _Pragma("unroll") for (int m = 0; m < 4; ++m) _Pragma("unroll") for (int n = 0; n < 2; ++n) { \
        if constexpr (QM == 2) acc[ai][bj][m][n] = mma_f8(Bt[n][0], Bt[n][1], At[m][0], At[m][1], acc[ai][bj][m][n]); \
        else { _Pragma("unroll") for (int k = 0; k < 2; ++k) acc[ai][bj][m][n] = mma16<QM == 1>(Bt[n][k], At[m][k], acc[ai][bj][m][n]); } } __builtin_amdgcn_s_setprio(0); } while (0)
#define PG8_WAIT_V(n) asm volatile("s_waitcnt vmcnt(" #n ")" ::: "memory")
#define PG8_WAIT_L(n) asm volatile("s_waitcnt lgkmcnt(" #n ")" ::: "memory")
#define PG8_BAR __builtin_amdgcn_s_barrier()
#define PG8_SCHED __builtin_amdgcn_sched_barrier(0)
    Unit cur, nxt; int ui = 0;
    if (!S.next(0, cur)) return;
    f32x4 acc[2][2][4][2];
#pragma unroll
    for (int a = 0; a < 2; ++a)
#pragma unroll
        for (int b = 0; b < 2; ++b)
#pragma unroll
            for (int m = 0; m < 4; ++m)
#pragma unroll
                for (int n = 0; n < 2; ++n) acc[a][b][m][n] = (f32x4){0.f, 0.f, 0.f, 0.f};
    bf16x8 At[4][2], B0[2][2], B1[2][2];
    const char* cA = (const char*)g.A + (size_t)cur.pm * tstep + cur.koff; const char* cB = (const char*)g.Bt + (size_t)cur.eb * g.estride + (size_t)cur.pn * tstep + cur.koff;
    S.a_ready(cur);
    PG8_LAS unsigned char* const scl = lds + 143360;
    if constexpr (Epi::PRE_RS) E.pre(cur, scl, wid, lane);
    if constexpr (SP2) {
        PG8_STAGE(PG8_SB(0, 0), cB, voffB); PG8_STAGE(PG8_SB(0, 1), cB + hstep, voffB); PG8_STAGE(PG8_SA(0, 0), cA, voffA); PG8_STAGE(PG8_SA(0, 1), cA + hstep, voffA);
        if (wr == 1) PG8_BAR;
        PG8_WAIT_V(2); PG8_BAR;
        PG8_STAGE(PG8_SB(1, 0), cB + kstep, voffB); PG8_STAGE(PG8_SA(1, 0), cA + kstep, voffA); PG8_STAGE(PG8_SB(1, 1), cB + hstep + kstep, voffB);
        PG8_WAIT_V(6); PG8_BAR;
    } else {
        PG8_STAGE(PG8_SB(0, 0), cB, voffB); PG8_STAGE(PG8_SA(0, 0), cA, voffA); PG8_STAGE(PG8_SB(0, 1), cB + hstep, voffB); PG8_STAGE(PG8_SA(0, 1), cA + hstep, voffA);
        if (wr == 1) PG8_BAR;
        PG8_WAIT_V(4); PG8_BAR;
        PG8_STAGE(PG8_SB(1, 0), cB + kstep, voffB); PG8_STAGE(PG8_SA(1, 0), cA + kstep, voffA); PG8_STAGE(PG8_SB(1, 1), cB + hstep + kstep, voffB);
        PG8_WAIT_V(6); PG8_BAR;
    }
    for (;;) {
        const bool has_next = S.next(ui + 1, nxt);
        const char* nA = has_next ? (const char*)g.A + (size_t)nxt.pm * tstep + nxt.koff : cA; const char* nB = has_next ? (const char*)g.Bt + (size_t)nxt.eb * g.estride + (size_t)nxt.pn * tstep + nxt.koff : cB;
        const int nt_u = cur.nt ? cur.nt : nt;
        for (int t = 0; t < nt_u; t += 2) {
            const bool last = (t == nt_u - 2);
            const char* a1 = cA + (size_t)(t + 1) * kstep;
            const char* a2 = last ? nA : cA + (size_t)(t + 2) * kstep; const char* b2 = last ? nB : cB + (size_t)(t + 2) * kstep;
            const char* a3 = a2 + kstep; const char* b3 = b2 + kstep;
            if (last && has_next) S.a_ready(nxt);
            if constexpr (SP2) {
            PG8_LDB(B0, 0, 0); PG8_LDB(B1, 0, 1); PG8_SCHED; PG8_LDA(At, 0, 0); PG8_STAGE(PG8_SA(1, 1), a1 + hstep, voffA);
            PG8_WAIT_V(8); PG8_WAIT_L(0); PG8_BAR; PG8_MMA(0, 0, At, B0); PG8_MMA(0, 1, At, B1); PG8_BAR; PG8_SCHED;
            PG8_LDA(At, 0, 1); PG8_STAGE(PG8_SB(0, 0), b2, voffB); PG8_STAGE(PG8_SB(0, 1), b2 + hstep, voffB); PG8_STAGE(PG8_SA(0, 0), a2, voffA);
            PG8_WAIT_V(8); PG8_WAIT_L(0); PG8_BAR; PG8_MMA(1, 0, At, B0); PG8_MMA(1, 1, At, B1); PG8_BAR; PG8_SCHED;
            PG8_LDB(B0, 1, 0); PG8_LDB(B1, 1, 1); PG8_SCHED; PG8_LDA(At, 1, 0); PG8_STAGE(PG8_SA(0, 1), a2 + hstep, voffA);
            PG8_WAIT_V(8); PG8_WAIT_L(0); PG8_BAR; PG8_MMA(0, 0, At, B0); PG8_MMA(0, 1, At, B1); PG8_BAR; PG8_SCHED;
            PG8_LDA(At, 1, 1); PG8_STAGE(PG8_SB(1, 0), b3, voffB); PG8_STAGE(PG8_SB(1, 1), b3 + hstep, voffB); PG8_STAGE(PG8_SA(1, 0), a3, voffA);
            PG8_WAIT_V(8); PG8_WAIT_L(0); PG8_BAR; PG8_MMA(1, 0, At, B0); PG8_MMA(1, 1, At, B1); PG8_BAR; PG8_SCHED;
            } else {
            PG8_LDB(B0, 0, 0); PG8_SCHED; PG8_LDA(At, 0, 0); PG8_STAGE(PG8_SA(1, 1), a1 + hstep, voffA);
            PG8_WAIT_L(8); PG8_BAR; PG8_WAIT_L(0); PG8_MMA(0, 0, At, B0); PG8_BAR; PG8_SCHED;
            PG8_LDB(B1, 0, 1); PG8_STAGE(PG8_SB(0, 0), b2, voffB);
            PG8_BAR; PG8_WAIT_L(0); PG8_MMA(0, 1, At, B1); PG8_BAR;
            PG8_LDA(At, 0, 1); PG8_STAGE(PG8_SA(0, 0), a2, voffA);
            PG8_BAR; PG8_WAIT_L(0); PG8_MMA(1, 0, At, B0); PG8_BAR; PG8_SCHED;
            PG8_STAGE(PG8_SB(0, 1), b2 + hstep, voffB);
            PG8_WAIT_V(6); PG8_BAR; PG8_MMA(1, 1, At, B1); PG8_BAR;
            PG8_LDB(B0, 1, 0); PG8_SCHED; PG8_LDA(At, 1, 0); PG8_STAGE(PG8_SA(0, 1), a2 + hstep, voffA);
            PG8_WAIT_L(8); PG8_BAR; PG8_WAIT_L(0); PG8_MMA(0, 0, At, B0); PG8_BAR; PG8_SCHED;
            PG8_LDB(B1, 1, 1); PG8_STAGE(PG8_SB(1, 0), b3, voffB);
            PG8_BAR; PG8_WAIT_L(0); PG8_MMA(0, 1, At, B1); PG8_BAR;
            PG8_LDA(At, 1, 1); PG8_STAGE(PG8_SA(1, 0), a3, voffA);
            PG8_BAR; PG8_WAIT_L(0); PG8_MMA(1, 0, At, B0); PG8_BAR; PG8_SCHED;
            PG8_STAGE(PG8_SB(1, 1), b3 + hstep, voffB);
            PG8_WAIT_V(6); PG8_BAR; PG8_MMA(1, 1, At, B1); PG8_BAR;
            }
        }
        if constexpr (QM == 2) { asm volatile("s_nop 15\n\ts_nop 15"); }
        if constexpr (ALIGN_EPI) { if (wr == 0) PG8_BAR; }
        if constexpr (Epi::PRE_RS) { if (has_next) E.pre(nxt, scl + ((ui + 1) & 1) * 1024, wid, lane); }
        if constexpr (!Epi::AFTER_DRAIN) { if constexpr (Epi::PRE_RS) E(acc, cur, wr, wc, fr, fq, scl + (ui & 1) * 1024); else E(acc, cur, wr, wc, fr, fq); S.done(cur); }
        if (!has_next) break;
#pragma unroll
        for (int a = 0; a < 2; ++a)
#pragma unroll
            for (int b = 0; b < 2; ++b)
#pragma unroll
                for (int m = 0; m < 4; ++m)
#pragma unroll
                    for (int n = 0; n < 2; ++n) acc[a][b][m][n] = (f32x4){0.f, 0.f, 0.f, 0.f};
        cur = nxt; cA = nA; cB = nB; ++ui;
        if constexpr (ALIGN_EPI) { if (wr == 1) PG8_BAR; }
    }
    PG8_WAIT_V(0);
    if constexpr (!ALIGN_EPI) { if (wr == 0) PG8_BAR; }
    PG8_BAR;
    if constexpr (Epi::AFTER_DRAIN) { E.fused(acc, cur, wr, wc, fr, fq, lds, wid, lane); S.done(cur); }
#undef PG8_SA
#undef PG8_SB
#undef PG8_STAGE
#undef PG8_LDA
#undef PG8_LDB
#undef PG8_MMA
#undef PG8_WAIT_V
#undef PG8_WAIT_L
#undef PG8_BAR
#undef PG8_SCHED
}
}

constexpr int NB = 8, SEQ = 2048, NMETA = 16, LSEQ = SEQ + NMETA;
constexpr int NMAIN = NB * SEQ, MTOK = NMAIN + NMETA, MP = 16640;
constexpr int DM = 1024, DINP = 2560, FF = 3584, NEXP = 8, DEPTH = 4;
constexpr int NCH = 33;
constexpr int UPN = 1792, UPK = 384;
constexpr int XS_ROWS = 35072;
constexpr float EPS = 1e-6f;
constexpr int NWAVES = 8;
#ifndef MK_MULTI
#define MK_MULTI 0
#endif

constexpr size_t MiB = 1u << 20;
constexpr size_t WS_CTL = 0, CTL_ZERO_BYTES = 2 * MiB;
constexpr size_t CTL_SSQ = 65536, CTL_SSKV = CTL_SSQ + (size_t)DEPTH * MP * 4;
static_assert(CTL_SSKV + (size_t)DEPTH * MP * 4 <= CTL_ZERO_BYTES, "ctl");
constexpr int CW_TMO = 0, CW_BAR = 4096, CW_CNT = 8192  , CW_QUEUE = 8320  , CW_SPLIT = 9216  ;
constexpr size_t WS_WIN = 2 * MiB;
constexpr size_t WS_WUP = WS_WIN + (size_t)DEPTH * DINP * DM * 2;
constexpr size_t WS_WOUT = WS_WUP + (size_t)DEPTH * UPN * UPK * 2;
constexpr size_t WS_WDGU = WS_WOUT + (size_t)DEPTH * DM * DM * 2;
constexpr size_t WS_WDD = WS_WDGU + (size_t)2 * 2 * FF * DM * 2;
constexpr size_t WS_WMGU = WS_WDD + (size_t)2 * DM * FF * 2;
constexpr size_t WS_WMD = WS_WMGU + (size_t)2 * NEXP * 2 * FF * DM * 2;
constexpr size_t WS_TAB = WS_WMD + (size_t)2 * NEXP * DM * FF * 2;
constexpr size_t TAB_RC = 0, TAB_RS = (size_t)LSEQ * 64 * 4, TAB_MC = 2 * TAB_RS, TAB_MS = TAB_MC + (size_t)LSEQ * 32 * 4;
constexpr size_t WS_HRES = WS_TAB + 2 * MiB;
constexpr size_t WS_XN = WS_HRES + (size_t)MP * DM * 4;
constexpr size_t WS_TOK = WS_XN + (size_t)MP * DM * 2;
constexpr size_t WS_SORT = WS_TOK + (size_t)MP * 32;
constexpr size_t WS_RS = WS_SORT, WS_RSS = WS_SORT + 262144;
constexpr size_t WS_WGCNT = WS_SORT + 524288;
constexpr size_t WS_XS = WS_SORT + 1 * MiB;
constexpr size_t WS_YS = WS_XS;
constexpr size_t WS_R = WS_XS + (size_t)XS_ROWS * DM * 2;
constexpr size_t R_RQ = 0, R_RK = R_RQ + (size_t)MP * 512 * 2, R_RKZ = R_RK + (size_t)MP * 512 * 2, R_RV = R_RKZ + (size_t)MP * 512 * 2, R_SG = R_RV + (size_t)MP * 512 * 2;
constexpr size_t R_LAT = R_SG + (size_t)MP * 512 * 2, R_KPE = R_LAT + (size_t)MP * 384 * 2;
constexpr size_t R_QN = R_KPE + (size_t)MP * 64 * 2, R_QPE = R_QN + (size_t)MP * 512 * 2, R_KN = R_QPE + (size_t)MP * 256 * 2, R_V = R_KN + (size_t)MP * 512 * 2;
constexpr size_t R_ST = R_V + (size_t)MP * 512 * 2;
constexpr size_t R_Y = R_ST + (size_t)NB * 4 * NCH * 128 * 128 * 2;
constexpr size_t R_MIX_END = R_Y + (size_t)MP * DM * 2;
constexpr size_t R_ACT = 0;
constexpr size_t R_END = ((size_t)XS_ROWS * FF * 2 > R_MIX_END) ? (size_t)XS_ROWS * FF * 2 : R_MIX_END;
constexpr int MOE_FULL_TILES = 128, MOE_KSPLIT = 4;
constexpr size_t WS_PART = WS_R + R_END;
constexpr size_t WS_END = WS_PART + (size_t)9 * MOE_KSPLIT * 256 * DM * 4;

constexpr int MOE_KSPLIT8 = 2;
constexpr float S_A8 = 8.0f, S_WD8 = 512.0f;
constexpr float S_W8 = 1016.0f;
constexpr int RING_BYTES = 131072, LDSCTL_OFF = RING_BYTES, MISC_OFF = LDSCTL_OFF + 320, LDS_BYTES = 147456;

#define GAS __attribute__((address_space(1)))
#define LAS __attribute__((address_space(3)))
typedef unsigned short bf16;
typedef unsigned v4u __attribute__((ext_vector_type(4)));
typedef unsigned v2u __attribute__((ext_vector_type(2)));
typedef float f32x4 __attribute__((ext_vector_type(4)));
typedef float f32x16 __attribute__((ext_vector_type(16)));
typedef short bf16x8 __attribute__((ext_vector_type(8)));
typedef short s16x4 __attribute__((ext_vector_type(4)));
typedef GAS unsigned gu32;
#define RLX_AGENT __ATOMIC_RELAXED, __HIP_MEMORY_SCOPE_AGENT
#define LDS_WAIT() asm volatile("s_waitcnt lgkmcnt(0)" ::: "memory")
#define VM_WAIT() asm volatile("s_waitcnt vmcnt(0)" ::: "memory")
__device__ __forceinline__ unsigned f2bf(float f) { unsigned u = __builtin_bit_cast(unsigned, f); return (u + 0x7fffu + ((u >> 16) & 1u)) >> 16; }
__device__ __forceinline__ unsigned pk2(float lo, float hi) { return pg8::cvt_pk_bf16(lo, hi); }
__device__ __forceinline__ v4u zero4() { unsigned z; asm volatile("v_mov_b32 %0, 0" : "=v"(z)); return (v4u){z, z, z, z}; }
__device__ __forceinline__ float bf2f(unsigned short b) { return __builtin_bit_cast(float, (unsigned)b << 16); }
template <int X> __device__ __forceinline__ float xshfl(float v) {
    if constexpr (X < 32) return __builtin_bit_cast(float, __builtin_amdgcn_ds_swizzle(__builtin_bit_cast(int, v), (X << 10) | 0x1f));
    else { const unsigned u = __builtin_bit_cast(unsigned, v); auto r = __builtin_amdgcn_permlane32_swap(u, u, false, false); const unsigned a = r[0], b = r[1]; return __builtin_bit_cast(float, a == u ? b : a); }
}
template <int X> __device__ __forceinline__ float xadd(float v) {
    if constexpr (X < 32) return v + xshfl<X>(v);
    else { const unsigned u = __builtin_bit_cast(unsigned, v); auto r = __builtin_amdgcn_permlane32_swap(u, u, false, false); return __builtin_bit_cast(float, (unsigned)r[0]) + __builtin_bit_cast(float, (unsigned)r[1]); }
}
__device__ __forceinline__ float wave_max(float v) { v = fmaxf(v, xshfl<1>(v)); v = fmaxf(v, xshfl<2>(v)); v = fmaxf(v, xshfl<4>(v)); v = fmaxf(v, xshfl<8>(v)); v = fmaxf(v, xshfl<16>(v)); v = fmaxf(v, xshfl<32>(v)); return v; }
__device__ __forceinline__ float wave_sum(float v) { v = xadd<1>(v); v = xadd<2>(v); v = xadd<4>(v); v = xadd<8>(v); v = xadd<16>(v); v = xadd<32>(v); return v; }
#define XB_TMO      128
#define XB_XCNT(j)  (256  + 64 * (j))
#define XB_XSUB(j)  (1280 + 64 * (j))
#define XB_XGEN(j)  (2304 + 64 * (j))
#define XB_TOP      3328
#define XB_TOPGEN   3392
#define XCD_BAR_WORDS 3456
#define XB_SPIN_CAP (1u << 18)

__device__ __forceinline__ unsigned xb_ld(unsigned* p)              { return __hip_atomic_load(p, __ATOMIC_RELAXED, __HIP_MEMORY_SCOPE_AGENT); }
__device__ __forceinline__ unsigned xb_add(unsigned* p, unsigned v) { return __hip_atomic_fetch_add(p, v, __ATOMIC_RELAXED, __HIP_MEMORY_SCOPE_AGENT); }
__device__ __forceinline__ unsigned xb_xcc_id() { return (unsigned)__builtin_amdgcn_s_getreg((3 << 11) | 20) & 0xFu; }
#define XB_SPIN(cond, bar) do { unsigned _sp = 0; while (cond) { __builtin_amdgcn_s_sleep(1); \
    if ((++_sp & 255u) == 0u) { if (xb_ld(&(bar)[XB_TMO])) break; if (_sp > XB_SPIN_CAP) { atomicAdd(&(bar)[XB_TMO], 1u); break; } } } } while (0)

struct XcdBarrier {
    unsigned* bar; unsigned x;
    volatile LAS unsigned* st;
};

__device__ __forceinline__ XcdBarrier xcd_barrier_post(unsigned* bar, volatile LAS unsigned* st) {
    XcdBarrier b; b.bar = bar; b.x = xb_xcc_id(); b.st = st;
    if (threadIdx.x == 0) (void)xb_add(&bar[XB_XCNT(b.x)], 1u);
    return b;
}
__device__ __forceinline__ void xcd_barrier_complete(unsigned* bar, unsigned x, unsigned& nloc, unsigned& nx) {
    const unsigned G = gridDim.x * gridDim.y * gridDim.z;
    unsigned sum, cnt, mine, sp = 0u;
    for (;;) {
        sum = 0u; cnt = 0u; mine = 0u;
#pragma unroll
        for (unsigned j = 0; j < 16; ++j) { const unsigned c = xb_ld(&bar[XB_XCNT(j)]); sum += c; cnt += (c > 0u) ? 1u : 0u; }
        mine = xb_ld(&bar[XB_XCNT(x)]);
        if (sum == G) break;
        __builtin_amdgcn_s_sleep(1);
        if ((++sp & 255u) == 0u) { if (xb_ld(&bar[XB_TMO])) break; if (sp > XB_SPIN_CAP) { atomicAdd(&bar[XB_TMO], 1u); break; } }
    }
    nloc = mine > 0u ? mine : 1u; nx = cnt > 0u ? cnt : 1u;
}

__device__ __forceinline__ void xcd_barrier(const XcdBarrier& b) {
    asm volatile("s_waitcnt vmcnt(0)" ::: "memory");
    __syncthreads();
    if (threadIdx.x == 0) {
        unsigned* bar = b.bar;
        __builtin_amdgcn_s_waitcnt(0);
        unsigned nloc = b.st[0], nx = b.st[1];
        if (nloc == 0u) { xcd_barrier_complete(bar, b.x, nloc, nx); b.st[0] = nloc; b.st[1] = nx; }
        const unsigned old = xb_add(&bar[XB_XSUB(b.x)], 1u);
        const unsigned gen = old / nloc;
        if (old + 1u == (gen + 1u) * nloc) {
            __builtin_amdgcn_fence(__ATOMIC_RELEASE, "agent");
            asm volatile("s_waitcnt vmcnt(0)" ::: "memory");
            const unsigned og = xb_add(&bar[XB_TOP], 1u);
            const unsigned tg = og / nx;
            if (og + 1u == (tg + 1u) * nx) xb_add(&bar[XB_TOPGEN], 1u);
            else XB_SPIN(xb_ld(&bar[XB_TOPGEN]) == tg, bar);
            __builtin_amdgcn_fence(__ATOMIC_ACQUIRE, "agent");
            xb_add(&bar[XB_XGEN(b.x)], 1u);
            asm volatile("s_waitcnt vmcnt(0)" ::: "memory");
        } else {
            XB_SPIN(xb_ld(&bar[XB_XGEN(b.x)]) == gen, bar);
            __builtin_amdgcn_fence(__ATOMIC_ACQUIRE, "agent");
            asm volatile("s_waitcnt vmcnt(0)" ::: "memory");
        }
    }
    __syncthreads();
}

struct Frame {
    LAS unsigned char* lds;
    volatile LAS unsigned* MISC;
    gu32* ctl;
    int tid, lane, wave, vcu, G;
    unsigned char* ws;
};
struct Inputs { const float* p[20]; };
__device__ __forceinline__ const float* ldin(int k) { unsigned long long v = 0;
#if defined(__HIP_DEVICE_COMPILE__)
    auto ka = __builtin_amdgcn_kernarg_segment_ptr();
    asm volatile("s_load_dwordx2 %0, %1, %2\n\ts_waitcnt lgkmcnt(0)" : "=s"(v) : "s"(ka), "n"(k * 8));
#endif
    return (const float*)v; }
enum { I_X = 0, I_META, I_ATTN_NORM, I_WIN, I_QNORM, I_WUQ, I_KVNORM, I_WUKV, I_RETG, I_MLAG, I_WOUT, I_FFNNORM, I_DWG, I_DWU, I_DWD, I_ROUTER, I_MWG, I_MWU, I_MWD, I_FINAL };

__device__ __forceinline__ int chunk_idx(int p) { return p < NMETA ? 48 + p : ((p - NMETA) & 63); }
__device__ __forceinline__ float log2_gamma(int h) { return h == 0 ? -0.045803689613124755f : h == 1 ? -0.022720076500083562f : h == 2 ? -0.011315313227834085f : -0.005646563141142062f; }

__device__ __forceinline__ void tr_load8(f32x4 (&v)[8], const float* Wcol, int ldw, int krow, const float* scale, float smul, int kr) {
#pragma unroll
    for (int i = 0; i < 8; ++i) v[i] = (f32x4){0.f, 0.f, 0.f, 0.f};
    if (Wcol) {
        const GAS float* src = (const GAS float*)Wcol + (size_t)(krow + 8 * kr) * ldw;
#pragma unroll
        for (int i = 0; i < 8; ++i) v[i] = __builtin_nontemporal_load((const GAS f32x4*)(src + (size_t)i * ldw));
        if (scale) { const f32x4 s0 = *(const GAS f32x4*)(scale + krow + 8 * kr) * smul, s1 = *(const GAS f32x4*)(scale + krow + 8 * kr + 4) * smul;
            v[0] *= s0.x; v[1] *= s0.y; v[2] *= s0.z; v[3] *= s0.w; v[4] *= s1.x; v[5] *= s1.y; v[6] *= s1.z; v[7] *= s1.w; }
    }
}
__device__ __forceinline__ void tr_store_bf16(const f32x4 (&v)[8], GAS bf16* dst, int Kdst) {
#pragma unroll
    for (int q = 0; q < 4; ++q) { v4u o; o.x = pk2(v[0][q], v[1][q]); o.y = pk2(v[2][q], v[3][q]); o.z = pk2(v[4][q], v[5][q]); o.w = pk2(v[6][q], v[7][q]);
        *(GAS v4u*)(dst + (size_t)q * Kdst) = o; }
}
__device__ __forceinline__ v2u tr_pack_q8(const f32x4 (&v)[8], int q) { unsigned lo = 0u, hi = 0u;
#pragma unroll
    for (int i = 0; i < 4; ++i) { const int a = (int)__builtin_rintf(fminf(fmaxf(v[i][q], -127.f), 127.f)), c = (int)__builtin_rintf(fminf(fmaxf(v[4 + i][q], -127.f), 127.f));
        lo |= (unsigned)(a & 255) << (8 * i); hi |= (unsigned)(c & 255) << (8 * i); }
    return (v2u){lo, hi}; }
__device__ __forceinline__ void transpose_item(const float* Wcol, int ldw, int krow0, const float* scale, bf16* WT, int Kdst, int k0dst, int n0, int lane) {
    const int sg = lane & 7, kr = lane >> 3; f32x4 v0[8], v1[8];
    tr_load8(v0, Wcol, ldw, krow0, scale, 1.0f, kr); tr_load8(v1, Wcol, ldw, krow0 + 64, scale, 1.0f, kr);
    GAS bf16* dst = (GAS bf16*)WT + (size_t)(n0 + 4 * sg) * Kdst + k0dst + 8 * kr;
    tr_store_bf16(v0, dst, Kdst); tr_store_bf16(v1, dst + 64, Kdst);
}
__device__ __forceinline__ void transpose_item_q8(const float* Wcol, int ldw, int krow0, const float* scale, unsigned char* WT, int Kdst, int k0dst, int n0, int lane) {
    const int sg = lane & 7, kr = lane >> 3; f32x4 v0[8], v1[8];
    tr_load8(v0, Wcol, ldw, krow0, scale, S_W8, 2 * kr); tr_load8(v1, Wcol, ldw, krow0 + 8, scale, S_W8, 2 * kr);
    GAS unsigned char* dst = (GAS unsigned char*)WT + (size_t)(n0 + 4 * sg) * Kdst + k0dst + 16 * kr;
#pragma unroll
    for (int q = 0; q < 4; ++q) { const v2u a = tr_pack_q8(v0, q), c = tr_pack_q8(v1, q); *(GAS v4u*)(dst + (size_t)q * Kdst) = (v4u){a.x, a.y, c.x, c.y}; }
}
__device__ __forceinline__ v2u tr_pack_f8(const f32x4 (&v)[8], int q) { float t[8];
#pragma unroll
    for (int i = 0; i < 8; ++i) t[i] = fminf(fmaxf(v[i][q] * S_WD8, -448.f), 448.f);
    int lo = __builtin_amdgcn_cvt_pk_fp8_f32(t[0], t[1], 0, false); lo = __builtin_amdgcn_cvt_pk_fp8_f32(t[2], t[3], lo, true);
    int hi = __builtin_amdgcn_cvt_pk_fp8_f32(t[4], t[5], 0, false); hi = __builtin_amdgcn_cvt_pk_fp8_f32(t[6], t[7], hi, true);
    return (v2u){(unsigned)lo, (unsigned)hi}; }
__device__ __forceinline__ void transpose_item_f8(const float* Wcol, int ldw, int krow0, unsigned char* WT, int Kdst, int k0dst, int n0, int lane) {
    const int sg = lane & 7, kr = lane >> 3; f32x4 v0[8], v1[8];
    tr_load8(v0, Wcol, ldw, krow0, nullptr, 1.0f, 2 * kr); tr_load8(v1, Wcol, ldw, krow0 + 8, nullptr, 1.0f, 2 * kr);
    GAS unsigned char* dst = (GAS unsigned char*)WT + (size_t)(n0 + 4 * sg) * Kdst + k0dst + 16 * kr;
#pragma unroll
    for (int q = 0; q < 4; ++q) { const v2u a = tr_pack_f8(v0, q), c = tr_pack_f8(v1, q); *(GAS v4u*)(dst + (size_t)q * Kdst) = (v4u){a.x, a.y, c.x, c.y}; }
}
__device__ __forceinline__ int slot_o8(int t) { return (t & 0x60) | ((t & 0xC) << 1) | ((t & 0x10) >> 2) | (t & 3); }
__device__ __forceinline__ int win_col(int s) {
    const int pn = s >> 8, t = s & 255, bj = t >> 7, t7 = t & 127, wc = (t >> 5) & 3, n = (t >> 4) & 1, fq = (t >> 2) & 3, i = t & 3;
    if (pn < 4) return (pn >> 1) * 512 + (2 * (pn & 1) + bj) * 128 + 16 * wc + 4 * fq + i + 64 * n;
    if (pn < 6) return 1024 + (pn & 1) * 256 + 128 * bj + slot_o8(t7);
    if (pn >= 8) return 1536 + (pn & 1) * 256 + 128 * bj + slot_o8(t7);
    if (pn == 6) return 2048 + 128 * bj + slot_o8(t7);
    if (bj == 0) return 2304 + slot_o8(t7);
    if (wc < 2) return 2432 + 16 * wc + 4 * fq + i + 32 * n;
    return -1;
}
__device__ __forceinline__ int wup_col(int s, bool& is_kv) {
    const int pn = s >> 8, t = s & 255, bj = t >> 7, t7 = t & 127, wc = (t >> 5) & 3, n = (t >> 4) & 1, fq = (t >> 2) & 3, i = t & 3;
    if (pn < 2) { is_kv = false; const int o = 256 * pn + 128 * bj + slot_o8(t7); return (o >> 7) * 192 + (o & 127); }
    if (pn == 2) { is_kv = false; const int hq = 2 * bj + (wc >> 1); return hq * 192 + 128 + 16 * (wc & 1) + 4 * fq + i + 32 * n; }
    is_kv = true;
    if (pn < 5) { const int o = 256 * (pn - 3) + 128 * bj + slot_o8(t7); return (o >> 7) * 256 + (o & 127); }
    { const int o = 256 * (pn - 5) + 128 * bj + slot_o8(t7); return (o >> 7) * 256 + 128 + (o & 127); }
}
__device__ __forceinline__ void sincos_d(double x, float& s, float& c) {
    const double k = __builtin_rint(x * 0.63661977236758134308);
    const double y = (x - k * 1.5707963267948966) - k * 6.123233995736766e-17;
    const double y2 = y * y;
    const double sn = y * (1.0 + y2 * (-1.0 / 6 + y2 * (1.0 / 120 + y2 * (-1.0 / 5040 + y2 * (1.0 / 362880 + y2 * (-1.0 / 39916800 + y2 * (1.0 / 6227020800.0)))))));
    const double cs = 1.0 + y2 * (-0.5 + y2 * (1.0 / 24 + y2 * (-1.0 / 720 + y2 * (1.0 / 40320 + y2 * (-1.0 / 3628800 + y2 * (1.0 / 479001600.0 + y2 * (-1.0 / 87178291200.0)))))));
    const int q = (int)((long long)k & 3);
    const double ss = (q & 1) ? cs : sn, cc = (q & 1) ? sn : cs;
    s = (float)((q & 2) ? -ss : ss); c = (float)(((q + 1) & 2) ? -cc : cc);
}
__device__ __forceinline__ float row_rstd(const f32x4 (&v)[4]);
__device__ __forceinline__ void store_xq(Frame& F, int r, const f32x4 (&v)[4], float rstd);
__device__ __forceinline__ void p0_prologue(Frame& F) {
    const int gw = F.vcu * NWAVES + F.wave, NGW = F.G * NWAVES, lane = F.lane;
    float* hres = (float*)(F.ws + WS_HRES);
    for (int r = gw; r < MP; r += NGW) {
        GAS f32x4* o = (GAS f32x4*)(hres + (size_t)r * DM) + lane;
        if (r < MTOK) {
            const GAS f32x4* src = (const GAS f32x4*)(r < NMAIN ? ldin(I_X) + (size_t)r * DM : ldin(I_META) + (size_t)(r - NMAIN) * DM) + lane;
            f32x4 v[4];
#pragma unroll
            for (int j = 0; j < 4; ++j) v[j] = src[64 * j];
#pragma unroll
            for (int j = 0; j < 4; ++j) o[64 * j] = v[j];
            store_xq(F, r, v, row_rstd(v)); }
        else {
#pragma unroll
            for (int j = 0; j < 4; ++j) o[64 * j] = (f32x4){0.f, 0.f, 0.f, 0.f}; }
    }
    { float* tab = (float*)(F.ws + WS_TAB);
      const int gt = gw * 64 + lane, NT = NGW * 64;
      for (int t = gt; t < LSEQ * 64; t += NT) { const int p = t >> 6, i = t & 63; const float inv = exp2f(-(float)(2 * i) * (13.287712379549449f / 128.0f)); const float ang = (float)p * inv;
          float s, c; sincos_d((double)ang, s, c); tab[TAB_RC / 4 + t] = c; tab[TAB_RS / 4 + t] = s; }
      for (int t = gt; t < LSEQ * 32; t += NT) { const int p = t >> 5, i = t & 31; const float inv = exp2f(-(float)(2 * i) * (13.287712379549449f / 64.0f)); const float ang = (float)p * inv;
          float s, c; sincos_d((double)ang, s, c); tab[TAB_MC / 4 + t] = c; tab[TAB_MS / 4 + t] = s; }
    }
    constexpr int I_IN = DEPTH * 8 * 80, I_UP = DEPTH * 3 * 56, I_OUT = DEPTH * 8 * 32, I_DGU = 2 * 8 * 224, I_DD = 2 * 28 * 32, I_MGU = 16 * 8 * 224, I_MD = 16 * 28 * 32;
    constexpr int NITEMS = I_IN + I_UP + I_OUT + I_DGU + I_DD + I_MGU + I_MD;
    for (int it = gw; it < NITEMS; it += NGW) {
        int r = it;
        if (r < I_IN) { const int l = r / 640, q = r % 640, kb = q / 80, nb = q % 80; const int col = win_col(nb * 32 + 4 * (lane & 7));
            const float* W = ldin(I_WIN) + (size_t)l * DM * 2496;
            transpose_item_q8(col >= 0 ? W + col : nullptr, 2496, kb * 128, ldin(I_ATTN_NORM) + l * DM, F.ws + WS_WIN + (size_t)l * DINP * DM, DM, kb * 128, nb * 32, lane); continue; }
        r -= I_IN;
        if (r < I_UP) { const int l = r / 168, q = r % 168, kb = q / 56, nb = q % 56; bool is_kv; const int col = wup_col(nb * 32 + 4 * (lane & 7), is_kv);
            const float* Wc = nullptr; const float* sc = nullptr; int ldw = 0, k0 = 0;
            if (!is_kv && kb < 2) { Wc = ldin(I_WUQ) + (size_t)l * 256 * 768 + col; sc = ldin(I_QNORM) + l * 256; ldw = 768; k0 = kb * 128; }
            if (is_kv && kb >= 2) { Wc = ldin(I_WUKV) + (size_t)l * 128 * 1024 + col; sc = ldin(I_KVNORM) + l * 128; ldw = 1024; k0 = (kb - 2) * 128; }
            transpose_item(Wc, ldw, k0, sc, (bf16*)(F.ws + WS_WUP) + (size_t)l * UPN * UPK, UPK, kb * 128, nb * 32, lane); continue; }
        r -= I_UP;
        if (r < I_OUT) { const int l = r / 256, q = r % 256, kb = q / 32, nb = q % 32;
            transpose_item(ldin(I_WOUT) + (size_t)l * DM * DM + nb * 32 + 4 * (lane & 7), DM, kb * 128, nullptr, (bf16*)(F.ws + WS_WOUT) + (size_t)l * DM * DM, DM, kb * 128, nb * 32, lane); continue; }
        r -= I_OUT;
        if (r < I_DGU + 0) { const int l = r / 1792, q = r % 1792, kb = q / 224, nb = q % 224; const int s = nb * 32 + 4 * (lane & 7), pn = s >> 8, t = s & 255;
            const float* W = ((t >> 7) ? ldin(I_DWU) : ldin(I_DWG)) + (size_t)l * DM * FF + 128 * pn + slot_o8(t & 127);
            transpose_item_q8(W, FF, kb * 128, ldin(I_FFNNORM) + (2 * l) * DM, F.ws + WS_WDGU + (size_t)l * 2 * FF * DM, DM, kb * 128, nb * 32, lane); continue; }
        r -= I_DGU;
        if (r < I_DD) { const int l = r / 896, q = r % 896, kb = q / 32, nb = q % 32;
            transpose_item_f8(ldin(I_DWD) + (size_t)l * FF * DM + nb * 32 + 4 * (lane & 7), DM, kb * 128, F.ws + WS_WDD + (size_t)l * DM * FF, FF, kb * 128, nb * 32, lane); continue; }
        r -= I_DD;
        if (r < I_MGU) { const int le = r / 1792, q = r % 1792, kb = q / 224, nb = q % 224; const int s = nb * 32 + 4 * (lane & 7), pn = s >> 8, t = s & 255;
            const float* W = ((t >> 7) ? ldin(I_MWU) : ldin(I_MWG)) + (size_t)le * DM * FF + 128 * pn + slot_o8(t & 127);
            transpose_item_q8(W, FF, kb * 128, ldin(I_FFNNORM) + (2 * (le >> 3) + 1) * DM, F.ws + WS_WMGU + (size_t)le * 2 * FF * DM, DM, kb * 128, nb * 32, lane); continue; }
        r -= I_MGU;
        { const int le = r / 896, q = r % 896, kb = q / 32, nb = q % 32;
            transpose_item_f8(ldin(I_MWD) + (size_t)le * FF * DM + nb * 32 + 4 * (lane & 7), DM, kb * 128, F.ws + WS_WMD + (size_t)le * DM * FF, FF, kb * 128, nb * 32, lane); }
    }
}

typedef pg8::f32x4 af4;
__device__ __forceinline__ v4u pack8(af4 a, af4 b) { v4u w; w.x = pk2(a[0], a[1]); w.y = pk2(a[2], a[3]); w.z = pk2(b[0], b[1]); w.w = pk2(b[2], b[3]); return w; }
__device__ __forceinline__ float silu_f(float x) { return x * __builtin_amdgcn_rcpf(1.0f + __builtin_amdgcn_exp2f(-1.4426950408889634f * x)); }
__device__ __forceinline__ float sumsq8(af4 a, af4 c) { return (a[0] * a[0] + a[1] * a[1]) + (a[2] * a[2] + a[3] * a[3]) + (c[0] * c[0] + c[1] * c[1]) + (c[2] * c[2] + c[3] * c[3]); }
__device__ __forceinline__ int row_pos(int row) { return row < NMAIN ? NMETA + (row & (SEQ - 1)) : ((row - NMAIN) & (NMETA - 1)); }
__device__ __forceinline__ af4 cvt_i8acc(af4 a, float sc) { return __builtin_convertvector(__builtin_bit_cast(pg8::i32x4, a), af4) * sc; }
#define EPI_MAIN_LOOP()                                                                                                                               \
    const float* rs = nullptr;                                                                 \
    __device__ __forceinline__ void operator()(const af4 (&acc)[2][2][4][2], const pg8::Unit& u, int wr, int wc, int fr, int fq) const {             \
        float rsl[8];                                                 \
        if (rs) { _Pragma("unroll") for (int ai = 0; ai < 2; ++ai) _Pragma("unroll") for (int m = 0; m < 4; ++m) rsl[ai * 4 + m] = rs[u.pm * 256 + ai * 128 + wr * 64 + m * 16 + fr]; } \
        _Pragma("unroll") for (int ai = 0; ai < 2; ++ai) _Pragma("unroll") for (int m = 0; m < 4; ++m) {                                             \
            const int r_ = u.pm * 256 + ai * 128 + wr * 64 + m * 16 + fr;                                                                            \
            af4 a00 = acc[ai][0][m][0], a01 = acc[ai][0][m][1], a10 = acc[ai][1][m][0], a11 = acc[ai][1][m][1];                                      \
            if (rs) { const float sc = rsl[ai * 4 + m]; a00 = cvt_i8acc(a00, sc); a01 = cvt_i8acc(a01, sc); a10 = cvt_i8acc(a10, sc); a11 = cvt_i8acc(a11, sc); } \
            row(r_, u.pn, wc, fq, a00, a01, a10, a11);                                                                                               \
            if (m == 3) asm volatile("" ::: "memory"); } }

struct EpiInProj {
    static constexpr bool PERM = false, AFTER_DRAIN = false, PRE_RS = false;
    unsigned char* R; float* ssq; float* sskv; const float* tab; float lg0, lg1, lg2, lg3; int pn0;
    __device__ __forceinline__ void row(int row, int pn, int wc, int fq, af4 a00, af4 a01, af4 a10, af4 a11) const {
        pn += pn0; const int pp = row_pos(row);
        if (pn < 4) {
            const af4 cs = *(const af4*)(tab + TAB_RC / 4 + pp * 64 + 16 * wc + 4 * fq), sn = *(const af4*)(tab + TAB_RS / 4 + pp * 64 + 16 * wc + 4 * fq);
            const size_t off = ((size_t)row * 512 + (2 * (pn & 1)) * 128 + 32 * wc + 8 * fq) * 2;
            af4 o1 = a00 * cs - a01 * sn, o2 = a00 * sn + a01 * cs, o3 = a10 * cs - a11 * sn, o4 = a10 * sn + a11 * cs;
            if (pn < 2) { o1 *= 0.08838834764831845f; o2 *= 0.08838834764831845f; o3 *= 0.08838834764831845f; o4 *= 0.08838834764831845f;
                *(v4u*)(R + R_RQ + off) = pack8(o1, o2); *(v4u*)(R + R_RQ + off + 256) = pack8(o3, o4); }
            else { *(v4u*)(R + R_RK + off) = pack8(o1, o2); *(v4u*)(R + R_RK + off + 256) = pack8(o3, o4);
                const float e = (float)(63 - chunk_idx(pp)); const float z0 = __builtin_amdgcn_exp2f(((pn & 1) ? lg2 : lg0) * e), z1 = __builtin_amdgcn_exp2f(((pn & 1) ? lg3 : lg1) * e);
                *(v4u*)(R + R_RKZ + off) = pack8(o1 * z0, o2 * z0); *(v4u*)(R + R_RKZ + off + 256) = pack8(o3 * z1, o4 * z1); }
        } else if (pn < 6) {
            const size_t off = ((size_t)row * 512 + (pn & 1) * 256 + 32 * wc + 8 * fq) * 2;
            *(v4u*)(R + R_RV + off) = pack8(a00, a01); *(v4u*)(R + R_RV + off + 256) = pack8(a10, a11);
        } else if (pn >= 8) {
            const size_t off = ((size_t)row * 512 + (pn & 1) * 256 + 32 * wc + 8 * fq) * 2;
#pragma unroll
            for (int j = 0; j < 4; ++j) { a00[j] = silu_f(a00[j]); a01[j] = silu_f(a01[j]); a10[j] = silu_f(a10[j]); a11[j] = silu_f(a11[j]); }
            *(v4u*)(R + R_SG + off) = pack8(a00, a01); *(v4u*)(R + R_SG + off + 256) = pack8(a10, a11);
        } else if (pn == 6) {
            const size_t off = ((size_t)row * 384 + 32 * wc + 8 * fq) * 2;
            *(v4u*)(R + R_LAT + off) = pack8(a00, a01); *(v4u*)(R + R_LAT + off + 256) = pack8(a10, a11);
            float s = sumsq8(a00, a01) + sumsq8(a10, a11); s = xadd<16>(s); s = xadd<32>(s);
            if (fq == 0) ssq[row * 4 + wc] = s;
        } else {
            *(v4u*)(R + R_LAT + ((size_t)row * 384 + 256 + 32 * wc + 8 * fq) * 2) = pack8(a00, a01);
            float s = sumsq8(a00, a01); s = xadd<16>(s); s = xadd<32>(s);
            if (fq == 0) sskv[row * 4 + wc] = s;
            if (wc < 2) { const af4 cs = *(const af4*)(tab + TAB_MC / 4 + pp * 32 + 16 * wc + 4 * fq), sn = *(const af4*)(tab + TAB_MS / 4 + pp * 32 + 16 * wc + 4 * fq);
                *(v4u*)(R + R_KPE + ((size_t)row * 64 + 32 * wc + 8 * fq) * 2) = pack8(a10 * cs - a11 * sn, a10 * sn + a11 * cs); }
        }
    }
    EPI_MAIN_LOOP()
};
struct EpiGate {
    static constexpr bool PERM = false, AFTER_DRAIN = false, PRE_RS = false;
    unsigned char* SG;
    __device__ __forceinline__ void row(int row, int pn, int wc, int fq, af4 a00, af4 a01, af4 a10, af4 a11) const {
        const size_t off = ((size_t)row * 512 + pn * 256 + 32 * wc + 8 * fq) * 2;
#pragma unroll
        for (int j = 0; j < 4; ++j) { a00[j] = silu_f(a00[j]); a01[j] = silu_f(a01[j]); a10[j] = silu_f(a10[j]); a11[j] = silu_f(a11[j]); }
        *(v4u*)(SG + off) = pack8(a00, a01); *(v4u*)(SG + off + 256) = pack8(a10, a11);
    }
    EPI_MAIN_LOOP()
};
constexpr float QSCALE = 0.07216878364870323f * 1.4426950408889634f;
struct EpiUp {
    static constexpr bool PERM = false, AFTER_DRAIN = false, PRE_RS = false;
    unsigned char* R; const float* ssq; const float* sskv; const float* tab;
    __device__ __forceinline__ void row(int row, int pn, int wc, int fq, af4 a00, af4 a01, af4 a10, af4 a11) const {
        if (pn < 3) { const af4 q4 = *(const af4*)(ssq + row * 4); const float sc = QSCALE * __builtin_amdgcn_rsqf(((q4[0] + q4[1]) + (q4[2] + q4[3])) * (1.0f / 256.0f) + EPS);
            a00 *= sc; a01 *= sc; a10 *= sc; a11 *= sc;
            if (pn < 2) { const size_t off = ((size_t)row * 512 + 256 * pn + 32 * wc + 8 * fq) * 2;
                *(v4u*)(R + R_QN + off) = pack8(a00, a01); *(v4u*)(R + R_QN + off + 256) = pack8(a10, a11);
            } else { const int pp = row_pos(row);
                const af4 cs = *(const af4*)(tab + TAB_MC / 4 + pp * 32 + 16 * (wc & 1) + 4 * fq), sn = *(const af4*)(tab + TAB_MS / 4 + pp * 32 + 16 * (wc & 1) + 4 * fq);
                const size_t off = ((size_t)row * 256 + (wc >> 1) * 64 + 32 * (wc & 1) + 8 * fq) * 2;
                *(v4u*)(R + R_QPE + off) = pack8(a00 * cs - a01 * sn, a00 * sn + a01 * cs); *(v4u*)(R + R_QPE + off + 256) = pack8(a10 * cs - a11 * sn, a10 * sn + a11 * cs); }
        } else { const af4 q4 = *(const af4*)(sskv + row * 4); const float sc = __builtin_amdgcn_rsqf(((q4[0] + q4[1]) + (q4[2] + q4[3])) * (1.0f / 128.0f) + EPS);
            const size_t off = (pn < 5 ? R_KN : R_V) + ((size_t)row * 512 + 256 * (pn < 5 ? pn - 3 : pn - 5) + 32 * wc + 8 * fq) * 2;
            *(v4u*)(R + off) = pack8(a00 * sc, a01 * sc); *(v4u*)(R + off + 256) = pack8(a10 * sc, a11 * sc);
        }
    }
    EPI_MAIN_LOOP()
};
struct EpiResid {
    static constexpr bool PERM = false, AFTER_DRAIN = false, PRE_RS = false;
    float* H; float sc;
    __device__ __forceinline__ void row(int row, int pn, int wc, int fq, af4 a00, af4 a01, af4 a10, af4 a11) const {
        af4* q = (af4*)(H + (size_t)row * DM + pn * 256 + wc * 32 + 4 * fq);
        q[0] = q[0] + a00 * sc; q[4] = q[4] + a01 * sc; q[32] = q[32] + a10 * sc; q[36] = q[36] + a11 * sc;
    }
    EPI_MAIN_LOOP()
};
struct EpiSwiGLU {
    static constexpr bool PERM = false, AFTER_DRAIN = false, PRE_RS = true;
    bf16* A;
    __device__ __forceinline__ void row(int row, int pn, int wc, int fq, af4 a00, af4 a01, af4 a10, af4 a11) const {
#pragma unroll
        for (int j = 0; j < 4; ++j) { a00[j] = silu_f(a00[j]) * a10[j]; a01[j] = silu_f(a01[j]) * a11[j]; }
        if (f8) { float t[8];
#pragma unroll
            for (int j = 0; j < 4; ++j) { t[j] = fminf(fmaxf(a00[j] * S_A8, -448.f), 448.f); t[4 + j] = fminf(fmaxf(a01[j] * S_A8, -448.f), 448.f); }
            int lo = __builtin_amdgcn_cvt_pk_fp8_f32(t[0], t[1], 0, false); lo = __builtin_amdgcn_cvt_pk_fp8_f32(t[2], t[3], lo, true);
            int hi = __builtin_amdgcn_cvt_pk_fp8_f32(t[4], t[5], 0, false); hi = __builtin_amdgcn_cvt_pk_fp8_f32(t[6], t[7], hi, true);
            *(v2u*)((unsigned char*)A + (size_t)row * FF + pn * 128 + wc * 32 + 8 * fq) = (v2u){(unsigned)lo, (unsigned)hi}; }
        else *(v4u*)(A + (size_t)row * FF + pn * 128 + wc * 32 + 8 * fq) = pack8(a00, a01);
    }
    typedef float f2v __attribute__((ext_vector_type(2)));
    __device__ __forceinline__ af4 swi_i8(af4 gi, af4 ui, float c1, float sc2) const {
        const pg8::i32x4 g4 = __builtin_bit_cast(pg8::i32x4, gi), u4 = __builtin_bit_cast(pg8::i32x4, ui); af4 o;
#pragma unroll
        for (int h = 0; h < 2; ++h) { const f2v g = {(float)g4[2 * h], (float)g4[2 * h + 1]}, u = {(float)u4[2 * h], (float)u4[2 * h + 1]};
            const f2v t = g * c1, p = (g * u) * sc2; f2v d; d.x = __builtin_amdgcn_exp2f(t.x); d.y = __builtin_amdgcn_exp2f(t.y); d = d + 1.0f;
            o[2 * h] = p.x * __builtin_amdgcn_rcpf(d.x); o[2 * h + 1] = p.y * __builtin_amdgcn_rcpf(d.y); }
        return o; }
    const float* rs = nullptr; int f8 = 0;
    __device__ __forceinline__ void pre(const pg8::Unit& u, LAS unsigned char* buf, int wid, int lane) const {
        if (wid < 4) __builtin_amdgcn_global_load_lds((const GAS unsigned*)(rs + u.pm * 256 + wid * 64 + lane), (LAS unsigned*)(buf + wid * 256), 4, 0, 0); }
    __device__ __forceinline__ void operator()(const af4 (&acc)[2][2][4][2], const pg8::Unit& u, int wr, int wc, int fr, int fq, const LAS unsigned char* buf) const {
        float rsl[8];
#pragma unroll
        for (int i = 0; i < 8; ++i) rsl[i] = *(const LAS float*)(buf + ((i >> 2) * 128 + wr * 64 + (i & 3) * 16 + fr) * 4);
#pragma unroll
        for (int ai = 0; ai < 2; ++ai)
#pragma unroll
            for (int m = 0; m < 4; ++m) { const int r_ = u.pm * 256 + ai * 128 + wr * 64 + m * 16 + fr;
                if (rs) { const float sc = rsl[ai * 4 + m], c1 = -1.4426950408889634f * sc, sc2 = sc * sc * (f8 ? S_A8 : 1.0f);
                    const af4 o0 = swi_i8(acc[ai][0][m][0], acc[ai][1][m][0], c1, sc2), o1 = swi_i8(acc[ai][0][m][1], acc[ai][1][m][1], c1, sc2);
                    if (f8) { float t[8];
#pragma unroll
                        for (int j = 0; j < 4; ++j) { t[j] = fminf(fmaxf(o0[j], -448.f), 448.f); t[4 + j] = fminf(fmaxf(o1[j], -448.f), 448.f); }
                        int lo = __builtin_amdgcn_cvt_pk_fp8_f32(t[0], t[1], 0, false); lo = __builtin_amdgcn_cvt_pk_fp8_f32(t[2], t[3], lo, true);
                        int hi = __builtin_amdgcn_cvt_pk_fp8_f32(t[4], t[5], 0, false); hi = __builtin_amdgcn_cvt_pk_fp8_f32(t[6], t[7], hi, true);
                        *(v2u*)((unsigned char*)A + (size_t)r_ * FF + u.pn * 128 + wc * 32 + 8 * fq) = (v2u){(unsigned)lo, (unsigned)hi}; }
                    else *(v4u*)(A + (size_t)r_ * FF + u.pn * 128 + wc * 32 + 8 * fq) = pack8(o0, o1); }
                else row(r_, u.pn, wc, fq, acc[ai][0][m][0], acc[ai][0][m][1], acc[ai][1][m][0], acc[ai][1][m][1]); }
    }
};
struct EpiMoeDown {
    static constexpr bool PERM = false, AFTER_DRAIN = false, PRE_RS = false;
    bf16* Y; float sc;
    __device__ __forceinline__ void row(int row, int pn, int wc, int fq, af4 a00, af4 a01, af4 a10, af4 a11) const {
        a00 *= sc; a01 *= sc; a10 *= sc; a11 *= sc;
        v2u* q = (v2u*)(Y + (size_t)row * DM + pn * 256 + wc * 32 + 4 * fq);
        q[0] = (v2u){pk2(a00[0], a00[1]), pk2(a00[2], a00[3])}; q[4] = (v2u){pk2(a01[0], a01[1]), pk2(a01[2], a01[3])};
        q[32] = (v2u){pk2(a10[0], a10[1]), pk2(a10[2], a10[3])}; q[36] = (v2u){pk2(a11[0], a11[1]), pk2(a11[2], a11[3])};
    }
    EPI_MAIN_LOOP()
};

struct EpiNone {
    static constexpr bool PERM = false, AFTER_DRAIN = false, PRE_RS = false;
    __device__ __forceinline__ void operator()(const af4 (&acc)[2][2][4][2], const pg8::Unit&, int, int, int, int) const {
#pragma unroll
        for (int ai = 0; ai < 2; ++ai)
#pragma unroll
            for (int m = 0; m < 4; ++m) asm volatile("" :: "v"(acc[ai][0][m][0]), "v"(acc[ai][0][m][1]), "v"(acc[ai][1][m][0]), "v"(acc[ai][1][m][1])); }
};
struct EpiPartial {
    static constexpr bool PERM = false, AFTER_DRAIN = false, PRE_RS = false;
    float* P; unsigned kbytes; int ks; float sc;
    __device__ __forceinline__ void operator()(const af4 (&acc)[2][2][4][2], const pg8::Unit& u, int wr, int wc, int fr, int fq) const {
        const int tile = (u.pm - MOE_FULL_TILES) * ks + (int)(u.koff / kbytes);
#pragma unroll
        for (int ai = 0; ai < 2; ++ai)
#pragma unroll
            for (int m = 0; m < 4; ++m) { af4* q = (af4*)(P + ((size_t)tile * 256 + ai * 128 + wr * 64 + m * 16 + fr) * DM + u.pn * 256 + wc * 32 + 4 * fq);
                q[0] = acc[ai][0][m][0] * sc; q[4] = acc[ai][0][m][1] * sc; q[32] = acc[ai][1][m][0] * sc; q[36] = acc[ai][1][m][1] * sc; }
    }
};

template <class Epi, int QM> __device__ __forceinline__ void meta_item(LAS unsigned char* lds, const unsigned char* A16, const unsigned char* Bt, int Kb, int item, const Epi& E) {
    int tid_ = threadIdx.x; asm volatile("" : "+v"(tid_));
    const int lane = tid_ & 63, w = __builtin_amdgcn_readfirstlane(tid_ >> 6), fr = lane & 15, fq = lane >> 4, pn = item >> 2, wc = item & 3;
    const int steps = Kb >> 6, spw = (steps + 7) >> 3, s0 = w * spw, s1 = (s0 + spw) < steps ? (s0 + spw) : steps;
    af4 acc[2][2];
#pragma unroll
    for (int bj = 0; bj < 2; ++bj)
#pragma unroll
        for (int n = 0; n < 2; ++n) acc[bj][n] = (af4){0.f, 0.f, 0.f, 0.f};
    const GAS unsigned char* ap = (const GAS unsigned char*)A16 + (size_t)fr * Kb + 16 * fq;
    const GAS unsigned char* bp = (const GAS unsigned char*)Bt + ((size_t)pn * 256 + 32 * wc + fr) * Kb + 16 * fq;
    for (int s = s0; s < s1; s += 4) {
        bf16x8 a[4], b[4][4];
#pragma unroll
        for (int g = 0; g < 4; ++g) if (s + g < s1) { a[g] = *(const GAS bf16x8*)(ap + 64 * (s + g));
#pragma unroll
            for (int f = 0; f < 4; ++f) b[g][f] = *(const GAS bf16x8*)(bp + (size_t)(128 * (f >> 1) + 16 * (f & 1)) * Kb + 64 * (s + g)); }
#pragma unroll
        for (int g = 0; g < 4; ++g) if (s + g < s1) {
#pragma unroll
            for (int f = 0; f < 4; ++f) {
                if constexpr (QM == 2) { typedef long l2v __attribute__((ext_vector_type(2))); const l2v bb = __builtin_bit_cast(l2v, b[g][f]), aa = __builtin_bit_cast(l2v, a[g]);
                    acc[f >> 1][f & 1] = __builtin_amdgcn_mfma_f32_16x16x32_fp8_fp8(bb[0], aa[0], acc[f >> 1][f & 1], 0, 0, 0); acc[f >> 1][f & 1] = __builtin_amdgcn_mfma_f32_16x16x32_fp8_fp8(bb[1], aa[1], acc[f >> 1][f & 1], 0, 0, 0); }
                else acc[f >> 1][f & 1] = pg8::mma16<QM == 1>(b[g][f], a[g], acc[f >> 1][f & 1]); } }
    }
    if (QM == 1) {
#pragma unroll
        for (int f = 0; f < 4; ++f) acc[f >> 1][f & 1] = __builtin_convertvector(__builtin_bit_cast(pg8::i32x4, acc[f >> 1][f & 1]), af4); }
    LAS af4* red = (LAS af4*)lds + (w * 64 + lane) * 4;
    red[0] = acc[0][0]; red[1] = acc[0][1]; red[2] = acc[1][0]; red[3] = acc[1][1];
    __syncthreads();
    if (w == 0) {
#pragma unroll
        for (int ww = 1; ww < 8; ++ww) { const LAS af4* r = (const LAS af4*)lds + (ww * 64 + lane) * 4; acc[0][0] += r[0]; acc[0][1] += r[1]; acc[1][0] += r[2]; acc[1][1] += r[3]; }
        if (QM == 1) { const float sc = E.rs[NMAIN + fr]; acc[0][0] *= sc; acc[0][1] *= sc; acc[1][0] *= sc; acc[1][1] *= sc; }
        E.row(NMAIN + fr, pn, wc, fq, acc[0][0], acc[0][1], acc[1][0], acc[1][1]);
    }
    __syncthreads();
}
template <class Epi, int QM = 0> __device__ __forceinline__ void meta_gemm(Frame& F, const void* A16, const void* Bt, int N, int Kb, const Epi& E) {
    const int nit = (N >> 8) * 4;
    for (int it = F.G - 1 - (int)blockIdx.x; it < nit; it += F.G) meta_item<Epi, QM>(F.lds, (const unsigned char*)A16, (const unsigned char*)Bt, Kb, it, E);
}

__device__ __forceinline__ int expert_base(const unsigned* cnt, int e) { int acc = 0;
#pragma unroll
    for (int k = 0; k < 7; ++k) acc += (k < e) ? (int)((cnt[k] + 255u) & ~255u) : 0;
    return acc; }
__device__ __forceinline__ void issue_row(const float* hres, int r, int lane, f32x4 (&v)[4]) { const GAS f32x4* xr = (const GAS f32x4*)(hres + (size_t)r * DM) + lane;
#pragma unroll
    for (int j = 0; j < 4; ++j) v[j] = xr[64 * j]; }
template <int KS = MOE_KSPLIT8, bool PRE = false> __device__ __forceinline__ void load_row(Frame& F, float* hres, int r, bool moe_prev, const unsigned* cnt, f32x4 (&v)[4]) {
    GAS f32x4* xr = (GAS f32x4*)(hres + (size_t)r * DM) + F.lane;
    if (!PRE) {
#pragma unroll
    for (int j = 0; j < 4; ++j) v[j] = xr[64 * j]; }
    if (moe_prev) {
        const int* ti = (const int*)(F.ws + WS_TOK) + (size_t)r * 8; const int e1 = ti[0], e2 = ti[1], s1 = ti[2], s2 = ti[3]; const float w1 = __builtin_bit_cast(float, ti[4]), w2 = __builtin_bit_cast(float, ti[5]);
        const int r1 = s1, r2 = s2;
#pragma unroll
        for (int k = 0; k < 2; ++k) { const int rr = k ? r2 : r1; const float ww = k ? w2 : w1;
            if (rr < MOE_FULL_TILES * 256) { const GAS v2u* y = (const GAS v2u*)((const bf16*)(F.ws + WS_YS) + (size_t)rr * DM) + F.lane;
#pragma unroll
                for (int j = 0; j < 4; ++j) { const v2u a = y[64 * j];
                    v[j].x += ww * __builtin_bit_cast(float, a.x << 16); v[j].y += ww * __builtin_bit_cast(float, a.x & 0xffff0000u); v[j].z += ww * __builtin_bit_cast(float, a.y << 16); v[j].w += ww * __builtin_bit_cast(float, a.y & 0xffff0000u); }
            } else {
                const GAS f32x4* p = (const GAS f32x4*)((const float*)(F.ws + WS_PART) + ((size_t)((rr >> 8) - MOE_FULL_TILES) * KS * 256 + (rr & 255)) * DM) + F.lane;
#pragma unroll
                for (int j = 0; j < 4; ++j) { f32x4 s = p[64 * j];
#pragma unroll
                    for (int kc = 1; kc < KS; ++kc) s += p[(size_t)kc * 256 * (DM / 4) + 64 * j];
                    v[j] += s * ww; } } }
#pragma unroll
        for (int j = 0; j < 4; ++j) {
            xr[64 * j] = v[j]; }
    }
}
__device__ __forceinline__ float row_rstd(const f32x4 (&v)[4]) { float s = 0.f;
#pragma unroll
    for (int j = 0; j < 4; ++j) s += (v[j].x * v[j].x + v[j].y * v[j].y) + (v[j].z * v[j].z + v[j].w * v[j].w);
    return __builtin_amdgcn_rsqf(wave_sum(s) * (1.0f / DM) + EPS); }
__device__ __forceinline__ void store_xn(Frame& F, int r, const f32x4 (&v)[4], float rstd) {
    GAS v2u* o = (GAS v2u*)((bf16*)(F.ws + WS_XN) + (size_t)r * DM) + F.lane;
#pragma unroll
    for (int j = 0; j < 4; ++j) { v2u w; w.x = pk2(v[j].x * rstd, v[j].y * rstd); w.y = pk2(v[j].z * rstd, v[j].w * rstd); o[64 * j] = w; }
}
__device__ __forceinline__ void store_xq(Frame& F, int r, const f32x4 (&v)[4], float rstd) {
    float amax = 0.f;
#pragma unroll
    for (int j = 0; j < 4; ++j) amax = fmaxf(fmaxf(amax, fmaxf(fabsf(v[j].x), fabsf(v[j].y))), fmaxf(fabsf(v[j].z), fabsf(v[j].w)));
    amax = fmaxf(wave_max(amax) * rstd, 1e-20f);
    const float s = rstd * (127.0f / amax);
    GAS unsigned* o = (GAS unsigned*)(F.ws + WS_XN + (size_t)r * DM) + F.lane;
#pragma unroll
    for (int j = 0; j < 4; ++j) { const int q0 = (int)__builtin_rintf(v[j].x * s), q1 = (int)__builtin_rintf(v[j].y * s), q2 = (int)__builtin_rintf(v[j].z * s), q3 = (int)__builtin_rintf(v[j].w * s);
        o[64 * j] = (unsigned)(q0 & 255) | ((unsigned)(q1 & 255) << 8) | ((unsigned)(q2 & 255) << 16) | ((unsigned)q3 << 24); }
    if (F.lane == 0) ((float*)(F.ws + WS_RS))[r] = amax * (1.0f / (127.0f * S_W8));
}
__device__ __forceinline__ void norm_phase(Frame& F, bool moe_prev, const unsigned* cnt_prev, bool q8) {
    const int gw = F.vcu * NWAVES + F.wave, NGW = F.G * NWAVES; float* hres = (float*)(F.ws + WS_HRES);
    f32x4 v[4]; if (gw < MTOK) issue_row(hres, gw, F.lane, v);
    for (int r = gw; r < MTOK; r += NGW) { f32x4 vn[4]; if (r + NGW < MTOK) issue_row(hres, r + NGW, F.lane, vn);
        load_row<MOE_KSPLIT8, true>(F, hres, r, moe_prev, cnt_prev, v); const float rstd = row_rstd(v); if (q8) store_xq(F, r, v, rstd); else store_xn(F, r, v, rstd);
#pragma unroll
        for (int j = 0; j < 4; ++j) v[j] = vn[j]; }
}
__device__ __forceinline__ void route_phase(Frame& F, const float* gain, const float* router_w, unsigned* cnt) {
    const int gw = F.vcu * NWAVES + F.wave, NGW = F.G * NWAVES; float* hres = (float*)(F.ws + WS_HRES);
    LAS float* rw = (LAS float*)F.lds;
    LAS unsigned* lcnt = (LAS unsigned*)(F.lds + 32768);
    for (int i = F.tid; i < DM * NEXP / 4; i += NWAVES * 64) { const f32x4 w4 = ((const f32x4*)router_w)[i]; const int k = i >> 1, e0 = (i & 1) * 4;
        rw[(e0 + 0) * DM + k] = w4.x; rw[(e0 + 1) * DM + k] = w4.y; rw[(e0 + 2) * DM + k] = w4.z; rw[(e0 + 3) * DM + k] = w4.w; }
    if (F.tid < 8) lcnt[F.tid] = 0u;
    __syncthreads();
    f32x4 v[4]; if (gw < MTOK) issue_row(hres, gw, F.lane, v);
    for (int r = gw; r < MTOK; r += NGW) {
        f32x4 vn[4]; if (r + NGW < MTOK) issue_row(hres, r + NGW, F.lane, vn);
        const float rstd = row_rstd(v); store_xq(F, r, v, rstd);
        float lg[8];
#pragma unroll
        for (int e = 0; e < 8; ++e) lg[e] = 0.f;
#pragma unroll
        for (int j = 0; j < 4; ++j) { const int k0 = 4 * F.lane + 256 * j; const f32x4 g = *(const f32x4*)(gain + k0);
            const float hv[4] = {v[j].x * rstd * g.x, v[j].y * rstd * g.y, v[j].z * rstd * g.z, v[j].w * rstd * g.w};
#pragma unroll
            for (int e = 0; e < 8; ++e) { const f32x4 w4 = *(const LAS f32x4*)(rw + e * DM + k0);
                lg[e] += hv[0] * w4.x; lg[e] += hv[1] * w4.y; lg[e] += hv[2] * w4.z; lg[e] += hv[3] * w4.w; } }
        { float a4[4];
#pragma unroll
          for (int e = 0; e < 4; ++e) { auto rr = __builtin_amdgcn_permlane32_swap(__builtin_bit_cast(unsigned, lg[e]), __builtin_bit_cast(unsigned, lg[e + 4]), false, false); a4[e] = __builtin_bit_cast(float, (unsigned)rr[0]) + __builtin_bit_cast(float, (unsigned)rr[1]); }
          const bool b4 = (F.lane & 16) != 0, b3 = (F.lane & 8) != 0; float b2[2];
#pragma unroll
          for (int k = 0; k < 2; ++k) { const float keep = b4 ? a4[k + 2] : a4[k], send = b4 ? a4[k] : a4[k + 2]; b2[k] = keep + xshfl<16>(send); }
          float cc = (b3 ? b2[1] : b2[0]) + xshfl<8>(b3 ? b2[0] : b2[1]);
          cc = xadd<4>(cc); cc = xadd<2>(cc); cc = xadd<1>(cc);
#pragma unroll
          for (int e = 0; e < 8; ++e) lg[e] = __builtin_bit_cast(float, __builtin_amdgcn_readlane(__builtin_bit_cast(int, cc), 32 * (e >> 2) + 16 * ((e >> 1) & 1) + 8 * (e & 1))); }
        int e1 = 0; float v1 = lg[0];
#pragma unroll
        for (int e = 1; e < 8; ++e) if (lg[e] > v1) { v1 = lg[e]; e1 = e; }
        int e2 = -1; float v2 = -3.0e38f;
#pragma unroll
        for (int e = 0; e < 8; ++e) if (e != e1 && (e2 < 0 || lg[e] > v2)) { v2 = lg[e]; e2 = e; }
        const float w2 = 1.0f / (1.0f + __expf(v1 - v2)), w1 = 1.0f - w2;
        if (F.lane == 0) { __hip_atomic_fetch_add(lcnt + e1, 1u, __ATOMIC_RELAXED, __HIP_MEMORY_SCOPE_WORKGROUP); __hip_atomic_fetch_add(lcnt + e2, 1u, __ATOMIC_RELAXED, __HIP_MEMORY_SCOPE_WORKGROUP);
            int* ti = (int*)(F.ws + WS_TOK) + (size_t)r * 8; ti[0] = e1; ti[1] = e2; ti[4] = __builtin_bit_cast(int, w1); ti[5] = __builtin_bit_cast(int, w2); }
#pragma unroll
        for (int j = 0; j < 4; ++j) v[j] = vn[j];
    }
    __syncthreads();
    if (F.tid < 8) { __hip_atomic_fetch_add(cnt + F.tid, lcnt[F.tid], RLX_AGENT); ((unsigned*)(F.ws + WS_WGCNT))[F.vcu * 8 + F.tid] = lcnt[F.tid]; }
    __syncthreads();
}
__device__ __forceinline__ void gather_phase(Frame& F, const unsigned* cnt) {
    const int gw = F.vcu * NWAVES + F.wave, NGW = F.G * NWAVES;
    LAS float* tb = (LAS float*)F.lds;
    LAS int* wgbase = (LAS int*)(F.lds + 8192); LAS int* wcnt = wgbase + 8; LAS int* run = wcnt + 64;
    for (int i = F.tid; i < 2048; i += NWAVES * 64) tb[i] = (i >> 3) < F.vcu ? (float)((const unsigned*)(F.ws + WS_WGCNT))[i] : 0.f;
    if (F.tid < 64) { wcnt[F.tid] = 0; }
    __syncthreads();
    { float s = 0.f;
#pragma unroll
      for (int k = 0; k < 4; ++k) s += tb[(F.lane + 64 * k) * 8 + F.wave];
      s = wave_sum(s); if (F.lane == 0) wgbase[F.wave] = expert_base(cnt, F.wave) + (int)s; }
    for (int r = gw; r < MTOK; r += NGW) if (F.lane == 0) { const int* ti = (const int*)(F.ws + WS_TOK) + (size_t)r * 8; wcnt[F.wave * 8 + ti[0]] += 1; wcnt[F.wave * 8 + ti[1]] += 1; }
    __syncthreads();
    if (F.lane < 8) { int a = 0; for (int ww = 0; ww < F.wave; ++ww) a += wcnt[ww * 8 + F.lane]; run[F.wave * 8 + F.lane] = wgbase[F.lane] + a; }
    asm volatile("s_waitcnt lgkmcnt(0)" ::: "memory");
    for (int r0 = gw; r0 < MTOK; r0 += 3 * NGW) {
        int d1[3], d2[3]; v4u a[3]; float sc[3];
#pragma unroll
        for (int k = 0; k < 3; ++k) { const int r = r0 + k * NGW; d1[k] = -1; d2[k] = -1;
            if (r < MTOK) { int* ti = (int*)(F.ws + WS_TOK) + (size_t)r * 8; const int e1 = ti[0], e2 = ti[1];
                a[k] = *((const GAS v4u*)(F.ws + WS_XN + (size_t)r * DM) + F.lane); sc[k] = ((const float*)(F.ws + WS_RS))[r];
                d1[k] = run[F.wave * 8 + e1]; d2[k] = run[F.wave * 8 + e2];
                asm volatile("s_waitcnt lgkmcnt(0)" ::: "memory");
                if (F.lane == 0) { run[F.wave * 8 + e1] = d1[k] + 1; run[F.wave * 8 + e2] = d2[k] + 1; ti[2] = d1[k]; ti[3] = d2[k]; }
                asm volatile("s_waitcnt lgkmcnt(0)" ::: "memory"); } }
#pragma unroll
        for (int k = 0; k < 3; ++k) if (d1[k] >= 0) {
            *((GAS v4u*)(F.ws + WS_XS + (size_t)d1[k] * DM) + F.lane) = a[k]; *((GAS v4u*)(F.ws + WS_XS + (size_t)d2[k] * DM) + F.lane) = a[k];
            if (F.lane == 0) { ((float*)(F.ws + WS_RSS))[d1[k]] = sc[k]; ((float*)(F.ws + WS_RSS))[d2[k]] = sc[k]; } }
    }
    for (int e = 0; e < 8; ++e) { const int c0 = (int)cnt[e], c1 = (c0 + 255) & ~255, b0 = expert_base(cnt, e);
        for (int q = c0 + gw; q < c1; q += NGW) { *((GAS v4u*)(F.ws + WS_XS + (size_t)(b0 + q) * DM) + F.lane) = zero4(); if (F.lane == 0) ((float*)(F.ws + WS_RSS))[b0 + q] = 0.f; } }
}
__device__ __forceinline__ void final_phase(Frame& F, const float* gain, float* out, const unsigned* cnt_prev) {
    const int gw = F.vcu * NWAVES + F.wave, NGW = F.G * NWAVES; float* hres = (float*)(F.ws + WS_HRES);
    for (int q = gw; q < NMAIN; q += NGW) { const int r = q;
        f32x4 v[4]; load_row<MOE_KSPLIT8>(F, hres, r, true, cnt_prev, v); const float rstd = row_rstd(v);
        GAS f32x4* o = (GAS f32x4*)(out + (size_t)q * DM) + F.lane;
#pragma unroll
        for (int j = 0; j < 4; ++j) { const f32x4 g = *(const f32x4*)(gain + 4 * F.lane + 256 * j); o[64 * j] = (f32x4){v[j].x * rstd * g.x, v[j].y * rstd * g.y, v[j].z * rstd * g.z, v[j].w * rstd * g.w}; }
    }
}

typedef short v4i16_t __attribute__((ext_vector_type(4)));
__device__ __forceinline__ s16x4 vtr(const LAS unsigned char* p) { return __builtin_bit_cast(s16x4, __builtin_amdgcn_ds_read_tr16_b64_v4i16((LAS v4i16_t*)p)); }
#define MFMA16(a, b, c) __builtin_amdgcn_mfma_f32_16x16x32_bf16((a), (b), (c), 0, 0, 0)
#define CAT8(L, H) (bf16x8){L[0], L[1], L[2], L[3], H[0], H[1], H[2], H[3]}
__device__ __forceinline__ void ret_state_unit(Frame& F, int unit) {
    const int b = unit >> 5, h = (unit >> 3) & 3, es = unit & 7;
    int tid_ = threadIdx.x; asm volatile("" : "+v"(tid_));
    const int tid = tid_, lane = tid & 63, w = __builtin_amdgcn_readfirstlane(tid >> 6), l15 = lane & 15, kg = lane >> 4, q = l15 >> 2, p_ = l15 & 3;
    const float g64 = exp2f(64.0f * log2_gamma(h));
    const bf16* rkz = (const bf16*)(F.ws + WS_R + R_RKZ) + h * 128;
    const bf16* rv = (const bf16*)(F.ws + WS_R + R_RV) + h * 128 + es * 16;
    bf16* ST = (bf16*)(F.ws + WS_R + R_ST) + (size_t)((b * 4 + h) * NCH) * 16384 + (es * 16 + l15) * 128 + w * 16 + 4 * kg;
    LAS unsigned char* KZ = F.lds; LAS unsigned char* VS = F.lds + 7 * 16384;
    const GAS unsigned char* zsrc = (const GAS unsigned char*)(F.ws + WS_CTL + 512);
#define RS_DMA(c, slot) do { const int cc = (c) < 31 ? (c) : 31; const size_t p0 = cc == 0 ? (size_t)NMAIN : (size_t)b * SEQ + 64 * (cc - 1); \
        _Pragma("unroll") for (int i_ = 0; i_ < 2; ++i_) { const int row = 4 * (2 * w + i_) + (lane >> 4); const GAS unsigned char* src = (const GAS unsigned char*)(rkz + (p0 + row) * 512 + (lane & 15) * 8); \
            if (cc == 0 && row >= NMETA) src = zsrc; __builtin_amdgcn_global_load_lds((const GAS unsigned*)src, (LAS unsigned*)(KZ + (slot) * 16384 + (2 * w + i_) * 1024), 16, 0, 0); } \
        if (w < 2) { const int row = 32 * w + (lane >> 1); const GAS unsigned char* src = (const GAS unsigned char*)(rv + (p0 + row) * 512 + (lane & 1) * 8); \
            if (cc == 0 && row >= NMETA) src = zsrc; __builtin_amdgcn_global_load_lds((const GAS unsigned*)src, (LAS unsigned*)(VS + (slot) * 2048 + w * 1024), 16, 0, 0); } } while (0)
    RS_DMA(0, 0); RS_DMA(1, 1); RS_DMA(2, 2); RS_DMA(3, 3); RS_DMA(4, 4); RS_DMA(5, 5);
    af4 S = {0.f, 0.f, 0.f, 0.f};
    int slot = 0;
#pragma unroll 1
    for (int c = 0; c <= 32; ++c) {
        { v2u o; o.x = pk2(S[0], S[1]); o.y = pk2(S[2], S[3]); *(GAS v2u*)(ST + (size_t)c * 16384) = o; }
        if (c == 32) break;
        if (w < 2) asm volatile("s_waitcnt vmcnt(15)" ::: "memory"); else asm volatile("s_waitcnt vmcnt(10)" ::: "memory");
        asm volatile("" ::: "memory"); __builtin_amdgcn_s_barrier(); asm volatile("" ::: "memory");
        { const int s6 = slot == 0 ? 6 : slot - 1; RS_DMA(c + 6, s6); }
        const int kza = (int)(size_t)(KZ + slot * 16384 + w * 32 + p_ * 8) + (8 * kg + q) * 256, vsa = (int)(size_t)(VS + slot * 2048 + p_ * 8) + (8 * kg + q) * 32;
        s16x4 a0, a1, a2, a3, b0, b1, b2, b3;
        asm volatile("ds_read_b64_tr_b16 %0, %8\n\tds_read_b64_tr_b16 %1, %8 offset:1024\n\tds_read_b64_tr_b16 %2, %8 offset:8192\n\tds_read_b64_tr_b16 %3, %8 offset:9216\n\t"
                     "ds_read_b64_tr_b16 %4, %9\n\tds_read_b64_tr_b16 %5, %9 offset:128\n\tds_read_b64_tr_b16 %6, %9 offset:1024\n\tds_read_b64_tr_b16 %7, %9 offset:1152\n\ts_waitcnt lgkmcnt(0)"
                     : "=&v"(a0), "=&v"(a1), "=&v"(a2), "=&v"(a3), "=&v"(b0), "=&v"(b1), "=&v"(b2), "=&v"(b3) : "v"(kza), "v"(vsa) : "memory");
        S *= g64;
        S = MFMA16(CAT8(a0, a1), CAT8(b0, b1), S); S = MFMA16(CAT8(a2, a3), CAT8(b2, b3), S);
        slot = slot == 6 ? 0 : slot + 1;
    }
    asm volatile("s_waitcnt vmcnt(0)" ::: "memory");
    __syncthreads();
#undef RS_DMA
}
__device__ __forceinline__ void ret_state64_unit(Frame& F, int unit) {
    asm volatile("" : "+s"(unit));
    const int b = unit >> 3, h = (unit >> 1) & 3, es = unit & 1;
    int tid_ = threadIdx.x; asm volatile("" : "+v"(tid_));
    const int tid = tid_, lane = tid & 63, w = __builtin_amdgcn_readfirstlane(tid >> 6), l15 = lane & 15, kg = lane >> 4, q = l15 >> 2, p_ = l15 & 3;
    const float g64 = exp2f(64.0f * log2_gamma(h));
    const bf16* rkz = (const bf16*)(F.ws + WS_R + R_RKZ) + h * 128;
    const bf16* rv = (const bf16*)(F.ws + WS_R + R_RV) + h * 128 + es * 64;
    bf16* ST = (bf16*)(F.ws + WS_R + R_ST) + (size_t)((b * 4 + h) * NCH) * 16384 + (es * 64 + l15) * 128 + w * 16 + 4 * kg;
    LAS unsigned char* KZ = F.lds; LAS unsigned char* VS = F.lds + 5 * 16384;
    const GAS unsigned char* zsrc = (const GAS unsigned char*)(F.ws + WS_CTL + 512);
#define RS_DMA(c, slot) do { const int cc = (c) < 31 ? (c) : 31; const size_t p0 = cc == 0 ? (size_t)NMAIN : (size_t)b * SEQ + 64 * (cc - 1); \
        _Pragma("unroll") for (int i_ = 0; i_ < 2; ++i_) { const int row = 4 * (2 * w + i_) + (lane >> 4); const GAS unsigned char* src = (const GAS unsigned char*)(rkz + (p0 + row) * 512 + (lane & 15) * 8); \
            if (cc == 0 && row >= NMETA) src = zsrc; __builtin_amdgcn_global_load_lds((const GAS unsigned*)src, (LAS unsigned*)(KZ + (slot) * 16384 + (2 * w + i_) * 1024), 16, 0, 0); } \
        { const int row = 8 * w + (lane >> 3); const GAS unsigned char* src = (const GAS unsigned char*)(rv + (p0 + row) * 512 + (lane & 7) * 8); \
            if (cc == 0 && row >= NMETA) src = zsrc; __builtin_amdgcn_global_load_lds((const GAS unsigned*)src, (LAS unsigned*)(VS + (slot) * 8192 + w * 1024), 16, 0, 0); } } while (0)
    RS_DMA(0, 0); RS_DMA(1, 1); RS_DMA(2, 2); RS_DMA(3, 3);
    af4 S[4];
#pragma unroll
    for (int vg = 0; vg < 4; ++vg) S[vg] = (af4){0.f, 0.f, 0.f, 0.f};
    int slot = 0;
#pragma unroll 1
    for (int c = 0; c <= 32; ++c) {
#pragma unroll
        for (int vg = 0; vg < 4; ++vg) { v2u o; o.x = pk2(S[vg][0], S[vg][1]); o.y = pk2(S[vg][2], S[vg][3]); *(GAS v2u*)(ST + (size_t)c * 16384 + vg * 2048) = o; }
        if (c == 32) break;
        asm volatile("s_waitcnt vmcnt(9)" ::: "memory");
        asm volatile("" ::: "memory"); __builtin_amdgcn_s_barrier(); asm volatile("" ::: "memory");
        { const int s4 = slot == 0 ? 4 : slot - 1; RS_DMA(c + 4, s4); }
        const int kza = (int)(size_t)(KZ + slot * 16384 + w * 32 + p_ * 8) + (8 * kg + q) * 256, vsa = (int)(size_t)(VS + slot * 8192 + p_ * 8) + (8 * kg + q) * 128;
        s16x4 a0, a1, a2, a3, bv[4][4];
        asm volatile("ds_read_b64_tr_b16 %0, %20\n\tds_read_b64_tr_b16 %1, %20 offset:1024\n\tds_read_b64_tr_b16 %2, %20 offset:8192\n\tds_read_b64_tr_b16 %3, %20 offset:9216\n\tds_read_b64_tr_b16 %4, %21\n\tds_read_b64_tr_b16 %5, %21 offset:512\n\tds_read_b64_tr_b16 %6, %21 offset:4096\n\tds_read_b64_tr_b16 %7, %21 offset:4608\n\tds_read_b64_tr_b16 %8, %21 offset:32\n\tds_read_b64_tr_b16 %9, %21 offset:544\n\tds_read_b64_tr_b16 %10, %21 offset:4128\n\tds_read_b64_tr_b16 %11, %21 offset:4640\n\tds_read_b64_tr_b16 %12, %21 offset:64\n\tds_read_b64_tr_b16 %13, %21 offset:576\n\tds_read_b64_tr_b16 %14, %21 offset:4160\n\tds_read_b64_tr_b16 %15, %21 offset:4672\n\tds_read_b64_tr_b16 %16, %21 offset:96\n\tds_read_b64_tr_b16 %17, %21 offset:608\n\tds_read_b64_tr_b16 %18, %21 offset:4192\n\tds_read_b64_tr_b16 %19, %21 offset:4704\n\ts_waitcnt lgkmcnt(0)"
                     : "=&v"(a0), "=&v"(a1), "=&v"(a2), "=&v"(a3), "=&v"(bv[0][0]), "=&v"(bv[0][1]), "=&v"(bv[0][2]), "=&v"(bv[0][3]), "=&v"(bv[1][0]), "=&v"(bv[1][1]), "=&v"(bv[1][2]), "=&v"(bv[1][3]), "=&v"(bv[2][0]), "=&v"(bv[2][1]), "=&v"(bv[2][2]), "=&v"(bv[2][3]), "=&v"(bv[3][0]), "=&v"(bv[3][1]), "=&v"(bv[3][2]), "=&v"(bv[3][3]) : "v"(kza), "v"(vsa) : "memory");
#pragma unroll
        for (int vg = 0; vg < 4; ++vg) { S[vg] *= g64;
            S[vg] = MFMA16(CAT8(a0, a1), CAT8(bv[vg][0], bv[vg][1]), S[vg]); S[vg] = MFMA16(CAT8(a2, a3), CAT8(bv[vg][2], bv[vg][3]), S[vg]); }
        slot = slot == 4 ? 0 : slot + 1;
    }
    asm volatile("s_waitcnt vmcnt(0)" ::: "memory");
    __syncthreads();
#undef RS_DMA
}
__device__ __forceinline__ void ret_out_unit(Frame& F, int unit, const float* gain) {
    const int c = unit < NB * 4 * 32 ? 1 + (unit & 31) : 0, b = unit < NB * 4 * 32 ? unit >> 7 : 0, h = unit < NB * 4 * 32 ? (unit >> 5) & 3 : unit - NB * 4 * 32;
    int tid_ = threadIdx.x; asm volatile("" : "+v"(tid_));
    const int tid = tid_, lane = tid & 63, w = __builtin_amdgcn_readfirstlane(tid >> 6), l15 = lane & 15, kg = lane >> 4, q = l15 >> 2, p_ = l15 & 3, it = w & 3, eh = w >> 2;
    const float lg = log2_gamma(h);
    const size_t r0 = c == 0 ? (size_t)NMAIN : (size_t)b * SEQ + 64 * (c - 1);
    const bf16* rq = (const bf16*)(F.ws + WS_R + R_RQ) + r0 * 512 + h * 128;
    const bf16* rk = (const bf16*)(F.ws + WS_R + R_RK) + r0 * 512 + h * 128;
    const bf16* rv = (const bf16*)(F.ws + WS_R + R_RV) + r0 * 512 + h * 128;
    const bf16* sg = (const bf16*)(F.ws + WS_R + R_SG) + r0 * 512 + h * 128;
    const bf16* ST = (const bf16*)(F.ws + WS_R + R_ST) + (size_t)((b * 4 + h) * NCH + c) * 16384;
    bf16* Y = (bf16*)(F.ws + WS_R + R_Y) + r0 * DM + h * 128;
    LAS unsigned char* VL = F.lds; LAS unsigned char* SGL = F.lds + 16384; LAS unsigned char* YL = F.lds + 32768; LAS float* red = (LAS float*)(F.lds + 49152);
    v4u vst[2], gst[2];
#pragma unroll
    for (int i = 0; i < 2; ++i) { const int idx = tid + 512 * i; vst[i] = zero4(); gst[i] = vst[i];
        if (c > 0 || (idx >> 4) < NMETA) { vst[i] = *(const GAS v4u*)(rv + (size_t)(idx >> 4) * 512 + (idx & 15) * 8); gst[i] = *(const GAS v4u*)(sg + (size_t)(idx >> 4) * 512 + (idx & 15) * 8); } }
    float gn[4];
#pragma unroll
    for (int et = 0; et < 4; ++et) gn[et] = gain[h * 128 + 64 * eh + 16 * et + l15];
    bf16x8 qf[4];
#pragma unroll
    for (int ks = 0; ks < 4; ++ks) qf[ks] = *(const GAS bf16x8*)(rq + (size_t)(16 * it + l15) * 512 + 32 * ks + 8 * kg);
    af4 pj[4];
#pragma unroll
    for (int jt = 0; jt < 4; ++jt) { pj[jt] = (af4){0.f, 0.f, 0.f, 0.f};
#pragma unroll
        for (int ks = 0; ks < 4; ++ks) { const bf16x8 kf = *(const GAS bf16x8*)(rk + (size_t)(16 * jt + l15) * 512 + 32 * ks + 8 * kg); pj[jt] = MFMA16(kf, qf[ks], pj[jt]); } }
#pragma unroll
    for (int i = 0; i < 2; ++i) { const int idx = tid + 512 * i; *(LAS v4u*)(VL + (idx >> 4) * 256 + (idx & 15) * 16) = vst[i]; *(LAS v4u*)(SGL + (idx >> 4) * 256 + (idx & 15) * 16) = gst[i]; }
    bf16x8 pa[2];
    { const int il = 16 * it + l15; unsigned pw[4][2];
#pragma unroll
      for (int jt = 0; jt < 4; ++jt) { float v[4];
#pragma unroll
          for (int r = 0; r < 4; ++r) { const int jl = 16 * jt + 4 * kg + r; const int dd = il > jl ? il - jl : jl - il; const float wgt = __builtin_amdgcn_exp2f(lg * (float)dd); v[r] = (c == 0 && jl >= NMETA) ? 0.f : pj[jt][r] * wgt; }
          pw[jt][0] = pk2(v[0], v[1]); pw[jt][1] = pk2(v[2], v[3]); }
      pa[0] = __builtin_bit_cast(bf16x8, (v4u){pw[0][0], pw[0][1], pw[1][0], pw[1][1]}); pa[1] = __builtin_bit_cast(bf16x8, (v4u){pw[2][0], pw[2][1], pw[3][0], pw[3][1]}); }
    af4 acc[4];
#pragma unroll
    for (int et = 0; et < 4; ++et) acc[et] = (af4){0.f, 0.f, 0.f, 0.f};
    if (c > 0) {
#pragma unroll
        for (int et = 0; et < 4; ++et)
#pragma unroll
            for (int ks = 0; ks < 4; ++ks) { const bf16x8 sf = *(const GAS bf16x8*)(ST + (size_t)(64 * eh + 16 * et + l15) * 128 + 32 * ks + 8 * kg); acc[et] = MFMA16(qf[ks], sf, acc[et]); }
        float xi[4];
#pragma unroll
        for (int r = 0; r < 4; ++r) xi[r] = __builtin_amdgcn_exp2f(lg * (float)(16 * it + 4 * kg + r + 1));
#pragma unroll
        for (int et = 0; et < 4; ++et)
#pragma unroll
            for (int r = 0; r < 4; ++r) acc[et][r] *= xi[r];
    }
    __syncthreads();
#pragma unroll
    for (int et = 0; et < 4; ++et)
#pragma unroll
        for (int u = 0; u < 2; ++u) { const LAS unsigned char* vb = VL + (size_t)(32 * u + 4 * kg + q) * 256 + (64 * eh + 16 * et + 4 * p_) * 2;
            const s16x4 b0 = vtr(vb), b1 = vtr(vb + 16 * 256); acc[et] = MFMA16(pa[u], CAT8(b0, b1), acc[et]); }
    float ss[4];
#pragma unroll
    for (int r = 0; r < 4; ++r) { float s = 0.f;
#pragma unroll
        for (int et = 0; et < 4; ++et) s += acc[et][r] * acc[et][r];
        s = xadd<1>(s); s = xadd<2>(s); s = xadd<4>(s); s = xadd<8>(s); ss[r] = s; }
    if (l15 == 0) {
#pragma unroll
        for (int r = 0; r < 4; ++r) red[eh * 64 + 16 * it + 4 * kg + r] = ss[r]; }
    __syncthreads();
#pragma unroll
    for (int r = 0; r < 4; ++r) { const int il = 16 * it + 4 * kg + r; const float rstd = __builtin_amdgcn_rsqf((red[il] + red[64 + il]) * (1.0f / 128.0f) + EPS);
#pragma unroll
        for (int et = 0; et < 4; ++et) { const int e = 64 * eh + 16 * et + l15; const float o = acc[et][r] * rstd * gn[et] * bf2f(*(const LAS bf16*)(SGL + il * 256 + e * 2)); *(LAS bf16*)(YL + il * 256 + e * 2) = (bf16)f2bf(o); } }
    __syncthreads();
#pragma unroll
    for (int i = 0; i < 2; ++i) { const int idx = tid + 512 * i; if (c > 0 || (idx >> 4) < NMETA) *(GAS v4u*)(Y + (size_t)(idx >> 4) * DM + (idx & 15) * 8) = *(const LAS v4u*)(YL + (idx >> 4) * 256 + (idx & 15) * 16); }
    asm volatile("s_waitcnt lgkmcnt(0)" ::: "memory"); __builtin_amdgcn_s_barrier(); asm volatile("" ::: "memory");
}

__device__ __forceinline__ void ret_out4_unit(Frame& F, int unit, const float* gain) {
    const int g = unit & 7, h = (unit >> 3) & 3, b = unit >> 5;
    int tid_ = threadIdx.x; asm volatile("" : "+v"(tid_));
    const int tid = tid_, lane = tid & 63, w = __builtin_amdgcn_readfirstlane(tid >> 6), l15 = lane & 15, kg = lane >> 4, q = l15 >> 2, p_ = l15 & 3, ci = w >> 1, hf = w & 1;
    const float lg = log2_gamma(h);
    const size_t r0 = (size_t)b * SEQ + 256 * g;
    const bf16* rq = (const bf16*)(F.ws + WS_R + R_RQ) + (r0 + 64 * ci) * 512 + h * 128;
    const bf16* rk = (const bf16*)(F.ws + WS_R + R_RK) + (r0 + 64 * ci) * 512 + h * 128;
    const bf16* rv = (const bf16*)(F.ws + WS_R + R_RV) + r0 * 512 + h * 128;
    const bf16* sg = (const bf16*)(F.ws + WS_R + R_SG) + r0 * 512 + h * 128;
    const bf16* ST = (const bf16*)(F.ws + WS_R + R_ST) + (size_t)((b * 4 + h) * NCH + 1 + 4 * g + ci) * 16384;
    bf16* Y = (bf16*)(F.ws + WS_R + R_Y) + r0 * DM + h * 128;
    LAS unsigned char* VL = F.lds; LAS unsigned char* SGL = F.lds + 65536;
#pragma unroll
    for (int i = 0; i < 8; ++i) { const int pc = 8 * w + i; const size_t go = (size_t)(4 * pc + (lane >> 4)) * 512 + (lane & 15) * 8;
        __builtin_amdgcn_global_load_lds((const GAS unsigned*)(rv + go), (LAS unsigned*)(VL + pc * 1024), 16, 0, 0);
        __builtin_amdgcn_global_load_lds((const GAS unsigned*)(sg + go), (LAS unsigned*)(SGL + pc * 1024), 16, 0, 0); }
    float gn[8];
#pragma unroll
    for (int et = 0; et < 8; ++et) gn[et] = gain[h * 128 + 16 * et + l15];
    bf16x8 qf[2][4];
#pragma unroll
    for (int rt = 0; rt < 2; ++rt)
#pragma unroll
        for (int ks = 0; ks < 4; ++ks) qf[rt][ks] = *(const GAS bf16x8*)(rq + (size_t)(16 * (2 * hf + rt) + l15) * 512 + 32 * ks + 8 * kg);
    af4 acc[2][8];
    { bf16x8 sf[8][4];
#pragma unroll
      for (int et = 0; et < 8; ++et)
#pragma unroll
          for (int ks = 0; ks < 4; ++ks) sf[et][ks] = *(const GAS bf16x8*)(ST + (size_t)(16 * et + l15) * 128 + 32 * ks + 8 * kg);
      asm volatile("" ::: "memory");
#pragma unroll
      for (int et = 0; et < 8; ++et) { acc[0][et] = (af4){0.f, 0.f, 0.f, 0.f}; acc[1][et] = acc[0][et];
#pragma unroll
          for (int ks = 0; ks < 4; ++ks) { acc[0][et] = MFMA16(qf[0][ks], sf[et][ks], acc[0][et]); acc[1][et] = MFMA16(qf[1][ks], sf[et][ks], acc[1][et]); } } }
#pragma unroll
    for (int rt = 0; rt < 2; ++rt) { float xi[4];
#pragma unroll
        for (int r = 0; r < 4; ++r) xi[r] = __builtin_amdgcn_exp2f(lg * (float)(16 * (2 * hf + rt) + 4 * kg + r + 1));
#pragma unroll
        for (int et = 0; et < 8; ++et)
#pragma unroll
            for (int r = 0; r < 4; ++r) acc[rt][et][r] *= xi[r]; }
    af4 pj[2][4];
    { bf16x8 kf[4][4];
#pragma unroll
      for (int jt = 0; jt < 4; ++jt)
#pragma unroll
          for (int ks = 0; ks < 4; ++ks) kf[jt][ks] = *(const GAS bf16x8*)(rk + (size_t)(16 * jt + l15) * 512 + 32 * ks + 8 * kg);
      asm volatile("" ::: "memory");
#pragma unroll
      for (int jt = 0; jt < 4; ++jt) { pj[0][jt] = (af4){0.f, 0.f, 0.f, 0.f}; pj[1][jt] = pj[0][jt];
#pragma unroll
          for (int ks = 0; ks < 4; ++ks) { pj[0][jt] = MFMA16(kf[jt][ks], qf[0][ks], pj[0][jt]); pj[1][jt] = MFMA16(kf[jt][ks], qf[1][ks], pj[1][jt]); } } }
    bf16x8 pa[2][2];
#pragma unroll
    for (int rt = 0; rt < 2; ++rt) { const int il = 16 * (2 * hf + rt) + l15; unsigned pw[4][2];
#pragma unroll
        for (int jt = 0; jt < 4; ++jt) { float v[4];
#pragma unroll
            for (int r = 0; r < 4; ++r) { const int jl = 16 * jt + 4 * kg + r; const int dd = il > jl ? il - jl : jl - il; v[r] = pj[rt][jt][r] * __builtin_amdgcn_exp2f(lg * (float)dd); }
            pw[jt][0] = pk2(v[0], v[1]); pw[jt][1] = pk2(v[2], v[3]); }
        pa[rt][0] = __builtin_bit_cast(bf16x8, (v4u){pw[0][0], pw[0][1], pw[1][0], pw[1][1]}); pa[rt][1] = __builtin_bit_cast(bf16x8, (v4u){pw[2][0], pw[2][1], pw[3][0], pw[3][1]}); }
    asm volatile("s_waitcnt vmcnt(0)" ::: "memory");
    __syncthreads();
#pragma unroll
    for (int et = 0; et < 8; ++et)
#pragma unroll
        for (int u = 0; u < 2; ++u) { const LAS unsigned char* vb = VL + (size_t)(64 * ci + 32 * u + 4 * kg + q) * 256 + (16 * et + 4 * p_) * 2;
            const s16x4 b0 = vtr(vb), b1 = vtr(vb + 16 * 256); const bf16x8 vf = CAT8(b0, b1); acc[0][et] = MFMA16(pa[0][u], vf, acc[0][et]); acc[1][et] = MFMA16(pa[1][u], vf, acc[1][et]); }
    float rstd[2][4];
#pragma unroll
    for (int rt = 0; rt < 2; ++rt)
#pragma unroll
        for (int r = 0; r < 4; ++r) { float s = 0.f;
#pragma unroll
            for (int et = 0; et < 8; ++et) s += acc[rt][et][r] * acc[rt][et][r];
            s = xadd<1>(s); s = xadd<2>(s); s = xadd<4>(s); s = xadd<8>(s); rstd[rt][r] = __builtin_amdgcn_rsqf(s * (1.0f / 128.0f) + EPS); }
    __syncthreads();
#pragma unroll
    for (int rt = 0; rt < 2; ++rt)
#pragma unroll
        for (int r = 0; r < 4; ++r) { const int row = 64 * ci + 16 * (2 * hf + rt) + 4 * kg + r;
#pragma unroll
            for (int et = 0; et < 8; ++et) { const int e = 16 * et + l15; const float o = acc[rt][et][r] * rstd[rt][r] * gn[et] * bf2f(*(const LAS bf16*)(SGL + row * 256 + e * 2)); *(LAS bf16*)(VL + row * 256 + e * 2) = (bf16)f2bf(o); } }
    __syncthreads();
#pragma unroll
    for (int i = 0; i < 8; ++i) { const int idx = tid + 512 * i; *(GAS v4u*)(Y + (size_t)(idx >> 4) * DM + (idx & 15) * 8) = *(const LAS v4u*)(VL + (idx >> 4) * 256 + (idx & 15) * 16); }
    asm volatile("s_waitcnt lgkmcnt(0)" ::: "memory"); __builtin_amdgcn_s_barrier(); asm volatile("" ::: "memory");
}

#define KSWZ(row, colB) ((row) * 256 + ((colB) ^ (((row) & 7) << 4)))
#define KPSWZ(row, colB) ((row) * 128 + ((colB) ^ (((row) & 7) << 4)))
#define SBAR() __builtin_amdgcn_sched_barrier(0)
__device__ __forceinline__ int crow(int r, int hi) { return (r & 3) + 8 * (r >> 2) + 4 * hi; }
__device__ __forceinline__ int v_st(int k, int c) { const int kk = (k & ~0xC) | ((k & 4) << 1) | ((k & 8) >> 1); return ((kk >> 3) * 4 + (c >> 5)) * 512 + ((kk & 7) * 32 + (c & 31)) * 2; }
__device__ __forceinline__ int v_rd_base(int lane) { return ((lane & 3) << 3) | (((lane >> 2) & 3) << 6) | (((lane >> 4) & 1) << 5) | (((lane >> 5) & 1) << 8); }
constexpr int v_rd_off(int d0, int ks, int half) { return d0 * 512 + ks * 4096 + half * 2048; }
template <int OFF> __device__ __forceinline__ s16x4 tr_read(int vb) { s16x4 r; asm volatile("ds_read_b64_tr_b16 %0, %1 offset:%2" : "=&v"(r) : "v"(vb), "i"(OFF) : "memory"); return r; }
template <int D0> __device__ __forceinline__ void pv_one(f32x16& od, int vb, bf16x8 pa0, bf16x8 pa1, bf16x8 pa2, bf16x8 pa3) {
    const s16x4 l0 = tr_read<v_rd_off(D0, 0, 0)>(vb), h0 = tr_read<v_rd_off(D0, 0, 1)>(vb), l1 = tr_read<v_rd_off(D0, 1, 0)>(vb), h1 = tr_read<v_rd_off(D0, 1, 1)>(vb);
    const s16x4 l2 = tr_read<v_rd_off(D0, 2, 0)>(vb), h2 = tr_read<v_rd_off(D0, 2, 1)>(vb), l3 = tr_read<v_rd_off(D0, 3, 0)>(vb), h3 = tr_read<v_rd_off(D0, 3, 1)>(vb);
    asm volatile("s_waitcnt lgkmcnt(0)" ::: "memory"); SBAR();
    od = __builtin_amdgcn_mfma_f32_32x32x16_bf16(pa0, CAT8(l0, h0), od, 0, 0, 0);
    od = __builtin_amdgcn_mfma_f32_32x32x16_bf16(pa1, CAT8(l1, h1), od, 0, 0, 0);
    od = __builtin_amdgcn_mfma_f32_32x32x16_bf16(pa2, CAT8(l2, h2), od, 0, 0, 0);
    od = __builtin_amdgcn_mfma_f32_32x32x16_bf16(pa3, CAT8(l3, h3), od, 0, 0, 0);
}
__device__ __forceinline__ void attn_unit(Frame& F, int b, int h, int j, const float* gain, char* lds) {
    int tid_ = threadIdx.x; asm volatile("" : "+v"(tid_));
    const int tid = tid_, wid = __builtin_amdgcn_readfirstlane(tid >> 6), lane = tid & 63, r32 = lane & 31, hi = lane >> 5;
    const unsigned char* Rb = F.ws + WS_R;
    const bf16* QN = (const bf16*)(Rb + R_QN); const bf16* QPE = (const bf16*)(Rb + R_QPE); const bf16* KN = (const bf16*)(Rb + R_KN) + h * 128; const bf16* VV = (const bf16*)(Rb + R_V) + h * 128; const bf16* KPE = (const bf16*)(Rb + R_KPE);
    char* V_lds = lds; char* K_lds = lds + 32768; char* KP_lds = lds + 65536; float* wsf = (float*)(lds + 81920) + wid * 64; float* li_l = wsf; float* al_l = wsf + 32;
    const size_t qbase = j < 0 ? (size_t)NMAIN : (size_t)b * SEQ + 256 * j; const size_t rowq = qbase + wid * 32 + r32;
    bf16x8 qr[12];
#pragma unroll
    for (int d0 = 0; d0 < 8; ++d0) qr[d0] = *(const GAS bf16x8*)(QN + rowq * 512 + h * 128 + d0 * 16 + hi * 8);
#pragma unroll
    for (int d0 = 0; d0 < 4; ++d0) qr[8 + d0] = *(const GAS bf16x8*)(QPE + rowq * 256 + h * 64 + d0 * 16 + hi * 8);
    const int NT = j < 0 ? 1 : 4 * j + 5, my_last = j < 0 ? 0 : 1 + 4 * j + (wid >> 1);
    const int vb0 = (int)(uintptr_t)V_lds + v_rd_base(lane);
    const int k_row = (lane >> 4), k_cb = ((lane & 15) * 16) ^ 0;
    const int kp_row = (lane >> 3), kp_cb = (lane & 7) * 16;
    const int v_kklo = (lane & 31) >> 2, v_cin = (lane & 3) * 8, v_sub = lane >> 5;
    const GAS unsigned char* zsrc = (const GAS unsigned char*)(F.ws + WS_CTL + 512);
#define A_DMA(t, bf) do { const size_t kr = (t) == 0 ? (size_t)NMAIN : (size_t)b * SEQ + 64 * ((t) - 1); const bool meta_ = (t) == 0; \
        _Pragma("unroll") for (int i_ = 0; i_ < 2; ++i_) { const int pc = 2 * wid + i_; \
            { const int row = 4 * pc + k_row, cb = k_cb ^ ((row & 7) << 4); const GAS unsigned char* src = (const GAS unsigned char*)(KN + (kr + row) * 512) + cb; if (meta_ && row >= NMETA) src = zsrc; \
              __builtin_amdgcn_global_load_lds((const GAS unsigned*)src, (LAS unsigned*)(F.lds + 32768 + (bf) * 16384 + pc * 1024), 16, 0, 0); } \
            { const int sub = 2 * pc + v_sub, kk = (sub >> 2) * 8 + v_kklo, k = (kk & ~0xC) | ((kk & 4) << 1) | ((kk & 8) >> 1), c = (sub & 3) * 32 + v_cin; \
              const GAS unsigned char* src = (const GAS unsigned char*)(VV + (kr + k) * 512 + c); if (meta_ && k >= NMETA) src = zsrc; \
              __builtin_amdgcn_global_load_lds((const GAS unsigned*)src, (LAS unsigned*)(F.lds + (bf) * 16384 + pc * 1024), 16, 0, 0); } } \
        { const int row = 8 * wid + kp_row, cb = kp_cb ^ ((row & 7) << 4); const GAS unsigned char* src = (const GAS unsigned char*)(KPE + (kr + row) * 64) + cb; if (meta_ && row >= NMETA) src = zsrc; \
          __builtin_amdgcn_global_load_lds((const GAS unsigned*)src, (LAS unsigned*)(F.lds + 65536 + (bf) * 8192 + wid * 1024), 16, 0, 0); } } while (0)
    float m_reg = -1e30f, l_reg = 0.f; f32x16 o[4];
#pragma unroll
    for (int d = 0; d < 4; ++d)
#pragma unroll
        for (int r = 0; r < 16; ++r) o[d][r] = 0.f;
    A_DMA(0, 0); asm volatile("s_waitcnt vmcnt(0)" ::: "memory"); __syncthreads();
    for (int t = 0; t < NT; ++t) {
        if (t + 1 < NT) A_DMA(t + 1, (t + 1) & 1);
        if (t <= my_last) {
            const char* Kt = K_lds + (t & 1) * 16384; const char* KPt = KP_lds + (t & 1) * 8192;
            f32x16 p0v, p1v;
#pragma unroll
            for (int r = 0; r < 16; ++r) { p0v[r] = 0.f; p1v[r] = 0.f; }
#define A_KLD(d0, B0, B1) do { if ((d0) < 8) { const int cb_ = ((d0) * 16 + hi * 8) * 2; B0 = *(const bf16x8*)(Kt + KSWZ(r32, cb_)); B1 = *(const bf16x8*)(Kt + KSWZ(32 + r32, cb_)); } \
                                else { const int cb_ = (((d0) - 8) * 16 + hi * 8) * 2; B0 = *(const bf16x8*)(KPt + KPSWZ(r32, cb_)); B1 = *(const bf16x8*)(KPt + KPSWZ(32 + r32, cb_)); } } while (0)
            { bf16x8 ka[3], kb[3];
              A_KLD(0, ka[0], kb[0]); A_KLD(1, ka[1], kb[1]); SBAR();
#pragma unroll
              for (int d0 = 0; d0 < 12; ++d0) {
                  if (d0 + 2 < 12) A_KLD(d0 + 2, ka[(d0 + 2) % 3], kb[(d0 + 2) % 3]);
                  SBAR();
                  p0v = __builtin_amdgcn_mfma_f32_32x32x16_bf16(ka[d0 % 3], qr[d0], p0v, 0, 0, 0); p1v = __builtin_amdgcn_mfma_f32_32x32x16_bf16(kb[d0 % 3], qr[d0], p1v, 0, 0, 0);
                  SBAR(); } }
#undef A_KLD
            if (t == 0) {
#pragma unroll
                for (int r = 8; r < 16; ++r) p0v[r] = -1e30f;
#pragma unroll
                for (int r = 0; r < 16; ++r) p1v[r] = -1e30f; }
            float pmax = p0v[0];
#pragma unroll
            for (int r = 1; r < 16; ++r) pmax = fmaxf(pmax, p0v[r]);
#pragma unroll
            for (int r = 0; r < 16; ++r) pmax = fmaxf(pmax, p1v[r]);
            { auto rr = __builtin_amdgcn_permlane32_swap(__float_as_uint(pmax), __float_as_uint(pmax), false, false); pmax = fmaxf(__uint_as_float(rr[0]), __uint_as_float(rr[1])); }
            const float mn = fmaxf(m_reg, pmax), alpha = __builtin_amdgcn_exp2f(m_reg - mn); m_reg = mn;
            float ps = 0.f;
#pragma unroll
            for (int r = 0; r < 16; ++r) { p0v[r] = __builtin_amdgcn_exp2f(p0v[r] - mn); p1v[r] = __builtin_amdgcn_exp2f(p1v[r] - mn); ps += p0v[r] + p1v[r]; }
            { auto rr = __builtin_amdgcn_permlane32_swap(__float_as_uint(ps), __float_as_uint(ps), false, false); ps = __uint_as_float(rr[0]) + __uint_as_float(rr[1]); }
            l_reg = l_reg * alpha + ps;
            if (__any(alpha < 1.f)) { if (hi == 0) al_l[r32] = alpha; asm volatile("s_waitcnt lgkmcnt(0)" ::: "memory");
#pragma unroll
                for (int r = 0; r < 16; ++r) { const float a = al_l[crow(r, hi)];
#pragma unroll
                    for (int d = 0; d < 4; ++d) o[d][r] *= a; } }
            bf16x8 pa0, pa1, pa2, pa3;
#define PK4(P, BASE, OUT) do { unsigned a0 = pk2(P[BASE + 0], P[BASE + 1]), a1 = pk2(P[BASE + 2], P[BASE + 3]); \
    unsigned b0_ = pk2(P[BASE + 4], P[BASE + 5]), b1_ = pk2(P[BASE + 6], P[BASE + 7]); \
    auto r0_ = __builtin_amdgcn_permlane32_swap(a0, b0_, false, false); auto r1_ = __builtin_amdgcn_permlane32_swap(a1, b1_, false, false); \
    v4u w_ = {r0_[0], r1_[0], r0_[1], r1_[1]}; OUT = __builtin_bit_cast(bf16x8, w_); } while (0)
            PK4(p0v, 0, pa0); PK4(p0v, 8, pa1); PK4(p1v, 0, pa2); PK4(p1v, 8, pa3);
#undef PK4
            const int vb = vb0 + (t & 1) * 16384;
            pv_one<0>(o[0], vb, pa0, pa1, pa2, pa3); pv_one<1>(o[1], vb, pa0, pa1, pa2, pa3); pv_one<2>(o[2], vb, pa0, pa1, pa2, pa3); pv_one<3>(o[3], vb, pa0, pa1, pa2, pa3);
        }
        asm volatile("s_waitcnt vmcnt(0)" ::: "memory");
        __syncthreads();
    }
    if (hi == 0) li_l[r32] = l_reg; asm volatile("s_waitcnt lgkmcnt(0)" ::: "memory");
    bf16* Y = (bf16*)(F.ws + WS_R + R_Y) + (qbase + wid * 32) * DM + 512 + h * 128;
    float gn[4];
#pragma unroll
    for (int d = 0; d < 4; ++d) gn[d] = gain[h * 128 + 32 * d + r32];
#pragma unroll
    for (int r = 0; r < 16; ++r) { const int orow = crow(r, hi); const float lr = li_l[orow];
        float s = (o[0][r] * o[0][r] + o[1][r] * o[1][r]) + (o[2][r] * o[2][r] + o[3][r] * o[3][r]);
        s = xadd<1>(s); s = xadd<2>(s); s = xadd<4>(s); s = xadd<8>(s); s = xadd<16>(s);
        const float rstd = __builtin_amdgcn_rsqf(s * (1.0f / 128.0f) + EPS * lr * lr);
        if (j >= 0 || (wid == 0 && orow < NMETA)) {
#pragma unroll
            for (int d = 0; d < 4; ++d) Y[(size_t)orow * DM + 32 * d + r32] = (bf16)f2bf(o[d][r] * rstd * gn[d]); } }
    asm volatile("s_waitcnt lgkmcnt(0)" ::: "memory"); __builtin_amdgcn_s_barrier(); asm volatile("" ::: "memory");
#undef A_DMA
}

struct Args { Inputs in; float* out; unsigned char* ws; int phase; int pad; };
constexpr int N_ATT_UNITS = 260, N_RO_UNITS = NB * 4 * 8 + 4;
constexpr int PH_PER_LAYER = 9, N_PHASES = 1 + DEPTH * PH_PER_LAYER + 1;

__global__ void __launch_bounds__(NWAVES * 64, 2) mk_fwd(Args args) {
    extern __shared__ __attribute__((aligned(16))) unsigned char lds[];
    Frame F;
    F.lds = (LAS unsigned char*)lds; F.MISC = (volatile LAS unsigned*)(F.lds + MISC_OFF);
    F.tid = threadIdx.x; F.lane = F.tid & 63; F.wave = __builtin_amdgcn_readfirstlane(F.tid >> 6);
    F.G = gridDim.x; { const int bx = blockIdx.x; F.vcu = (F.G % 8 == 0) ? (bx % 8) * (F.G / 8) + bx / 8 : bx; }
    F.ws = args.ws; F.ctl = (gu32*)(args.ws + WS_CTL);
    for (int u = F.tid; u < (LDS_BYTES - LDSCTL_OFF) / 4; u += NWAVES * 64) ((LAS unsigned*)(F.lds + LDSCTL_OFF))[u] = 0u;
    __syncthreads();
    XcdBarrier bar; bar.bar = (unsigned*)(F.ctl + CW_BAR); bar.x = 0; bar.st = nullptr;
    if (!MK_MULTI) bar = xcd_barrier_post((unsigned*)(F.ctl + CW_BAR), F.MISC + 8);
#define R (F.ws + WS_R)
#define tab ((const float*)(F.ws + WS_TAB))
#define hres ((float*)(F.ws + WS_HRES))
#define XN ((const pg8::bf16_t*)(F.ws + WS_XN))
#define cnt ((unsigned*)(F.ctl + CW_CNT) + li * 8)
    int ph = 0;
#ifndef MK_ALIGN
#define MK_ALIGN true
#endif
#ifndef MK_SP2
#define MK_SP2 true
#endif
#ifndef MK_MASK
#define MK_MASK 0xFFFFFFFFu
#endif
#define ON(k) (((MK_MASK) >> (k)) & 1u)
#ifndef MK_STAMP_A
#define MK_STAMP_A (-1)
#define MK_STAMP_B (-1)
#endif
#ifndef MK_ATT_REP
#define MK_ATT_REP 1
#endif
#ifndef MK_RO_REP
#define MK_RO_REP 1
#endif
#ifndef MK_REP_PH
#define MK_REP_PH (-1)
#endif
#ifndef MK_REP_N
#define MK_REP_N 1
#endif
#define RUN() (MK_MULTI ? (ph == args.phase) : true)
#define SEAM() do { if (!MK_MULTI) { asm volatile("" : "+s"(bar.x)); bar.bar = (unsigned*)(F.ctl + CW_BAR); xcd_barrier(bar); } if (MK_STAMP_A >= 0 && blockIdx.x == 0 && F.tid == 0) ((unsigned long long*)(F.ws + WS_CTL + 1572864))[ph] = __builtin_amdgcn_s_memrealtime();   ++ph; int z_ = 0; F.tid = threadIdx.x; asm volatile("" : "+v"(F.tid), "+s"(z_));     F.lane = F.tid & 63; F.wave = __builtin_amdgcn_readfirstlane(F.tid >> 6); F.ws = args.ws + z_; F.ctl = (gu32*)(F.ws + WS_CTL); } while (0)
#define REPS(k) _Pragma("unroll 1") for (int rep_ = 0; rep_ < ((k) == MK_REP_PH ? MK_REP_N : 1); ++rep_, ((rep_ < ((k) == MK_REP_PH ? MK_REP_N : 1)) ? ({ SEAM(); --ph; 0; }) : 0))

    REPS(0) if (ON(0) && RUN()) p0_prologue(F);
    SEAM();
#if defined(MK_PROBE_GEMM)
    {
        pg8::Gemm g{XN, (const pg8::bf16_t*)(F.ws + WS_WDGU), NMAIN, 2 * FF, DM / 2, 0};
        pg8::StaticOrder S; S.init(NMAIN, 2 * FF, F.G, (int)blockIdx.x);
#if MK_PROBE_GEMM == 1
        EpiSwiGLU E{(bf16*)(R + R_ACT)}; E.rs = (const float*)(F.ws + WS_TAB);
        pg8::gemm_phase<EpiSwiGLU, pg8::StaticOrder, MK_ALIGN, MK_SP2, true>(F.lds, g, S, E);
#else
        EpiNone E{};
        pg8::gemm_phase<EpiNone, pg8::StaticOrder, MK_ALIGN, MK_SP2, true>(F.lds, g, S, E);
#endif
        if (!MK_MULTI) { asm volatile("" : "+s"(bar.x)); bar.bar = (unsigned*)(F.ctl + CW_BAR); xcd_barrier(bar); }
    }
#endif
#pragma unroll 1
    for (int l = 0; l < DEPTH; ++l) {
        const bool moe = (l & 1) != 0; const int li = l >> 1;
        REPS(1) if (ON(1) && RUN() && l > 0) norm_phase(F, l == 2 && rep_ == 0, (const unsigned*)(F.ctl + CW_CNT), true);
        SEAM();
        REPS(2) if (ON(2) && RUN()) {
            pg8::Gemm g{XN, (const pg8::bf16_t*)(F.ws + WS_WIN + (size_t)l * DINP * DM), NMAIN, DINP - 512, DM / 2, 0};
            pg8::StaticOrder S; S.init(NMAIN, DINP - 512, F.G, (int)blockIdx.x);
            EpiInProj E{R, (float*)(F.ws + CTL_SSQ), (float*)(F.ws + CTL_SSKV), tab, log2_gamma(0), log2_gamma(1), log2_gamma(2), log2_gamma(3), 0}; E.rs = (const float*)(F.ws + WS_RS);
            meta_gemm<EpiInProj, 1>(F, F.ws + WS_XN + (size_t)NMAIN * DM, g.Bt, DINP, DM, E);
            pg8::gemm_phase<EpiInProj, pg8::StaticOrder, MK_ALIGN, MK_SP2, 1>(F.lds, g, S, E);
        }
        SEAM();
        REPS(3) if (ON(3) && RUN()) {
            const int c_ = (int)blockIdx.x, hG = F.G >> 1;
            {
                pg8::Gemm g{XN, (const pg8::bf16_t*)(F.ws + WS_WIN + (size_t)l * DINP * DM + (size_t)(DINP - 512) * DM), NMAIN, 512, DM / 2, 0};
                pg8::StaticOrder S; S.init(NMAIN, 512, F.G, c_);
                if (F.G == 256) { if (c_ >= 64 && c_ < 192) S.window(0, 128, c_ - 64, 128); else S.window(128, 128, 0, 128); }
                EpiGate E{R + R_SG}; E.rs = (const float*)(F.ws + WS_RS);
                pg8::gemm_phase<EpiGate, pg8::StaticOrder, MK_ALIGN, MK_SP2, 1>(F.lds, g, S, E);
            }
            pg8::Gemm g{(const pg8::bf16_t*)(R + R_LAT), (const pg8::bf16_t*)(F.ws + WS_WUP) + (size_t)l * UPN * UPK, NMAIN, UPN, UPK, 0};
            pg8::StaticOrder S; S.init(NMAIN, UPN, F.G, c_);
            S.pnsplit = 3; S.nt_lo = 4; S.koff_hi = 512u; S.nt_hi = 2;
            if (F.G == 256) { if (c_ >= 192) S.window(256, 64, c_ - 192, 448); else if (c_ >= 64) S.window(0, 128, c_ - 64, 256); else S.window(448, hG, 0, 448); }
            EpiUp E{R, (const float*)(F.ws + CTL_SSQ), (const float*)(F.ws + CTL_SSKV), tab};
            meta_gemm<EpiUp>(F, g.A + (size_t)NMAIN * UPK, g.Bt, UPN, UPK * 2, E);
            pg8::gemm_phase<EpiUp, pg8::StaticOrder, MK_ALIGN, MK_SP2>(F.lds, g, S, E);
            if (ON(4)) { if (F.G == 256) { if (c_ < 64) ret_state64_unit(F, c_); } else for (int u = c_; u < NB * 4 * 2; u += F.G) ret_state64_unit(F, u); }
        }
        SEAM();
        REPS(5) if (RUN()) {
            gu32* qh = F.ctl + CW_QUEUE + 64 * l + 8 * rep_;
            for (;;) {
                if (F.tid == 0) F.MISC[16] = __hip_atomic_fetch_add(qh, 1u, RLX_AGENT);
                asm volatile("s_waitcnt lgkmcnt(0)" ::: "memory"); __builtin_amdgcn_s_barrier(); asm volatile("" ::: "memory"); const int u = (int)F.MISC[16]; asm volatile("s_waitcnt lgkmcnt(0)" ::: "memory"); __builtin_amdgcn_s_barrier(); asm volatile("" ::: "memory");
                if (u >= N_ATT_UNITS + N_RO_UNITS) break;
                const bool is_ro = u >= 192 && u < 192 + N_RO_UNITS;
                if (!is_ro) { if (ON(5)) { const int v = u < 192 ? u : u - N_RO_UNITS; const int j = v < 256 ? 7 - (v >> 5) : -1, bh = v < 256 ? (v & 31) : (v - 256); attn_unit(F, bh >> 2, bh & 3, j, ldin(I_MLAG) + l * 512, (char*)lds); } }
                else if (ON(6)) { const int v = u - 192; if (v < NB * 4 * 8) ret_out4_unit(F, v, ldin(I_RETG) + l * 512); else ret_out_unit(F, NB * 4 * 32 + (v - NB * 4 * 8), ldin(I_RETG) + l * 512); }
            }
        }
        SEAM();
        REPS(7) if (ON(7) && RUN()) {
            pg8::Gemm g{(const pg8::bf16_t*)(R + R_Y), (const pg8::bf16_t*)(F.ws + WS_WOUT) + (size_t)l * DM * DM, NMAIN, DM, DM, 0};
            pg8::StaticOrder S; S.init(NMAIN, DM, F.G, (int)blockIdx.x);
            EpiResid E{rep_ == 0 ? hres : (float*)(F.ws + WS_XS), 1.0f};
            meta_gemm<EpiResid>(F, g.A + (size_t)NMAIN * DM, g.Bt, DM, DM * 2, E);
            pg8::gemm_phase<EpiResid, pg8::StaticOrder, MK_ALIGN, MK_SP2>(F.lds, g, S, E);
        }
        SEAM();
        if (!moe) {
            REPS(8) if (ON(8) && RUN()) norm_phase(F, false, nullptr, true);
            SEAM();
            REPS(9) if (ON(9) && RUN()) {
                pg8::Gemm g{XN, (const pg8::bf16_t*)(F.ws + WS_WDGU + (size_t)li * 2 * FF * DM), NMAIN, 2 * FF, DM / 2, 0};
                pg8::StaticOrder S; S.init(NMAIN, 2 * FF, F.G, (int)blockIdx.x);
                EpiSwiGLU E{(bf16*)(R + R_ACT)}; E.rs = (const float*)(F.ws + WS_RS); E.f8 = 1;
                meta_gemm<EpiSwiGLU, true>(F, F.ws + WS_XN + (size_t)NMAIN * DM, g.Bt, 2 * FF, DM, E);
                pg8::gemm_phase<EpiSwiGLU, pg8::StaticOrder, MK_ALIGN, MK_SP2, true>(F.lds, g, S, E);
            }
            SEAM();
            REPS(10) if (ON(10) && RUN()) {
                pg8::Gemm g{(const pg8::bf16_t*)(R + R_ACT), (const pg8::bf16_t*)(F.ws + WS_WDD + (size_t)li * DM * FF), NMAIN, DM, FF / 2, 0};
                pg8::StaticOrder S; S.init(NMAIN, DM, F.G, (int)blockIdx.x);
                EpiResid E{rep_ == 0 ? hres : (float*)(F.ws + WS_XS), 1.0f / (S_A8 * S_WD8)};
                meta_gemm<EpiResid, 2>(F, R + R_ACT + (size_t)NMAIN * FF, g.Bt, DM, FF, E);
                pg8::gemm_phase<EpiResid, pg8::StaticOrder, MK_ALIGN, MK_SP2, 2>(F.lds, g, S, E);
            }
            SEAM();
            ++ph;
        } else {
            if (ON(11) && RUN()) route_phase(F, ldin(I_FFNNORM) + l * DM, ldin(I_ROUTER) + (size_t)li * DM * NEXP, cnt);
            SEAM();
            REPS(12) if (ON(12) && RUN()) gather_phase(F, cnt);
            SEAM();
            REPS(13) if (ON(13) && RUN()) {
                pg8::Gemm g{(const pg8::bf16_t*)(F.ws + WS_XS), (const pg8::bf16_t*)(F.ws + WS_WMGU + (size_t)li * NEXP * 2 * FF * DM), XS_ROWS, 2 * FF, DM / 2, (size_t)2 * FF * DM};
                pg8::GroupedOrder S; S.init(cnt, 2 * FF, F.G, (int)blockIdx.x);
                EpiSwiGLU E{(bf16*)(R + R_ACT)}; E.rs = (const float*)(F.ws + WS_RSS); E.f8 = 1;
                pg8::gemm_phase<EpiSwiGLU, pg8::GroupedOrder, MK_ALIGN, MK_SP2, true>(F.lds, g, S, E);
            }
            SEAM();
            REPS(14) if (ON(14) && RUN()) {
                pg8::Gemm g{(const pg8::bf16_t*)(R + R_ACT), (const pg8::bf16_t*)(F.ws + WS_WMD + (size_t)li * NEXP * DM * FF), XS_ROWS, DM, FF / 2, (size_t)DM * FF};
                { asm volatile("" ::: "memory"); pg8::GroupedOrder S; S.init(cnt, DM, F.G, (int)blockIdx.x, 0, MOE_FULL_TILES);
                  EpiMoeDown E{(bf16*)(F.ws + WS_YS), 1.0f / (S_A8 * S_WD8)};
                  pg8::gemm_phase<EpiMoeDown, pg8::GroupedOrder, MK_ALIGN, MK_SP2, 2>(F.lds, g, S, E); }
                { pg8::Gemm g2 = g; g2.K = FF / 2 / MOE_KSPLIT8; g2.ld = FF / 2;
                  asm volatile("" ::: "memory"); pg8::GroupedOrder S; S.init(cnt, DM, F.G, (int)blockIdx.x, MOE_FULL_TILES, 1 << 30, MOE_KSPLIT8, (unsigned)(FF / MOE_KSPLIT8));
                  EpiPartial E{(float*)(F.ws + WS_PART), (unsigned)(FF / MOE_KSPLIT8), MOE_KSPLIT8, 1.0f / (S_A8 * S_WD8)};
                  pg8::gemm_phase<EpiPartial, pg8::GroupedOrder, MK_ALIGN, MK_SP2, 2>(F.lds, g2, S, E); }
            }
            SEAM();
        }
    }
    if (ON(15) && RUN()) final_phase(F, ldin(I_FINAL), args.out, (const unsigned*)(F.ctl + CW_CNT) + 8);
    if (MK_STAMP_A >= 0 && blockIdx.x == 0 && F.tid == 0) {
        unsigned long long* st = (unsigned long long*)(F.ws + WS_CTL + 1572864); st[ph] = __builtin_amdgcn_s_memrealtime();
        const unsigned long long d = 8ull * (st[MK_STAMP_B] - st[MK_STAMP_A]), t0 = __builtin_amdgcn_s_memrealtime();
        while (__builtin_amdgcn_s_memrealtime() - t0 < d) __builtin_amdgcn_s_sleep(8);
    }
#undef RUN
#undef SEAM
#undef R
#undef tab
#undef hres
#undef XN
#undef cnt
}

extern "C" void kernel_launch(void* const* d_in, const int* in_sizes, int n_in, void* d_out, int out_size, void* d_ws, size_t ws_size, hipStream_t stream) {
    static int grid = 0;
    if (grid == 0) {
        if (n_in != 20 || in_sizes[0] != NB * SEQ * DM || out_size != NB * SEQ * DM || ws_size < WS_END) {
            fprintf(stderr, "kernel_launch: shape mismatch: n_in %d in0 %d out %d ws %zu (need >= %zu)\n", n_in, n_in > 0 ? in_sizes[0] : -1, out_size, ws_size, (size_t)WS_END); grid = -1; return; }
        int dev = 0, cus = 0, per_cu = 0;
        if (hipGetDevice(&dev) != hipSuccess || hipDeviceGetAttribute(&cus, hipDeviceAttributeMultiprocessorCount, dev) != hipSuccess) { grid = -1; return; }
        if (hipFuncSetAttribute((const void*)mk_fwd, hipFuncAttributeMaxDynamicSharedMemorySize, LDS_BYTES) != hipSuccess) { fprintf(stderr, "kernel_launch: hipFuncSetAttribute failed\n"); grid = -1; return; }
        if (hipOccupancyMaxActiveBlocksPerMultiprocessor(&per_cu, (const void*)mk_fwd, NWAVES * 64, LDS_BYTES) != hipSuccess || per_cu < 1)
            fprintf(stderr, "kernel_launch: occupancy query reports %d workgroups per CU\n", per_cu);
        (void)hipGetLastError();
        grid = cus < 256 ? cus : 256;
    }
    if (grid < 0) return;
    if (hipMemsetAsync((char*)d_ws + WS_CTL, 0, CTL_ZERO_BYTES, stream) != hipSuccess) { fprintf(stderr, "kernel_launch: memset failed\n"); return; }
    Args a{};
    for (int i = 0; i < 20; ++i) a.in.p[i] = (const float*)d_in[i];
    a.out = (float*)d_out; a.ws = (unsigned char*)d_ws; a.phase = 0; a.pad = 0;
#if MK_MULTI
    for (int ph = 0; ph < N_PHASES; ++ph) { a.phase = ph; hipLaunchKernelGGL(mk_fwd, dim3(grid), dim3(NWAVES * 64), LDS_BYTES, stream, a); }
#else
    hipLaunchKernelGGL(mk_fwd, dim3(grid), dim3(NWAVES * 64), LDS_BYTES, stream, a);
#endif
    const hipError_t le = hipPeekAtLastError();
    if (le != hipSuccess) fprintf(stderr, "kernel_launch: launch failed: %s\n", hipGetErrorName(le));
}
```

```cpp
#include <hip/hip_runtime.h>
#include <cstdio>
#include <cstdint>
namespace pg8 {
#define PG8_LAS __attribute__((address_space(3)))
typedef unsigned short bf16_t;
typedef short bf16x8 __attribute__((ext_vector_type(8)));
typedef float f32x4 __attribute__((ext_vector_type(4)));
typedef unsigned u32x4 __attribute__((ext_vector_type(4)));
constexpr int BM = 256, BK = 64, HALF = 128, HTB = HALF * BK * 2  , STAGE_BYTES = 8 * HTB, NXCD = 8, WGM = 4;

__host__ __device__ __forceinline__ int lds_byte(int r, int c) { const int st = (r >> 4) * 2 + (c >> 5), rr = r & 15, cc = c & 31, ob = rr * 64 + cc * 2; return st * 1024 + (ob ^ (((ob >> 9) & 1) << 5)); }
__host__ __device__ __forceinline__ void stage_rc(int b, int& R, int& C) { const int st = b / 1024, sb = b % 1024, swz = sb ^ (((sb >> 9) & 1) << 5); R = (st >> 1) * 16 + swz / 64; C = (st & 1) * 32 + (swz % 64) / 2; }
__host__ __device__ __forceinline__ int perm32(int rho) { const int n = rho >> 4, i = rho & 15; return 8 * (i >> 2) + 4 * n + (i & 3); }

struct Unit { int pm, pn, eb; unsigned koff; int nt; };
struct Gemm { const bf16_t* A; const bf16_t* Bt; int M, N, K; size_t estride; int ld = 0; };

struct StaticOrder {
    int nM, nN, nwg, G, c, base, lim; int pnsplit = 1 << 30; unsigned koff_hi = 0u; int nt_lo = 0, nt_hi = 0;
    __host__ __device__ void init(int M, int N, int G_, int c_) { nM = M / BM; nN = N / BM; nwg = nM * nN; G = G_; c = c_; base = 0; lim = nwg; }
    __host__ __device__ void window(int base_, int G_, int c_, int lim_) { base = base_; G = G_; c = c_; lim = lim_; }
    __host__ __device__ bool next(int i, Unit& u) const {
        const long L = (long)i * G + c + base; if (L >= lim) return false;
        int wgid = (int)L; { const int q = nwg / NXCD, r = nwg % NXCD, xcd = wgid % NXCD, off = wgid / NXCD; wgid = (xcd < r ? xcd * (q + 1) : r * (q + 1) + (xcd - r) * q) + off; }
        const int nig = WGM * nN, gid = wgid / nig, fm = gid * WGM, gsz = (nM - fm) < WGM ? (nM - fm) : WGM;
        u.pm = fm + ((wgid % nig) % gsz); u.pn = (wgid % nig) / gsz; u.eb = 0; u.koff = u.pn >= pnsplit ? koff_hi : 0u; u.nt = u.pn >= pnsplit ? nt_hi : nt_lo; return true;
    }
    __device__ __forceinline__ void a_ready(const Unit&) const {}
    __device__ __forceinline__ void done(const Unit&) const {}
};
struct GroupedOrder {
    int nM, nN, nwg, G, c; int tp[9]; int pm0, nK; unsigned kbytes;
    __device__ __forceinline__ void init(const unsigned* cnt, int N, int G_, int c_, int pm_lo = 0, int pm_cap = 1 << 30, int nK_ = 1, unsigned kbytes_ = 0u) {
        tp[0] = 0;
#pragma unroll
        for (int e = 0; e < 8; ++e) tp[e + 1] = tp[e] + __builtin_amdgcn_readfirstlane((int)((cnt[e] + 255u) >> 8));
        const int hi = tp[8] < pm_cap ? tp[8] : pm_cap; pm0 = pm_lo; nM = hi > pm_lo ? hi - pm_lo : 0; nK = nK_; kbytes = kbytes_;
        nN = (N / BM) * nK; nwg = nM * nN; G = G_; c = c_; }
    __device__ __forceinline__ bool next(int i, Unit& u) const {
        const long L = (long)i * G + c; if (L >= nwg) return false;
        int wgid = (int)L; { const int q = nwg / NXCD, r = nwg % NXCD, xcd = wgid % NXCD, off = wgid / NXCD; wgid = (xcd < r ? xcd * (q + 1) : r * (q + 1) + (xcd - r) * q) + off; }
        const int nig = WGM * nN, gid = wgid / nig, fm = gid * WGM, gsz = (nM - fm) < WGM ? (nM - fm) : WGM;
        u.pm = pm0 + fm + ((wgid % nig) % gsz); const int pk = (wgid % nig) / gsz; u.pn = pk / nK; u.koff = (unsigned)(pk % nK) * kbytes; u.nt = 0;
        int e = 0;
#pragma unroll
        for (int k = 1; k < 8; ++k) e += (u.pm >= tp[k]) ? 1 : 0;
        u.eb = e; return true;
    }
    __device__ __forceinline__ void a_ready(const Unit&) const {}
    __device__ __forceinline__ void done(const Unit&) const {}
};
__device__ __forceinline__ unsigned cvt_pk_bf16(float lo, float hi) { unsigned r; asm volatile("v_cvt_pk_bf16_f32 %0, %1, %2" : "=v"(r) : "v"(lo), "v"(hi)); return r; }
typedef int i32x4 __attribute__((ext_vector_type(4)));
__device__ __forceinline__ f32x4 zero_acc() { float z; asm volatile("v_mov_b32 %0, 0" : "=v"(z)); return (f32x4){z, z, z, z}; }
template <bool I8> __device__ __forceinline__ f32x4 mma16(bf16x8 b, bf16x8 a, f32x4 c) {
    if constexpr (I8) return __builtin_bit_cast(f32x4, __builtin_amdgcn_mfma_i32_16x16x64_i8(__builtin_bit_cast(i32x4, b), __builtin_bit_cast(i32x4, a), __builtin_bit_cast(i32x4, c), 0, 0, 0));
    else return __builtin_amdgcn_mfma_f32_16x16x32_bf16(b, a, c, 0, 0, 0);
}
typedef int i32x8 __attribute__((ext_vector_type(8)));
__device__ __forceinline__ f32x4 mma_f8(bf16x8 b0, bf16x8 b1, bf16x8 a0, bf16x8 a1, f32x4 c) {
    const i32x8 B = __builtin_shufflevector(__builtin_bit_cast(i32x4, b0), __builtin_bit_cast(i32x4, b1), 0, 1, 2, 3, 4, 5, 6, 7), A = __builtin_shufflevector(__builtin_bit_cast(i32x4, a0), __builtin_bit_cast(i32x4, a1), 0, 1, 2, 3, 4, 5, 6, 7);
    asm volatile("v_mfma_f32_16x16x128_f8f6f4 %0, %1, %2, %0" : "+v"(c) : "v"(B), "v"(A));
    return c;
}
template <class Epi, class Sched, bool ALIGN_EPI = false, bool SP2 = false, int QM = 0>
__device__ __forceinline__ void gemm_phase(PG8_LAS unsigned char* lds, const Gemm g, const Sched& S, const Epi& E) {
    int tid_ = threadIdx.x; asm volatile("" : "+v"(tid_));
    const int tid = tid_, wid = __builtin_amdgcn_readfirstlane(tid >> 6), lane = tid & 63, wr = wid >> 2, wc = wid & 3, fr = lane & 15, fq = lane >> 4;
    const int K = g.ld ? g.ld : g.K, nt = g.K / BK;
    unsigned voffA[2], voffB[2];
#pragma unroll
    for (int i = 0; i < 2; ++i) { int R, C; stage_rc(tid * 16 + i * 8192, R, C); const int Rb = Epi::PERM ? ((R & ~31) + perm32(R & 31)) : R;
        voffA[i] = (unsigned)(R * K + C) * 2u; voffB[i] = (unsigned)(Rb * K + C) * 2u; }
    const size_t kstep = (size_t)(BK * 2);
    const size_t hstep = (size_t)HALF * K * 2;
    const size_t tstep = 2 * hstep;
    const unsigned ldsw = (unsigned)wid * 1024u;
    const int aoff = lds_byte(wr * 64 + fr, fq * 8), boff = lds_byte(wc * 32 + fr, fq * 8);
#define PG8_SA(b, h) (((b) * 2 + (h)) * HTB)
#define PG8_SB(b, h) ((4 + (b) * 2 + (h)) * HTB)
#define PG8_STAGE(bufoff, gbase, voff) do { _Pragma("unroll") for (int _i = 0; _i < 2; ++_i) \
        __builtin_amdgcn_global_load_lds((const unsigned*)((const char*)(gbase) + (voff)[_i]), (PG8_LAS unsigned*)(lds + (bufoff) + ldsw + _i * 8192), 16, 0, 0); } while (0)
#define PG8_LDA(dst, b, h) do { _Pragma("unroll") for (int m = 0; m < 4; ++m) _Pragma("unroll") for (int k = 0; k < 2; ++k) dst[m][k] = *(const PG8_LAS bf16x8*)(lds + PG8_SA(b, h) + aoff + m * 2048 + k * 1024); } while (0)
#define PG8_LDB(dst, b, h) do { _Pragma("unroll") for (int n = 0; n < 2; ++n) _Pragma("unroll") for (int k = 0; k < 2; ++k) dst[n][k] = *(const PG8_LAS bf16x8*)(lds + PG8_SB(b, h) + boff + n * 2048 + k * 1024); } while (0)
#define PG8_MMA(ai, bj, At, Bt) do { __builtin_amdgcn_s_setprio(1); _Pragma("unroll") for (int m = 0; m < 4; ++m) _Pragma("unroll") for (int n = 0; n < 2; ++n) { \
        if constexpr (QM == 2) acc[ai][bj][m][n] = mma_f8(Bt[n][0], Bt[n][1], At[m][0], At[m][1], acc[ai][bj][m][n]); \
        else { _Pragma("unroll") for (int k = 0; k < 2; ++k) acc[ai][bj][m][n] = mma16<QM == 1>(Bt[n][k], At[m][k], acc[ai][bj][m][n]); } } __builtin_amdgcn_s_setprio(0); } while (0)
#define PG8_WAIT_V(n) asm volatile("s_waitcnt vmcnt(" #n ")" ::: "memory")
#define PG8_WAIT_L(n) asm volatile("s_waitcnt lgkmcnt(" #n ")" ::: "memory")
#define PG8_BAR __builtin_amdgcn_s_barrier()
#define PG8_SCHED __builtin_amdgcn_sched_barrier(0)
    Unit cur, nxt; int ui = 0;
    if (!S.next(0, cur)) return;
    f32x4 acc[2][2][4][2];
#pragma unroll
    for (int a = 0; a < 2; ++a)
#pragma unroll
        for (int b = 0; b < 2; ++b)
#pragma unroll
            for (int m = 0; m < 4; ++m)
#pragma unroll
                for (int n = 0; n < 2; ++n) acc[a][b][m][n] = (f32x4){0.f, 0.f, 0.f, 0.f};
    bf16x8 At[4][2], B0[2][2], B1[2][2];
    const char* cA = (const char*)g.A + (size_t)cur.pm * tstep + cur.koff; const char* cB = (const char*)g.Bt + (size_t)cur.eb * g.estride + (size_t)cur.pn * tstep + cur.koff;
    S.a_ready(cur);
    PG8_LAS unsigned char* const scl = lds + 143360;
    if constexpr (Epi::PRE_RS) E.pre(cur, scl, wid, lane);
    if constexpr (SP2) {
        PG8_STAGE(PG8_SB(0, 0), cB, voffB); PG8_STAGE(PG8_SB(0, 1), cB + hstep, voffB); PG8_STAGE(PG8_SA(0, 0), cA, voffA); PG8_STAGE(PG8_SA(0, 1), cA + hstep, voffA);
        if (wr == 1) PG8_BAR;
        PG8_WAIT_V(2); PG8_BAR;
        PG8_STAGE(PG8_SB(1, 0), cB + kstep, voffB); PG8_STAGE(PG8_SA(1, 0), cA + kstep, voffA); PG8_STAGE(PG8_SB(1, 1), cB + hstep + kstep, voffB);
        PG8_WAIT_V(6); PG8_BAR;
    } else {
        PG8_STAGE(PG8_SB(0, 0), cB, voffB); PG8_STAGE(PG8_SA(0, 0), cA, voffA); PG8_STAGE(PG8_SB(0, 1), cB + hstep, voffB); PG8_STAGE(PG8_SA(0, 1), cA + hstep, voffA);
        if (wr == 1) PG8_BAR;
        PG8_WAIT_V(4); PG8_BAR;
        PG8_STAGE(PG8_SB(1, 0), cB + kstep, voffB); PG8_STAGE(PG8_SA(1, 0), cA + kstep, voffA); PG8_STAGE(PG8_SB(1, 1), cB + hstep + kstep, voffB);
        PG8_WAIT_V(6); PG8_BAR;
    }
    for (;;) {
        const bool has_next = S.next(ui + 1, nxt);
        const char* nA = has_next ? (const char*)g.A + (size_t)nxt.pm * tstep + nxt.koff : cA; const char* nB = has_next ? (const char*)g.Bt + (size_t)nxt.eb * g.estride + (size_t)nxt.pn * tstep + nxt.koff : cB;
        const int nt_u = cur.nt ? cur.nt : nt;
        for (int t = 0; t < nt_u; t += 2) {
            const bool last = (t == nt_u - 2);
            const char* a1 = cA + (size_t)(t + 1) * kstep;
            const char* a2 = last ? nA : cA + (size_t)(t + 2) * kstep; const char* b2 = last ? nB : cB + (size_t)(t + 2) * kstep;
            const char* a3 = a2 + kstep; const char* b3 = b2 + kstep;
            if (last && has_next) S.a_ready(nxt);
            if constexpr (SP2) {
            PG8_LDB(B0, 0, 0); PG8_LDB(B1, 0, 1); PG8_SCHED; PG8_LDA(At, 0, 0); PG8_STAGE(PG8_SA(1, 1), a1 + hstep, voffA);
            PG8_WAIT_V(8); PG8_WAIT_L(0); PG8_BAR; PG8_MMA(0, 0, At, B0); PG8_MMA(0, 1, At, B1); PG8_BAR; PG8_SCHED;
            PG8_LDA(At, 0, 1); PG8_STAGE(PG8_SB(0, 0), b2, voffB); PG8_STAGE(PG8_SB(0, 1), b2 + hstep, voffB); PG8_STAGE(PG8_SA(0, 0), a2, voffA);
            PG8_WAIT_V(8); PG8_WAIT_L(0); PG8_BAR; PG8_MMA(1, 0, At, B0); PG8_MMA(1, 1, At, B1); PG8_BAR; PG8_SCHED;
            PG8_LDB(B0, 1, 0); PG8_LDB(B1, 1, 1); PG8_SCHED; PG8_LDA(At, 1, 0); PG8_STAGE(PG8_SA(0, 1), a2 + hstep, voffA);
            PG8_WAIT_V(8); PG8_WAIT_L(0); PG8_BAR; PG8_MMA(0, 0, At, B0); PG8_MMA(0, 1, At, B1); PG8_BAR; PG8_SCHED;
            PG8_LDA(At, 1, 1); PG8_STAGE(PG8_SB(1, 0), b3, voffB); PG8_STAGE(PG8_SB(1, 1), b3 + hstep, voffB); PG8_STAGE(PG8_SA(1, 0), a3, voffA);
            PG8_WAIT_V(8); PG8_WAIT_L(0); PG8_BAR; PG8_MMA(1, 0, At, B0); PG8_MMA(1, 1, At, B1); PG8_BAR; PG8_SCHED;
            } else {
            PG8_LDB(B0, 0, 0); PG8_SCHED; PG8_LDA(At, 0, 0); PG8_STAGE(PG8_SA(1, 1), a1 + hstep, voffA);
            PG8_WAIT_L(8); PG8_BAR; PG8_WAIT_L(0); PG8_MMA(0, 0, At, B0); PG8_BAR; PG8_SCHED;
            PG8_LDB(B1, 0, 1); PG8_STAGE(PG8_SB(0, 0), b2, voffB);
            PG8_BAR; PG8_WAIT_L(0); PG8_MMA(0, 1, At, B1); PG8_BAR;
            PG8_LDA(At, 0, 1); PG8_STAGE(PG8_SA(0, 0), a2, voffA);
            PG8_BAR; PG8_WAIT_L(0); PG8_MMA(1, 0, At, B0); PG8_BAR; PG8_SCHED;
            PG8_STAGE(PG8_SB(0, 1), b2 + hstep, voffB);
            PG8_WAIT_V(6); PG8_BAR; PG8_MMA(1, 1, At, B1); PG8_BAR;
            PG8_LDB(B0, 1, 0); PG8_SCHED; PG8_LDA(At, 1, 0); PG8_STAGE(PG8_SA(0, 1), a2 + hstep, voffA);
            PG8_WAIT_L(8); PG8_BAR; PG8_WAIT_L(0); PG8_MMA(0, 0, At, B0); PG8_BAR; PG8_SCHED;
            PG8_LDB(B1, 1, 1); PG8_STAGE(PG8_SB(1, 0), b3, voffB);
            PG8_BAR; PG8_WAIT_L(0); PG8_MMA(0, 1, At, B1); PG8_BAR;
            PG8_LDA(At, 1, 1); PG8_STAGE(PG8_SA(1, 0), a3, voffA);
            PG8_BAR; PG8_WAIT_L(0); PG8_MMA(1, 0, At, B0); PG8_BAR; PG8_SCHED;
            PG8_STAGE(PG8_SB(1, 1), b3 + hstep, voffB);
            PG8_WAIT_V(6); PG8_BAR; PG8_MMA(1, 1, At, B1); PG8_BAR;
            }
        }
        if constexpr (QM == 2) { asm volatile("s_nop 15\n\ts_nop 15"); }
        if constexpr (ALIGN_EPI) { if (wr == 0) PG8_BAR; }
        if constexpr (Epi::PRE_RS) { if (has_next) E.pre(nxt, scl + ((ui + 1) & 1) * 1024, wid, lane); }
        if constexpr (!Epi::AFTER_DRAIN) { if constexpr (Epi::PRE_RS) E(acc, cur, wr, wc, fr, fq, scl + (ui & 1) * 1024); else E(acc, cur, wr, wc, fr, fq); S.done(cur); }
        if (!has_next) break;
#pragma unroll
        for (int a = 0; a < 2; ++a)
#pragma unroll
            for (int b = 0; b < 2; ++b)
#pragma unroll
                for (int m = 0; m < 4; ++m)
#pragma unroll
                    for (int n = 0; n < 2; ++n) acc[a][b][m][n] = (f32x4){0.f, 0.f, 0.f, 0.f};
        cur = nxt; cA = nA; cB = nB; ++ui;
        if constexpr (ALIGN_EPI) { if (wr == 1) PG8_BAR; }
    }
    PG8_WAIT_V(0);
    if constexpr (!ALIGN_EPI) { if (wr == 0) PG8_BAR; }
    PG8_BAR;
    if constexpr (Epi::AFTER_DRAIN) { E.fused(acc, cur, wr, wc, fr, fq, lds, wid, lane); S.done(cur); }
#undef PG8_SA
#undef PG8_SB
#undef PG8_STAGE
#undef PG8_LDA
#undef PG8_LDB
#undef PG8_MMA
#undef PG8_WAIT_V
#undef PG8_WAIT_L
#undef PG8_BAR
#undef PG8_SCHED
}
}

constexpr int NB = 8, SEQ = 2048, NMETA = 16, LSEQ = SEQ + NMETA;
constexpr int NMAIN = NB * SEQ, MTOK = NMAIN + NMETA, MP = 16640;
constexpr int DM = 1024, DINP = 2560, FF = 3584, NEXP = 8, DEPTH = 4;
constexpr int NCH = 33;
constexpr int UPN = 1792, UPK = 384;
constexpr int XS_ROWS = 35072;
constexpr float EPS = 1e-6f;
constexpr int NWAVES = 8;
#ifndef MK_MULTI
#define MK_MULTI 0
#endif

constexpr size_t MiB = 1u << 20;
constexpr size_t WS_CTL = 0, CTL_ZERO_BYTES = 2 * MiB;
constexpr size_t CTL_SSQ = 65536, CTL_SSKV = CTL_SSQ + (size_t)DEPTH * MP * 4;
static_assert(CTL_SSKV + (size_t)DEPTH * MP * 4 <= CTL_ZERO_BYTES, "ctl");
constexpr int CW_TMO = 0, CW_BAR = 4096, CW_CNT = 8192  , CW_QUEUE = 8320  , CW_SPLIT = 9216  ;
constexpr size_t WS_WIN = 2 * MiB;
constexpr size_t WS_WUP = WS_WIN + (size_t)DEPTH * DINP * DM * 2;
constexpr size_t WS_WOUT = WS_WUP + (size_t)DEPTH * UPN * UPK * 2;
constexpr size_t WS_WDGU = WS_WOUT + (size_t)DEPTH * DM * DM * 2;
constexpr size_t WS_WDD = WS_WDGU + (size_t)2 * 2 * FF * DM * 2;
constexpr size_t WS_WMGU = WS_WDD + (size_t)2 * DM * FF * 2;
constexpr size_t WS_WMD = WS_WMGU + (size_t)2 * NEXP * 2 * FF * DM * 2;
constexpr size_t WS_TAB = WS_WMD + (size_t)2 * NEXP * DM * FF * 2;
constexpr size_t TAB_RC = 0, TAB_RS = (size_t)LSEQ * 64 * 4, TAB_MC = 2 * TAB_RS, TAB_MS = TAB_MC + (size_t)LSEQ * 32 * 4;
constexpr size_t WS_HRES = WS_TAB + 2 * MiB;
constexpr size_t WS_XN = WS_HRES + (size_t)MP * DM * 4;
constexpr size_t WS_TOK = WS_XN + (size_t)MP * DM * 2;
constexpr size_t WS_SORT = WS_TOK + (size_t)MP * 32;
constexpr size_t WS_RS = WS_SORT, WS_RSS = WS_SORT + 262144;
constexpr size_t WS_WGCNT = WS_SORT + 524288;
constexpr size_t WS_XS = WS_SORT + 1 * MiB;
constexpr size_t WS_YS = WS_XS;
constexpr size_t WS_R = WS_XS + (size_t)XS_ROWS * DM * 2;
constexpr size_t R_RQ = 0, R_RK = R_RQ + (size_t)MP * 512 * 2, R_RKZ = R_RK + (size_t)MP * 512 * 2, R_RV = R_RKZ + (size_t)MP * 512 * 2, R_SG = R_RV + (size_t)MP * 512 * 2;
constexpr size_t R_LAT = R_SG + (size_t)MP * 512 * 2, R_KPE = R_LAT + (size_t)MP * 384 * 2;
constexpr size_t R_QN = R_KPE + (size_t)MP * 64 * 2, R_QPE = R_QN + (size_t)MP * 512 * 2, R_KN = R_QPE + (size_t)MP * 256 * 2, R_V = R_KN + (size_t)MP * 512 * 2;
constexpr size_t R_ST = R_V + (size_t)MP * 512 * 2;
constexpr size_t R_Y = R_ST + (size_t)NB * 4 * NCH * 128 * 128 * 2;
constexpr size_t R_MIX_END = R_Y + (size_t)MP * DM * 2;
constexpr size_t R_ACT = 0;
constexpr size_t R_END = ((size_t)XS_ROWS * FF * 2 > R_MIX_END) ? (size_t)XS_ROWS * FF * 2 : R_MIX_END;
constexpr int MOE_FULL_TILES = 128, MOE_KSPLIT = 4;
constexpr size_t WS_PART = WS_R + R_END;
constexpr size_t WS_END = WS_PART + (size_t)9 * MOE_KSPLIT * 256 * DM * 4;

constexpr int MOE_KSPLIT8 = 2;
constexpr float S_A8 = 8.0f, S_WD8 = 512.0f;
constexpr float S_W8 = 1016.0f;
constexpr int RING_BYTES = 131072, LDSCTL_OFF = RING_BYTES, MISC_OFF = LDSCTL_OFF + 320, LDS_BYTES = 147456;

#define GAS __attribute__((address_space(1)))
#define LAS __attribute__((address_space(3)))
typedef unsigned short bf16;
typedef unsigned v4u __attribute__((ext_vector_type(4)));
typedef unsigned v2u __attribute__((ext_vector_type(2)));
typedef float f32x4 __attribute__((ext_vector_type(4)));
typedef float f32x16 __attribute__((ext_vector_type(16)));
typedef short bf16x8 __attribute__((ext_vector_type(8)));
typedef short s16x4 __attribute__((ext_vector_type(4)));
typedef GAS unsigned gu32;
#define RLX_AGENT __ATOMIC_RELAXED, __HIP_MEMORY_SCOPE_AGENT
#define LDS_WAIT() asm volatile("s_waitcnt lgkmcnt(0)" ::: "memory")
#define VM_WAIT() asm volatile("s_waitcnt vmcnt(0)" ::: "memory")
__device__ __forceinline__ unsigned f2bf(float f) { unsigned u = __builtin_bit_cast(unsigned, f); return (u + 0x7fffu + ((u >> 16) & 1u)) >> 16; }
__device__ __forceinline__ unsigned pk2(float lo, float hi) { return pg8::cvt_pk_bf16(lo, hi); }
__device__ __forceinline__ v4u zero4() { unsigned z; asm volatile("v_mov_b32 %0, 0" : "=v"(z)); return (v4u){z, z, z, z}; }
__device__ __forceinline__ f32x4 bf4_to_f32(v2u a) { return (f32x4){__builtin_bit_cast(float, a.x << 16), __builtin_bit_cast(float, a.x & 0xffff0000u), __builtin_bit_cast(float, a.y << 16), __builtin_bit_cast(float, a.y & 0xffff0000u)}; }
__device__ __forceinline__ v2u f32_to_bf4(f32x4 v) { return (v2u){pk2(v.x, v.y), pk2(v.z, v.w)}; }
__device__ __forceinline__ float bf2f(unsigned short b) { return __builtin_bit_cast(float, (unsigned)b << 16); }
template <int X> __device__ __forceinline__ float xshfl(float v) {
    if constexpr (X < 32) return __builtin_bit_cast(float, __builtin_amdgcn_ds_swizzle(__builtin_bit_cast(int, v), (X << 10) | 0x1f));
    else { const unsigned u = __builtin_bit_cast(unsigned, v); auto r = __builtin_amdgcn_permlane32_swap(u, u, false, false); const unsigned a = r[0], b = r[1]; return __builtin_bit_cast(float, a == u ? b : a); }
}
template <int X> __device__ __forceinline__ float xadd(float v) {
    if constexpr (X < 32) return v + xshfl<X>(v);
    else { const unsigned u = __builtin_bit_cast(unsigned, v); auto r = __builtin_amdgcn_permlane32_swap(u, u, false, false); return __builtin_bit_cast(float, (unsigned)r[0]) + __builtin_bit_cast(float, (unsigned)r[1]); }
}
__device__ __forceinline__ float wave_max(float v) { v = fmaxf(v, xshfl<1>(v)); v = fmaxf(v, xshfl<2>(v)); v = fmaxf(v, xshfl<4>(v)); v = fmaxf(v, xshfl<8>(v)); v = fmaxf(v, xshfl<16>(v)); v = fmaxf(v, xshfl<32>(v)); return v; }
__device__ __forceinline__ float wave_sum(float v) { v = xadd<1>(v); v = xadd<2>(v); v = xadd<4>(v); v = xadd<8>(v); v = xadd<16>(v); v = xadd<32>(v); return v; }
#define XB_TMO      128
#define XB_XCNT(j)  (256  + 64 * (j))
#define XB_XSUB(j)  (1280 + 64 * (j))
#define XB_XGEN(j)  (2304 + 64 * (j))
#define XB_TOP      3328
#define XB_TOPGEN   3392
#define XCD_BAR_WORDS 3456
#define XB_SPIN_CAP (1u << 18)

__device__ __forceinline__ unsigned xb_ld(unsigned* p)              { return __hip_atomic_load(p, __ATOMIC_RELAXED, __HIP_MEMORY_SCOPE_AGENT); }
__device__ __forceinline__ unsigned xb_add(unsigned* p, unsigned v) { return __hip_atomic_fetch_add(p, v, __ATOMIC_RELAXED, __HIP_MEMORY_SCOPE_AGENT); }
__device__ __forceinline__ unsigned xb_xcc_id() { return (unsigned)__builtin_amdgcn_s_getreg((3 << 11) | 20) & 0xFu; }
#define XB_SPIN(cond, bar) do { unsigned _sp = 0; while (cond) { __builtin_amdgcn_s_sleep(1); \
    if ((++_sp & 255u) == 0u) { if (xb_ld(&(bar)[XB_TMO])) break; if (_sp > XB_SPIN_CAP) { atomicAdd(&(bar)[XB_TMO], 1u); break; } } } } while (0)

struct XcdBarrier {
    unsigned* bar; unsigned x;
    volatile LAS unsigned* st;
};

__device__ __forceinline__ XcdBarrier xcd_barrier_post(unsigned* bar, volatile LAS unsigned* st) {
    XcdBarrier b; b.bar = bar; b.x = xb_xcc_id(); b.st = st;
    if (threadIdx.x == 0) (void)xb_add(&bar[XB_XCNT(b.x)], 1u);
    return b;
}
__device__ __forceinline__ void xcd_barrier_complete(unsigned* bar, unsigned x, unsigned& nloc, unsigned& nx) {
    const unsigned G = gridDim.x * gridDim.y * gridDim.z;
    unsigned sum, cnt, mine, sp = 0u;
    for (;;) {
        sum = 0u; cnt = 0u; mine = 0u;
#pragma unroll
        for (unsigned j = 0; j < 16; ++j) { const unsigned c = xb_ld(&bar[XB_XCNT(j)]); sum += c; cnt += (c > 0u) ? 1u : 0u; }
        mine = xb_ld(&bar[XB_XCNT(x)]);
        if (sum == G) break;
        __builtin_amdgcn_s_sleep(1);
        if ((++sp & 255u) == 0u) { if (xb_ld(&bar[XB_TMO])) break; if (sp > XB_SPIN_CAP) { atomicAdd(&bar[XB_TMO], 1u); break; } }
    }
    nloc = mine > 0u ? mine : 1u; nx = cnt > 0u ? cnt : 1u;
}

__device__ __forceinline__ void xcd_barrier(const XcdBarrier& b) {
    asm volatile("s_waitcnt vmcnt(0)" ::: "memory");
    __syncthreads();
    if (threadIdx.x == 0) {
        unsigned* bar = b.bar;
        __builtin_amdgcn_s_waitcnt(0);
        unsigned nloc = b.st[0], nx = b.st[1];
        if (nloc == 0u) { xcd_barrier_complete(bar, b.x, nloc, nx); b.st[0] = nloc; b.st[1] = nx; }
        const unsigned old = xb_add(&bar[XB_XSUB(b.x)], 1u);
        const unsigned gen = old / nloc;
        if (old + 1u == (gen + 1u) * nloc) {
            __builtin_amdgcn_fence(__ATOMIC_RELEASE, "agent");
            asm volatile("s_waitcnt vmcnt(0)" ::: "memory");
            const unsigned og = xb_add(&bar[XB_TOP], 1u);
            const unsigned tg = og / nx;
            if (og + 1u == (tg + 1u) * nx) xb_add(&bar[XB_TOPGEN], 1u);
            else XB_SPIN(xb_ld(&bar[XB_TOPGEN]) == tg, bar);
            __builtin_amdgcn_fence(__ATOMIC_ACQUIRE, "agent");
            xb_add(&bar[XB_XGEN(b.x)], 1u);
            asm volatile("s_waitcnt vmcnt(0)" ::: "memory");
        } else {
            XB_SPIN(xb_ld(&bar[XB_XGEN(b.x)]) == gen, bar);
            __builtin_amdgcn_fence(__ATOMIC_ACQUIRE, "agent");
            asm volatile("s_waitcnt vmcnt(0)" ::: "memory");
        }
    }
    __syncthreads();
}

struct Frame {
    LAS unsigned char* lds;
    volatile LAS unsigned* MISC;
    gu32* ctl;
    int tid, lane, wave, vcu, G;
    unsigned char* ws;
};
struct Inputs { const float* p[20]; };
__device__ __forceinline__ const float* ldin(int k) { unsigned long long v = 0;
#if defined(__HIP_DEVICE_COMPILE__)
    auto ka = __builtin_amdgcn_kernarg_segment_ptr();
    asm volatile("s_load_dwordx2 %0, %1, %2\n\ts_waitcnt lgkmcnt(0)" : "=s"(v) : "s"(ka), "n"(k * 8));
#endif
    return (const float*)v; }
enum { I_X = 0, I_META, I_ATTN_NORM, I_WIN, I_QNORM, I_WUQ, I_KVNORM, I_WUKV, I_RETG, I_MLAG, I_WOUT, I_FFNNORM, I_DWG, I_DWU, I_DWD, I_ROUTER, I_MWG, I_MWU, I_MWD, I_FINAL };

__device__ __forceinline__ int chunk_idx(int p) { return p < NMETA ? 48 + p : ((p - NMETA) & 63); }
__device__ __forceinline__ float log2_gamma(int h) { return h == 0 ? -0.045803689613124755f : h == 1 ? -0.022720076500083562f : h == 2 ? -0.011315313227834085f : -0.005646563141142062f; }

__device__ __forceinline__ void tr_load8(f32x4 (&v)[8], const float* Wcol, int ldw, int krow, const float* scale, float smul, int kr) {
#pragma unroll
    for (int i = 0; i < 8; ++i) v[i] = (f32x4){0.f, 0.f, 0.f, 0.f};
    if (Wcol) {
        const GAS float* src = (const GAS float*)Wcol + (size_t)(krow + 8 * kr) * ldw;
#pragma unroll
        for (int i = 0; i < 8; ++i) v[i] = __builtin_nontemporal_load((const GAS f32x4*)(src + (size_t)i * ldw));
        if (scale) { const f32x4 s0 = *(const GAS f32x4*)(scale + krow + 8 * kr) * smul, s1 = *(const GAS f32x4*)(scale + krow + 8 * kr + 4) * smul;
            v[0] *= s0.x; v[1] *= s0.y; v[2] *= s0.z; v[3] *= s0.w; v[4] *= s1.x; v[5] *= s1.y; v[6] *= s1.z; v[7] *= s1.w; }
    }
}
__device__ __forceinline__ void tr_store_bf16(const f32x4 (&v)[8], GAS bf16* dst, int Kdst) {
#pragma unroll
    for (int q = 0; q < 4; ++q) { v4u o; o.x = pk2(v[0][q], v[1][q]); o.y = pk2(v[2][q], v[3][q]); o.z = pk2(v[4][q], v[5][q]); o.w = pk2(v[6][q], v[7][q]);
        *(GAS v4u*)(dst + (size_t)q * Kdst) = o; }
}
__device__ __forceinline__ v2u tr_pack_q8(const f32x4 (&v)[8], int q) { unsigned lo = 0u, hi = 0u;
#pragma unroll
    for (int i = 0; i < 4; ++i) { const int a = (int)__builtin_rintf(fminf(fmaxf(v[i][q], -127.f), 127.f)), c = (int)__builtin_rintf(fminf(fmaxf(v[4 + i][q], -127.f), 127.f));
        lo |= (unsigned)(a & 255) << (8 * i); hi |= (unsigned)(c & 255) << (8 * i); }
    return (v2u){lo, hi}; }
__device__ __forceinline__ void transpose_item(const float* Wcol, int ldw, int krow0, const float* scale, bf16* WT, int Kdst, int k0dst, int n0, int lane) {
    const int sg = lane & 7, kr = lane >> 3; f32x4 v0[8], v1[8];
    tr_load8(v0, Wcol, ldw, krow0, scale, 1.0f, kr); tr_load8(v1, Wcol, ldw, krow0 + 64, scale, 1.0f, kr);
    GAS bf16* dst = (GAS bf16*)WT + (size_t)(n0 + 4 * sg) * Kdst + k0dst + 8 * kr;
    tr_store_bf16(v0, dst, Kdst); tr_store_bf16(v1, dst + 64, Kdst);
}
__device__ __forceinline__ void transpose_item_q8(const float* Wcol, int ldw, int krow0, const float* scale, unsigned char* WT, int Kdst, int k0dst, int n0, int lane) {
    const int sg = lane & 7, kr = lane >> 3; f32x4 v0[8], v1[8];
    tr_load8(v0, Wcol, ldw, krow0, scale, S_W8, 2 * kr); tr_load8(v1, Wcol, ldw, krow0 + 8, scale, S_W8, 2 * kr);
    GAS unsigned char* dst = (GAS unsigned char*)WT + (size_t)(n0 + 4 * sg) * Kdst + k0dst + 16 * kr;
#pragma unroll
    for (int q = 0; q < 4; ++q) { const v2u a = tr_pack_q8(v0, q), c = tr_pack_q8(v1, q); *(GAS v4u*)(dst + (size_t)q * Kdst) = (v4u){a.x, a.y, c.x, c.y}; }
}
__device__ __forceinline__ v2u tr_pack_f8(const f32x4 (&v)[8], int q) { float t[8];
#pragma unroll
    for (int i = 0; i < 8; ++i) t[i] = fminf(fmaxf(v[i][q] * S_WD8, -448.f), 448.f);
    int lo = __builtin_amdgcn_cvt_pk_fp8_f32(t[0], t[1], 0, false); lo = __builtin_amdgcn_cvt_pk_fp8_f32(t[2], t[3], lo, true);
    int hi = __builtin_amdgcn_cvt_pk_fp8_f32(t[4], t[5], 0, false); hi = __builtin_amdgcn_cvt_pk_fp8_f32(t[6], t[7], hi, true);
    return (v2u){(unsigned)lo, (unsigned)hi}; }
__device__ __forceinline__ void transpose_item_f8(const float* Wcol, int ldw, int krow0, unsigned char* WT, int Kdst, int k0dst, int n0, int lane) {
    const int sg = lane & 7, kr = lane >> 3; f32x4 v0[8], v1[8];
    tr_load8(v0, Wcol, ldw, krow0, nullptr, 1.0f, 2 * kr); tr_load8(v1, Wcol, ldw, krow0 + 8, nullptr, 1.0f, 2 * kr);
    GAS unsigned char* dst = (GAS unsigned char*)WT + (size_t)(n0 + 4 * sg) * Kdst + k0dst + 16 * kr;
#pragma unroll
    for (int q = 0; q < 4; ++q) { const v2u a = tr_pack_f8(v0, q), c = tr_pack_f8(v1, q); *(GAS v4u*)(dst + (size_t)q * Kdst) = (v4u){a.x, a.y, c.x, c.y}; }
}
__device__ __forceinline__ int slot_o8(int t) { return (t & 0x60) | ((t & 0xC) << 1) | ((t & 0x10) >> 2) | (t & 3); }
__device__ __forceinline__ int out_col(int s) { const int t = s & 255; return (s & ~255) + 128 * (t >> 7) + slot_o8(t & 127); }
__device__ __forceinline__ int win_col(int s) {
    const int pn = s >> 8, t = s & 255, bj = t >> 7, t7 = t & 127, wc = (t >> 5) & 3, n = (t >> 4) & 1, fq = (t >> 2) & 3, i = t & 3;
    if (pn < 4) return (pn >> 1) * 512 + (2 * (pn & 1) + bj) * 128 + 16 * wc + 4 * fq + i + 64 * n;
    if (pn < 6) return 1024 + (pn & 1) * 256 + 128 * bj + slot_o8(t7);
    if (pn >= 8) return 1536 + (pn & 1) * 256 + 128 * bj + slot_o8(t7);
    if (pn == 6) return 2048 + 128 * bj + slot_o8(t7);
    if (bj == 0) return 2304 + slot_o8(t7);
    if (wc < 2) return 2432 + 16 * wc + 4 * fq + i + 32 * n;
    return -1;
}
__device__ __forceinline__ int wup_col(int s, bool& is_kv) {
    const int pn = s >> 8, t = s & 255, bj = t >> 7, t7 = t & 127, wc = (t >> 5) & 3, n = (t >> 4) & 1, fq = (t >> 2) & 3, i = t & 3;
    if (pn < 2) { is_kv = false; const int o = 256 * pn + 128 * bj + slot_o8(t7); return (o >> 7) * 192 + (o & 127); }
    if (pn == 2) { is_kv = false; const int hq = 2 * bj + (wc >> 1); return hq * 192 + 128 + 16 * (wc & 1) + 4 * fq + i + 32 * n; }
    is_kv = true;
    if (pn < 5) { const int o = 256 * (pn - 3) + 128 * bj + slot_o8(t7); return (o >> 7) * 256 + (o & 127); }
    { const int o = 256 * (pn - 5) + 128 * bj + slot_o8(t7); return (o >> 7) * 256 + 128 + (o & 127); }
}
__device__ __forceinline__ void sincos_d(double x, float& s, float& c) {
    const double k = __builtin_rint(x * 0.63661977236758134308);
    const double y = (x - k * 1.5707963267948966) - k * 6.123233995736766e-17;
    const double y2 = y * y;
    const double sn = y * (1.0 + y2 * (-1.0 / 6 + y2 * (1.0 / 120 + y2 * (-1.0 / 5040 + y2 * (1.0 / 362880 + y2 * (-1.0 / 39916800 + y2 * (1.0 / 6227020800.0)))))));
    const double cs = 1.0 + y2 * (-0.5 + y2 * (1.0 / 24 + y2 * (-1.0 / 720 + y2 * (1.0 / 40320 + y2 * (-1.0 / 3628800 + y2 * (1.0 / 479001600.0 + y2 * (-1.0 / 87178291200.0)))))));
    const int q = (int)((long long)k & 3);
    const double ss = (q & 1) ? cs : sn, cc = (q & 1) ? sn : cs;
    s = (float)((q & 2) ? -ss : ss); c = (float)(((q + 1) & 2) ? -cc : cc);
}
__device__ __forceinline__ float row_rstd(const f32x4 (&v)[4]);
__device__ __forceinline__ void store_xq(Frame& F, int r, const f32x4 (&v)[4], float rstd);
constexpr int I_IN = DEPTH * 8 * 80, I_UP = DEPTH * 3 * 56, I_OUT = DEPTH * 8 * 32, I_DGU = 2 * 8 * 224, I_DD = 2 * 28 * 32, I_MGU = 16 * 8 * 224, I_MD = 16 * 28 * 32;
constexpr int NITEMS = I_IN + I_UP + I_OUT + I_DGU + I_DD + I_MGU + I_MD;
constexpr int OFF_MGU = I_IN + I_UP + I_OUT + I_DGU + I_DD, OFF_MD = OFF_MGU + I_MGU, N_DEFER = I_MGU / 2 + I_MD / 2;
constexpr int N_DEFER_R = 8832;
constexpr int N_DEFER_G = 4096;
__device__ __forceinline__ int defer_item(int d) { return d < I_MGU / 2 ? OFF_MGU + I_MGU / 2 + d : OFF_MD + I_MD / 2 + (d - I_MGU / 2); }
__device__ __forceinline__ void convert_item(Frame& F, int it, int lane) {
        int r = it;
        if (r < I_IN) { const int l = r / 640, q = r % 640, kb = q / 80, nb = q % 80; const int col = win_col(nb * 32 + 4 * (lane & 7));
            const float* W = ldin(I_WIN) + (size_t)l * DM * 2496;
            transpose_item_q8(col >= 0 ? W + col : nullptr, 2496, kb * 128, ldin(I_ATTN_NORM) + l * DM, F.ws + WS_WIN + (size_t)l * DINP * DM, DM, kb * 128, nb * 32, lane); return; }
        r -= I_IN;
        if (r < I_UP) { const int l = r / 168, q = r % 168, kb = q / 56, nb = q % 56; bool is_kv; const int col = wup_col(nb * 32 + 4 * (lane & 7), is_kv);
            const float* Wc = nullptr; const float* sc = nullptr; int ldw = 0, k0 = 0;
            if (!is_kv && kb < 2) { Wc = ldin(I_WUQ) + (size_t)l * 256 * 768 + col; sc = ldin(I_QNORM) + l * 256; ldw = 768; k0 = kb * 128; }
            if (is_kv && kb >= 2) { Wc = ldin(I_WUKV) + (size_t)l * 128 * 1024 + col; sc = ldin(I_KVNORM) + l * 128; ldw = 1024; k0 = (kb - 2) * 128; }
            transpose_item(Wc, ldw, k0, sc, (bf16*)(F.ws + WS_WUP) + (size_t)l * UPN * UPK, UPK, kb * 128, nb * 32, lane); return; }
        r -= I_UP;
        if (r < I_OUT) { const int l = r / 256, q = r % 256, kb = q / 32, nb = q % 32;
            transpose_item(ldin(I_WOUT) + (size_t)l * DM * DM + out_col(nb * 32 + 4 * (lane & 7)), DM, kb * 128, nullptr, (bf16*)(F.ws + WS_WOUT) + (size_t)l * DM * DM, DM, kb * 128, nb * 32, lane); return; }
        r -= I_OUT;
        if (r < I_DGU + 0) { const int l = r / 1792, q = r % 1792, kb = q / 224, nb = q % 224; const int s = nb * 32 + 4 * (lane & 7), pn = s >> 8, t = s & 255;
            const float* W = ((t >> 7) ? ldin(I_DWU) : ldin(I_DWG)) + (size_t)l * DM * FF + 128 * pn + slot_o8(t & 127);
            transpose_item_q8(W, FF, kb * 128, ldin(I_FFNNORM) + (2 * l) * DM, F.ws + WS_WDGU + (size_t)l * 2 * FF * DM, DM, kb * 128, nb * 32, lane); return; }
        r -= I_DGU;
        if (r < I_DD) { const int l = r / 896, q = r % 896, kb = q / 32, nb = q % 32;
            transpose_item_f8(ldin(I_DWD) + (size_t)l * FF * DM + out_col(nb * 32 + 4 * (lane & 7)), DM, kb * 128, F.ws + WS_WDD + (size_t)l * DM * FF, FF, kb * 128, nb * 32, lane); return; }
        r -= I_DD;
        if (r < I_MGU) { const int le = r / 1792, q = r % 1792, kb = q / 224, nb = q % 224; const int s = nb * 32 + 4 * (lane & 7), pn = s >> 8, t = s & 255;
            const float* W = ((t >> 7) ? ldin(I_MWU) : ldin(I_MWG)) + (size_t)le * DM * FF + 128 * pn + slot_o8(t & 127);
            transpose_item_q8(W, FF, kb * 128, ldin(I_FFNNORM) + (2 * (le >> 3) + 1) * DM, F.ws + WS_WMGU + (size_t)le * 2 * FF * DM, DM, kb * 128, nb * 32, lane); return; }
        r -= I_MGU;
        { const int le = r / 896, q = r % 896, kb = q / 32, nb = q % 32;
            transpose_item_f8(ldin(I_MWD) + (size_t)le * FF * DM + out_col(nb * 32 + 4 * (lane & 7)), DM, kb * 128, F.ws + WS_WMD + (size_t)le * DM * FF, FF, kb * 128, nb * 32, lane); }
}
__device__ __forceinline__ void p0_prologue(Frame& F) {
    const int gw = F.vcu * NWAVES + F.wave, NGW = F.G * NWAVES, lane = F.lane;
    bf16* hres = (bf16*)(F.ws + WS_HRES);
    for (int r = gw; r < MP; r += NGW) {
        GAS v2u* o = (GAS v2u*)(hres + (size_t)r * DM) + lane;
        if (r < MTOK) {
            const GAS f32x4* src = (const GAS f32x4*)(r < NMAIN ? ldin(I_X) + (size_t)r * DM : ldin(I_META) + (size_t)(r - NMAIN) * DM) + lane;
            f32x4 v[4];
#pragma unroll
            for (int j = 0; j < 4; ++j) v[j] = src[64 * j];
#pragma unroll
            for (int j = 0; j < 4; ++j) o[64 * j] = f32_to_bf4(v[j]);
            store_xq(F, r, v, row_rstd(v)); }
        else {
#pragma unroll
            for (int j = 0; j < 4; ++j) o[64 * j] = (v2u){0u, 0u}; }
    }
    { float* tab = (float*)(F.ws + WS_TAB);
      const int gt = gw * 64 + lane, NT = NGW * 64;
      for (int t = gt; t < LSEQ * 64; t += NT) { const int p = t >> 6, i = t & 63; const float inv = exp2f(-(float)(2 * i) * (13.287712379549449f / 128.0f)); const float ang = (float)p * inv;
          float s, c; sincos_d((double)ang, s, c); tab[TAB_RC / 4 + t] = c; tab[TAB_RS / 4 + t] = s; }
      for (int t = gt; t < LSEQ * 32; t += NT) { const int p = t >> 5, i = t & 31; const float inv = exp2f(-(float)(2 * i) * (13.287712379549449f / 64.0f)); const float ang = (float)p * inv;
          float s, c; sincos_d((double)ang, s, c); tab[TAB_MC / 4 + t] = c; tab[TAB_MS / 4 + t] = s; }
    }
    if (F.G <= 72) for (int d = gw; d < N_DEFER_R; d += NGW) convert_item(F, defer_item(d), lane);
    for (int d = N_DEFER_R + N_DEFER_G + gw; d < N_DEFER; d += NGW) if (d < I_MGU / 2 || d >= I_MGU / 2 + N_DEFER_G) convert_item(F, defer_item(d), lane);
    for (int k = gw; k < NITEMS - N_DEFER; k += NGW) convert_item(F, k < OFF_MGU + I_MGU / 2 ? k : k + I_MGU / 2, lane);
}

typedef pg8::f32x4 af4;
__device__ __forceinline__ v4u pack8(af4 a, af4 b) { v4u w; w.x = pk2(a[0], a[1]); w.y = pk2(a[2], a[3]); w.z = pk2(b[0], b[1]); w.w = pk2(b[2], b[3]); return w; }
__device__ __forceinline__ float silu_f(float x) { return x * __builtin_amdgcn_rcpf(1.0f + __builtin_amdgcn_exp2f(-1.4426950408889634f * x)); }
__device__ __forceinline__ float sumsq8(af4 a, af4 c) { return (a[0] * a[0] + a[1] * a[1]) + (a[2] * a[2] + a[3] * a[3]) + (c[0] * c[0] + c[1] * c[1]) + (c[2] * c[2] + c[3] * c[3]); }
__device__ __forceinline__ int row_pos(int row) { return row < NMAIN ? NMETA + (row & (SEQ - 1)) : ((row - NMAIN) & (NMETA - 1)); }
__device__ __forceinline__ af4 cvt_i8acc(af4 a, float sc) { return __builtin_convertvector(__builtin_bit_cast(pg8::i32x4, a), af4) * sc; }
#define EPI_MAIN_LOOP()                                                                                                                               \
    const float* rs = nullptr;                                                                 \
    __device__ __forceinline__ void operator()(const af4 (&acc)[2][2][4][2], const pg8::Unit& u, int wr, int wc, int fr, int fq) const {             \
        float rsl[8];                                                 \
        if (rs) { _Pragma("unroll") for (int ai = 0; ai < 2; ++ai) _Pragma("unroll") for (int m = 0; m < 4; ++m) rsl[ai * 4 + m] = rs[u.pm * 256 + ai * 128 + wr * 64 + m * 16 + fr]; } \
        _Pragma("unroll") for (int ai = 0; ai < 2; ++ai) _Pragma("unroll") for (int m = 0; m < 4; ++m) {                                             \
            const int r_ = u.pm * 256 + ai * 128 + wr * 64 + m * 16 + fr;                                                                            \
            af4 a00 = acc[ai][0][m][0], a01 = acc[ai][0][m][1], a10 = acc[ai][1][m][0], a11 = acc[ai][1][m][1];                                      \
            if (rs) { const float sc = rsl[ai * 4 + m]; a00 = cvt_i8acc(a00, sc); a01 = cvt_i8acc(a01, sc); a10 = cvt_i8acc(a10, sc); a11 = cvt_i8acc(a11, sc); } \
            row(r_, u.pn, wc, fq, a00, a01, a10, a11);                                                                                               \
            if (m == 3) asm volatile("" ::: "memory"); } }

#define EPI_MAIN_LOOP_PRE()                                                                                                                           \
    const float* rs = nullptr;                                                                                                                        \
    __device__ __forceinline__ void pre(const pg8::Unit& u, LAS unsigned char* buf, int wid, int lane) const {                                        \
        if (wid < 4) __builtin_amdgcn_global_load_lds((const GAS unsigned*)(rs + u.pm * 256 + wid * 64 + lane), (LAS unsigned*)(buf + wid * 256), 4, 0, 0); } \
    __device__ __forceinline__ void operator()(const af4 (&acc)[2][2][4][2], const pg8::Unit& u, int wr, int wc, int fr, int fq, const LAS unsigned char* buf) const { \
        float rsl[8];                                                                                                                                 \
        _Pragma("unroll") for (int i = 0; i < 8; ++i) rsl[i] = *(const LAS float*)(buf + ((i >> 2) * 128 + wr * 64 + (i & 3) * 16 + fr) * 4);         \
        _Pragma("unroll") for (int ai = 0; ai < 2; ++ai) _Pragma("unroll") for (int m = 0; m < 4; ++m) {                                             \
            const int r_ = u.pm * 256 + ai * 128 + wr * 64 + m * 16 + fr; const float sc = rsl[ai * 4 + m];                                          \
            row(r_, u.pn, wc, fq, cvt_i8acc(acc[ai][0][m][0], sc), cvt_i8acc(acc[ai][0][m][1], sc), cvt_i8acc(acc[ai][1][m][0], sc), cvt_i8acc(acc[ai][1][m][1], sc)); \
            if (m == 3) asm volatile("" ::: "memory"); } }
struct EpiInProj {
    static constexpr bool PERM = false, AFTER_DRAIN = false, PRE_RS = true;
    unsigned char* R; float* ssq; float* sskv; const float* tab; float lg0, lg1, lg2, lg3; int pn0;
    __device__ __forceinline__ void row(int row, int pn, int wc, int fq, af4 a00, af4 a01, af4 a10, af4 a11) const {
        pn += pn0; const int pp = row_pos(row);
        if (pn < 4) {
            const af4 cs = *(const af4*)(tab + TAB_RC / 4 + pp * 64 + 16 * wc + 4 * fq), sn = *(const af4*)(tab + TAB_RS / 4 + pp * 64 + 16 * wc + 4 * fq);
            const size_t off = ((size_t)row * 512 + (2 * (pn & 1)) * 128 + 32 * wc + 8 * fq) * 2;
            af4 o1 = a00 * cs - a01 * sn, o2 = a00 * sn + a01 * cs, o3 = a10 * cs - a11 * sn, o4 = a10 * sn + a11 * cs;
            if (pn < 2) { o1 *= 0.08838834764831845f; o2 *= 0.08838834764831845f; o3 *= 0.08838834764831845f; o4 *= 0.08838834764831845f;
                *(v4u*)(R + R_RQ + off) = pack8(o1, o2); *(v4u*)(R + R_RQ + off + 256) = pack8(o3, o4); }
            else { *(v4u*)(R + R_RK + off) = pack8(o1, o2); *(v4u*)(R + R_RK + off + 256) = pack8(o3, o4);
                const float e = (float)(63 - chunk_idx(pp)); const float z0 = __builtin_amdgcn_exp2f(((pn & 1) ? lg2 : lg0) * e), z1 = __builtin_amdgcn_exp2f(((pn & 1) ? lg3 : lg1) * e);
                *(v4u*)(R + R_RKZ + off) = pack8(o1 * z0, o2 * z0); *(v4u*)(R + R_RKZ + off + 256) = pack8(o3 * z1, o4 * z1); }
        } else if (pn < 6) {
            const size_t off = ((size_t)row * 512 + (pn & 1) * 256 + 32 * wc + 8 * fq) * 2;
            *(v4u*)(R + R_RV + off) = pack8(a00, a01); *(v4u*)(R + R_RV + off + 256) = pack8(a10, a11);
        } else if (pn >= 8) {
            const size_t off = ((size_t)row * 512 + (pn & 1) * 256 + 32 * wc + 8 * fq) * 2;
#pragma unroll
            for (int j = 0; j < 4; ++j) { a00[j] = silu_f(a00[j]); a01[j] = silu_f(a01[j]); a10[j] = silu_f(a10[j]); a11[j] = silu_f(a11[j]); }
            *(v4u*)(R + R_SG + off) = pack8(a00, a01); *(v4u*)(R + R_SG + off + 256) = pack8(a10, a11);
        } else if (pn == 6) {
            const size_t off = ((size_t)row * 384 + 32 * wc + 8 * fq) * 2;
            *(v4u*)(R + R_LAT + off) = pack8(a00, a01); *(v4u*)(R + R_LAT + off + 256) = pack8(a10, a11);
            float s = sumsq8(a00, a01) + sumsq8(a10, a11); s = xadd<16>(s); s = xadd<32>(s);
            if (fq == 0) ssq[row * 4 + wc] = s;
        } else {
            *(v4u*)(R + R_LAT + ((size_t)row * 384 + 256 + 32 * wc + 8 * fq) * 2) = pack8(a00, a01);
            float s = sumsq8(a00, a01); s = xadd<16>(s); s = xadd<32>(s);
            if (fq == 0) sskv[row * 4 + wc] = s;
            if (wc < 2) { const af4 cs = *(const af4*)(tab + TAB_MC / 4 + pp * 32 + 16 * wc + 4 * fq), sn = *(const af4*)(tab + TAB_MS / 4 + pp * 32 + 16 * wc + 4 * fq);
                *(v4u*)(R + R_KPE + ((size_t)row * 64 + 32 * wc + 8 * fq) * 2) = pack8(a10 * cs - a11 * sn, a10 * sn + a11 * cs); }
        }
    }
    EPI_MAIN_LOOP_PRE()
};
struct EpiGate {
    static constexpr bool PERM = false, AFTER_DRAIN = false, PRE_RS = true;
    unsigned char* SG;
    __device__ __forceinline__ void row(int row, int pn, int wc, int fq, af4 a00, af4 a01, af4 a10, af4 a11) const {
        const size_t off = ((size_t)row * 512 + pn * 256 + 32 * wc + 8 * fq) * 2;
#pragma unroll
        for (int j = 0; j < 4; ++j) { a00[j] = silu_f(a00[j]); a01[j] = silu_f(a01[j]); a10[j] = silu_f(a10[j]); a11[j] = silu_f(a11[j]); }
        *(v4u*)(SG + off) = pack8(a00, a01); *(v4u*)(SG + off + 256) = pack8(a10, a11);
    }
    EPI_MAIN_LOOP_PRE()
};
constexpr float QSCALE = 0.07216878364870323f * 1.4426950408889634f;
struct EpiUp {
    static constexpr bool PERM = false, AFTER_DRAIN = false, PRE_RS = false;
    unsigned char* R; const float* ssq; const float* sskv; const float* tab;
    __device__ __forceinline__ void row(int row, int pn, int wc, int fq, af4 a00, af4 a01, af4 a10, af4 a11) const {
        if (pn < 3) { const af4 q4 = *(const af4*)(ssq + row * 4); const float sc = QSCALE * __builtin_amdgcn_rsqf(((q4[0] + q4[1]) + (q4[2] + q4[3])) * (1.0f / 256.0f) + EPS);
            a00 *= sc; a01 *= sc; a10 *= sc; a11 *= sc;
            if (pn < 2) { const size_t off = ((size_t)row * 512 + 256 * pn + 32 * wc + 8 * fq) * 2;
                *(v4u*)(R + R_QN + off) = pack8(a00, a01); *(v4u*)(R + R_QN + off + 256) = pack8(a10, a11);
            } else { const int pp = row_pos(row);
                const af4 cs = *(const af4*)(tab + TAB_MC / 4 + pp * 32 + 16 * (wc & 1) + 4 * fq), sn = *(const af4*)(tab + TAB_MS / 4 + pp * 32 + 16 * (wc & 1) + 4 * fq);
                const size_t off = ((size_t)row * 256 + (wc >> 1) * 64 + 32 * (wc & 1) + 8 * fq) * 2;
                *(v4u*)(R + R_QPE + off) = pack8(a00 * cs - a01 * sn, a00 * sn + a01 * cs); *(v4u*)(R + R_QPE + off + 256) = pack8(a10 * cs - a11 * sn, a10 * sn + a11 * cs); }
        } else { const af4 q4 = *(const af4*)(sskv + row * 4); const float sc = __builtin_amdgcn_rsqf(((q4[0] + q4[1]) + (q4[2] + q4[3])) * (1.0f / 128.0f) + EPS);
            const size_t off = (pn < 5 ? R_KN : R_V) + ((size_t)row * 512 + 256 * (pn < 5 ? pn - 3 : pn - 5) + 32 * wc + 8 * fq) * 2;
            *(v4u*)(R + off) = pack8(a00 * sc, a01 * sc); *(v4u*)(R + off + 256) = pack8(a10 * sc, a11 * sc);
        }
    }
    EPI_MAIN_LOOP()
};
struct EpiResid {
    static constexpr bool PERM = false, AFTER_DRAIN = false, PRE_RS = false;
    bf16* H; float sc;
    __device__ __forceinline__ void row(int row, int pn, int wc, int fq, af4 a00, af4 a01, af4 a10, af4 a11) const {
        v4u* q = (v4u*)(H + (size_t)row * DM + pn * 256 + wc * 32 + 8 * fq);
        const v4u h0 = q[0], h1 = q[16];
        q[0] = pack8(bf4_to_f32((v2u){h0.x, h0.y}) + a00 * sc, bf4_to_f32((v2u){h0.z, h0.w}) + a01 * sc);
        q[16] = pack8(bf4_to_f32((v2u){h1.x, h1.y}) + a10 * sc, bf4_to_f32((v2u){h1.z, h1.w}) + a11 * sc);
    }
    EPI_MAIN_LOOP()
};
struct EpiSwiGLU {
    static constexpr bool PERM = false, AFTER_DRAIN = false, PRE_RS = true;
    bf16* A;
    __device__ __forceinline__ void row(int row, int pn, int wc, int fq, af4 a00, af4 a01, af4 a10, af4 a11) const {
#pragma unroll
        for (int j = 0; j < 4; ++j) { a00[j] = silu_f(a00[j]) * a10[j]; a01[j] = silu_f(a01[j]) * a11[j]; }
        if (f8) { float t[8];
#pragma unroll
            for (int j = 0; j < 4; ++j) { t[j] = fminf(fmaxf(a00[j] * S_A8, -448.f), 448.f); t[4 + j] = fminf(fmaxf(a01[j] * S_A8, -448.f), 448.f); }
            int lo = __builtin_amdgcn_cvt_pk_fp8_f32(t[0], t[1], 0, false); lo = __builtin_amdgcn_cvt_pk_fp8_f32(t[2], t[3], lo, true);
            int hi = __builtin_amdgcn_cvt_pk_fp8_f32(t[4], t[5], 0, false); hi = __builtin_amdgcn_cvt_pk_fp8_f32(t[6], t[7], hi, true);
            *(v2u*)((unsigned char*)A + (size_t)row * FF + pn * 128 + wc * 32 + 8 * fq) = (v2u){(unsigned)lo, (unsigned)hi}; }
        else *(v4u*)(A + (size_t)row * FF + pn * 128 + wc * 32 + 8 * fq) = pack8(a00, a01);
    }
    typedef float f2v __attribute__((ext_vector_type(2)));
    __device__ __forceinline__ af4 swi_i8(af4 gi, af4 ui, float c1, float sc2) const {
        const pg8::i32x4 g4 = __builtin_bit_cast(pg8::i32x4, gi), u4 = __builtin_bit_cast(pg8::i32x4, ui); af4 o;
#pragma unroll
        for (int h = 0; h < 2; ++h) { const f2v g = {(float)g4[2 * h], (float)g4[2 * h + 1]}, u = {(float)u4[2 * h], (float)u4[2 * h + 1]};
            const f2v t = g * c1, p = (g * u) * sc2; f2v d; d.x = __builtin_amdgcn_exp2f(t.x); d.y = __builtin_amdgcn_exp2f(t.y); d = d + 1.0f;
            o[2 * h] = p.x * __builtin_amdgcn_rcpf(d.x); o[2 * h + 1] = p.y * __builtin_amdgcn_rcpf(d.y); }
        return o; }
    const float* rs = nullptr; int f8 = 0;
    __device__ __forceinline__ void pre(const pg8::Unit& u, LAS unsigned char* buf, int wid, int lane) const {
        if (wid < 4) __builtin_amdgcn_global_load_lds((const GAS unsigned*)(rs + u.pm * 256 + wid * 64 + lane), (LAS unsigned*)(buf + wid * 256), 4, 0, 0); }
    __device__ __forceinline__ void operator()(const af4 (&acc)[2][2][4][2], const pg8::Unit& u, int wr, int wc, int fr, int fq, const LAS unsigned char* buf) const {
        float rsl[8];
#pragma unroll
        for (int i = 0; i < 8; ++i) rsl[i] = *(const LAS float*)(buf + ((i >> 2) * 128 + wr * 64 + (i & 3) * 16 + fr) * 4);
#pragma unroll
        for (int ai = 0; ai < 2; ++ai)
#pragma unroll
            for (int m = 0; m < 4; ++m) { const int r_ = u.pm * 256 + ai * 128 + wr * 64 + m * 16 + fr;
                if (rs) { const float sc = rsl[ai * 4 + m], c1 = -1.4426950408889634f * sc, sc2 = sc * sc * (f8 ? S_A8 : 1.0f);
                    const af4 o0 = swi_i8(acc[ai][0][m][0], acc[ai][1][m][0], c1, sc2), o1 = swi_i8(acc[ai][0][m][1], acc[ai][1][m][1], c1, sc2);
                    if (f8) { float t[8];
#pragma unroll
                        for (int j = 0; j < 4; ++j) { t[j] = fminf(fmaxf(o0[j], -448.f), 448.f); t[4 + j] = fminf(fmaxf(o1[j], -448.f), 448.f); }
                        int lo = __builtin_amdgcn_cvt_pk_fp8_f32(t[0], t[1], 0, false); lo = __builtin_amdgcn_cvt_pk_fp8_f32(t[2], t[3], lo, true);
                        int hi = __builtin_amdgcn_cvt_pk_fp8_f32(t[4], t[5], 0, false); hi = __builtin_amdgcn_cvt_pk_fp8_f32(t[6], t[7], hi, true);
                        *(v2u*)((unsigned char*)A + (size_t)r_ * FF + u.pn * 128 + wc * 32 + 8 * fq) = (v2u){(unsigned)lo, (unsigned)hi}; }
                    else *(v4u*)(A + (size_t)r_ * FF + u.pn * 128 + wc * 32 + 8 * fq) = pack8(o0, o1); }
                else row(r_, u.pn, wc, fq, acc[ai][0][m][0], acc[ai][0][m][1], acc[ai][1][m][0], acc[ai][1][m][1]); }
    }
};
struct EpiMoeDown {
    static constexpr bool PERM = false, AFTER_DRAIN = false, PRE_RS = false;
    bf16* Y; float sc;
    __device__ __forceinline__ void row(int row, int pn, int wc, int fq, af4 a00, af4 a01, af4 a10, af4 a11) const {
        v4u* q = (v4u*)(Y + (size_t)row * DM + pn * 256 + wc * 32 + 8 * fq);
        q[0] = pack8(a00 * sc, a01 * sc); q[16] = pack8(a10 * sc, a11 * sc);
    }
    EPI_MAIN_LOOP()
};

struct EpiNone {
    static constexpr bool PERM = false, AFTER_DRAIN = false, PRE_RS = false;
    __device__ __forceinline__ void operator()(const af4 (&acc)[2][2][4][2], const pg8::Unit&, int, int, int, int) const {
#pragma unroll
        for (int ai = 0; ai < 2; ++ai)
#pragma unroll
            for (int m = 0; m < 4; ++m) asm volatile("" :: "v"(acc[ai][0][m][0]), "v"(acc[ai][0][m][1]), "v"(acc[ai][1][m][0]), "v"(acc[ai][1][m][1])); }
};
struct EpiPartial {
    static constexpr bool PERM = false, AFTER_DRAIN = false, PRE_RS = false;
    float* P; unsigned kbytes; int ks; float sc;
    __device__ __forceinline__ void operator()(const af4 (&acc)[2][2][4][2], const pg8::Unit& u, int wr, int wc, int fr, int fq) const {
        const int tile = (u.pm - MOE_FULL_TILES) * ks + (int)(u.koff / kbytes);
#pragma unroll
        for (int ai = 0; ai < 2; ++ai)
#pragma unroll
            for (int m = 0; m < 4; ++m) { af4* q = (af4*)(P + ((size_t)tile * 256 + ai * 128 + wr * 64 + m * 16 + fr) * DM + u.pn * 256 + wc * 32 + 8 * fq);
                q[0] = acc[ai][0][m][0] * sc; q[1] = acc[ai][0][m][1] * sc; q[32] = acc[ai][1][m][0] * sc; q[33] = acc[ai][1][m][1] * sc; }
    }
};

template <class Epi, int QM> __device__ __forceinline__ void meta_item(LAS unsigned char* lds, const unsigned char* A16, const unsigned char* Bt, int Kb, int item, const Epi& E) {
    int tid_ = threadIdx.x; asm volatile("" : "+v"(tid_));
    const int lane = tid_ & 63, w = __builtin_amdgcn_readfirstlane(tid_ >> 6), fr = lane & 15, fq = lane >> 4, pn = item >> 2, wc = item & 3;
    const int steps = Kb >> 6, spw = (steps + 7) >> 3, s0 = w * spw, s1 = (s0 + spw) < steps ? (s0 + spw) : steps;
    af4 acc[2][2];
#pragma unroll
    for (int bj = 0; bj < 2; ++bj)
#pragma unroll
        for (int n = 0; n < 2; ++n) acc[bj][n] = (af4){0.f, 0.f, 0.f, 0.f};
    const GAS unsigned char* ap = (const GAS unsigned char*)A16 + (size_t)fr * Kb + 16 * fq;
    const GAS unsigned char* bp = (const GAS unsigned char*)Bt + ((size_t)pn * 256 + 32 * wc + fr) * Kb + 16 * fq;
    for (int s = s0; s < s1; s += 4) {
        bf16x8 a[4], b[4][4];
#pragma unroll
        for (int g = 0; g < 4; ++g) if (s + g < s1) { a[g] = *(const GAS bf16x8*)(ap + 64 * (s + g));
#pragma unroll
            for (int f = 0; f < 4; ++f) b[g][f] = *(const GAS bf16x8*)(bp + (size_t)(128 * (f >> 1) + 16 * (f & 1)) * Kb + 64 * (s + g)); }
#pragma unroll
        for (int g = 0; g < 4; ++g) if (s + g < s1) {
#pragma unroll
            for (int f = 0; f < 4; ++f) {
                if constexpr (QM == 2) { typedef long l2v __attribute__((ext_vector_type(2))); const l2v bb = __builtin_bit_cast(l2v, b[g][f]), aa = __builtin_bit_cast(l2v, a[g]);
                    acc[f >> 1][f & 1] = __builtin_amdgcn_mfma_f32_16x16x32_fp8_fp8(bb[0], aa[0], acc[f >> 1][f & 1], 0, 0, 0); acc[f >> 1][f & 1] = __builtin_amdgcn_mfma_f32_16x16x32_fp8_fp8(bb[1], aa[1], acc[f >> 1][f & 1], 0, 0, 0); }
                else acc[f >> 1][f & 1] = pg8::mma16<QM == 1>(b[g][f], a[g], acc[f >> 1][f & 1]); } }
    }
    if (QM == 1) {
#pragma unroll
        for (int f = 0; f < 4; ++f) acc[f >> 1][f & 1] = __builtin_convertvector(__builtin_bit_cast(pg8::i32x4, acc[f >> 1][f & 1]), af4); }
    LAS af4* red = (LAS af4*)lds + (w * 64 + lane) * 4;
    red[0] = acc[0][0]; red[1] = acc[0][1]; red[2] = acc[1][0]; red[3] = acc[1][1];
    __syncthreads();
    if (w == 0) {
#pragma unroll
        for (int ww = 1; ww < 8; ++ww) { const LAS af4* r = (const LAS af4*)lds + (ww * 64 + lane) * 4; acc[0][0] += r[0]; acc[0][1] += r[1]; acc[1][0] += r[2]; acc[1][1] += r[3]; }
        if (QM == 1) { const float sc = E.rs[NMAIN + fr]; acc[0][0] *= sc; acc[0][1] *= sc; acc[1][0] *= sc; acc[1][1] *= sc; }
        E.row(NMAIN + fr, pn, wc, fq, acc[0][0], acc[0][1], acc[1][0], acc[1][1]);
    }
    __syncthreads();
}
template <class Epi, int QM = 0> __device__ __forceinline__ void meta_gemm(Frame& F, const void* A16, const void* Bt, int N, int Kb, const Epi& E) {
    const int nit = (N >> 8) * 4;
    for (int it = F.G - 1 - (int)blockIdx.x; it < nit; it += F.G) meta_item<Epi, QM>(F.lds, (const unsigned char*)A16, (const unsigned char*)Bt, Kb, it, E);
}

__device__ __forceinline__ int expert_base(const unsigned* cnt, int e) { int acc = 0;
#pragma unroll
    for (int k = 0; k < 7; ++k) acc += (k < e) ? (int)((cnt[k] + 255u) & ~255u) : 0;
    return acc; }
__device__ __forceinline__ void issue_row(const bf16* hres, int r, int lane, v2u (&w)[4]) { const GAS v2u* xr = (const GAS v2u*)(hres + (size_t)r * DM) + lane;
#pragma unroll
    for (int j = 0; j < 4; ++j) w[j] = xr[64 * j]; }
__device__ __forceinline__ void expand_row(const v2u (&w)[4], f32x4 (&v)[4]) {
#pragma unroll
    for (int j = 0; j < 4; ++j) v[j] = bf4_to_f32(w[j]); }
__device__ __forceinline__ void issue_tok(Frame& F, int r, int (&tk)[6]) { const int* ti = (const int*)(F.ws + WS_TOK) + (size_t)r * 8;
#pragma unroll
    for (int i = 0; i < 6; ++i) tk[i] = ti[i]; }
template <int KS = MOE_KSPLIT8, bool PRE = false, bool WB = true> __device__ __forceinline__ void load_row(Frame& F, bf16* hres, int r, bool moe_prev, const unsigned* cnt, f32x4 (&v)[4], const int* tkp = nullptr) {
    GAS v2u* xr = (GAS v2u*)(hres + (size_t)r * DM) + F.lane;
    if (!PRE) {
#pragma unroll
    for (int j = 0; j < 4; ++j) v[j] = bf4_to_f32(xr[64 * j]); }
    if (moe_prev) {
        const int* ti = tkp ? tkp : (const int*)(F.ws + WS_TOK) + (size_t)r * 8; const int e1 = ti[0], e2 = ti[1], s1 = ti[2], s2 = ti[3]; const float w1 = __builtin_bit_cast(float, ti[4]), w2 = __builtin_bit_cast(float, ti[5]);
        const int r1 = s1, r2 = s2;
#pragma unroll
        for (int k = 0; k < 2; ++k) { const int rr = k ? r2 : r1; const float ww = k ? w2 : w1;
            if (rr < MOE_FULL_TILES * 256) { const GAS v2u* y = (const GAS v2u*)((const bf16*)(F.ws + WS_YS) + (size_t)rr * DM) + F.lane;
#pragma unroll
                for (int j = 0; j < 4; ++j) { const v2u a = y[64 * j];
                    v[j].x += ww * __builtin_bit_cast(float, a.x << 16); v[j].y += ww * __builtin_bit_cast(float, a.x & 0xffff0000u); v[j].z += ww * __builtin_bit_cast(float, a.y << 16); v[j].w += ww * __builtin_bit_cast(float, a.y & 0xffff0000u); }
            } else {
                const GAS f32x4* p = (const GAS f32x4*)((const float*)(F.ws + WS_PART) + ((size_t)((rr >> 8) - MOE_FULL_TILES) * KS * 256 + (rr & 255)) * DM) + F.lane;
#pragma unroll
                for (int j = 0; j < 4; ++j) { f32x4 s = p[64 * j];
#pragma unroll
                    for (int kc = 1; kc < KS; ++kc) s += p[(size_t)kc * 256 * (DM / 4) + 64 * j];
                    v[j] += s * ww; } } }
        if (WB) {
#pragma unroll
        for (int j = 0; j < 4; ++j) {
            xr[64 * j] = f32_to_bf4(v[j]); } }
    }
}
__device__ __forceinline__ float row_rstd(const f32x4 (&v)[4]) { float s = 0.f;
#pragma unroll
    for (int j = 0; j < 4; ++j) s += (v[j].x * v[j].x + v[j].y * v[j].y) + (v[j].z * v[j].z + v[j].w * v[j].w);
    return __builtin_amdgcn_rsqf(wave_sum(s) * (1.0f / DM) + EPS); }
__device__ __forceinline__ void store_xn(Frame& F, int r, const f32x4 (&v)[4], float rstd) {
    GAS v2u* o = (GAS v2u*)((bf16*)(F.ws + WS_XN) + (size_t)r * DM) + F.lane;
#pragma unroll
    for (int j = 0; j < 4; ++j) { v2u w; w.x = pk2(v[j].x * rstd, v[j].y * rstd); w.y = pk2(v[j].z * rstd, v[j].w * rstd); o[64 * j] = w; }
}
__device__ __forceinline__ void store_xq(Frame& F, int r, const f32x4 (&v)[4], float rstd) {
    float amax = 0.f;
#pragma unroll
    for (int j = 0; j < 4; ++j) amax = fmaxf(fmaxf(amax, fmaxf(fabsf(v[j].x), fabsf(v[j].y))), fmaxf(fabsf(v[j].z), fabsf(v[j].w)));
    amax = fmaxf(wave_max(amax) * rstd, 1e-20f);
    const float s = rstd * (127.0f / amax);
    GAS unsigned* o = (GAS unsigned*)(F.ws + WS_XN + (size_t)r * DM) + F.lane;
#pragma unroll
    for (int j = 0; j < 4; ++j) { const int q0 = (int)__builtin_rintf(v[j].x * s), q1 = (int)__builtin_rintf(v[j].y * s), q2 = (int)__builtin_rintf(v[j].z * s), q3 = (int)__builtin_rintf(v[j].w * s);
        o[64 * j] = (unsigned)(q0 & 255) | ((unsigned)(q1 & 255) << 8) | ((unsigned)(q2 & 255) << 16) | ((unsigned)q3 << 24); }
    if (F.lane == 0) ((float*)(F.ws + WS_RS))[r] = amax * (1.0f / (127.0f * S_W8));
}
__device__ __forceinline__ void norm_phase(Frame& F, bool moe_prev, const unsigned* cnt_prev, bool q8) {
    const int gw = F.vcu * NWAVES + F.wave, NGW = F.G * NWAVES; bf16* hres = (bf16*)(F.ws + WS_HRES);
    if (moe_prev) {
        v2u w[4]; if (gw < MTOK) issue_row(hres, gw, F.lane, w);
        for (int r = gw; r < MTOK; r += NGW) { v2u wn[4]; if (r + NGW < MTOK) issue_row(hres, r + NGW, F.lane, wn);
            f32x4 v[4]; expand_row(w, v); load_row<MOE_KSPLIT8, true>(F, hres, r, true, cnt_prev, v); const float rstd = row_rstd(v); if (q8) store_xq(F, r, v, rstd); else store_xn(F, r, v, rstd);
#pragma unroll
            for (int j = 0; j < 4; ++j) w[j] = wn[j]; }
        return; }
    v2u wa[4], wb[4]; if (gw < MTOK) issue_row(hres, gw, F.lane, wa); if (gw + NGW < MTOK) issue_row(hres, gw + NGW, F.lane, wb);
    for (int r = gw; r < MTOK; r += 2 * NGW) {
        const bool hb = r + NGW < MTOK;
        v2u na[4], nb[4]; if (r + 2 * NGW < MTOK) issue_row(hres, r + 2 * NGW, F.lane, na); if (r + 3 * NGW < MTOK) issue_row(hres, r + 3 * NGW, F.lane, nb);
        f32x4 v[2][4]; expand_row(wa, v[0]); if (hb) expand_row(wb, v[1]); else expand_row(wa, v[1]);
        float rstd[2];
#pragma unroll
        for (int p = 0; p < 2; ++p) rstd[p] = row_rstd(v[p]);
        if (q8) { store_xq(F, r, v[0], rstd[0]); if (hb) store_xq(F, r + NGW, v[1], rstd[1]); }
        else { store_xn(F, r, v[0], rstd[0]); if (hb) store_xn(F, r + NGW, v[1], rstd[1]); }
#pragma unroll
        for (int j = 0; j < 4; ++j) { wa[j] = na[j]; wb[j] = nb[j]; }
    }
}
__device__ __forceinline__ void route_phase(Frame& F, const float* gain, const float* router_w, unsigned* cnt) {
    const int gw = F.vcu * NWAVES + F.wave, NGW = F.G * NWAVES; bf16* hres = (bf16*)(F.ws + WS_HRES);
    LAS float* rw = (LAS float*)F.lds;
    LAS unsigned* lcnt = (LAS unsigned*)(F.lds + 32768);
    for (int i = F.tid; i < DM * NEXP / 4; i += NWAVES * 64) { const f32x4 w4 = ((const f32x4*)router_w)[i]; const int k = i >> 1, e0 = (i & 1) * 4;
        rw[(e0 + 0) * DM + k] = w4.x; rw[(e0 + 1) * DM + k] = w4.y; rw[(e0 + 2) * DM + k] = w4.z; rw[(e0 + 3) * DM + k] = w4.w; }
    if (F.tid < 8) lcnt[F.tid] = 0u;
    __syncthreads();
    f32x4 gq[4];
#pragma unroll
    for (int j = 0; j < 4; ++j) gq[j] = *(const f32x4*)(gain + 4 * F.lane + 256 * j);
    v2u wa[4], wb[4]; if (gw < MTOK) issue_row(hres, gw, F.lane, wa); if (gw + NGW < MTOK) issue_row(hres, gw + NGW, F.lane, wb);
    for (int r = gw; r < MTOK; r += 2 * NGW) {
        const bool hb = r + NGW < MTOK;
        v2u na[4], nb[4]; if (r + 2 * NGW < MTOK) issue_row(hres, r + 2 * NGW, F.lane, na); if (r + 3 * NGW < MTOK) issue_row(hres, r + 3 * NGW, F.lane, nb);
        const int rr2[2] = {r, hb ? r + NGW : r};
        f32x4 v[2][4]; expand_row(wa, v[0]); if (hb) expand_row(wb, v[1]); else expand_row(wa, v[1]);
        float rstd[2];
#pragma unroll
        for (int p = 0; p < 2; ++p) rstd[p] = row_rstd(v[p]);
        store_xq(F, rr2[0], v[0], rstd[0]); if (hb) store_xq(F, rr2[1], v[1], rstd[1]);
        float lg[2][8];
#pragma unroll
        for (int p = 0; p < 2; ++p)
#pragma unroll
            for (int e = 0; e < 8; ++e) lg[p][e] = 0.f;
#pragma unroll
        for (int j = 0; j < 4; ++j) { const int k0 = 4 * F.lane + 256 * j; const f32x4 g = gq[j];
            float hv[2][4];
#pragma unroll
            for (int p = 0; p < 2; ++p) { hv[p][0] = v[p][j].x * rstd[p] * g.x; hv[p][1] = v[p][j].y * rstd[p] * g.y; hv[p][2] = v[p][j].z * rstd[p] * g.z; hv[p][3] = v[p][j].w * rstd[p] * g.w; }
#pragma unroll
            for (int e = 0; e < 8; ++e) { const f32x4 w4 = *(const LAS f32x4*)(rw + e * DM + k0);
#pragma unroll
                for (int p = 0; p < 2; ++p) { lg[p][e] += hv[p][0] * w4.x; lg[p][e] += hv[p][1] * w4.y; lg[p][e] += hv[p][2] * w4.z; lg[p][e] += hv[p][3] * w4.w; } } }
        { float a4[2][4], b2[2][2], cc[2]; const bool b4 = (F.lane & 16) != 0, b3 = (F.lane & 8) != 0;
#pragma unroll
          for (int p = 0; p < 2; ++p)
#pragma unroll
            for (int e = 0; e < 4; ++e) { auto rr = __builtin_amdgcn_permlane32_swap(__builtin_bit_cast(unsigned, lg[p][e]), __builtin_bit_cast(unsigned, lg[p][e + 4]), false, false); a4[p][e] = __builtin_bit_cast(float, (unsigned)rr[0]) + __builtin_bit_cast(float, (unsigned)rr[1]); }
#pragma unroll
          for (int p = 0; p < 2; ++p)
#pragma unroll
            for (int k = 0; k < 2; ++k) { const float keep = b4 ? a4[p][k + 2] : a4[p][k], send = b4 ? a4[p][k] : a4[p][k + 2]; b2[p][k] = keep + xshfl<16>(send); }
#pragma unroll
          for (int p = 0; p < 2; ++p) cc[p] = (b3 ? b2[p][1] : b2[p][0]) + xshfl<8>(b3 ? b2[p][0] : b2[p][1]);
#pragma unroll
          for (int p = 0; p < 2; ++p) cc[p] = xadd<4>(cc[p]);
#pragma unroll
          for (int p = 0; p < 2; ++p) cc[p] = xadd<2>(cc[p]);
#pragma unroll
          for (int p = 0; p < 2; ++p) cc[p] = xadd<1>(cc[p]);
#pragma unroll
          for (int p = 0; p < 2; ++p)
#pragma unroll
            for (int e = 0; e < 8; ++e) lg[p][e] = __builtin_bit_cast(float, __builtin_amdgcn_readlane(__builtin_bit_cast(int, cc[p]), 32 * (e >> 2) + 16 * ((e >> 1) & 1) + 8 * (e & 1))); }
#pragma unroll
        for (int p = 0; p < 2; ++p) {
            int e1 = 0; float v1 = lg[p][0];
#pragma unroll
            for (int e = 1; e < 8; ++e) if (lg[p][e] > v1) { v1 = lg[p][e]; e1 = e; }
            int e2 = -1; float v2 = -3.0e38f;
#pragma unroll
            for (int e = 0; e < 8; ++e) if (e != e1 && (e2 < 0 || lg[p][e] > v2)) { v2 = lg[p][e]; e2 = e; }
            const float w2 = 1.0f / (1.0f + __expf(v1 - v2)), w1 = 1.0f - w2;
            if (F.lane == 0 && (p == 0 || hb)) { __hip_atomic_fetch_add(lcnt + e1, 1u, __ATOMIC_RELAXED, __HIP_MEMORY_SCOPE_WORKGROUP); __hip_atomic_fetch_add(lcnt + e2, 1u, __ATOMIC_RELAXED, __HIP_MEMORY_SCOPE_WORKGROUP);
                int* ti = (int*)(F.ws + WS_TOK) + (size_t)rr2[p] * 8; ti[0] = e1; ti[1] = e2; ti[4] = __builtin_bit_cast(int, w1); ti[5] = __builtin_bit_cast(int, w2); } }
#pragma unroll
        for (int j = 0; j < 4; ++j) { wa[j] = na[j]; wb[j] = nb[j]; }
    }
    __syncthreads();
    if (F.tid < 8) { __hip_atomic_fetch_add(cnt + F.tid, lcnt[F.tid], RLX_AGENT); ((unsigned*)(F.ws + WS_WGCNT))[F.vcu * 8 + F.tid] = lcnt[F.tid]; }
    __syncthreads();
}
__device__ __forceinline__ void gather_phase(Frame& F, const unsigned* cnt) {
    const int gw = F.vcu * NWAVES + F.wave, NGW = F.G * NWAVES;
    LAS float* tb = (LAS float*)F.lds;
    LAS int* wgbase = (LAS int*)(F.lds + 8192); LAS int* wcnt = wgbase + 8; LAS int* run = wcnt + 64;
    for (int i = F.tid; i < 2048; i += NWAVES * 64) tb[i] = (i >> 3) < F.vcu ? (float)((const unsigned*)(F.ws + WS_WGCNT))[i] : 0.f;
    if (F.tid < 64) { wcnt[F.tid] = 0; }
    __syncthreads();
    { float s = 0.f;
#pragma unroll
      for (int k = 0; k < 4; ++k) s += tb[(F.lane + 64 * k) * 8 + F.wave];
      s = wave_sum(s); if (F.lane == 0) wgbase[F.wave] = expert_base(cnt, F.wave) + (int)s; }
    v4u a[9]; float sc[9];
#pragma unroll
    for (int k = 0; k < 9; ++k) { const int r = gw + k * NGW; if (r < MTOK) { a[k] = *((const GAS v4u*)(F.ws + WS_XN + (size_t)r * DM) + F.lane); sc[k] = ((const float*)(F.ws + WS_RS))[r]; } }
    int e1s[9], e2s[9];
#pragma unroll
    for (int k = 0; k < 9; ++k) { const int r = gw + k * NGW; e1s[k] = 0; e2s[k] = 0; if (r < MTOK) { const int* ti = (const int*)(F.ws + WS_TOK) + (size_t)r * 8; e1s[k] = ti[0]; e2s[k] = ti[1]; } }
    asm volatile("" ::: "memory");
#pragma unroll
    for (int k = 0; k < 9; ++k) if (gw + k * NGW < MTOK && F.lane == 0) { wcnt[F.wave * 8 + e1s[k]] += 1; wcnt[F.wave * 8 + e2s[k]] += 1; }
    for (int r = gw + 9 * NGW; r < MTOK; r += NGW) if (F.lane == 0) { const int* ti = (const int*)(F.ws + WS_TOK) + (size_t)r * 8; wcnt[F.wave * 8 + ti[0]] += 1; wcnt[F.wave * 8 + ti[1]] += 1; }
    __syncthreads();
    if (F.lane < 8) { int a = 0; for (int ww = 0; ww < F.wave; ++ww) a += wcnt[ww * 8 + F.lane]; run[F.wave * 8 + F.lane] = wgbase[F.lane] + a; }
    asm volatile("s_waitcnt lgkmcnt(0)" ::: "memory");
    { int d1[9], d2[9];
#pragma unroll
      for (int k = 0; k < 9; ++k) { d1[k] = -1; d2[k] = -1; }
#pragma unroll
      for (int k = 0; k < 9; ++k) { const int r = gw + k * NGW;
          if (r < MTOK) { int* ti = (int*)(F.ws + WS_TOK) + (size_t)r * 8; const int e1 = e1s[k], e2 = e2s[k];
              d1[k] = run[F.wave * 8 + e1]; d2[k] = run[F.wave * 8 + e2];
              asm volatile("s_waitcnt lgkmcnt(0)" ::: "memory");
              if (F.lane == 0) { run[F.wave * 8 + e1] = d1[k] + 1; run[F.wave * 8 + e2] = d2[k] + 1; ti[2] = d1[k]; ti[3] = d2[k]; }
              asm volatile("s_waitcnt lgkmcnt(0)" ::: "memory"); } }
#pragma unroll
      for (int k = 0; k < 9; ++k) if (d1[k] >= 0) {
          *((GAS v4u*)(F.ws + WS_XS + (size_t)d1[k] * DM) + F.lane) = a[k]; *((GAS v4u*)(F.ws + WS_XS + (size_t)d2[k] * DM) + F.lane) = a[k];
          if (F.lane == 0) { ((float*)(F.ws + WS_RSS))[d1[k]] = sc[k]; ((float*)(F.ws + WS_RSS))[d2[k]] = sc[k]; } } }
    for (int r = gw + 9 * NGW; r < MTOK; r += NGW) {
        int* ti = (int*)(F.ws + WS_TOK) + (size_t)r * 8; const int e1 = ti[0], e2 = ti[1];
        const v4u a = *((const GAS v4u*)(F.ws + WS_XN + (size_t)r * DM) + F.lane); const float sc = ((const float*)(F.ws + WS_RS))[r];
        const int d1 = run[F.wave * 8 + e1], d2 = run[F.wave * 8 + e2];
        asm volatile("s_waitcnt lgkmcnt(0)" ::: "memory");
        if (F.lane == 0) { run[F.wave * 8 + e1] = d1 + 1; run[F.wave * 8 + e2] = d2 + 1; ti[2] = d1; ti[3] = d2; }
        asm volatile("s_waitcnt lgkmcnt(0)" ::: "memory");
        *((GAS v4u*)(F.ws + WS_XS + (size_t)d1 * DM) + F.lane) = a; *((GAS v4u*)(F.ws + WS_XS + (size_t)d2 * DM) + F.lane) = a;
        if (F.lane == 0) { ((float*)(F.ws + WS_RSS))[d1] = sc; ((float*)(F.ws + WS_RSS))[d2] = sc; } }
    for (int e = 0; e < 8; ++e) { const int c0 = (int)cnt[e], c1 = (c0 + 255) & ~255, b0 = expert_base(cnt, e);
        for (int q = c0 + gw; q < c1; q += NGW) { *((GAS v4u*)(F.ws + WS_XS + (size_t)(b0 + q) * DM) + F.lane) = zero4(); if (F.lane == 0) ((float*)(F.ws + WS_RSS))[b0 + q] = 0.f; } }
}
__device__ __forceinline__ void final_phase(Frame& F, const float* gain, float* out, const unsigned* cnt_prev) {
    const int gw = F.vcu * NWAVES + F.wave, NGW = F.G * NWAVES; bf16* hres = (bf16*)(F.ws + WS_HRES);
    f32x4 gq[4];
#pragma unroll
    for (int j = 0; j < 4; ++j) gq[j] = *(const f32x4*)(gain + 4 * F.lane + 256 * j);
    v2u w[4]; int tk[6]; if (gw < NMAIN) { issue_row(hres, gw, F.lane, w); issue_tok(F, gw, tk); }
    for (int q = gw; q < NMAIN; q += NGW) { const int r = q;
        v2u wn[4]; int tn[6]; if (q + NGW < NMAIN) { issue_row(hres, q + NGW, F.lane, wn); issue_tok(F, q + NGW, tn); }
        f32x4 v[4]; expand_row(w, v); load_row<MOE_KSPLIT8, true, false>(F, hres, r, true, cnt_prev, v, tk); const float rstd = row_rstd(v);
        GAS f32x4* o = (GAS f32x4*)(out + (size_t)q * DM) + F.lane;
#pragma unroll
        for (int j = 0; j < 4; ++j) { const f32x4 g = gq[j]; o[64 * j] = (f32x4){v[j].x * rstd * g.x, v[j].y * rstd * g.y, v[j].z * rstd * g.z, v[j].w * rstd * g.w}; }
#pragma unroll
        for (int j = 0; j < 4; ++j) w[j] = wn[j];
#pragma unroll
        for (int i = 0; i < 6; ++i) tk[i] = tn[i];
    }
}

typedef short v4i16_t __attribute__((ext_vector_type(4)));
__device__ __forceinline__ s16x4 vtr(const LAS unsigned char* p) { return __builtin_bit_cast(s16x4, __builtin_amdgcn_ds_read_tr16_b64_v4i16((LAS v4i16_t*)p)); }
#define MFMA16(a, b, c) __builtin_amdgcn_mfma_f32_16x16x32_bf16((a), (b), (c), 0, 0, 0)
#define CAT8(L, H) (bf16x8){L[0], L[1], L[2], L[3], H[0], H[1], H[2], H[3]}
__device__ __forceinline__ void ret_state_unit(Frame& F, int unit) {
    const int b = unit >> 5, h = (unit >> 3) & 3, es = unit & 7;
    int tid_ = threadIdx.x; asm volatile("" : "+v"(tid_));
    const int tid = tid_, lane = tid & 63, w = __builtin_amdgcn_readfirstlane(tid >> 6), l15 = lane & 15, kg = lane >> 4, q = l15 >> 2, p_ = l15 & 3;
    const float g64 = exp2f(64.0f * log2_gamma(h));
    const bf16* rkz = (const bf16*)(F.ws + WS_R + R_RKZ) + h * 128;
    const bf16* rv = (const bf16*)(F.ws + WS_R + R_RV) + h * 128 + es * 16;
    bf16* ST = (bf16*)(F.ws + WS_R + R_ST) + (size_t)((b * 4 + h) * NCH) * 16384 + (es * 16 + l15) * 128 + w * 16 + 4 * kg;
    LAS unsigned char* KZ = F.lds; LAS unsigned char* VS = F.lds + 7 * 16384;
    const GAS unsigned char* zsrc = (const GAS unsigned char*)(F.ws + WS_CTL + 512);
#define RS_DMA(c, slot) do { const int cc = (c) < 31 ? (c) : 31; const size_t p0 = cc == 0 ? (size_t)NMAIN : (size_t)b * SEQ + 64 * (cc - 1); \
        _Pragma("unroll") for (int i_ = 0; i_ < 2; ++i_) { const int row = 4 * (2 * w + i_) + (lane >> 4); const GAS unsigned char* src = (const GAS unsigned char*)(rkz + (p0 + row) * 512 + (lane & 15) * 8); \
            if (cc == 0 && row >= NMETA) src = zsrc; __builtin_amdgcn_global_load_lds((const GAS unsigned*)src, (LAS unsigned*)(KZ + (slot) * 16384 + (2 * w + i_) * 1024), 16, 0, 0); } \
        if (w < 2) { const int row = 32 * w + (lane >> 1); const GAS unsigned char* src = (const GAS unsigned char*)(rv + (p0 + row) * 512 + (lane & 1) * 8); \
            if (cc == 0 && row >= NMETA) src = zsrc; __builtin_amdgcn_global_load_lds((const GAS unsigned*)src, (LAS unsigned*)(VS + (slot) * 2048 + w * 1024), 16, 0, 0); } } while (0)
    RS_DMA(0, 0); RS_DMA(1, 1); RS_DMA(2, 2); RS_DMA(3, 3); RS_DMA(4, 4); RS_DMA(5, 5);
    af4 S = {0.f, 0.f, 0.f, 0.f};
    int slot = 0;
#pragma unroll 1
    for (int c = 0; c <= 32; ++c) {
        { v2u o; o.x = pk2(S[0], S[1]); o.y = pk2(S[2], S[3]); *(GAS v2u*)(ST + (size_t)c * 16384) = o; }
        if (c == 32) break;
        if (w < 2) asm volatile("s_waitcnt vmcnt(15)" ::: "memory"); else asm volatile("s_waitcnt vmcnt(10)" ::: "memory");
        asm volatile("" ::: "memory"); __builtin_amdgcn_s_barrier(); asm volatile("" ::: "memory");
        { const int s6 = slot == 0 ? 6 : slot - 1; RS_DMA(c + 6, s6); }
        const int kza = (int)(size_t)(KZ + slot * 16384 + w * 32 + p_ * 8) + (8 * kg + q) * 256, vsa = (int)(size_t)(VS + slot * 2048 + p_ * 8) + (8 * kg + q) * 32;
        s16x4 a0, a1, a2, a3, b0, b1, b2, b3;
        asm volatile("ds_read_b64_tr_b16 %0, %8\n\tds_read_b64_tr_b16 %1, %8 offset:1024\n\tds_read_b64_tr_b16 %2, %8 offset:8192\n\tds_read_b64_tr_b16 %3, %8 offset:9216\n\t"
                     "ds_read_b64_tr_b16 %4, %9\n\tds_read_b64_tr_b16 %5, %9 offset:128\n\tds_read_b64_tr_b16 %6, %9 offset:1024\n\tds_read_b64_tr_b16 %7, %9 offset:1152\n\ts_waitcnt lgkmcnt(0)"
                     : "=&v"(a0), "=&v"(a1), "=&v"(a2), "=&v"(a3), "=&v"(b0), "=&v"(b1), "=&v"(b2), "=&v"(b3) : "v"(kza), "v"(vsa) : "memory");
        S *= g64;
        S = MFMA16(CAT8(a0, a1), CAT8(b0, b1), S); S = MFMA16(CAT8(a2, a3), CAT8(b2, b3), S);
        slot = slot == 6 ? 0 : slot + 1;
    }
    asm volatile("s_waitcnt vmcnt(0)" ::: "memory");
    __syncthreads();
#undef RS_DMA
}
__device__ __forceinline__ void ret_state64_unit(Frame& F, int unit) {
    asm volatile("" : "+s"(unit));
    const int b = unit >> 3, h = (unit >> 1) & 3, es = unit & 1;
    int tid_ = threadIdx.x; asm volatile("" : "+v"(tid_));
    const int tid = tid_, lane = tid & 63, w = __builtin_amdgcn_readfirstlane(tid >> 6), l15 = lane & 15, kg = lane >> 4, q = l15 >> 2, p_ = l15 & 3;
    LAS unsigned char* KZ = F.lds; LAS unsigned char* VS = F.lds + 5 * 16384;
    if (w >= 4) {
        const int pw = w - 4;
        const bf16* rkz = (const bf16*)(F.ws + WS_R + R_RKZ) + h * 128;
        const bf16* rv = (const bf16*)(F.ws + WS_R + R_RV) + h * 128 + es * 64;
        const GAS unsigned char* zsrc = (const GAS unsigned char*)(F.ws + WS_CTL + 512);
#define RS_DMA(c, slot) do { const int cc = (c) < 31 ? (c) : 31; const size_t p0 = cc == 0 ? (size_t)NMAIN : (size_t)b * SEQ + 64 * (cc - 1); \
        _Pragma("unroll") for (int i_ = 0; i_ < 4; ++i_) { const int pc = 4 * pw + i_, row = 4 * pc + (lane >> 4); const GAS unsigned char* src = (const GAS unsigned char*)(rkz + (p0 + row) * 512 + (lane & 15) * 8); \
            if (cc == 0 && row >= NMETA) src = zsrc; __builtin_amdgcn_global_load_lds((const GAS unsigned*)src, (LAS unsigned*)(KZ + (slot) * 16384 + pc * 1024), 16, 0, 0); } \
        _Pragma("unroll") for (int i_ = 0; i_ < 2; ++i_) { const int pc = 2 * pw + i_, row = 8 * pc + (lane >> 3); const GAS unsigned char* src = (const GAS unsigned char*)(rv + (p0 + row) * 512 + (lane & 7) * 8); \
            if (cc == 0 && row >= NMETA) src = zsrc; __builtin_amdgcn_global_load_lds((const GAS unsigned*)src, (LAS unsigned*)(VS + (slot) * 8192 + pc * 1024), 16, 0, 0); } } while (0)
        RS_DMA(0, 0); RS_DMA(1, 1); RS_DMA(2, 2); RS_DMA(3, 3);
        int slot = 0;
#pragma unroll 1
        for (int c = 0; c < 32; ++c) {
            asm volatile("s_waitcnt vmcnt(18)" ::: "memory");
            asm volatile("" ::: "memory"); __builtin_amdgcn_s_barrier(); asm volatile("" ::: "memory");
            { const int s4 = slot == 0 ? 4 : slot - 1; RS_DMA(c + 4, s4); }
            slot = slot == 4 ? 0 : slot + 1;
        }
        asm volatile("s_waitcnt vmcnt(0)" ::: "memory");
#undef RS_DMA
    } else {
        const float g64 = exp2f(64.0f * log2_gamma(h));
        bf16* ST = (bf16*)(F.ws + WS_R + R_ST) + (size_t)((b * 4 + h) * NCH) * 16384 + ((es * 4) * 8 + 2 * w) * 256 + l15 * 16 + 4 * kg;
        af4 S[2][4];
#pragma unroll
        for (int kb = 0; kb < 2; ++kb)
#pragma unroll
            for (int vg = 0; vg < 4; ++vg) S[kb][vg] = (af4){0.f, 0.f, 0.f, 0.f};
        int slot = 0;
#pragma unroll 1
        for (int c = 0; c <= 32; ++c) {
#pragma unroll
            for (int kb = 0; kb < 2; ++kb)
#pragma unroll
                for (int vg = 0; vg < 4; ++vg) { v2u o; o.x = pk2(S[kb][vg][0], S[kb][vg][1]); o.y = pk2(S[kb][vg][2], S[kb][vg][3]); *(GAS v2u*)(ST + (size_t)c * 16384 + vg * 2048 + kb * 256) = o; }
            if (c == 32) break;
            asm volatile("" ::: "memory"); __builtin_amdgcn_s_barrier(); asm volatile("" ::: "memory");
            const int kza = (int)(size_t)(KZ + slot * 16384 + w * 64 + p_ * 8) + (8 * kg + q) * 256, vsa = (int)(size_t)(VS + slot * 8192 + p_ * 8) + (8 * kg + q) * 128;
            s16x4 av[2][4], bv[4][4];
            asm volatile("ds_read_b64_tr_b16 %0, %24\n\tds_read_b64_tr_b16 %1, %24 offset:1024\n\tds_read_b64_tr_b16 %2, %24 offset:8192\n\tds_read_b64_tr_b16 %3, %24 offset:9216\n\tds_read_b64_tr_b16 %4, %24 offset:32\n\tds_read_b64_tr_b16 %5, %24 offset:1056\n\tds_read_b64_tr_b16 %6, %24 offset:8224\n\tds_read_b64_tr_b16 %7, %24 offset:9248\n\tds_read_b64_tr_b16 %8, %25\n\tds_read_b64_tr_b16 %9, %25 offset:512\n\tds_read_b64_tr_b16 %10, %25 offset:4096\n\tds_read_b64_tr_b16 %11, %25 offset:4608\n\tds_read_b64_tr_b16 %12, %25 offset:32\n\tds_read_b64_tr_b16 %13, %25 offset:544\n\tds_read_b64_tr_b16 %14, %25 offset:4128\n\tds_read_b64_tr_b16 %15, %25 offset:4640\n\tds_read_b64_tr_b16 %16, %25 offset:64\n\tds_read_b64_tr_b16 %17, %25 offset:576\n\tds_read_b64_tr_b16 %18, %25 offset:4160\n\tds_read_b64_tr_b16 %19, %25 offset:4672\n\tds_read_b64_tr_b16 %20, %25 offset:96\n\tds_read_b64_tr_b16 %21, %25 offset:608\n\tds_read_b64_tr_b16 %22, %25 offset:4192\n\tds_read_b64_tr_b16 %23, %25 offset:4704\n\ts_waitcnt lgkmcnt(0)"
                         : "=&v"(av[0][0]), "=&v"(av[0][1]), "=&v"(av[0][2]), "=&v"(av[0][3]), "=&v"(av[1][0]), "=&v"(av[1][1]), "=&v"(av[1][2]), "=&v"(av[1][3]), "=&v"(bv[0][0]), "=&v"(bv[0][1]), "=&v"(bv[0][2]), "=&v"(bv[0][3]), "=&v"(bv[1][0]), "=&v"(bv[1][1]), "=&v"(bv[1][2]), "=&v"(bv[1][3]), "=&v"(bv[2][0]), "=&v"(bv[2][1]), "=&v"(bv[2][2]), "=&v"(bv[2][3]), "=&v"(bv[3][0]), "=&v"(bv[3][1]), "=&v"(bv[3][2]), "=&v"(bv[3][3]) : "v"(kza), "v"(vsa) : "memory");
#pragma unroll
            for (int kb = 0; kb < 2; ++kb)
#pragma unroll
                for (int vg = 0; vg < 4; ++vg) { S[kb][vg] *= g64;
                    S[kb][vg] = MFMA16(CAT8(av[kb][0], av[kb][1]), CAT8(bv[vg][0], bv[vg][1]), S[kb][vg]); S[kb][vg] = MFMA16(CAT8(av[kb][2], av[kb][3]), CAT8(bv[vg][2], bv[vg][3]), S[kb][vg]); }
            slot = slot == 4 ? 0 : slot + 1;
        }
    }
    __syncthreads();
}
__device__ __forceinline__ void ret_out_unit(Frame& F, int unit, const float* gain) {
    const int c = unit < NB * 4 * 32 ? 1 + (unit & 31) : 0, b = unit < NB * 4 * 32 ? unit >> 7 : 0, h = unit < NB * 4 * 32 ? (unit >> 5) & 3 : unit - NB * 4 * 32;
    int tid_ = threadIdx.x; asm volatile("" : "+v"(tid_));
    const int tid = tid_, lane = tid & 63, w = __builtin_amdgcn_readfirstlane(tid >> 6), l15 = lane & 15, kg = lane >> 4, q = l15 >> 2, p_ = l15 & 3, it = w & 3, eh = w >> 2;
    const float lg = log2_gamma(h);
    const size_t r0 = c == 0 ? (size_t)NMAIN : (size_t)b * SEQ + 64 * (c - 1);
    const bf16* rq = (const bf16*)(F.ws + WS_R + R_RQ) + r0 * 512 + h * 128;
    const bf16* rk = (const bf16*)(F.ws + WS_R + R_RK) + r0 * 512 + h * 128;
    const bf16* rv = (const bf16*)(F.ws + WS_R + R_RV) + r0 * 512 + h * 128;
    const bf16* sg = (const bf16*)(F.ws + WS_R + R_SG) + r0 * 512 + h * 128;
    const bf16* ST = (const bf16*)(F.ws + WS_R + R_ST) + (size_t)((b * 4 + h) * NCH + c) * 16384;
    bf16* Y = (bf16*)(F.ws + WS_R + R_Y) + r0 * DM + h * 128;
    LAS unsigned char* VL = F.lds; LAS unsigned char* SGL = F.lds + 16384; LAS unsigned char* YL = F.lds + 32768; LAS float* red = (LAS float*)(F.lds + 49152);
    v4u vst[2], gst[2];
#pragma unroll
    for (int i = 0; i < 2; ++i) { const int idx = tid + 512 * i; vst[i] = zero4(); gst[i] = vst[i];
        if (c > 0 || (idx >> 4) < NMETA) { vst[i] = *(const GAS v4u*)(rv + (size_t)(idx >> 4) * 512 + (idx & 15) * 8); gst[i] = *(const GAS v4u*)(sg + (size_t)(idx >> 4) * 512 + (idx & 15) * 8); } }
    float gn[4];
#pragma unroll
    for (int et = 0; et < 4; ++et) gn[et] = gain[h * 128 + 64 * eh + 16 * et + l15];
    bf16x8 qf[4];
#pragma unroll
    for (int ks = 0; ks < 4; ++ks) qf[ks] = *(const GAS bf16x8*)(rq + (size_t)(16 * it + l15) * 512 + 32 * ks + 8 * kg);
    af4 pj[4];
#pragma unroll
    for (int jt = 0; jt < 4; ++jt) { pj[jt] = (af4){0.f, 0.f, 0.f, 0.f};
#pragma unroll
        for (int ks = 0; ks < 4; ++ks) { const bf16x8 kf = *(const GAS bf16x8*)(rk + (size_t)(16 * jt + l15) * 512 + 32 * ks + 8 * kg); pj[jt] = MFMA16(kf, qf[ks], pj[jt]); } }
#pragma unroll
    for (int i = 0; i < 2; ++i) { const int idx = tid + 512 * i; *(LAS v4u*)(VL + (idx >> 4) * 256 + (idx & 15) * 16) = vst[i]; *(LAS v4u*)(SGL + (idx >> 4) * 256 + (idx & 15) * 16) = gst[i]; }
    bf16x8 pa[2];
    { const int il = 16 * it + l15; unsigned pw[4][2];
#pragma unroll
      for (int jt = 0; jt < 4; ++jt) { float v[4];
#pragma unroll
          for (int r = 0; r < 4; ++r) { const int jl = 16 * jt + 4 * kg + r; const int dd = il > jl ? il - jl : jl - il; const float wgt = __builtin_amdgcn_exp2f(lg * (float)dd); v[r] = (c == 0 && jl >= NMETA) ? 0.f : pj[jt][r] * wgt; }
          pw[jt][0] = pk2(v[0], v[1]); pw[jt][1] = pk2(v[2], v[3]); }
      pa[0] = __builtin_bit_cast(bf16x8, (v4u){pw[0][0], pw[0][1], pw[1][0], pw[1][1]}); pa[1] = __builtin_bit_cast(bf16x8, (v4u){pw[2][0], pw[2][1], pw[3][0], pw[3][1]}); }
    af4 acc[4];
#pragma unroll
    for (int et = 0; et < 4; ++et) acc[et] = (af4){0.f, 0.f, 0.f, 0.f};
    if (c > 0) {
#pragma unroll
        for (int et = 0; et < 4; ++et)
#pragma unroll
            for (int ks = 0; ks < 4; ++ks) { const bf16x8 sf = *(const GAS bf16x8*)(ST + (size_t)(((4 * eh + et) * 8 + 2 * ks + (kg >> 1)) * 256 + l15 * 16 + 8 * (kg & 1))); acc[et] = MFMA16(qf[ks], sf, acc[et]); }
        float xi[4];
#pragma unroll
        for (int r = 0; r < 4; ++r) xi[r] = __builtin_amdgcn_exp2f(lg * (float)(16 * it + 4 * kg + r + 1));
#pragma unroll
        for (int et = 0; et < 4; ++et)
#pragma unroll
            for (int r = 0; r < 4; ++r) acc[et][r] *= xi[r];
    }
    __syncthreads();
#pragma unroll
    for (int et = 0; et < 4; ++et)
#pragma unroll
        for (int u = 0; u < 2; ++u) { const LAS unsigned char* vb = VL + (size_t)(32 * u + 4 * kg + q) * 256 + (64 * eh + 16 * et + 4 * p_) * 2;
            const s16x4 b0 = vtr(vb), b1 = vtr(vb + 16 * 256); acc[et] = MFMA16(pa[u], CAT8(b0, b1), acc[et]); }
    float ss[4];
#pragma unroll
    for (int r = 0; r < 4; ++r) { float s = 0.f;
#pragma unroll
        for (int et = 0; et < 4; ++et) s += acc[et][r] * acc[et][r];
        s = xadd<1>(s); s = xadd<2>(s); s = xadd<4>(s); s = xadd<8>(s); ss[r] = s; }
    if (l15 == 0) {
#pragma unroll
        for (int r = 0; r < 4; ++r) red[eh * 64 + 16 * it + 4 * kg + r] = ss[r]; }
    __syncthreads();
#pragma unroll
    for (int r = 0; r < 4; ++r) { const int il = 16 * it + 4 * kg + r; const float rstd = __builtin_amdgcn_rsqf((red[il] + red[64 + il]) * (1.0f / 128.0f) + EPS);
#pragma unroll
        for (int et = 0; et < 4; ++et) { const int e = 64 * eh + 16 * et + l15; const float o = acc[et][r] * rstd * gn[et] * bf2f(*(const LAS bf16*)(SGL + il * 256 + e * 2)); *(LAS bf16*)(YL + il * 256 + e * 2) = (bf16)f2bf(o); } }
    __syncthreads();
#pragma unroll
    for (int i = 0; i < 2; ++i) { const int idx = tid + 512 * i; if (c > 0 || (idx >> 4) < NMETA) *(GAS v4u*)(Y + (size_t)(idx >> 4) * DM + (idx & 15) * 8) = *(const LAS v4u*)(YL + (idx >> 4) * 256 + (idx & 15) * 16); }
    asm volatile("s_waitcnt lgkmcnt(0)" ::: "memory"); __builtin_amdgcn_s_barrier(); asm volatile("" ::: "memory");
}

__device__ __forceinline__ void ret_out4_unit(Frame& F, int unit, const float* gain) {
    const int g = unit & 7, h = (unit >> 3) & 3, b = unit >> 5;
    int tid_ = threadIdx.x; asm volatile("" : "+v"(tid_));
    const int tid = tid_, lane = tid & 63, w = __builtin_amdgcn_readfirstlane(tid >> 6), l15 = lane & 15, kg = lane >> 4, q = l15 >> 2, p_ = l15 & 3, ci = w >> 1, hf = w & 1;
    const float lg = log2_gamma(h);
    const size_t r0 = (size_t)b * SEQ + 256 * g;
    const bf16* rq = (const bf16*)(F.ws + WS_R + R_RQ) + (r0 + 64 * ci) * 512 + h * 128;
    const bf16* rk = (const bf16*)(F.ws + WS_R + R_RK) + (r0 + 64 * ci) * 512 + h * 128;
    const bf16* rv = (const bf16*)(F.ws + WS_R + R_RV) + r0 * 512 + h * 128;
    const bf16* sg = (const bf16*)(F.ws + WS_R + R_SG) + r0 * 512 + h * 128;
    const bf16* ST = (const bf16*)(F.ws + WS_R + R_ST) + (size_t)((b * 4 + h) * NCH + 1 + 4 * g + ci) * 16384;
    bf16* Y = (bf16*)(F.ws + WS_R + R_Y) + r0 * DM + h * 128;
    LAS unsigned char* VL = F.lds; LAS unsigned char* SGL = F.lds + 65536;
#pragma unroll
    for (int i = 0; i < 8; ++i) { const int pc = 8 * w + i; const size_t go = (size_t)(4 * pc + (lane >> 4)) * 512 + (lane & 15) * 8;
        __builtin_amdgcn_global_load_lds((const GAS unsigned*)(rv + go), (LAS unsigned*)(VL + pc * 1024), 16, 0, 0);
        __builtin_amdgcn_global_load_lds((const GAS unsigned*)(sg + go), (LAS unsigned*)(SGL + pc * 1024), 16, 0, 0); }
    float gn[8];
#pragma unroll
    for (int et = 0; et < 8; ++et) gn[et] = gain[h * 128 + 16 * et + l15];
    bf16x8 qf[2][4];
#pragma unroll
    for (int rt = 0; rt < 2; ++rt)
#pragma unroll
        for (int ks = 0; ks < 4; ++ks) qf[rt][ks] = *(const GAS bf16x8*)(rq + (size_t)(16 * (2 * hf + rt) + l15) * 512 + 32 * ks + 8 * kg);
    af4 acc[2][8];
    { bf16x8 sf[8][4];
#pragma unroll
      for (int et = 0; et < 8; ++et)
#pragma unroll
          for (int ks = 0; ks < 4; ++ks) sf[et][ks] = *(const GAS bf16x8*)(ST + (size_t)((et * 8 + 2 * ks + (kg >> 1)) * 256 + l15 * 16 + 8 * (kg & 1)));
      asm volatile("" ::: "memory");
#pragma unroll
      for (int et = 0; et < 8; ++et) { acc[0][et] = (af4){0.f, 0.f, 0.f, 0.f}; acc[1][et] = acc[0][et];
#pragma unroll
          for (int ks = 0; ks < 4; ++ks) { acc[0][et] = MFMA16(qf[0][ks], sf[et][ks], acc[0][et]); acc[1][et] = MFMA16(qf[1][ks], sf[et][ks], acc[1][et]); } } }
#pragma unroll
    for (int rt = 0; rt < 2; ++rt) { float xi[4];
#pragma unroll
        for (int r = 0; r < 4; ++r) xi[r] = __builtin_amdgcn_exp2f(lg * (float)(16 * (2 * hf + rt) + 4 * kg + r + 1));
#pragma unroll
        for (int et = 0; et < 8; ++et)
#pragma unroll
            for (int r = 0; r < 4; ++r) acc[rt][et][r] *= xi[r]; }
    af4 pj[2][4];
    { bf16x8 kf[4][4];
#pragma unroll
      for (int jt = 0; jt < 4; ++jt)
#pragma unroll
          for (int ks = 0; ks < 4; ++ks) kf[jt][ks] = *(const GAS bf16x8*)(rk + (size_t)(16 * jt + l15) * 512 + 32 * ks + 8 * kg);
      asm volatile("" ::: "memory");
#pragma unroll
      for (int jt = 0; jt < 4; ++jt) { pj[0][jt] = (af4){0.f, 0.f, 0.f, 0.f}; pj[1][jt] = pj[0][jt];
#pragma unroll
          for (int ks = 0; ks < 4; ++ks) { pj[0][jt] = MFMA16(kf[jt][ks], qf[0][ks], pj[0][jt]); pj[1][jt] = MFMA16(kf[jt][ks], qf[1][ks], pj[1][jt]); } } }
    bf16x8 pa[2][2];
#pragma unroll
    for (int rt = 0; rt < 2; ++rt) { const int il = 16 * (2 * hf + rt) + l15; unsigned pw[4][2];
#pragma unroll
        for (int jt = 0; jt < 4; ++jt) { float v[4];
#pragma unroll
            for (int r = 0; r < 4; ++r) { const int jl = 16 * jt + 4 * kg + r; const int dd = il > jl ? il - jl : jl - il; v[r] = pj[rt][jt][r] * __builtin_amdgcn_exp2f(lg * (float)dd); }
            pw[jt][0] = pk2(v[0], v[1]); pw[jt][1] = pk2(v[2], v[3]); }
        pa[rt][0] = __builtin_bit_cast(bf16x8, (v4u){pw[0][0], pw[0][1], pw[1][0], pw[1][1]}); pa[rt][1] = __builtin_bit_cast(bf16x8, (v4u){pw[2][0], pw[2][1], pw[3][0], pw[3][1]}); }
    asm volatile("s_waitcnt vmcnt(0)" ::: "memory");
    __syncthreads();
#pragma unroll
    for (int et = 0; et < 8; ++et)
#pragma unroll
        for (int u = 0; u < 2; ++u) { const LAS unsigned char* vb = VL + (size_t)(64 * ci + 32 * u + 4 * kg + q) * 256 + (16 * et + 4 * p_) * 2;
            const s16x4 b0 = vtr(vb), b1 = vtr(vb + 16 * 256); const bf16x8 vf = CAT8(b0, b1); acc[0][et] = MFMA16(pa[0][u], vf, acc[0][et]); acc[1][et] = MFMA16(pa[1][u], vf, acc[1][et]); }
    float rstd[2][4];
#pragma unroll
    for (int rt = 0; rt < 2; ++rt)
#pragma unroll
        for (int r = 0; r < 4; ++r) { float s = 0.f;
#pragma unroll
            for (int et = 0; et < 8; ++et) s += acc[rt][et][r] * acc[rt][et][r];
            s = xadd<1>(s); s = xadd<2>(s); s = xadd<4>(s); s = xadd<8>(s); rstd[rt][r] = __builtin_amdgcn_rsqf(s * (1.0f / 128.0f) + EPS); }
    __syncthreads();
#pragma unroll
    for (int rt = 0; rt < 2; ++rt)
#pragma unroll
        for (int r = 0; r < 4; ++r) { const int row = 64 * ci + 16 * (2 * hf + rt) + 4 * kg + r;
#pragma unroll
            for (int et = 0; et < 8; ++et) { const int e = 16 * et + l15; const float o = acc[rt][et][r] * rstd[rt][r] * gn[et] * bf2f(*(const LAS bf16*)(SGL + row * 256 + e * 2)); *(LAS bf16*)(VL + row * 256 + e * 2) = (bf16)f2bf(o); } }
    __syncthreads();
#pragma unroll
    for (int i = 0; i < 8; ++i) { const int idx = tid + 512 * i; *(GAS v4u*)(Y + (size_t)(idx >> 4) * DM + (idx & 15) * 8) = *(const LAS v4u*)(VL + (idx >> 4) * 256 + (idx & 15) * 16); }
    asm volatile("s_waitcnt lgkmcnt(0)" ::: "memory"); __builtin_amdgcn_s_barrier(); asm volatile("" ::: "memory");
}

#define KSWZ(row, colB) ((row) * 256 + ((colB) ^ (((row) & 7) << 4)))
#define KPSWZ(row, colB) ((row) * 128 + ((colB) ^ (((row) & 7) << 4)))
#define SBAR() __builtin_amdgcn_sched_barrier(0)
__device__ __forceinline__ int crow(int r, int hi) { return (r & 3) + 8 * (r >> 2) + 4 * hi; }
__device__ __forceinline__ int v_st(int k, int c) { const int kk = (k & ~0xC) | ((k & 4) << 1) | ((k & 8) >> 1); return ((kk >> 3) * 4 + (c >> 5)) * 512 + ((kk & 7) * 32 + (c & 31)) * 2; }
__device__ __forceinline__ int v_rd_base(int lane) { return ((lane & 3) << 3) | (((lane >> 2) & 3) << 6) | (((lane >> 4) & 1) << 5) | (((lane >> 5) & 1) << 8); }
constexpr int v_rd_off(int d0, int ks, int half) { return d0 * 512 + ks * 4096 + half * 2048; }
template <int OFF> __device__ __forceinline__ s16x4 tr_read(int vb) { s16x4 r; asm volatile("ds_read_b64_tr_b16 %0, %1 offset:%2" : "=&v"(r) : "v"(vb), "i"(OFF) : "memory"); return r; }
template <int D0> __device__ __forceinline__ void pv_one(f32x16& od, int vb, bf16x8 pa0, bf16x8 pa1, bf16x8 pa2, bf16x8 pa3) {
    const s16x4 l0 = tr_read<v_rd_off(D0, 0, 0)>(vb), h0 = tr_read<v_rd_off(D0, 0, 1)>(vb), l1 = tr_read<v_rd_off(D0, 1, 0)>(vb), h1 = tr_read<v_rd_off(D0, 1, 1)>(vb);
    const s16x4 l2 = tr_read<v_rd_off(D0, 2, 0)>(vb), h2 = tr_read<v_rd_off(D0, 2, 1)>(vb), l3 = tr_read<v_rd_off(D0, 3, 0)>(vb), h3 = tr_read<v_rd_off(D0, 3, 1)>(vb);
    asm volatile("s_waitcnt lgkmcnt(0)" ::: "memory"); SBAR();
    od = __builtin_amdgcn_mfma_f32_32x32x16_bf16(pa0, CAT8(l0, h0), od, 0, 0, 0);
    od = __builtin_amdgcn_mfma_f32_32x32x16_bf16(pa1, CAT8(l1, h1), od, 0, 0, 0);
    od = __builtin_amdgcn_mfma_f32_32x32x16_bf16(pa2, CAT8(l2, h2), od, 0, 0, 0);
    od = __builtin_amdgcn_mfma_f32_32x32x16_bf16(pa3, CAT8(l3, h3), od, 0, 0, 0);
}
__device__ __forceinline__ void attn_unit(Frame& F, int b, int h, int j, const float* gain, char* lds) {
    int tid_ = threadIdx.x; asm volatile("" : "+v"(tid_));
    const int tid = tid_, wid = __builtin_amdgcn_readfirstlane(tid >> 6), lane = tid & 63, r32 = lane & 31, hi = lane >> 5;
    const unsigned char* Rb = F.ws + WS_R;
    const bf16* QN = (const bf16*)(Rb + R_QN); const bf16* QPE = (const bf16*)(Rb + R_QPE); const bf16* KN = (const bf16*)(Rb + R_KN) + h * 128; const bf16* VV = (const bf16*)(Rb + R_V) + h * 128; const bf16* KPE = (const bf16*)(Rb + R_KPE);
    char* V_lds = lds; char* K_lds = lds + 32768; char* KP_lds = lds + 65536; float* wsf = (float*)(lds + 81920) + wid * 64; float* li_l = wsf; float* al_l = wsf + 32;
    const size_t qbase = j < 0 ? (size_t)NMAIN : (size_t)b * SEQ + 256 * j; const size_t rowq = qbase + wid * 32 + r32;
    bf16x8 qr[12];
#pragma unroll
    for (int d0 = 0; d0 < 8; ++d0) qr[d0] = *(const GAS bf16x8*)(QN + rowq * 512 + h * 128 + d0 * 16 + hi * 8);
#pragma unroll
    for (int d0 = 0; d0 < 4; ++d0) qr[8 + d0] = *(const GAS bf16x8*)(QPE + rowq * 256 + h * 64 + d0 * 16 + hi * 8);
    const int NT = j < 0 ? 1 : 4 * j + 5, my_last = j < 0 ? 0 : 1 + 4 * j + (wid >> 1);
    const int vb0 = (int)(uintptr_t)V_lds + v_rd_base(lane);
    const int k_row = (lane >> 4), k_cb = ((lane & 15) * 16) ^ 0;
    const int kp_row = (lane >> 3), kp_cb = (lane & 7) * 16;
    const int v_kklo = (lane & 31) >> 2, v_cin = (lane & 3) * 8, v_sub = lane >> 5;
    const GAS unsigned char* zsrc = (const GAS unsigned char*)(F.ws + WS_CTL + 512);
#define A_DMA(t, bf) do { const size_t kr = (t) == 0 ? (size_t)NMAIN : (size_t)b * SEQ + 64 * ((t) - 1); const bool meta_ = (t) == 0; \
        _Pragma("unroll") for (int i_ = 0; i_ < 2; ++i_) { const int pc = 2 * wid + i_; \
            { const int row = 4 * pc + k_row, cb = k_cb ^ ((row & 7) << 4); const GAS unsigned char* src = (const GAS unsigned char*)(KN + (kr + row) * 512) + cb; if (meta_ && row >= NMETA) src = zsrc; \
              __builtin_amdgcn_global_load_lds((const GAS unsigned*)src, (LAS unsigned*)(F.lds + 32768 + (bf) * 16384 + pc * 1024), 16, 0, 0); } \
            { const int sub = 2 * pc + v_sub, kk = (sub >> 2) * 8 + v_kklo, k = (kk & ~0xC) | ((kk & 4) << 1) | ((kk & 8) >> 1), c = (sub & 3) * 32 + v_cin; \
              const GAS unsigned char* src = (const GAS unsigned char*)(VV + (kr + k) * 512 + c); if (meta_ && k >= NMETA) src = zsrc; \
              __builtin_amdgcn_global_load_lds((const GAS unsigned*)src, (LAS unsigned*)(F.lds + (bf) * 16384 + pc * 1024), 16, 0, 0); } } \
        { const int row = 8 * wid + kp_row, cb = kp_cb ^ ((row & 7) << 4); const GAS unsigned char* src = (const GAS unsigned char*)(KPE + (kr + row) * 64) + cb; if (meta_ && row >= NMETA) src = zsrc; \
          __builtin_amdgcn_global_load_lds((const GAS unsigned*)src, (LAS unsigned*)(F.lds + 65536 + (bf) * 8192 + wid * 1024), 16, 0, 0); } } while (0)
    float m_reg = -1e30f, l_reg = 0.f; f32x16 o[4];
#pragma unroll
    for (int d = 0; d < 4; ++d)
#pragma unroll
        for (int r = 0; r < 16; ++r) o[d][r] = 0.f;
    A_DMA(0, 0); asm volatile("s_waitcnt vmcnt(0)" ::: "memory"); __syncthreads();
    for (int t = 0; t < NT; ++t) {
        if (t + 1 < NT) A_DMA(t + 1, (t + 1) & 1);
        if (t <= my_last) {
            const char* Kt = K_lds + (t & 1) * 16384; const char* KPt = KP_lds + (t & 1) * 8192;
            f32x16 p0v, p1v;
#pragma unroll
            for (int r = 0; r < 16; ++r) { p0v[r] = 0.f; p1v[r] = 0.f; }
#define A_KLD(d0, B0, B1) do { if ((d0) < 8) { const int cb_ = ((d0) * 16 + hi * 8) * 2; B0 = *(const bf16x8*)(Kt + KSWZ(r32, cb_)); B1 = *(const bf16x8*)(Kt + KSWZ(32 + r32, cb_)); } \
                                else { const int cb_ = (((d0) - 8) * 16 + hi * 8) * 2; B0 = *(const bf16x8*)(KPt + KPSWZ(r32, cb_)); B1 = *(const bf16x8*)(KPt + KPSWZ(32 + r32, cb_)); } } while (0)
            { bf16x8 ka[3], kb[3];
              __builtin_amdgcn_s_setprio(1);
              A_KLD(0, ka[0], kb[0]); A_KLD(1, ka[1], kb[1]); SBAR();
#pragma unroll
              for (int d0 = 0; d0 < 12; ++d0) {
                  if (d0 + 2 < 12) A_KLD(d0 + 2, ka[(d0 + 2) % 3], kb[(d0 + 2) % 3]);
                  SBAR();
                  p0v = __builtin_amdgcn_mfma_f32_32x32x16_bf16(ka[d0 % 3], qr[d0], p0v, 0, 0, 0); p1v = __builtin_amdgcn_mfma_f32_32x32x16_bf16(kb[d0 % 3], qr[d0], p1v, 0, 0, 0);
                  SBAR(); } }
              __builtin_amdgcn_s_setprio(0);
#undef A_KLD
            if (t == 0) {
#pragma unroll
                for (int r = 8; r < 16; ++r) p0v[r] = -1e30f;
#pragma unroll
                for (int r = 0; r < 16; ++r) p1v[r] = -1e30f; }
            float pmax = p0v[0];
#pragma unroll
            for (int r = 1; r < 16; ++r) pmax = fmaxf(pmax, p0v[r]);
#pragma unroll
            for (int r = 0; r < 16; ++r) pmax = fmaxf(pmax, p1v[r]);
            { auto rr = __builtin_amdgcn_permlane32_swap(__float_as_uint(pmax), __float_as_uint(pmax), false, false); pmax = fmaxf(__uint_as_float(rr[0]), __uint_as_float(rr[1])); }
            const float mn = fmaxf(m_reg, pmax), alpha = __builtin_amdgcn_exp2f(m_reg - mn); m_reg = mn;
            float ps = 0.f;
#pragma unroll
            for (int r = 0; r < 16; ++r) { p0v[r] = __builtin_amdgcn_exp2f(p0v[r] - mn); p1v[r] = __builtin_amdgcn_exp2f(p1v[r] - mn); ps += p0v[r] + p1v[r]; }
            { auto rr = __builtin_amdgcn_permlane32_swap(__float_as_uint(ps), __float_as_uint(ps), false, false); ps = __uint_as_float(rr[0]) + __uint_as_float(rr[1]); }
            l_reg = l_reg * alpha + ps;
            if (__any(alpha < 1.f)) { if (hi == 0) al_l[r32] = alpha; asm volatile("s_waitcnt lgkmcnt(0)" ::: "memory");
#pragma unroll
                for (int r = 0; r < 16; ++r) { const float a = al_l[crow(r, hi)];
#pragma unroll
                    for (int d = 0; d < 4; ++d) o[d][r] *= a; } }
            bf16x8 pa0, pa1, pa2, pa3;
#define PK4(P, BASE, OUT) do { unsigned a0 = pk2(P[BASE + 0], P[BASE + 1]), a1 = pk2(P[BASE + 2], P[BASE + 3]); \
    unsigned b0_ = pk2(P[BASE + 4], P[BASE + 5]), b1_ = pk2(P[BASE + 6], P[BASE + 7]); \
    auto r0_ = __builtin_amdgcn_permlane32_swap(a0, b0_, false, false); auto r1_ = __builtin_amdgcn_permlane32_swap(a1, b1_, false, false); \
    v4u w_ = {r0_[0], r1_[0], r0_[1], r1_[1]}; OUT = __builtin_bit_cast(bf16x8, w_); } while (0)
            PK4(p0v, 0, pa0); PK4(p0v, 8, pa1); PK4(p1v, 0, pa2); PK4(p1v, 8, pa3);
#undef PK4
            const int vb = vb0 + (t & 1) * 16384;
            __builtin_amdgcn_s_setprio(1);
            pv_one<0>(o[0], vb, pa0, pa1, pa2, pa3); pv_one<1>(o[1], vb, pa0, pa1, pa2, pa3); pv_one<2>(o[2], vb, pa0, pa1, pa2, pa3); pv_one<3>(o[3], vb, pa0, pa1, pa2, pa3);
            __builtin_amdgcn_s_setprio(0);
        }
        asm volatile("s_waitcnt vmcnt(0)" ::: "memory");
        __syncthreads();
    }
    if (hi == 0) li_l[r32] = l_reg; asm volatile("s_waitcnt lgkmcnt(0)" ::: "memory");
    bf16* Y = (bf16*)(F.ws + WS_R + R_Y) + (qbase + wid * 32) * DM + 512 + h * 128;
    float gn[4];
#pragma unroll
    for (int d = 0; d < 4; ++d) gn[d] = gain[h * 128 + 32 * d + r32];
    LAS unsigned char* stg = (LAS unsigned char*)F.lds + wid * 8192;
#pragma unroll
    for (int r = 0; r < 16; ++r) { const int orow = crow(r, hi); const float lr = li_l[orow];
        float s = (o[0][r] * o[0][r] + o[1][r] * o[1][r]) + (o[2][r] * o[2][r] + o[3][r] * o[3][r]);
        s = xadd<1>(s); s = xadd<2>(s); s = xadd<4>(s); s = xadd<8>(s); s = xadd<16>(s);
        const float rstd = __builtin_amdgcn_rsqf(s * (1.0f / 128.0f) + EPS * lr * lr);
#pragma unroll
        for (int d = 0; d < 4; ++d) *(LAS bf16*)(stg + orow * 256 + (32 * d + r32) * 2) = (bf16)f2bf(o[d][r] * rstd * gn[d]); }
    asm volatile("s_waitcnt lgkmcnt(0)" ::: "memory");
#pragma unroll
    for (int i = 0; i < 8; ++i) { const int ch = lane + 64 * i, row = ch >> 4, c16 = ch & 15;
        const v4u val = *(const LAS v4u*)(stg + row * 256 + c16 * 16);
        if (j >= 0 || (wid == 0 && row < NMETA)) *(GAS v4u*)(Y + (size_t)row * DM + c16 * 8) = val; }
    asm volatile("s_waitcnt lgkmcnt(0)" ::: "memory"); __builtin_amdgcn_s_barrier(); asm volatile("" ::: "memory");
#undef A_DMA
}

struct Args { Inputs in; float* out; unsigned char* ws; int phase; int pad; };
constexpr int N_ATT_UNITS = 260, N_RO_UNITS = NB * 4 * 8 + 4;
constexpr int PH_PER_LAYER = 9, N_PHASES = 1 + DEPTH * PH_PER_LAYER + 1;

__global__ void __launch_bounds__(NWAVES * 64, 2) mk_fwd(Args args) {
    extern __shared__ __attribute__((aligned(16))) unsigned char lds[];
    Frame F;
    F.lds = (LAS unsigned char*)lds; F.MISC = (volatile LAS unsigned*)(F.lds + MISC_OFF);
    F.tid = threadIdx.x; F.lane = F.tid & 63; F.wave = __builtin_amdgcn_readfirstlane(F.tid >> 6);
    F.G = gridDim.x; { const int bx = blockIdx.x; F.vcu = (F.G % 8 == 0) ? (bx % 8) * (F.G / 8) + bx / 8 : bx; }
    F.ws = args.ws; F.ctl = (gu32*)(args.ws + WS_CTL);
    for (int u = F.tid; u < (LDS_BYTES - LDSCTL_OFF) / 4; u += NWAVES * 64) ((LAS unsigned*)(F.lds + LDSCTL_OFF))[u] = 0u;
    __syncthreads();
    XcdBarrier bar; bar.bar = (unsigned*)(F.ctl + CW_BAR); bar.x = 0; bar.st = nullptr;
    if (!MK_MULTI) bar = xcd_barrier_post((unsigned*)(F.ctl + CW_BAR), F.MISC + 8);
#define R (F.ws + WS_R)
#define tab ((const float*)(F.ws + WS_TAB))
#define hres ((bf16*)(F.ws + WS_HRES))
#define XN ((const pg8::bf16_t*)(F.ws + WS_XN))
#define cnt ((unsigned*)(F.ctl + CW_CNT) + li * 8)
    int ph = 0;
#ifndef MK_ALIGN
#define MK_ALIGN true
#endif
#ifndef MK_SP2
#define MK_SP2 true
#endif
#ifndef MK_MASK
#define MK_MASK 0xFFFFFFFFu
#endif
#define ON(k) (((MK_MASK) >> (k)) & 1u)
#ifndef MK_STAMP_A
#define MK_STAMP_A (-1)
#define MK_STAMP_B (-1)
#endif
#ifndef MK_ATT_REP
#define MK_ATT_REP 1
#endif
#ifndef MK_RO_REP
#define MK_RO_REP 1
#endif
#ifndef MK_REP_PH
#define MK_REP_PH (-1)
#endif
#ifndef MK_REP_N
#define MK_REP_N 1
#endif
#define RUN() (MK_MULTI ? (ph == args.phase) : true)
#define SEAM() do { if (!MK_MULTI) { asm volatile("" : "+s"(bar.x)); bar.bar = (unsigned*)(F.ctl + CW_BAR); xcd_barrier(bar); } if (MK_STAMP_A >= 0 && blockIdx.x == 0 && F.tid == 0) ((unsigned long long*)(F.ws + WS_CTL + 1572864))[ph] = __builtin_amdgcn_s_memrealtime();   ++ph; int z_ = 0; F.tid = threadIdx.x; asm volatile("" : "+v"(F.tid), "+s"(z_));     F.lane = F.tid & 63; F.wave = __builtin_amdgcn_readfirstlane(F.tid >> 6); F.ws = args.ws + z_; F.ctl = (gu32*)(F.ws + WS_CTL); } while (0)
#define REPS(k) _Pragma("unroll 1") for (int rep_ = 0; rep_ < ((k) == MK_REP_PH ? MK_REP_N : 1); ++rep_, ((rep_ < ((k) == MK_REP_PH ? MK_REP_N : 1)) ? ({ SEAM(); --ph; 0; }) : 0))

    if (MK_STAMP_A >= 0 && blockIdx.x == 0 && F.tid == 0) ((unsigned long long*)(F.ws + WS_CTL + 1572864))[63] = __builtin_amdgcn_s_memrealtime();
    REPS(0) if (ON(0) && RUN()) p0_prologue(F);
#if defined(MK_PROBE_GEMM)
    {
        pg8::Gemm g{XN, (const pg8::bf16_t*)(F.ws + WS_WDGU), NMAIN, 2 * FF, DM / 2, 0};
        pg8::StaticOrder S; S.init(NMAIN, 2 * FF, F.G, (int)blockIdx.x);
#if MK_PROBE_GEMM == 1
        EpiSwiGLU E{(bf16*)(R + R_ACT)}; E.rs = (const float*)(F.ws + WS_TAB);
        pg8::gemm_phase<EpiSwiGLU, pg8::StaticOrder, MK_ALIGN, MK_SP2, true>(F.lds, g, S, E);
#else
        EpiNone E{};
        pg8::gemm_phase<EpiNone, pg8::StaticOrder, MK_ALIGN, MK_SP2, true>(F.lds, g, S, E);
#endif
        if (!MK_MULTI) { asm volatile("" : "+s"(bar.x)); bar.bar = (unsigned*)(F.ctl + CW_BAR); xcd_barrier(bar); }
    }
#endif
#pragma unroll 1
    for (int l = 0; l < DEPTH; ++l) {
        const bool moe = (l & 1) != 0; const int li = l >> 1;
        REPS(1) if (ON(1) && RUN() && l > 0) norm_phase(F, l == 2 && rep_ == 0, (const unsigned*)(F.ctl + CW_CNT), true);
        SEAM();
        REPS(2) if (ON(2) && RUN()) {
            pg8::Gemm g{XN, (const pg8::bf16_t*)(F.ws + WS_WIN + (size_t)l * DINP * DM), NMAIN, DINP - 512, DM / 2, 0};
            pg8::StaticOrder S; S.init(NMAIN, DINP - 512, F.G, (int)blockIdx.x);
            EpiInProj E{R, (float*)(F.ws + CTL_SSQ), (float*)(F.ws + CTL_SSKV), tab, log2_gamma(0), log2_gamma(1), log2_gamma(2), log2_gamma(3), 0}; E.rs = (const float*)(F.ws + WS_RS);
            meta_gemm<EpiInProj, 1>(F, F.ws + WS_XN + (size_t)NMAIN * DM, g.Bt, DINP, DM, E);
            pg8::gemm_phase<EpiInProj, pg8::StaticOrder, MK_ALIGN, MK_SP2, 1>(F.lds, g, S, E);
        }
        SEAM();
        REPS(3) if (ON(3) && RUN()) {
            const int c_ = (int)blockIdx.x, hG = F.G >> 1;
            {
                pg8::Gemm g{XN, (const pg8::bf16_t*)(F.ws + WS_WIN + (size_t)l * DINP * DM + (size_t)(DINP - 512) * DM), NMAIN, 512, DM / 2, 0};
                pg8::StaticOrder S; S.init(NMAIN, 512, F.G, c_);
                if (F.G == 256) { if (c_ >= 64 && c_ < 192) S.window(0, 128, c_ - 64, 128); else S.window(128, 128, 0, 128); }
                EpiGate E{R + R_SG}; E.rs = (const float*)(F.ws + WS_RS);
                pg8::gemm_phase<EpiGate, pg8::StaticOrder, MK_ALIGN, MK_SP2, 1>(F.lds, g, S, E);
            }
            pg8::Gemm g{(const pg8::bf16_t*)(R + R_LAT), (const pg8::bf16_t*)(F.ws + WS_WUP) + (size_t)l * UPN * UPK, NMAIN, UPN, UPK, 0};
            pg8::StaticOrder S; S.init(NMAIN, UPN, F.G, c_);
            S.pnsplit = 3; S.nt_lo = 4; S.koff_hi = 512u; S.nt_hi = 2;
            if (F.G == 256) { if (c_ >= 192) S.window(256, 64, c_ - 192, 448); else if (c_ >= 64) S.window(0, 128, c_ - 64, 256); else S.window(448, hG, 0, 448); }
            EpiUp E{R, (const float*)(F.ws + CTL_SSQ), (const float*)(F.ws + CTL_SSKV), tab};
            meta_gemm<EpiUp>(F, g.A + (size_t)NMAIN * UPK, g.Bt, UPN, UPK * 2, E);
            pg8::gemm_phase<EpiUp, pg8::StaticOrder, MK_ALIGN, MK_SP2>(F.lds, g, S, E);
            if (ON(4)) { if (F.G == 256) { if (c_ < 64) ret_state64_unit(F, c_); } else for (int u = c_; u < NB * 4 * 2; u += F.G) ret_state64_unit(F, u); }
        }
        SEAM();
        REPS(5) if (RUN()) {
            gu32* qh = F.ctl + CW_QUEUE + 64 * l + 8 * rep_;
            bool first_ = true;
            for (;;) {
                if (F.tid == 0) F.MISC[16] = first_ ? (F.G == 256 ? (unsigned)(((F.vcu & 31) >> 2) * 32 + 4 * (F.vcu >> 5) + (F.vcu & 3)) : (unsigned)F.vcu) : (unsigned)F.G + __hip_atomic_fetch_add(qh, 1u, RLX_AGENT);
                first_ = false;
                asm volatile("s_waitcnt lgkmcnt(0)" ::: "memory"); __builtin_amdgcn_s_barrier(); asm volatile("" ::: "memory"); const int u = (int)F.MISC[16]; asm volatile("s_waitcnt lgkmcnt(0)" ::: "memory"); __builtin_amdgcn_s_barrier(); asm volatile("" ::: "memory");
                if (u >= N_ATT_UNITS + N_RO_UNITS) break;
                const bool is_ro = u >= 192 && u < 192 + N_RO_UNITS;
                if (!is_ro) { if (ON(5)) { const int v = u < 192 ? u : u - N_RO_UNITS; const int j = v < 256 ? 7 - (v >> 5) : -1, bh = v < 256 ? (v & 31) : (v - 256); attn_unit(F, bh >> 2, bh & 3, j, ldin(I_MLAG) + l * 512, (char*)lds); } }
                else if (ON(6)) { const int v = u - 192; if (v < NB * 4 * 8) ret_out4_unit(F, v, ldin(I_RETG) + l * 512); else ret_out_unit(F, NB * 4 * 32 + (v - NB * 4 * 8), ldin(I_RETG) + l * 512); }
            }
        }
        SEAM();
        REPS(7) if (ON(7) && RUN()) {
            pg8::Gemm g{(const pg8::bf16_t*)(R + R_Y), (const pg8::bf16_t*)(F.ws + WS_WOUT) + (size_t)l * DM * DM, NMAIN, DM, DM, 0};
            pg8::StaticOrder S; S.init(NMAIN, DM, F.G, (int)blockIdx.x);
            EpiResid E{rep_ == 0 ? hres : (bf16*)(F.ws + WS_XS), 1.0f};
            meta_gemm<EpiResid>(F, g.A + (size_t)NMAIN * DM, g.Bt, DM, DM * 2, E);
            pg8::gemm_phase<EpiResid, pg8::StaticOrder, MK_ALIGN, MK_SP2>(F.lds, g, S, E);
        }
        SEAM();
        if (!moe) {
            REPS(8) if (ON(8) && RUN()) norm_phase(F, false, nullptr, true);
            SEAM();
            REPS(9) if (ON(9) && RUN()) {
                pg8::Gemm g{XN, (const pg8::bf16_t*)(F.ws + WS_WDGU + (size_t)li * 2 * FF * DM), NMAIN, 2 * FF, DM / 2, 0};
                pg8::StaticOrder S; S.init(NMAIN, 2 * FF, F.G, (int)blockIdx.x);
                EpiSwiGLU E{(bf16*)(R + R_ACT)}; E.rs = (const float*)(F.ws + WS_RS); E.f8 = 1;
                meta_gemm<EpiSwiGLU, true>(F, F.ws + WS_XN + (size_t)NMAIN * DM, g.Bt, 2 * FF, DM, E);
                pg8::gemm_phase<EpiSwiGLU, pg8::StaticOrder, MK_ALIGN, MK_SP2, true>(F.lds, g, S, E);
            }
            SEAM();
            REPS(10) if (ON(10) && RUN()) {
                pg8::Gemm g{(const pg8::bf16_t*)(R + R_ACT), (const pg8::bf16_t*)(F.ws + WS_WDD + (size_t)li * DM * FF), NMAIN, DM, FF / 2, 0};
                pg8::StaticOrder S; S.init(NMAIN, DM, F.G, (int)blockIdx.x);
                EpiResid E{rep_ == 0 ? hres : (bf16*)(F.ws + WS_XS), 1.0f / (S_A8 * S_WD8)};
                meta_gemm<EpiResid, 2>(F, R + R_ACT + (size_t)NMAIN * FF, g.Bt, DM, FF, E);
                pg8::gemm_phase<EpiResid, pg8::StaticOrder, MK_ALIGN, MK_SP2, 2>(F.lds, g, S, E);
            }
            SEAM();
            ++ph;
        } else {
            if (ON(11) && RUN()) route_phase(F, ldin(I_FFNNORM) + l * DM, ldin(I_ROUTER) + (size_t)li * DM * NEXP, cnt);
            SEAM();
            REPS(12) if (ON(12) && RUN()) gather_phase(F, cnt);
            SEAM();
            REPS(13) if (ON(13) && RUN()) {
                pg8::Gemm g{(const pg8::bf16_t*)(F.ws + WS_XS), (const pg8::bf16_t*)(F.ws + WS_WMGU + (size_t)li * NEXP * 2 * FF * DM), XS_ROWS, 2 * FF, DM / 2, (size_t)2 * FF * DM};
                pg8::GroupedOrder S; S.init(cnt, 2 * FF, F.G, (int)blockIdx.x);
                EpiSwiGLU E{(bf16*)(R + R_ACT)}; E.rs = (const float*)(F.ws + WS_RSS); E.f8 = 1;
                pg8::gemm_phase<EpiSwiGLU, pg8::GroupedOrder, MK_ALIGN, MK_SP2, true>(F.lds, g, S, E);
                { const int b0 = li == 0 ? N_DEFER_R : I_MGU / 2;
                  for (int d = b0 + F.vcu * NWAVES + F.wave; d < b0 + N_DEFER_G; d += F.G * NWAVES) convert_item(F, defer_item(d), F.lane); }
            }
            SEAM();
            REPS(14) if (ON(14) && RUN()) {
                pg8::Gemm g{(const pg8::bf16_t*)(R + R_ACT), (const pg8::bf16_t*)(F.ws + WS_WMD + (size_t)li * NEXP * DM * FF), XS_ROWS, DM, FF / 2, (size_t)DM * FF};
                { asm volatile("" ::: "memory"); pg8::GroupedOrder S; S.init(cnt, DM, F.G, (int)blockIdx.x, 0, MOE_FULL_TILES);
                  EpiMoeDown E{(bf16*)(F.ws + WS_YS), 1.0f / (S_A8 * S_WD8)};
                  pg8::gemm_phase<EpiMoeDown, pg8::GroupedOrder, MK_ALIGN, MK_SP2, 2>(F.lds, g, S, E); }
                { pg8::Gemm g2 = g; g2.K = FF / 2 / MOE_KSPLIT8; g2.ld = FF / 2;
                  asm volatile("" ::: "memory"); pg8::GroupedOrder S; S.init(cnt, DM, F.G, (int)blockIdx.x, MOE_FULL_TILES, 1 << 30, MOE_KSPLIT8, (unsigned)(FF / MOE_KSPLIT8));
                  EpiPartial E{(float*)(F.ws + WS_PART), (unsigned)(FF / MOE_KSPLIT8), MOE_KSPLIT8, 1.0f / (S_A8 * S_WD8)};
                  pg8::gemm_phase<EpiPartial, pg8::GroupedOrder, MK_ALIGN, MK_SP2, 2>(F.lds, g2, S, E); }
                if (li == 0 && (int)blockIdx.x >= 72) { const int NEW = (F.G - 72) * NWAVES;
                    for (int d = ((int)blockIdx.x - 72) * NWAVES + F.wave; d < N_DEFER_R; d += NEW) convert_item(F, defer_item(d), F.lane); }
            }
            SEAM();
        }
    }
    if (ON(15) && RUN()) final_phase(F, ldin(I_FINAL), args.out, (const unsigned*)(F.ctl + CW_CNT) + 8);
    if (MK_STAMP_A >= 0 && blockIdx.x == 0 && F.tid == 0) {
        unsigned long long* st = (unsigned long long*)(F.ws + WS_CTL + 1572864); st[ph] = __builtin_amdgcn_s_memrealtime();
        const unsigned long long d = 8ull * (st[MK_STAMP_B] - st[MK_STAMP_A]), t0 = __builtin_amdgcn_s_memrealtime();
        while (__builtin_amdgcn_s_memrealtime() - t0 < d) __builtin_amdgcn_s_sleep(8);
    }
#undef RUN
#undef SEAM
#undef R
#undef tab
#undef hres
#undef XN
#undef cnt
}

extern "C" void kernel_launch(void* const* d_in, const int* in_sizes, int n_in, void* d_out, int out_size, void* d_ws, size_t ws_size, hipStream_t stream) {
    static int grid = 0;
    if (grid == 0) {
        if (n_in != 20 || in_sizes[0] != NB * SEQ * DM || out_size != NB * SEQ * DM || ws_size < WS_END) {
            fprintf(stderr, "kernel_launch: shape mismatch: n_in %d in0 %d out %d ws %zu (need >= %zu)\n", n_in, n_in > 0 ? in_sizes[0] : -1, out_size, ws_size, (size_t)WS_END); grid = -1; return; }
        int dev = 0, cus = 0, per_cu = 0;
        if (hipGetDevice(&dev) != hipSuccess || hipDeviceGetAttribute(&cus, hipDeviceAttributeMultiprocessorCount, dev) != hipSuccess) { grid = -1; return; }
        if (hipFuncSetAttribute((const void*)mk_fwd, hipFuncAttributeMaxDynamicSharedMemorySize, LDS_BYTES) != hipSuccess) { fprintf(stderr, "kernel_launch: hipFuncSetAttribute failed\n"); grid = -1; return; }
        if (hipOccupancyMaxActiveBlocksPerMultiprocessor(&per_cu, (const void*)mk_fwd, NWAVES * 64, LDS_BYTES) != hipSuccess || per_cu < 1)
            fprintf(stderr, "kernel_launch: occupancy query reports %d workgroups per CU\n", per_cu);
        (void)hipGetLastError();
        grid = cus < 256 ? cus : 256;
    }
    if (grid < 0) return;
    if (hipMemsetAsync((char*)d_ws + WS_CTL, 0, CTL_ZERO_BYTES, stream) != hipSuccess) { fprintf(stderr, "kernel_launch: memset failed\n"); return; }
    Args a{};
    for (int i = 0; i < 20; ++i) a.in.p[i] = (const float*)d_in[i];
    a.out = (float*)d_out; a.ws = (unsigned char*)d_ws; a.phase = 0; a.pad = 0;
#if MK_MULTI
    for (int ph = 0; ph < N_PHASES; ++ph) { a.phase = ph; hipLaunchKernelGGL(mk_fwd, dim3(grid), dim3(NWAVES * 64), LDS_BYTES, stream, a); }
#else
    hipLaunchKernelGGL(mk_fwd, dim3(grid), dim3(NWAVES * 64), LDS_BYTES, stream, a);
#endif
    const hipError_t le = hipPeekAtLastError();
    if (le != hipSuccess) fprintf(stderr, "kernel_launch: launch failed: %s\n", hipGetErrorName(le));
}
```
